# Optimizing an MI355X kernel written in HIP

```python
import math
import jax, jax.numpy as jnp
from jax import lax
import numpy as np

D_MODEL = 1024
BATCH = 8
SEQ = 2048
DEPTH = 1

GRID_W = 64
NA_HEADS = 8
NA_HEAD_DIM = 64
NA_WIN_ROWS = 8
NA_WIN_COLS = 16
NA_WIDTH = NA_HEADS * NA_HEAD_DIM
DN_HEADS = 8
DN_HEAD_DIM = 64
DN_WIDTH = DN_HEADS * DN_HEAD_DIM
DN_CONV = 5
DN_CHUNK = 64
N_GROUPS = 4
EXPERTS_PER_GROUP = 8
N_EXPERTS = N_GROUPS * EXPERTS_PER_GROUP
TOP_K = 2
D_EXPERT = 256
DEEPNORM_ALPHA = (2.0 * DEPTH) ** 0.25
DEEPNORM_BETA = (8.0 * DEPTH) ** -0.25
LN_EPS = 1e-5
RMS_EPS = 1e-6

IN_SPLITS = (NA_WIDTH, NA_WIDTH, NA_WIDTH, DN_WIDTH, DN_WIDTH, DN_WIDTH, DN_WIDTH,
             DN_HEADS, DN_HEADS, DN_HEADS, DN_HEADS, D_MODEL, D_MODEL)
D_IN = sum(IN_SPLITS)
VALUE_SLOTS = (2, 5)

kernel_name = "hybrid_natten_gdn_hiermoe_deepnorm"


def layer_norm(x, g, b):
    xf = x.astype(jnp.float32)
    mu = jnp.mean(xf, -1, keepdims=True)
    var = jnp.mean(jnp.square(xf - mu), -1, keepdims=True)
    return ((xf - mu) * lax.rsqrt(var + LN_EPS) * g + b).astype(x.dtype)


def l2norm(a):
    return a * lax.rsqrt(jnp.sum(a * a, -1, keepdims=True) + RMS_EPS)


def neighborhood_attention(q, k, v, rpb):
    B, T, _ = q.shape
    rows = T // GRID_W
    kr = min(NA_WIN_ROWS, rows)
    to_grid = lambda a: a.reshape(B, rows, GRID_W, NA_HEADS, NA_HEAD_DIM).transpose(0, 3, 1, 2, 4)
    qg, kg, vg = to_grid(q), to_grid(k), to_grid(v)
    r = np.arange(rows)
    row_start = np.clip(r - kr // 2, 0, rows - kr)
    row_idx = row_start[:, None] + np.arange(kr)[None, :]
    dr_idx = row_idx - r[:, None] + (NA_WIN_ROWS - 1)
    c = np.arange(GRID_W)
    col_start = np.clip(c - NA_WIN_COLS // 2, 0, GRID_W - NA_WIN_COLS)
    col_mask = (c[None, :] >= col_start[:, None]) & (c[None, :] < col_start[:, None] + NA_WIN_COLS)
    dc_idx = np.clip(c[None, :] - c[:, None], -(NA_WIN_COLS - 1), NA_WIN_COLS - 1) + (NA_WIN_COLS - 1)
    k_blk = kg[:, :, row_idx]
    v_blk = vg[:, :, row_idx]
    scale = NA_HEAD_DIM ** -0.5
    s = jnp.einsum('bhrcd,bhrjkd->bhrcjk', qg * scale, k_blk).astype(jnp.float32)
    bias = rpb[:, dr_idx[:, None, :, None], dc_idx[None, :, None, :]]
    s = s + bias[None].astype(jnp.float32)
    s = jnp.where(col_mask[:, None, :], s, -1e30)
    p = jax.nn.softmax(s.reshape(B, NA_HEADS, rows, GRID_W, kr * GRID_W), axis=-1)
    p = p.reshape(s.shape).astype(v.dtype)
    o = jnp.einsum('bhrcjk,bhrjkd->bhrcd', p, v_blk)
    return o.transpose(0, 2, 3, 1, 4).reshape(B, T, NA_WIDTH)


def short_conv(x, w):
    y = lax.conv_general_dilated(x, w[:, None, :].astype(x.dtype), window_strides=(1,),
                                 padding=[(DN_CONV // 2, DN_CONV // 2)],
                                 dimension_numbers=('NWC', 'WIO', 'NWC'),
                                 feature_group_count=x.shape[-1])
    return jax.nn.silu(y)


def chunk_gated_delta(q, k, v, beta, g):
    B, H, T, dk = q.shape
    dv = v.shape[-1]
    c = DN_CHUNK
    n = T // c
    q = q * dk ** -0.5
    blk = lambda a: a.reshape(B, H, n, c, *a.shape[3:])
    q, k, v, beta, g = blk(q), blk(k), blk(v), blk(beta), blk(g)
    gc = jnp.cumsum(g, axis=-1)
    incl = np.tril(np.ones((c, c), bool))
    strict = np.tril(np.ones((c, c), bool), -1)
    decay = jnp.exp(jnp.where(incl, gc[..., :, None] - gc[..., None, :], -jnp.inf))
    kb = k * beta[..., None]
    kk = jnp.einsum('bhnid,bhnjd->bhnij', kb, k) * decay
    a_mat = jnp.where(strict, kk, 0.0) + np.eye(c, dtype=np.float32)
    rhs = jnp.concatenate([v * beta[..., None], kb * jnp.exp(gc)[..., None]], axis=-1)
    sol = lax.linalg.triangular_solve(a_mat, rhs, left_side=True, lower=True, unit_diagonal=True)
    u, w = sol[..., :dv], sol[..., dv:]
    intra = jnp.einsum('bhnid,bhnjd->bhnij', q, k) * decay
    q_dec = q * jnp.exp(gc)[..., None]
    g_last = gc[..., -1]
    k_dec = k * jnp.exp(g_last[..., None] - gc)[..., None]

    def step(S, xs):
        qe, ke, u_c, w_c, a_c, gl = xs
        v_new = u_c - jnp.einsum('bhik,bhkv->bhiv', w_c, S)
        o = jnp.einsum('bhik,bhkv->bhiv', qe, S) + jnp.einsum('bhij,bhjv->bhiv', a_c, v_new)
        S = S * jnp.exp(gl)[..., None, None] + jnp.einsum('bhik,bhiv->bhkv', ke, v_new)
        return S, o

    xs = tuple(jnp.moveaxis(a, 2, 0) for a in (q_dec, k_dec, u, w, intra, g_last))
    S0 = jnp.zeros((B, H, dk, dv), jnp.float32)
    _, o = lax.scan(step, S0, xs)
    return jnp.moveaxis(o, 0, 2).reshape(B, H, T, dv)


def gated_deltanet_bidir(q, k, v, z, beta_f, beta_b, a_f, a_b, conv_w,
                         a_log_f, a_log_b, dt_bias_f, dt_bias_b, norm_w):
    B, T, _ = q.shape
    qkv = short_conv(jnp.concatenate([q, k, v], axis=-1), conv_w)
    q, k, v = jnp.split(qkv, 3, axis=-1)
    heads = lambda a: a.reshape(B, T, DN_HEADS, DN_HEAD_DIM).transpose(0, 2, 1, 3).astype(jnp.float32)
    q, k, v, zh = heads(q), heads(k), heads(v), heads(z)
    q, k = l2norm(q), l2norm(k)

    def gates(beta_raw, a_raw, a_log, dt_bias):
        bt = jax.nn.sigmoid(beta_raw.astype(jnp.float32))
        gl = -jnp.exp(a_log.astype(jnp.float32)) * jax.nn.softplus(
            a_raw.astype(jnp.float32) + dt_bias.astype(jnp.float32))
        return bt.transpose(0, 2, 1), gl.transpose(0, 2, 1)

    bf, gf = gates(beta_f, a_f, a_log_f, dt_bias_f)
    bb, gb = gates(beta_b, a_b, a_log_b, dt_bias_b)
    flip = lambda a: jnp.flip(a, axis=2)
    o_fwd = chunk_gated_delta(q, k, v, bf, gf)
    o_bwd = flip(chunk_gated_delta(flip(q), flip(k), flip(v), flip(bb), flip(gb)))
    o = o_fwd + o_bwd
    o = o * lax.rsqrt(jnp.mean(o * o, -1, keepdims=True) + RMS_EPS) * norm_w.astype(jnp.float32)
    o = o * jax.nn.silu(zh)
    return o.transpose(0, 2, 1, 3).reshape(B, T, DN_WIDTH).astype(z.dtype)


def token_mixer(x, w_in, na_rpb, dn_conv_w, dn_a_log_f, dn_a_log_b, dn_dt_bias_f, dn_dt_bias_b,
                dn_norm_w, w_proj_na, w_proj_dn, w_out):
    h = jnp.einsum('btd,de->bte', x, w_in)
    offs = np.cumsum(IN_SPLITS)[:-1].tolist()
    (q_na, k_na, v_na, q_dn, k_dn, v_dn, z_dn, b_f, b_b, a_f, a_b,
     gate_na, gate_dn) = jnp.split(h, offs, axis=-1)
    y_na = neighborhood_attention(q_na, k_na, v_na, na_rpb) @ w_proj_na
    y_dn = gated_deltanet_bidir(q_dn, k_dn, v_dn, z_dn, b_f, b_b, a_f, a_b, dn_conv_w,
                                dn_a_log_f, dn_a_log_b, dn_dt_bias_f, dn_dt_bias_b, dn_norm_w) @ w_proj_dn
    merged = jax.nn.sigmoid(gate_na) * y_na + jax.nn.sigmoid(gate_dn) * y_dn
    return merged @ w_out


def hierarchical_moe(x, w_router_group, b_router_group, w_router_expert, b_router_expert,
                     w_expert_gate_up, w_expert_down):
    B, T, D = x.shape
    N = B * T
    xt = x.reshape(N, D)
    group_logits = (xt @ w_router_group + b_router_group).astype(jnp.float32)
    group_p, group_idx = lax.top_k(jax.nn.softmax(group_logits, axis=-1), 1)
    expert_logits = (xt @ w_router_expert + b_router_expert).astype(jnp.float32)
    expert_logits = expert_logits.reshape(N, N_GROUPS, EXPERTS_PER_GROUP)
    sel = jnp.take_along_axis(expert_logits, group_idx[:, :, None], axis=1)[:, 0]
    top_l, top_i = lax.top_k(sel, TOP_K)
    top_p = jax.nn.softmax(top_l, axis=-1) * group_p
    expert_id = group_idx * EXPERTS_PER_GROUP + top_i
    combine = jnp.sum(jax.nn.one_hot(expert_id, N_EXPERTS, dtype=jnp.float32) * top_p[..., None], axis=1)
    hgu = jnp.einsum('nd,edf->nef', xt, w_expert_gate_up)
    hg, hu = jnp.split(hgu, 2, axis=-1)
    hid = jax.nn.silu(hg) * hu * combine[:, :, None].astype(x.dtype)
    y = jnp.einsum('nef,efd->nd', hid, w_expert_down)
    return y.reshape(B, T, D)


def setup_inputs(seed: int = 0) -> dict:
    key = jax.random.key(seed)
    ks = jax.random.split(key, 24)
    nrm = lambda k, shape, s: jax.random.normal(k, shape, jnp.float32) * s
    col_scale = jnp.concatenate([
        jnp.full((w,), DEEPNORM_BETA if i in VALUE_SLOTS else 1.0, jnp.float32)
        for i, w in enumerate(IN_SPLITS)])
    x = nrm(ks[0], (BATCH, SEQ, D_MODEL), 1.0)
    w_in = nrm(ks[1], (DEPTH, D_MODEL, D_IN), D_MODEL ** -0.5) * col_scale
    na_rpb = nrm(ks[2], (DEPTH, NA_HEADS, 2 * NA_WIN_ROWS - 1, 2 * NA_WIN_COLS - 1), 0.5)
    dn_conv_w = nrm(ks[3], (DEPTH, DN_CONV, 3 * DN_WIDTH), DN_CONV ** -0.5)
    dn_a_log_f = jnp.log(jax.random.uniform(ks[4], (DEPTH, DN_HEADS), jnp.float32, 1.0, 16.0))
    dn_a_log_b = jnp.log(jax.random.uniform(ks[5], (DEPTH, DN_HEADS), jnp.float32, 1.0, 16.0))

    def dt_bias(k):
        u = jax.random.uniform(k, (DEPTH, DN_HEADS), jnp.float32)
        dt = jnp.exp(u * (math.log(0.1) - math.log(0.001)) + math.log(0.001))
        return dt + jnp.log(-jnp.expm1(-dt))

    dn_dt_bias_f = dt_bias(ks[6])
    dn_dt_bias_b = dt_bias(ks[7])
    dn_norm_w = 1.0 + nrm(ks[8], (DEPTH, DN_HEAD_DIM), 0.02)
    w_proj_na = nrm(ks[9], (DEPTH, NA_WIDTH, D_MODEL), NA_WIDTH ** -0.5 * DEEPNORM_BETA)
    w_proj_dn = nrm(ks[10], (DEPTH, DN_WIDTH, D_MODEL), DN_WIDTH ** -0.5 * DEEPNORM_BETA)
    w_out = nrm(ks[11], (DEPTH, D_MODEL, D_MODEL), D_MODEL ** -0.5 * DEEPNORM_BETA)
    ln1_g = 1.0 + nrm(ks[12], (DEPTH, D_MODEL), 0.02)
    ln1_b = nrm(ks[13], (DEPTH, D_MODEL), 0.02)
    w_router_group = nrm(ks[14], (DEPTH, D_MODEL, N_GROUPS), D_MODEL ** -0.5)
    b_router_group = nrm(ks[15], (DEPTH, N_GROUPS), 0.01)
    w_router_expert = nrm(ks[16], (DEPTH, D_MODEL, N_EXPERTS), D_MODEL ** -0.5)
    b_router_expert = nrm(ks[17], (DEPTH, N_EXPERTS), 0.01)
    w_expert_gate_up = nrm(ks[18], (DEPTH, N_EXPERTS, D_MODEL, 2 * D_EXPERT), D_MODEL ** -0.5)
    w_expert_down = nrm(ks[19], (DEPTH, N_EXPERTS, D_EXPERT, D_MODEL), D_EXPERT ** -0.5 * DEEPNORM_BETA)
    ln2_g = 1.0 + nrm(ks[20], (DEPTH, D_MODEL), 0.02)
    ln2_b = nrm(ks[21], (DEPTH, D_MODEL), 0.02)
    return {"x": x, "w_in": w_in, "na_rpb": na_rpb, "dn_conv_w": dn_conv_w,
            "dn_a_log_f": dn_a_log_f, "dn_a_log_b": dn_a_log_b,
            "dn_dt_bias_f": dn_dt_bias_f, "dn_dt_bias_b": dn_dt_bias_b, "dn_norm_w": dn_norm_w,
            "w_proj_na": w_proj_na, "w_proj_dn": w_proj_dn, "w_out": w_out,
            "ln1_g": ln1_g, "ln1_b": ln1_b,
            "w_router_group": w_router_group, "b_router_group": b_router_group,
            "w_router_expert": w_router_expert, "b_router_expert": b_router_expert,
            "w_expert_gate_up": w_expert_gate_up, "w_expert_down": w_expert_down,
            "ln2_g": ln2_g, "ln2_b": ln2_b}


def reference(x, w_in, na_rpb, dn_conv_w, dn_a_log_f, dn_a_log_b, dn_dt_bias_f, dn_dt_bias_b,
              dn_norm_w, w_proj_na, w_proj_dn, w_out, ln1_g, ln1_b,
              w_router_group, b_router_group, w_router_expert, b_router_expert,
              w_expert_gate_up, w_expert_down, ln2_g, ln2_b):
    for l in range(DEPTH):
        mix = token_mixer(x, w_in[l], na_rpb[l], dn_conv_w[l], dn_a_log_f[l], dn_a_log_b[l],
                          dn_dt_bias_f[l], dn_dt_bias_b[l], dn_norm_w[l],
                          w_proj_na[l], w_proj_dn[l], w_out[l])
        x = layer_norm(DEEPNORM_ALPHA * x + mix, ln1_g[l], ln1_b[l])
        ffn = hierarchical_moe(x, w_router_group[l], b_router_group[l], w_router_expert[l],
                               b_router_expert[l], w_expert_gate_up[l], w_expert_down[l])
        x = layer_norm(DEEPNORM_ALPHA * x + ffn, ln2_g[l], ln2_b[l])
    return x
```

```cpp
#include <hip/hip_runtime.h>
#include <math.h>
#include <stdint.h>

#define D_MODEL 1024
#define BATCH 8
#define SEQ 2048
#define D_IN 5664
#define NTOK (BATCH * SEQ)
#define ALPHA 1.189207115002721f
#define LN_EPS 1e-5f
#define RMS_EPS 1e-6f

#define C_QNA 0
#define C_KNA 512
#define C_VNA 1024
#define C_QDN 1536
#define C_KDN 2048
#define C_VDN 2560
#define C_ZDN 3072
#define C_BF 3584
#define C_BB 3592
#define C_AF 3600
#define C_AB 3608
#define C_GNA 3616
#define C_GDN 4640

__device__ __forceinline__ float sigmoidf_(float x) { return 1.f / (1.f + expf(-x)); }
__device__ __forceinline__ float siluf_(float x) { return x / (1.f + expf(-x)); }
__device__ __forceinline__ float softplusf_(float x) { return x > 20.f ? x : log1pf(expf(x)); }

__global__ void __launch_bounds__(256) gemm_f32_kernel(const float* __restrict__ A, const float* __restrict__ B, float* __restrict__ C,
                                                       int M, int N, int K, int lda, int ldb, int ldc) {
    __shared__ float As[16][68];
    __shared__ float Bs[16][68];
    const int tx = threadIdx.x & 15, ty = threadIdx.x >> 4;
    const int m0 = blockIdx.y * 64, n0 = blockIdx.x * 64;
    float acc[4][4];
#pragma unroll
    for (int i = 0; i < 4; ++i)
#pragma unroll
        for (int j = 0; j < 4; ++j) acc[i][j] = 0.f;
    for (int k0 = 0; k0 < K; k0 += 16) {
#pragma unroll
        for (int i = 0; i < 4; ++i) {
            const int e = threadIdx.x + i * 256;
            const int m = e >> 4, k = e & 15;
            As[k][m] = (m0 + m < M) ? A[(size_t)(m0 + m) * lda + k0 + k] : 0.f;
        }
#pragma unroll
        for (int i = 0; i < 4; ++i) {
            const int e = threadIdx.x + i * 256;
            const int k = e >> 6, n = e & 63;
            Bs[k][n] = (n0 + n < N) ? B[(size_t)(k0 + k) * ldb + n0 + n] : 0.f;
        }
        __syncthreads();
#pragma unroll
        for (int k = 0; k < 16; ++k) {
            float a[4], b[4];
#pragma unroll
            for (int i = 0; i < 4; ++i) a[i] = As[k][ty * 4 + i];
#pragma unroll
            for (int j = 0; j < 4; ++j) b[j] = Bs[k][tx * 4 + j];
#pragma unroll
            for (int i = 0; i < 4; ++i)
#pragma unroll
                for (int j = 0; j < 4; ++j) acc[i][j] = fmaf(a[i], b[j], acc[i][j]);
        }
        __syncthreads();
    }
#pragma unroll
    for (int i = 0; i < 4; ++i)
#pragma unroll
        for (int j = 0; j < 4; ++j) {
            const int m = m0 + ty * 4 + i, n = n0 + tx * 4 + j;
            if (m < M && n < N) C[(size_t)m * ldc + n] = acc[i][j];
        }
}

__global__ void __launch_bounds__(128) na_attn_kernel(const float* __restrict__ h, const float* __restrict__ rpb, float* __restrict__ na_out) {
    const int t = blockIdx.x, hd = blockIdx.y;
    const int r = t >> 6, c = t & 63;
    int rs = r - 4; rs = rs < 0 ? 0 : (rs > 24 ? 24 : rs);
    int cs = c - 8; cs = cs < 0 ? 0 : (cs > 48 ? 48 : cs);
    __shared__ float qs[64];
    __shared__ float ps[128];
    __shared__ float red[128];
    const int j = threadIdx.x;
    if (j < 64) qs[j] = h[(size_t)t * D_IN + C_QNA + hd * 64 + j] * 0.125f;
    __syncthreads();
    const int kr = rs + (j >> 4), kc = cs + (j & 15);
    const int kt = kr * 64 + kc;
    const float* kp = h + (size_t)kt * D_IN + C_KNA + hd * 64;
    float s = 0.f;
    for (int d = 0; d < 64; ++d) s = fmaf(qs[d], kp[d], s);
    s += rpb[(hd * 15 + (kr - r + 7)) * 31 + (kc - c + 15)];
    red[j] = s;
    __syncthreads();
    for (int o = 64; o > 0; o >>= 1) { if (j < o) red[j] = fmaxf(red[j], red[j + o]); __syncthreads(); }
    const float mx = red[0];
    __syncthreads();
    const float p = expf(s - mx);
    red[j] = p;
    __syncthreads();
    for (int o = 64; o > 0; o >>= 1) { if (j < o) red[j] += red[j + o]; __syncthreads(); }
    const float sum = red[0];
    ps[j] = p / sum;
    __syncthreads();
    if (j < 64) {
        float o = 0.f;
        for (int jj = 0; jj < 128; ++jj) {
            const int kt2 = (rs + (jj >> 4)) * 64 + cs + (jj & 15);
            o = fmaf(ps[jj], h[(size_t)kt2 * D_IN + C_VNA + hd * 64 + j], o);
        }
        na_out[(size_t)t * 512 + hd * 64 + j] = o;
    }
}

__global__ void __launch_bounds__(64) dn_conv_kernel(const float* __restrict__ h, const float* __restrict__ conv_w,
                                                     const float* __restrict__ a_log_f, const float* __restrict__ a_log_b,
                                                     const float* __restrict__ dtb_f, const float* __restrict__ dtb_b,
                                                     float* __restrict__ qc, float* __restrict__ kc, float* __restrict__ vc, float* __restrict__ gates) {
    const int t = blockIdx.x, hd = blockIdx.y, d = threadIdx.x;
    const int ch = hd * 64 + d;
    float yq = 0.f, yk = 0.f, yv = 0.f;
#pragma unroll
    for (int j = 0; j < 5; ++j) {
        const int tt = t + j - 2;
        if (tt >= 0 && tt < SEQ) {
            const float* hr = h + (size_t)tt * D_IN;
            yq = fmaf(hr[C_QDN + ch], conv_w[j * 1536 + ch], yq);
            yk = fmaf(hr[C_KDN + ch], conv_w[j * 1536 + 512 + ch], yk);
            yv = fmaf(hr[C_VDN + ch], conv_w[j * 1536 + 1024 + ch], yv);
        }
    }
    yq = siluf_(yq); yk = siluf_(yk); yv = siluf_(yv);
    float sq = yq * yq, sk = yk * yk;
#pragma unroll
    for (int o = 1; o < 64; o <<= 1) { sq += __shfl_xor(sq, o); sk += __shfl_xor(sk, o); }
    yq *= rsqrtf(sq + RMS_EPS); yk *= rsqrtf(sk + RMS_EPS);
    qc[(size_t)t * 512 + ch] = yq; kc[(size_t)t * 512 + ch] = yk; vc[(size_t)t * 512 + ch] = yv;
    if (d == 0) {
        const float* hr = h + (size_t)t * D_IN;
        float* g = gates + ((size_t)t * 8 + hd) * 4;
        g[0] = sigmoidf_(hr[C_BF + hd]);
        g[1] = sigmoidf_(hr[C_BB + hd]);
        g[2] = -expf(a_log_f[hd]) * softplusf_(hr[C_AF + hd] + dtb_f[hd]);
        g[3] = -expf(a_log_b[hd]) * softplusf_(hr[C_AB + hd] + dtb_b[hd]);
    }
}

__global__ void __launch_bounds__(64) dn_scan_kernel(const float* __restrict__ qc, const float* __restrict__ kc, const float* __restrict__ vc,
                                                     const float* __restrict__ gates, float* __restrict__ o_f, float* __restrict__ o_b) {
    const int hd = blockIdx.x, dir = blockIdx.y, lane = threadIdx.x;
    __shared__ float ks[64];
    __shared__ float qs[64];
    float S[64];
#pragma unroll
    for (int k = 0; k < 64; ++k) S[k] = 0.f;
    float* op = dir == 0 ? o_f : o_b;
    for (int step = 0; step < SEQ; ++step) {
        const int t = dir == 0 ? step : SEQ - 1 - step;
        ks[lane] = kc[(size_t)t * 512 + hd * 64 + lane];
        qs[lane] = qc[(size_t)t * 512 + hd * 64 + lane];
        const float vv = vc[(size_t)t * 512 + hd * 64 + lane];
        const float* g = gates + ((size_t)t * 8 + hd) * 4;
        const float beta = g[dir], eg = expf(g[2 + dir]);
        __syncthreads();
        float sk = 0.f;
#pragma unroll
        for (int k = 0; k < 64; ++k) sk = fmaf(S[k], ks[k], sk);
        const float dd = beta * (vv - eg * sk);
        float o = 0.f;
#pragma unroll
        for (int k = 0; k < 64; ++k) { S[k] = fmaf(ks[k], dd, eg * S[k]); o = fmaf(S[k], qs[k], o); }
        op[(size_t)t * 512 + hd * 64 + lane] = o * 0.125f;
        __syncthreads();
    }
}

__global__ void __launch_bounds__(64) dn_out_kernel(const float* __restrict__ o_f, const float* __restrict__ o_b, const float* __restrict__ h,
                                                    const float* __restrict__ norm_w, float* __restrict__ dn_out) {
    const int t = blockIdx.x, hd = blockIdx.y, d = threadIdx.x;
    const size_t idx = (size_t)t * 512 + hd * 64 + d;
    float o = o_f[idx] + o_b[idx];
    float ss = o * o;
#pragma unroll
    for (int k = 1; k < 64; k <<= 1) ss += __shfl_xor(ss, k);
    o = o * rsqrtf(ss * (1.f / 64.f) + RMS_EPS) * norm_w[d];
    const float z = h[(size_t)t * D_IN + C_ZDN + hd * 64 + d];
    dn_out[idx] = o * siluf_(z);
}

__global__ void __launch_bounds__(256) merge_kernel(const float* __restrict__ h, const float* __restrict__ y_na, const float* __restrict__ y_dn, float* __restrict__ merged) {
    const int t = blockIdx.x;
    for (int c = threadIdx.x; c < 1024; c += 256) {
        const float g1 = h[(size_t)t * D_IN + C_GNA + c], g2 = h[(size_t)t * D_IN + C_GDN + c];
        merged[(size_t)t * 1024 + c] = sigmoidf_(g1) * y_na[(size_t)t * 1024 + c] + sigmoidf_(g2) * y_dn[(size_t)t * 1024 + c];
    }
}

__device__ __forceinline__ float block_sum_256(float v, float* red) {
#pragma unroll
    for (int o = 1; o < 64; o <<= 1) v += __shfl_xor(v, o);
    __syncthreads();
    if ((threadIdx.x & 63) == 0) red[threadIdx.x >> 6] = v;
    __syncthreads();
    return red[0] + red[1] + red[2] + red[3];
}

__global__ void __launch_bounds__(256) ln1_router_kernel(const float* __restrict__ x, const float* __restrict__ mix, const float* __restrict__ g1, const float* __restrict__ b1,
                                                         const float* __restrict__ wrg, const float* __restrict__ brg, const float* __restrict__ wre, const float* __restrict__ bre,
                                                         float* __restrict__ x1, int* __restrict__ route_e, float* __restrict__ route_p) {
    const int t = blockIdx.x, tid = threadIdx.x;
    __shared__ float xs[1024];
    __shared__ float red[4];
    __shared__ float logits[36];
    float v[4]; float s = 0.f;
#pragma unroll
    for (int i = 0; i < 4; ++i) { const int c = tid + 256 * i; v[i] = ALPHA * x[(size_t)t * 1024 + c] + mix[(size_t)t * 1024 + c]; s += v[i]; }
    const float mu = block_sum_256(s, red) * (1.f / 1024.f);
    float q = 0.f;
#pragma unroll
    for (int i = 0; i < 4; ++i) { const float d = v[i] - mu; q += d * d; }
    const float var = block_sum_256(q, red) * (1.f / 1024.f);
    const float rstd = rsqrtf(var + LN_EPS);
#pragma unroll
    for (int i = 0; i < 4; ++i) { const int c = tid + 256 * i; const float y = (v[i] - mu) * rstd * g1[c] + b1[c]; xs[c] = y; x1[(size_t)t * 1024 + c] = y; }
    __syncthreads();
    if (tid < 36) {
        float a = 0.f;
        if (tid < 4) { for (int c = 0; c < 1024; ++c) a = fmaf(xs[c], wrg[c * 4 + tid], a); a += brg[tid]; }
        else { const int e = tid - 4; for (int c = 0; c < 1024; ++c) a = fmaf(xs[c], wre[c * 32 + e], a); a += bre[e]; }
        logits[tid] = a;
    }
    __syncthreads();
    if (tid == 0) {
        int gi = 0; float gm = logits[0];
        for (int g = 1; g < 4; ++g) if (logits[g] > gm) { gm = logits[g]; gi = g; }
        float gs = 0.f;
        for (int g = 0; g < 4; ++g) gs += expf(logits[g] - gm);
        const float gp = 1.f / gs;
        const float* el = logits + 4 + gi * 8;
        int i1 = 0; float l1 = el[0];
        for (int e = 1; e < 8; ++e) if (el[e] > l1) { l1 = el[e]; i1 = e; }
        int i2 = -1; float l2 = -3.0e38f;
        for (int e = 0; e < 8; ++e) if (e != i1 && el[e] > l2) { l2 = el[e]; i2 = e; }
        const float e2 = expf(l2 - l1);
        const float p1 = 1.f / (1.f + e2), p2 = e2 / (1.f + e2);
        route_e[t * 2 + 0] = gi * 8 + i1; route_e[t * 2 + 1] = gi * 8 + i2;
        route_p[t * 2 + 0] = p1 * gp; route_p[t * 2 + 1] = p2 * gp;
    }
}

__global__ void __launch_bounds__(256) moe_ln2_kernel(const float* __restrict__ x1, const int* __restrict__ route_e, const float* __restrict__ route_p,
                                                      const float* __restrict__ wgu, const float* __restrict__ wd, const float* __restrict__ g2, const float* __restrict__ b2,
                                                      float* __restrict__ out) {
    const int t = blockIdx.x, tid = threadIdx.x;
    __shared__ float xs[1024];
    __shared__ float hid[512];
    __shared__ float red[4];
#pragma unroll
    for (int i = 0; i < 4; ++i) xs[tid + 256 * i] = x1[(size_t)t * 1024 + tid + 256 * i];
    __syncthreads();
    int ee[2]; ee[0] = route_e[t * 2]; ee[1] = route_e[t * 2 + 1];
#pragma unroll
    for (int kk = 0; kk < 2; ++kk) {
        const float* W = wgu + (size_t)ee[kk] * 1024 * 512;
        float a = 0.f, u = 0.f;
        for (int d = 0; d < 1024; ++d) { a = fmaf(xs[d], W[(size_t)d * 512 + tid], a); u = fmaf(xs[d], W[(size_t)d * 512 + 256 + tid], u); }
        hid[kk * 256 + tid] = siluf_(a) * u * route_p[t * 2 + kk];
    }
    __syncthreads();
    float y[4];
#pragma unroll
    for (int i = 0; i < 4; ++i) y[i] = 0.f;
#pragma unroll
    for (int kk = 0; kk < 2; ++kk) {
        const float* W = wd + (size_t)ee[kk] * 256 * 1024;
        for (int f = 0; f < 256; ++f) {
            const float hv = hid[kk * 256 + f];
#pragma unroll
            for (int i = 0; i < 4; ++i) y[i] = fmaf(hv, W[(size_t)f * 1024 + tid + 256 * i], y[i]);
        }
    }
    float v[4]; float s = 0.f;
#pragma unroll
    for (int i = 0; i < 4; ++i) { v[i] = ALPHA * xs[tid + 256 * i] + y[i]; s += v[i]; }
    const float mu = block_sum_256(s, red) * (1.f / 1024.f);
    float q = 0.f;
#pragma unroll
    for (int i = 0; i < 4; ++i) { const float d = v[i] - mu; q += d * d; }
    const float var = block_sum_256(q, red) * (1.f / 1024.f);
    const float rstd = rsqrtf(var + LN_EPS);
#pragma unroll
    for (int i = 0; i < 4; ++i) { const int c = tid + 256 * i; out[(size_t)t * 1024 + c] = (v[i] - mu) * rstd * g2[c] + b2[c]; }
}

static void gemm(const float* A, const float* B, float* C, int M, int N, int K, int lda, int ldb, int ldc, hipStream_t s) {
    dim3 grid((N + 63) / 64, (M + 63) / 64);
    hipLaunchKernelGGL(gemm_f32_kernel, grid, dim3(256), 0, s, A, B, C, M, N, K, lda, ldb, ldc);
}

extern "C" void kernel_launch(void* const* d_in, const int* in_sizes, int n_in, void* d_out, int out_size, void* d_ws, size_t ws_size, hipStream_t stream) {
    const float* x = (const float*)d_in[0];
    const float* w_in = (const float*)d_in[1];
    const float* rpb = (const float*)d_in[2];
    const float* conv_w = (const float*)d_in[3];
    const float* a_log_f = (const float*)d_in[4];
    const float* a_log_b = (const float*)d_in[5];
    const float* dtb_f = (const float*)d_in[6];
    const float* dtb_b = (const float*)d_in[7];
    const float* norm_w = (const float*)d_in[8];
    const float* w_proj_na = (const float*)d_in[9];
    const float* w_proj_dn = (const float*)d_in[10];
    const float* w_out = (const float*)d_in[11];
    const float* ln1_g = (const float*)d_in[12];
    const float* ln1_b = (const float*)d_in[13];
    const float* wrg = (const float*)d_in[14];
    const float* brg = (const float*)d_in[15];
    const float* wre = (const float*)d_in[16];
    const float* bre = (const float*)d_in[17];
    const float* wgu = (const float*)d_in[18];
    const float* wd = (const float*)d_in[19];
    const float* ln2_g = (const float*)d_in[20];
    const float* ln2_b = (const float*)d_in[21];
    float* out = (float*)d_out;

    char* ws = (char*)d_ws;
    size_t off = 0;
    auto take = [&](size_t bytes) { char* p = ws + off; off += (bytes + 255) & ~(size_t)255; return p; };
    float* h = (float*)take((size_t)SEQ * D_IN * 4);
    float* na_out = (float*)take((size_t)SEQ * 512 * 4);
    float* qc = (float*)take((size_t)SEQ * 512 * 4);
    float* kc = (float*)take((size_t)SEQ * 512 * 4);
    float* vc = (float*)take((size_t)SEQ * 512 * 4);
    float* gates = (float*)take((size_t)SEQ * 8 * 4 * 4);
    float* o_f = (float*)take((size_t)SEQ * 512 * 4);
    float* o_b = (float*)take((size_t)SEQ * 512 * 4);
    float* dn_out = (float*)take((size_t)SEQ * 512 * 4);
    float* y_na = (float*)take((size_t)SEQ * 1024 * 4);
    float* y_dn = (float*)take((size_t)SEQ * 1024 * 4);
    float* merged = (float*)take((size_t)SEQ * 1024 * 4);
    float* mix = (float*)take((size_t)SEQ * 1024 * 4);
    float* x1 = (float*)take((size_t)SEQ * 1024 * 4);
    int* route_e = (int*)take((size_t)SEQ * 2 * 4);
    float* route_p = (float*)take((size_t)SEQ * 2 * 4);

    for (int b = 0; b < BATCH; ++b) {
        const float* xb = x + (size_t)b * SEQ * D_MODEL;
        float* outb = out + (size_t)b * SEQ * D_MODEL;
        gemm(xb, w_in, h, SEQ, D_IN, D_MODEL, D_MODEL, D_IN, D_IN, stream);
        hipLaunchKernelGGL(na_attn_kernel, dim3(SEQ, 8), dim3(128), 0, stream, h, rpb, na_out);
        hipLaunchKernelGGL(dn_conv_kernel, dim3(SEQ, 8), dim3(64), 0, stream, h, conv_w, a_log_f, a_log_b, dtb_f, dtb_b, qc, kc, vc, gates);
        hipLaunchKernelGGL(dn_scan_kernel, dim3(8, 2), dim3(64), 0, stream, qc, kc, vc, gates, o_f, o_b);
        hipLaunchKernelGGL(dn_out_kernel, dim3(SEQ, 8), dim3(64), 0, stream, o_f, o_b, h, norm_w, dn_out);
        gemm(na_out, w_proj_na, y_na, SEQ, 1024, 512, 512, 1024, 1024, stream);
        gemm(dn_out, w_proj_dn, y_dn, SEQ, 1024, 512, 512, 1024, 1024, stream);
        hipLaunchKernelGGL(merge_kernel, dim3(SEQ), dim3(256), 0, stream, h, y_na, y_dn, merged);
        gemm(merged, w_out, mix, SEQ, 1024, 1024, 1024, 1024, 1024, stream);
        hipLaunchKernelGGL(ln1_router_kernel, dim3(SEQ), dim3(256), 0, stream, xb, mix, ln1_g, ln1_b, wrg, brg, wre, bre, x1, route_e, route_p);
        hipLaunchKernelGGL(moe_ln2_kernel, dim3(SEQ), dim3(256), 0, stream, x1, route_e, route_p, wgu, wd, ln2_g, ln2_b, outb);
    }
}
```

```cpp
#include <hip/hip_runtime.h>
#include <math.h>
#include <stdint.h>
#include <stdio.h>
namespace pg8 {
#define PG8_LAS __attribute__((address_space(3)))
typedef unsigned short bf16_t;
typedef short bf16x8 __attribute__((ext_vector_type(8)));
typedef float f32x4 __attribute__((ext_vector_type(4)));
typedef unsigned u32x4 __attribute__((ext_vector_type(4)));
constexpr int BM = 256, BK = 64, HALF = 128, HTB = HALF * BK * 2  , STAGE_BYTES = 8 * HTB, NXCD = 8, WGM = 8;

__host__ __device__ __forceinline__ int lds_byte(int r, int c) { const int st = (r >> 4) * 2 + (c >> 5), rr = r & 15, cc = c & 31, ob = rr * 64 + cc * 2; return st * 1024 + (ob ^ (((ob >> 9) & 1) << 5)); }
__host__ __device__ __forceinline__ void stage_rc(int b, int& R, int& C) { const int st = b / 1024, sb = b % 1024, swz = sb ^ (((sb >> 9) & 1) << 5); R = (st >> 1) * 16 + swz / 64; C = (st & 1) * 32 + (swz % 64) / 2; }
__host__ __device__ __forceinline__ int perm32(int rho) { const int n = rho >> 4, i = rho & 15; return 8 * (i >> 2) + 4 * n + (i & 3); }

struct Unit { int pm, pn; };
struct Gemm { const bf16_t* A; const bf16_t* Bt; int M, N, K; };

struct StaticOrder {
    int nM, nN, nwg, G, c;
    __host__ __device__ void init(int M, int N, int G_, int c_) { nM = M / BM; nN = N / BM; nwg = nM * nN; G = G_; c = c_; }
    __host__ __device__ bool next(int i, Unit& u) const {
        const long L = (long)i * G + c; if (L >= nwg) return false;
        int wgid = (int)L; { const int q = nwg / NXCD, r = nwg % NXCD, xcd = wgid % NXCD, off = wgid / NXCD; wgid = (xcd < r ? xcd * (q + 1) : r * (q + 1) + (xcd - r) * q) + off; }
        const int nig = WGM * nN, gid = wgid / nig, fm = gid * WGM, gsz = (nM - fm) < WGM ? (nM - fm) : WGM;
        u.pm = fm + ((wgid % nig) % gsz); u.pn = (wgid % nig) / gsz; return true;
    }
    __device__ __forceinline__ void a_ready(const Unit&) const {}
    __device__ __forceinline__ void done(const Unit&) const {}
};
__device__ __forceinline__ unsigned cvt_pk_bf16(float lo, float hi) { unsigned r; asm volatile("v_cvt_pk_bf16_f32 %0, %1, %2" : "=v"(r) : "v"(lo), "v"(hi)); return r; }

template <class Epi, class Sched, bool ALIGN_EPI = false, bool SP2 = false>
__device__ __forceinline__ void gemm_phase(PG8_LAS unsigned char* lds, const Gemm g, const Sched& S, const Epi& E) {
    const int tid = threadIdx.x, wid = __builtin_amdgcn_readfirstlane(tid >> 6), lane = tid & 63, wr = wid >> 2, wc = wid & 3, fr = lane & 15, fq = lane >> 4;
    const int K = g.K, nt = K / BK;
    unsigned voffA[2], voffB[2];
#pragma unroll
    for (int i = 0; i < 2; ++i) { int R, C; stage_rc(tid * 16 + i * 8192, R, C); const int Rb = Epi::PERM ? ((R & ~31) + perm32(R & 31)) : R;
        voffA[i] = (unsigned)(R * K + C) * 2u; voffB[i] = (unsigned)(Rb * K + C) * 2u; }
    const size_t kstep = (size_t)(BK * 2);
    const size_t hstep = (size_t)HALF * K * 2;
    const size_t tstep = 2 * hstep;
    const unsigned ldsw = (unsigned)wid * 1024u;
    const int aoff = lds_byte(wr * 64 + fr, fq * 8), boff = lds_byte(wc * 32 + fr, fq * 8);
#define PG8_SA(b, h) (((b) * 2 + (h)) * HTB)
#define PG8_SB(b, h) ((4 + (b) * 2 + (h)) * HTB)
#define PG8_STAGE(bufoff, gbase, voff) do { _Pragma("unroll") for (int _i = 0; _i < 2; ++_i) \
        __builtin_amdgcn_global_load_lds((const unsigned*)((const char*)(gbase) + (voff)[_i]), (PG8_LAS unsigned*)(lds + (bufoff) + ldsw + _i * 8192), 16, 0, 0); } while (0)
#define PG8_LDA(dst, b, h) do { _Pragma("unroll") for (int m = 0; m < 4; ++m) _Pragma("unroll") for (int k = 0; k < 2; ++k) dst[m][k] = *(const PG8_LAS bf16x8*)(lds + PG8_SA(b, h) + aoff + m * 2048 + k * 1024); } while (0)
#define PG8_LDB(dst, b, h) do { _Pragma("unroll") for (int n = 0; n < 2; ++n) _Pragma("unroll") for (int k = 0; k < 2; ++k) dst[n][k] = *(const PG8_LAS bf16x8*)(lds + PG8_SB(b, h) + boff + n * 2048 + k * 1024); } while (0)
#define PG8_MMA(ai, bj, At, Bt) do { __builtin_amdgcn_s_setprio(1); _Pragma("unroll") for (int m = 0; m < 4; ++m) _Pragma("unroll") for (int n = 0; n < 2; ++n) _Pragma("unroll") for (int k = 0; k < 2; ++k) \
        acc[ai][bj][m][n] = __builtin_amdgcn_mfma_f32_16x16x32_bf16(Bt[n][k], At[m][k], acc[ai][bj][m][n], 0, 0, 0); __builtin_amdgcn_s_setprio(0); } while (0)
#define PG8_WAIT_V(n) asm volatile("s_waitcnt vmcnt(" #n ")" ::: "memory")
#define PG8_WAIT_L(n) asm volatile("s_waitcnt lgkmcnt(" #n ")" ::: "memory")
#define PG8_BAR __builtin_amdgcn_s_barrier()
#define PG8_SCHED __builtin_amdgcn_sched_barrier(0)
    Unit cur, nxt; int ui = 0;
    if (!S.next(0, cur)) return;
    f32x4 acc[2][2][4][2];
#pragma unroll
    for (int a = 0; a < 2; ++a)
#pragma unroll
        for (int b = 0; b < 2; ++b)
#pragma unroll
            for (int m = 0; m < 4; ++m)
#pragma unroll
                for (int n = 0; n < 2; ++n) acc[a][b][m][n] = (f32x4){0.f, 0.f, 0.f, 0.f};
    bf16x8 At[4][2], B0[2][2], B1[2][2];
    const char* cA = (const char*)g.A + (size_t)cur.pm * tstep; const char* cB = (const char*)g.Bt + (size_t)cur.pn * tstep;
    S.a_ready(cur);
    if constexpr (SP2) {
        PG8_STAGE(PG8_SB(0, 0), cB, voffB); PG8_STAGE(PG8_SB(0, 1), cB + hstep, voffB); PG8_STAGE(PG8_SA(0, 0), cA, voffA); PG8_STAGE(PG8_SA(0, 1), cA + hstep, voffA);
        if (wr == 1) PG8_BAR;
        PG8_WAIT_V(2); PG8_BAR;
        PG8_STAGE(PG8_SB(1, 0), cB + kstep, voffB); PG8_STAGE(PG8_SA(1, 0), cA + kstep, voffA); PG8_STAGE(PG8_SB(1, 1), cB + hstep + kstep, voffB);
        PG8_WAIT_V(6); PG8_BAR;
    } else {
        PG8_STAGE(PG8_SB(0, 0), cB, voffB); PG8_STAGE(PG8_SA(0, 0), cA, voffA); PG8_STAGE(PG8_SB(0, 1), cB + hstep, voffB); PG8_STAGE(PG8_SA(0, 1), cA + hstep, voffA);
        if (wr == 1) PG8_BAR;
        PG8_WAIT_V(4); PG8_BAR;
        PG8_STAGE(PG8_SB(1, 0), cB + kstep, voffB); PG8_STAGE(PG8_SA(1, 0), cA + kstep, voffA); PG8_STAGE(PG8_SB(1, 1), cB + hstep + kstep, voffB);
        PG8_WAIT_V(6); PG8_BAR;
    }
    for (;;) {
        const bool has_next = S.next(ui + 1, nxt);
        const char* nA = has_next ? (const char*)g.A + (size_t)nxt.pm * tstep : cA; const char* nB = has_next ? (const char*)g.Bt + (size_t)nxt.pn * tstep : cB;
        for (int t = 0; t < nt; t += 2) {
            const bool last = (t == nt - 2);
            const char* a1 = cA + (size_t)(t + 1) * kstep;
            const char* a2 = last ? nA : cA + (size_t)(t + 2) * kstep; const char* b2 = last ? nB : cB + (size_t)(t + 2) * kstep;
            const char* a3 = a2 + kstep; const char* b3 = b2 + kstep;
            if (last && has_next) S.a_ready(nxt);
            if constexpr (SP2) {
            PG8_LDB(B0, 0, 0); PG8_LDB(B1, 0, 1); PG8_SCHED; PG8_LDA(At, 0, 0); PG8_STAGE(PG8_SA(1, 1), a1 + hstep, voffA);
            PG8_WAIT_V(8); PG8_WAIT_L(0); PG8_BAR; PG8_MMA(0, 0, At, B0); PG8_MMA(0, 1, At, B1); PG8_BAR; PG8_SCHED;
            PG8_LDA(At, 0, 1); PG8_STAGE(PG8_SB(0, 0), b2, voffB); PG8_STAGE(PG8_SB(0, 1), b2 + hstep, voffB); PG8_STAGE(PG8_SA(0, 0), a2, voffA);
            PG8_WAIT_V(8); PG8_WAIT_L(0); PG8_BAR; PG8_MMA(1, 0, At, B0); PG8_MMA(1, 1, At, B1); PG8_BAR; PG8_SCHED;
            PG8_LDB(B0, 1, 0); PG8_LDB(B1, 1, 1); PG8_SCHED; PG8_LDA(At, 1, 0); PG8_STAGE(PG8_SA(0, 1), a2 + hstep, voffA);
            PG8_WAIT_V(8); PG8_WAIT_L(0); PG8_BAR; PG8_MMA(0, 0, At, B0); PG8_MMA(0, 1, At, B1); PG8_BAR; PG8_SCHED;
            PG8_LDA(At, 1, 1); PG8_STAGE(PG8_SB(1, 0), b3, voffB); PG8_STAGE(PG8_SB(1, 1), b3 + hstep, voffB); PG8_STAGE(PG8_SA(1, 0), a3, voffA);
            PG8_WAIT_V(8); PG8_WAIT_L(0); PG8_BAR; PG8_MMA(1, 0, At, B0); PG8_MMA(1, 1, At, B1); PG8_BAR; PG8_SCHED;
            } else {
            PG8_LDB(B0, 0, 0); PG8_SCHED; PG8_LDA(At, 0, 0); PG8_STAGE(PG8_SA(1, 1), a1 + hstep, voffA);
            PG8_WAIT_L(8); PG8_BAR; PG8_WAIT_L(0); PG8_MMA(0, 0, At, B0); PG8_BAR; PG8_SCHED;
            PG8_LDB(B1, 0, 1); PG8_STAGE(PG8_SB(0, 0), b2, voffB);
            PG8_BAR; PG8_WAIT_L(0); PG8_MMA(0, 1, At, B1); PG8_BAR;
            PG8_LDA(At, 0, 1); PG8_STAGE(PG8_SA(0, 0), a2, voffA);
            PG8_BAR; PG8_WAIT_L(0); PG8_MMA(1, 0, At, B0); PG8_BAR; PG8_SCHED;
            PG8_STAGE(PG8_SB(0, 1), b2 + hstep, voffB);
            PG8_WAIT_V(6); PG8_BAR; PG8_MMA(1, 1, At, B1); PG8_BAR;
            PG8_LDB(B0, 1, 0); PG8_SCHED; PG8_LDA(At, 1, 0); PG8_STAGE(PG8_SA(0, 1), a2 + hstep, voffA);
            PG8_WAIT_L(8); PG8_BAR; PG8_WAIT_L(0); PG8_MMA(0, 0, At, B0); PG8_BAR; PG8_SCHED;
            PG8_LDB(B1, 1, 1); PG8_STAGE(PG8_SB(1, 0), b3, voffB);
            PG8_BAR; PG8_WAIT_L(0); PG8_MMA(0, 1, At, B1); PG8_BAR;
            PG8_LDA(At, 1, 1); PG8_STAGE(PG8_SA(1, 0), a3, voffA);
            PG8_BAR; PG8_WAIT_L(0); PG8_MMA(1, 0, At, B0); PG8_BAR; PG8_SCHED;
            PG8_STAGE(PG8_SB(1, 1), b3 + hstep, voffB);
            PG8_WAIT_V(6); PG8_BAR; PG8_MMA(1, 1, At, B1); PG8_BAR;
            }
        }
        if constexpr (ALIGN_EPI) { if (wr == 0) PG8_BAR; }
        if constexpr (!Epi::AFTER_DRAIN) { E(acc, cur, wr, wc, fr, fq); S.done(cur); }
        if (!has_next) break;
#pragma unroll
        for (int a = 0; a < 2; ++a)
#pragma unroll
            for (int b = 0; b < 2; ++b)
#pragma unroll
                for (int m = 0; m < 4; ++m)
#pragma unroll
                    for (int n = 0; n < 2; ++n) acc[a][b][m][n] = (f32x4){0.f, 0.f, 0.f, 0.f};
        cur = nxt; cA = nA; cB = nB; ++ui;
        if constexpr (ALIGN_EPI) { if (wr == 1) PG8_BAR; }
    }
    PG8_WAIT_V(0);
    if constexpr (!ALIGN_EPI) { if (wr == 0) PG8_BAR; }
    PG8_BAR;
    if constexpr (Epi::AFTER_DRAIN) { E.fused(acc, cur, wr, wc, fr, fq, lds, wid, lane); S.done(cur); }
#undef PG8_SA
#undef PG8_SB
#undef PG8_STAGE
#undef PG8_LDA
#undef PG8_LDB
#undef PG8_MMA
#undef PG8_WAIT_V
#undef PG8_WAIT_L
#undef PG8_BAR
#undef PG8_SCHED
}
}
typedef unsigned short bf16;
#define LAS __attribute__((address_space(3)))
typedef float f32x4 __attribute__((ext_vector_type(4)));
typedef short bf16x8 __attribute__((ext_vector_type(8)));
typedef unsigned u32x4 __attribute__((ext_vector_type(4)));
typedef unsigned u32x2 __attribute__((ext_vector_type(2)));

#define D_MODEL 1024
#define BATCH 8
#define SEQ 2048
#define D_IN 5664
#define NTOK (BATCH * SEQ)
#define ALPHA 1.189207115002721f
#define LN_EPS 1e-5f
#define RMS_EPS 1e-6f
#define NWIN 3840
#define NT 512
#define LDS_BYTES 147456

#define LDS_WAIT() asm volatile("s_waitcnt lgkmcnt(0)" ::: "memory")
#define VM_WAIT() asm volatile("s_waitcnt vmcnt(0)" ::: "memory")

__device__ __forceinline__ unsigned f2bf(float f) { unsigned u = __builtin_bit_cast(unsigned, f); return (u + 0x7fffu + ((u >> 16) & 1u)) >> 16; }
__device__ __forceinline__ unsigned pk2(float lo, float hi) { return f2bf(lo) | (f2bf(hi) << 16); }
__device__ __forceinline__ float bf2f(unsigned h) { return __builtin_bit_cast(float, (h & 0xffffu) << 16); }
__device__ __forceinline__ float sigmoidf_(float x) { return 1.f / (1.f + __expf(-x)); }
__device__ __forceinline__ float siluf_(float x) { return x / (1.f + __expf(-x)); }
__device__ __forceinline__ float softplusf_(float x) { return x > 20.f ? x : log1pf(expf(x)); }

struct Params {
    const float *x, *w_in, *rpb, *conv_w, *a_log_f, *a_log_b, *dtb_f, *dtb_b, *norm_w, *w_proj_na, *w_proj_dn, *w_out, *ln1_g, *ln1_b;
    const float *wrg, *brg, *wre, *bre, *wgu, *wd, *ln2_g, *ln2_b;
    float* out;
    unsigned* ctl;
    bf16 *WIN, *WG, *WPNA, *WPDN, *WOUT, *WGU, *WD;
    bf16 *XB, *QNA, *KNA, *VNAT, *QKVDN, *Z;
    float* GATES;
    bf16 *NAOUT, *DNOUT;
};

__device__ __forceinline__ void transpose_item(const float* W, size_t ldW, bf16* WT, int Kdst, int k0, int n0, int rowdst0, LAS float* scr, int lane) {
#pragma unroll 8
    for (int i = 0; i < 32; ++i) { const int kk = 2 * i + (lane >> 5); scr[kk * 33 + (lane & 31)] = W[(size_t)(k0 + kk) * ldW + n0 + (lane & 31)]; }
    LDS_WAIT(); asm volatile("" ::: "memory");
    const int c = lane & 7;
#pragma unroll
    for (int j = 0; j < 4; ++j) { const int n = (lane >> 3) + 8 * j; const LAS float* s = scr + (8 * c) * 33 + n;
        u32x4 o; o.x = pk2(s[0 * 33], s[1 * 33]); o.y = pk2(s[2 * 33], s[3 * 33]); o.z = pk2(s[4 * 33], s[5 * 33]); o.w = pk2(s[6 * 33], s[7 * 33]);
        *(u32x4*)(WT + (size_t)(rowdst0 + n) * Kdst + k0 + 8 * c) = o; }
    LDS_WAIT(); asm volatile("" ::: "memory");
}

#define IT_WIN (16 * 113)
#define IT_WG (16 * 64)
#define IT_WPNA (8 * 32)
#define IT_WPDN (8 * 32)
#define IT_WOUT (16 * 32)
#define IT_SMALL (IT_WIN + IT_WG + IT_WPNA + IT_WPDN + IT_WOUT)
#define IT_WGU (32 * 16 * 16)
#define IT_WD (32 * 4 * 32)

__device__ __forceinline__ void p0_small_item(const Params& p, int r, LAS float* scr, int lane) {
    if (r < IT_WIN) { const int kb = r / 113, nb = r % 113; transpose_item(p.w_in, D_IN, p.WIN, 1024, kb * 64, nb * 32, nb * 32, scr, lane); return; } r -= IT_WIN;
    if (r < IT_WG) { const int kb = r / 64, nb = r % 64; transpose_item(p.w_in + 3616, D_IN, p.WG, 1024, kb * 64, nb * 32, nb * 32, scr, lane); return; } r -= IT_WG;
    if (r < IT_WPNA) { const int kb = r / 32, nb = r % 32; transpose_item(p.w_proj_na, 1024, p.WPNA, 512, kb * 64, nb * 32, nb * 32, scr, lane); return; } r -= IT_WPNA;
    if (r < IT_WPDN) { const int kb = r / 32, nb = r % 32; transpose_item(p.w_proj_dn, 1024, p.WPDN, 512, kb * 64, nb * 32, nb * 32, scr, lane); return; } r -= IT_WPDN;
    { const int kb = r / 32, nb = r % 32; transpose_item(p.w_out, 1024, p.WOUT, 1024, kb * 64, nb * 32, nb * 32, scr, lane); }
}
__device__ __forceinline__ void p0_moe_item(const Params& p, int r, LAS float* scr, int lane) {
    if (r < IT_WGU) { const int e = r / 256, q = r % 256, kb = q / 16, nb = q % 16;
        const int n0 = nb * 32, up = n0 >= 256, f0 = n0 - (up ? 256 : 0);
        transpose_item(p.wgu + (size_t)e * 1024 * 512, 512, p.WGU, 1024, kb * 64, n0, e * 512 + (f0 / 128) * 256 + (up ? 128 : 0) + (f0 % 128), scr, lane); return; }
    r -= IT_WGU;
    { const int e = r / 128, q = r % 128, kb = q / 32, nb = q % 32;
        transpose_item(p.wd + (size_t)e * 256 * 1024, 1024, p.WD, 256, kb * 64, nb * 32, e * 1024 + nb * 32, scr, lane); }
}

__device__ __forceinline__ void phase0_moe(const Params& p, LAS unsigned char* lds, int gw, int NGW) {
    const int tid = threadIdx.x, lane = tid & 63, wave = tid >> 6;
    LAS float* scr = (LAS float*)(lds + wave * 16384);
    for (int it = gw; it < IT_WGU + IT_WD; it += NGW) p0_moe_item(p, it, scr, lane);
}
__device__ __forceinline__ void phase0(const Params& p, LAS unsigned char* lds) {
    const int tid = threadIdx.x, lane = tid & 63, wave = tid >> 6, G = gridDim.x;
    LAS float* scr = (LAS float*)(lds + wave * 16384);
    const int gw = blockIdx.x * 8 + wave, NGW = G * 8;
    for (int it = gw; it < IT_SMALL; it += NGW) p0_small_item(p, it, scr, lane);
    const size_t gt = (size_t)blockIdx.x * NT + tid, GT = (size_t)G * NT;
    for (size_t i = gt; i < (size_t)NTOK * 1024 / 8; i += GT) {
        const f32x4 a = *(const f32x4*)(p.x + i * 8), b = *(const f32x4*)(p.x + i * 8 + 4);
        u32x4 o; o.x = pk2(a.x, a.y); o.y = pk2(a.z, a.w); o.z = pk2(b.x, b.y); o.w = pk2(b.z, b.w);
        *(u32x4*)(p.XB + i * 8) = o;
    }
    for (size_t i = gt; i < (size_t)(NWIN - 3616) * 1024 / 8; i += GT) *(u32x4*)(p.WIN + (size_t)3616 * 1024 + i * 8) = (u32x4){0u, 0u, 0u, 0u};
}

struct EpiInProj {
    static constexpr bool PERM = true, AFTER_DRAIN = false;
    Params p;
    __device__ __forceinline__ void operator()(const pg8::f32x4 (&acc)[2][2][4][2], const pg8::Unit& u, int wr, int wc, int fr, int fq) const {
        const int pn = u.pn;
#pragma unroll
        for (int ai = 0; ai < 2; ++ai)
#pragma unroll
            for (int m = 0; m < 4; ++m) {
                const int row = u.pm * 256 + ai * 128 + wr * 64 + m * 16 + fr;
                const int b = row >> 11, t = row & 2047;
#pragma unroll
                for (int bj = 0; bj < 2; ++bj) {
                    const pg8::f32x4 v0 = acc[ai][bj][m][0], v1 = acc[ai][bj][m][1];
                    const int head = (pn & 1) * 4 + bj * 2 + (wc >> 1), d0 = (wc & 1) * 32 + 8 * fq;
                    const size_t hm = ((size_t)(b * 8 + head) * 2048 + t) * 64 + d0;
                    if (pn < 4 || (pn >= 6 && pn < 14)) {
                        bf16* dst; float sc = 1.f; bool act = false;
                        if (pn < 2) { dst = p.QNA; sc = 0.125f; }
                        else if (pn < 4) dst = p.KNA;
                        else if (pn < 12) dst = p.QKVDN + (size_t)((pn - 6) >> 1) * ((size_t)NTOK * 512);
                        else { dst = p.Z; act = true; }
                        float e[8] = {v0[0], v0[1], v0[2], v0[3], v1[0], v1[1], v1[2], v1[3]};
#pragma unroll
                        for (int j = 0; j < 8; ++j) e[j] = act ? siluf_(e[j]) : e[j] * sc;
                        u32x4 w; w.x = pk2(e[0], e[1]); w.y = pk2(e[2], e[3]); w.z = pk2(e[4], e[5]); w.w = pk2(e[6], e[7]);
                        *(u32x4*)(dst + hm) = w;
                    } else if (pn < 6) {
                        bf16* dst = p.VNAT + ((size_t)(b * 8 + head) * 64 + d0) * 2048 + t;
                        const float e[8] = {v0[0], v0[1], v0[2], v0[3], v1[0], v1[1], v1[2], v1[3]};
#pragma unroll
                        for (int j = 0; j < 8; ++j) dst[(size_t)j * 2048] = (bf16)f2bf(e[j]);
                    } else {
                        if (bj == 0 && wc == 0) {
                            const float e[8] = {v0[0], v0[1], v0[2], v0[3], v1[0], v1[1], v1[2], v1[3]};
                            float* g = p.GATES + (size_t)fq * NTOK * 8 + (size_t)b * 8 * 2048 + t;
#pragma unroll
                            for (int j = 0; j < 8; ++j) {
                                float val;
                                if (fq < 2) val = sigmoidf_(e[j]);
                                else if (fq == 2) val = -expf(p.a_log_f[j]) * softplusf_(e[j] + p.dtb_f[j]);
                                else val = -expf(p.a_log_b[j]) * softplusf_(e[j] + p.dtb_b[j]);
                                g[(size_t)j * 2048] = val;
                            }
                        }
                    }
                }
            }
    }
};

__device__ __forceinline__ void phase1(const Params& p, LAS unsigned char* lds) {
    pg8::Gemm g{p.XB, p.WIN, NTOK, NWIN, 1024};
    pg8::StaticOrder S; S.init(NTOK, NWIN, gridDim.x, (int)blockIdx.x);
    EpiInProj E{p};
    pg8::gemm_phase<EpiInProj, pg8::StaticOrder, true, true>(lds, g, S, E);
}

__global__ void __launch_bounds__(NT, 2) k_p0(Params p) {
    extern __shared__ __attribute__((aligned(16))) unsigned char lds_raw[];
    phase0(p, (LAS unsigned char*)lds_raw);
}
__global__ void __launch_bounds__(NT, 2) k_p0moe(Params p) {
    extern __shared__ __attribute__((aligned(16))) unsigned char lds_raw[];
    phase0_moe(p, (LAS unsigned char*)lds_raw, blockIdx.x * 8 + (threadIdx.x >> 6), gridDim.x * 8);
}
__global__ void __launch_bounds__(NT, 2) k_p1(Params p) {
    extern __shared__ __attribute__((aligned(16))) unsigned char lds_raw[];
    phase1(p, (LAS unsigned char*)lds_raw);
}
typedef short s16x4 __attribute__((ext_vector_type(4)));
__device__ __forceinline__ void phase_na(const Params& p, LAS unsigned char* lds) {
    const int tid = threadIdx.x, lane = tid & 63, wave = tid >> 6, G = gridDim.x;
    const int vcu = (G % 8 == 0) ? ((int)blockIdx.x % 8) * (G / 8) + (int)blockIdx.x / 8 : (int)blockIdx.x;
    LAS float* rpb_s = (LAS float*)lds;
    const int qi = lane & 15, g = lane >> 4;
    for (int it = vcu; it < 1024; it += G) {
        const int bh = it >> 4, rp = it & 15;
        const int h = bh & 7, b = bh >> 3;
        __syncthreads();
        for (int i = tid; i < 465; i += NT) rpb_s[i] = p.rpb[h * 465 + i];
        __syncthreads();
        const int r = rp * 2 + (wave >> 2), c0 = (wave & 3) * 16;
        int rs = r - 4; rs = rs < 0 ? 0 : (rs > 24 ? 24 : rs);
        int cs0 = c0 - 8; cs0 = cs0 < 0 ? 0 : (cs0 > 32 ? 32 : cs0);
        const int c = c0 + qi;
        int csq = c - 8; csq = csq < 0 ? 0 : (csq > 48 ? 48 : csq);
        const size_t hb = (size_t)(b * 8 + h) * 2048;
        bf16x8 qf[2];
#pragma unroll
        for (int ks = 0; ks < 2; ++ks) qf[ks] = *(const bf16x8*)(p.QNA + (hb + r * 64 + c) * 64 + ks * 32 + 8 * g);
        float s[16][4];
#pragma unroll
        for (int j = 0; j < 8; ++j)
#pragma unroll
            for (int ct = 0; ct < 2; ++ct) {
                const int kt = (rs + j) * 64 + cs0 + ct * 16 + qi;
                f32x4 a = {0.f, 0.f, 0.f, 0.f};
#pragma unroll
                for (int ks = 0; ks < 2; ++ks) {
                    const bf16x8 kf = *(const bf16x8*)(p.KNA + (hb + kt) * 64 + ks * 32 + 8 * g);
                    a = __builtin_amdgcn_mfma_f32_16x16x32_bf16(kf, qf[ks], a, 0, 0, 0);
                }
                const LAS float* brow = rpb_s + (rs + j - r + 7) * 31;
#pragma unroll
                for (int rr = 0; rr < 4; ++rr) {
                    const int kc = cs0 + ct * 16 + 4 * g + rr;
                    const bool valid = (kc >= csq) && (kc < csq + 16);
                    int dc = kc - c + 15; dc = dc < 0 ? 0 : (dc > 30 ? 30 : dc);
                    s[j * 2 + ct][rr] = valid ? a[rr] + brow[dc] : -1e30f;
                }
            }
        float mx = -3e38f;
#pragma unroll
        for (int i = 0; i < 16; ++i)
#pragma unroll
            for (int rr = 0; rr < 4; ++rr) mx = fmaxf(mx, s[i][rr]);
        mx = fmaxf(mx, __shfl_xor(mx, 16)); mx = fmaxf(mx, __shfl_xor(mx, 32));
        float sum = 0.f;
#pragma unroll
        for (int i = 0; i < 16; ++i)
#pragma unroll
            for (int rr = 0; rr < 4; ++rr) { s[i][rr] = __expf(s[i][rr] - mx); sum += s[i][rr]; }
        sum += __shfl_xor(sum, 16); sum += __shfl_xor(sum, 32);
        const float inv = 1.f / sum;
        f32x4 o[4];
#pragma unroll
        for (int dt = 0; dt < 4; ++dt) o[dt] = (f32x4){0.f, 0.f, 0.f, 0.f};
#pragma unroll
        for (int kk = 0; kk < 8; ++kk) {
            u32x4 pw; pw.x = pk2(s[2 * kk][0] * inv, s[2 * kk][1] * inv); pw.y = pk2(s[2 * kk][2] * inv, s[2 * kk][3] * inv);
            pw.z = pk2(s[2 * kk + 1][0] * inv, s[2 * kk + 1][1] * inv); pw.w = pk2(s[2 * kk + 1][2] * inv, s[2 * kk + 1][3] * inv);
            const bf16x8 pf = __builtin_bit_cast(bf16x8, pw);
            const int tk = (rs + kk) * 64 + cs0 + 4 * g;
#pragma unroll
            for (int dt = 0; dt < 4; ++dt) {
                const bf16* vp = p.VNAT + ((size_t)(b * 8 + h) * 64 + dt * 16 + qi) * 2048 + tk;
                const s16x4 lo = *(const s16x4*)vp, hi = *(const s16x4*)(vp + 16);
                const bf16x8 vf = __builtin_shufflevector(lo, hi, 0, 1, 2, 3, 4, 5, 6, 7);
                o[dt] = __builtin_amdgcn_mfma_f32_16x16x32_bf16(pf, vf, o[dt], 0, 0, 0);
            }
        }
#pragma unroll
        for (int dt = 0; dt < 4; ++dt)
#pragma unroll
            for (int rr = 0; rr < 4; ++rr) {
                const size_t tg = (size_t)b * 2048 + r * 64 + c0 + 4 * g + rr;
                p.NAOUT[tg * 512 + h * 64 + dt * 16 + qi] = (bf16)f2bf(o[dt][rr]);
            }
    }
}
__global__ void __launch_bounds__(NT, 2) k_na(Params p) {
    extern __shared__ __attribute__((aligned(16))) unsigned char lds_raw[];
    phase_na(p, (LAS unsigned char*)lds_raw);
}
#define LDSTR 72
#define MATB (64 * LDSTR * 2)
__device__ __forceinline__ f32x4 mfma16(bf16x8 a, bf16x8 b, f32x4 c) { return __builtin_amdgcn_mfma_f32_16x16x32_bf16(a, b, c, 0, 0, 0); }

__device__ __forceinline__ void slab_mma(const LAS bf16* A, const LAS bf16* Bt, int w, int lane, f32x4 (&acc)[4]) {
    const int r16 = lane & 15, g = lane >> 4;
    const bf16x8 a0 = *(const LAS bf16x8*)(A + (16 * w + r16) * LDSTR + 8 * g);
    const bf16x8 a1 = *(const LAS bf16x8*)(A + (16 * w + r16) * LDSTR + 32 + 8 * g);
#pragma unroll
    for (int nt = 0; nt < 4; ++nt) {
        const bf16x8 b0 = *(const LAS bf16x8*)(Bt + (nt * 16 + r16) * LDSTR + 8 * g);
        const bf16x8 b1 = *(const LAS bf16x8*)(Bt + (nt * 16 + r16) * LDSTR + 32 + 8 * g);
        acc[nt] = mfma16(a0, b0, acc[nt]); acc[nt] = mfma16(a1, b1, acc[nt]);
    }
}

struct DnBufs { bf16* MN; bf16* QO; bf16* SB; };

__device__ __forceinline__ void conv16(const Params& p, const bf16* src, size_t hb, int t, int d0, int wch, float (&y)[16]) {
#pragma unroll
    for (int d = 0; d < 16; ++d) y[d] = 0.f;
#pragma unroll
    for (int j = 0; j < 5; ++j) {
        const int tt = t + j - 2;
        if (tt >= 0 && tt < SEQ) {
            const bf16x8 x0 = *(const bf16x8*)(src + (hb + tt) * 64 + d0), x1 = *(const bf16x8*)(src + (hb + tt) * 64 + d0 + 8);
            const float* cw = p.conv_w + j * 1536 + wch + d0;
#pragma unroll
            for (int d = 0; d < 8; ++d) { y[d] = fmaf(bf2f((unsigned short)x0[d]), cw[d], y[d]); y[8 + d] = fmaf(bf2f((unsigned short)x1[d]), cw[8 + d], y[8 + d]); }
        }
    }
#pragma unroll
    for (int d = 0; d < 16; ++d) y[d] = siluf_(y[d]);
}

__device__ __forceinline__ void phase_dnprep(const Params& p, const DnBufs& B, LAS unsigned char* lds) {
    const int tid = threadIdx.x, lane = tid & 63, wave = tid >> 6, team = wave >> 2, w = wave & 3, tt = tid & 255, G = gridDim.x;
    const int r16 = lane & 15, g = lane >> 4;
    LAS unsigned char* base = lds + team * 71680;
    LAS bf16* Kr = (LAS bf16*)(base);
    LAS bf16* Qr = (LAS bf16*)(base + MATB);
    LAS bf16* KdT = (LAS bf16*)(base + 2 * MATB);
    LAS bf16* KbT = (LAS bf16*)(base + 3 * MATB);
    LAS bf16* VbT = (LAS bf16*)(base + 4 * MATB);
    LAS bf16* IN = (LAS bf16*)(base + 5 * MATB);
    LAS float* Lm = (LAS float*)(base + 6 * MATB);
    LAS bf16* Tm = Kr; LAS bf16* WT = (LAS bf16*)Lm; LAS bf16* UT = KbT;
    LAS float* sm = (LAS float*)(lds + 143360 + team * 1024);
    LAS float* beta_s = sm; LAS float* gc_s = sm + 64;
    for (int it = blockIdx.x * 2 + team; it < 4096; it += G * 2) {
        const int cc = it & 31, dir = (it >> 5) & 1, bh = it >> 6, h = bh & 7, b = bh >> 3;
        const size_t hb = (size_t)bh * 2048;
        __syncthreads();
        if (w == 0) {
            const int s = cc * 64 + lane, t = dir ? 2047 - s : s;
            const float be = p.GATES[(size_t)dir * NTOK * 8 + hb + t];
            float gv = p.GATES[(size_t)(2 + dir) * NTOK * 8 + hb + t];
#pragma unroll
            for (int o = 1; o < 64; o <<= 1) { const float n = __shfl_up(gv, o); if (lane >= o) gv += n; }
            beta_s[lane] = be; gc_s[lane] = gv;
        }
        __syncthreads();
        {
            const int i = tt >> 2, d0 = (tt & 3) * 16;
            const int s = cc * 64 + i, t = dir ? 2047 - s : s;
            const float be = beta_s[i], gci = gc_s[i], gl = gc_s[63];
            const float e_gc = __expf(gci), e_kd = __expf(gl - gci);
            float y[16];
            conv16(p, p.QKVDN + (size_t)NTOK * 512, hb, t, d0, 512 + h * 64, y);
            float ss = 0.f;
#pragma unroll
            for (int d = 0; d < 16; ++d) ss = fmaf(y[d], y[d], ss);
            ss += __shfl_xor(ss, 1); ss += __shfl_xor(ss, 2);
            float rn = rsqrtf(ss + RMS_EPS);
#pragma unroll
            for (int d = 0; d < 16; ++d) y[d] *= rn;
            {
                u32x4 o0, o1; o0.x = pk2(y[0], y[1]); o0.y = pk2(y[2], y[3]); o0.z = pk2(y[4], y[5]); o0.w = pk2(y[6], y[7]);
                o1.x = pk2(y[8], y[9]); o1.y = pk2(y[10], y[11]); o1.z = pk2(y[12], y[13]); o1.w = pk2(y[14], y[15]);
                *(LAS u32x4*)(Kr + i * LDSTR + d0) = o0; *(LAS u32x4*)(Kr + i * LDSTR + d0 + 8) = o1;
            }
#pragma unroll
            for (int d = 0; d < 16; ++d) { KdT[(d0 + d) * LDSTR + i] = (bf16)f2bf(y[d] * e_kd); KbT[(d0 + d) * LDSTR + i] = (bf16)f2bf(y[d] * be * e_gc); }
            conv16(p, p.QKVDN, hb, t, d0, h * 64, y);
            ss = 0.f;
#pragma unroll
            for (int d = 0; d < 16; ++d) ss = fmaf(y[d], y[d], ss);
            ss += __shfl_xor(ss, 1); ss += __shfl_xor(ss, 2);
            rn = rsqrtf(ss + RMS_EPS);
#pragma unroll
            for (int d = 0; d < 16; ++d) y[d] *= rn;
            {
                u32x4 o0, o1; o0.x = pk2(y[0], y[1]); o0.y = pk2(y[2], y[3]); o0.z = pk2(y[4], y[5]); o0.w = pk2(y[6], y[7]);
                o1.x = pk2(y[8], y[9]); o1.y = pk2(y[10], y[11]); o1.z = pk2(y[12], y[13]); o1.w = pk2(y[14], y[15]);
                *(LAS u32x4*)(Qr + i * LDSTR + d0) = o0; *(LAS u32x4*)(Qr + i * LDSTR + d0 + 8) = o1;
            }
            conv16(p, p.QKVDN + (size_t)2 * NTOK * 512, hb, t, d0, 1024 + h * 64, y);
#pragma unroll
            for (int d = 0; d < 16; ++d) VbT[(d0 + d) * LDSTR + i] = (bf16)f2bf(y[d] * be);
        }
        __syncthreads();
        {
            f32x4 akk[4], aqk[4];
#pragma unroll
            for (int nt = 0; nt < 4; ++nt) { akk[nt] = (f32x4){0.f, 0.f, 0.f, 0.f}; aqk[nt] = (f32x4){0.f, 0.f, 0.f, 0.f}; }
            slab_mma(Kr, Kr, w, lane, akk);
            slab_mma(Qr, Kr, w, lane, aqk);
#pragma unroll
            for (int nt = 0; nt < 4; ++nt) {
                const int j = nt * 16 + r16; const float gcj = gc_s[j];
#pragma unroll
                for (int r = 0; r < 4; ++r) {
                    const int i = 16 * w + 4 * g + r;
                    const float dec = (j <= i) ? __expf(gc_s[i] - gcj) : 0.f;
                    Lm[i * 64 + j] = (j < i) ? beta_s[i] * akk[nt][r] * dec : 0.f;
                    IN[i * LDSTR + j] = (bf16)f2bf(aqk[nt][r] * 0.125f * dec);
                }
            }
        }
        __syncthreads();
        if (w == 0) {
            float x[64];
#pragma unroll
            for (int i = 0; i < 64; ++i) {
                float a0 = (i == lane) ? 1.f : 0.f, a1 = 0.f, a2 = 0.f, a3 = 0.f;
#pragma unroll
                for (int m = 0; m < i; ++m) {
                    const float l = Lm[i * 64 + m];
                    if ((m & 3) == 0) a0 = fmaf(-l, x[m], a0); else if ((m & 3) == 1) a1 = fmaf(-l, x[m], a1); else if ((m & 3) == 2) a2 = fmaf(-l, x[m], a2); else a3 = fmaf(-l, x[m], a3);
                }
                x[i] = (a0 + a1) + (a2 + a3);
                Tm[i * LDSTR + lane] = (bf16)f2bf(x[i]);
            }
        }
        __syncthreads();
        {
            f32x4 a[4];
#pragma unroll
            for (int nt = 0; nt < 4; ++nt) a[nt] = (f32x4){0.f, 0.f, 0.f, 0.f};
            slab_mma(Tm, KbT, w, lane, a);
#pragma unroll
            for (int nt = 0; nt < 4; ++nt) { u32x2 o; o.x = pk2(a[nt][0], a[nt][1]); o.y = pk2(a[nt][2], a[nt][3]); *(LAS u32x2*)(WT + (nt * 16 + r16) * LDSTR + 16 * w + 4 * g) = o; }
        }
        __syncthreads();
        {
            f32x4 a[4];
#pragma unroll
            for (int nt = 0; nt < 4; ++nt) a[nt] = (f32x4){0.f, 0.f, 0.f, 0.f};
            slab_mma(Tm, VbT, w, lane, a);
#pragma unroll
            for (int nt = 0; nt < 4; ++nt) { u32x2 o; o.x = pk2(a[nt][0], a[nt][1]); o.y = pk2(a[nt][2], a[nt][3]); *(LAS u32x2*)(UT + (nt * 16 + r16) * LDSTR + 16 * w + 4 * g) = o; }
        }
        __syncthreads();
        {
            const float egl = __expf(gc_s[63]);
            bf16* Mg = B.MN + (size_t)it * 8192; bf16* NTg = Mg + 4096;
            const int tc = dir ? 31 - cc : cc;
            bf16* Qg = B.QO + ((size_t)((bh * 2 + dir) * 32 + tc)) * 8192; bf16* OTg = Qg + 4096;
            f32x4 a[4];
#pragma unroll
            for (int nt = 0; nt < 4; ++nt) a[nt] = (f32x4){0.f, 0.f, 0.f, 0.f};
            slab_mma(KdT, WT, w, lane, a);
#pragma unroll
            for (int nt = 0; nt < 4; ++nt)
#pragma unroll
                for (int r = 0; r < 4; ++r) { const int ra = 16 * w + 4 * g + r, cb = nt * 16 + r16; Mg[ra * 64 + cb] = (bf16)f2bf((ra == cb ? egl : 0.f) - a[nt][r]); }
#pragma unroll
            for (int nt = 0; nt < 4; ++nt) a[nt] = (f32x4){0.f, 0.f, 0.f, 0.f};
            slab_mma(KdT, UT, w, lane, a);
#pragma unroll
            for (int nt = 0; nt < 4; ++nt) { u32x2 o; o.x = pk2(a[nt][0], a[nt][1]); o.y = pk2(a[nt][2], a[nt][3]); *(u32x2*)(NTg + (nt * 16 + r16) * 64 + 16 * w + 4 * g) = o; }
#pragma unroll
            for (int nt = 0; nt < 4; ++nt) a[nt] = (f32x4){0.f, 0.f, 0.f, 0.f};
            slab_mma(IN, WT, w, lane, a);
#pragma unroll
            for (int nt = 0; nt < 4; ++nt)
#pragma unroll
                for (int r = 0; r < 4; ++r) { const int i = 16 * w + 4 * g + r, cb = nt * 16 + r16; const int ro = dir ? 63 - i : i;
                    const float qd = bf2f(Qr[i * LDSTR + cb]) * 0.125f * __expf(gc_s[i]);
                    Qg[ro * 64 + cb] = (bf16)f2bf(qd - a[nt][r]); }
#pragma unroll
            for (int nt = 0; nt < 4; ++nt) a[nt] = (f32x4){0.f, 0.f, 0.f, 0.f};
            slab_mma(IN, UT, w, lane, a);
#pragma unroll
            for (int nt = 0; nt < 4; ++nt) { const int i0 = 16 * w + 4 * g; u32x2 o;
                if (dir) { o.x = pk2(a[nt][3], a[nt][2]); o.y = pk2(a[nt][1], a[nt][0]); *(u32x2*)(OTg + (nt * 16 + r16) * 64 + 60 - i0) = o; }
                else { o.x = pk2(a[nt][0], a[nt][1]); o.y = pk2(a[nt][2], a[nt][3]); *(u32x2*)(OTg + (nt * 16 + r16) * 64 + i0) = o; } }
        }
    }
}

__device__ __forceinline__ void phase_dnscan(const Params& p, const DnBufs& B, LAS unsigned char* lds) {
    const int tid = threadIdx.x, lane = tid & 63, wave = tid >> 6;
    const int r16 = lane & 15, g = lane >> 4;
    if (blockIdx.x >= 128 || wave >= 4) return;
    const int chain = blockIdx.x, vp = wave;
    LAS bf16* St = (LAS bf16*)(lds + wave * (16 * LDSTR * 2));
    f32x4 sacc[4];
#pragma unroll
    for (int mt = 0; mt < 4; ++mt) sacc[mt] = (f32x4){0.f, 0.f, 0.f, 0.f};
    for (int cc = 0; cc < 32; ++cc) {
        const size_t item = (size_t)chain * 32 + cc;
        const bf16* Mg = B.MN + item * 8192; const bf16* NTg = Mg + 4096;
        bf16* Sg = B.SB + item * 4096;
#pragma unroll
        for (int mt = 0; mt < 4; ++mt) { u32x2 o; o.x = pk2(sacc[mt][0], sacc[mt][1]); o.y = pk2(sacc[mt][2], sacc[mt][3]);
            *(u32x2*)(Sg + (vp * 16 + r16) * 64 + mt * 16 + 4 * g) = o; *(LAS u32x2*)(St + r16 * LDSTR + mt * 16 + 4 * g) = o; }
        LDS_WAIT();
        const bf16x8 s0 = *(const LAS bf16x8*)(St + r16 * LDSTR + 8 * g), s1 = *(const LAS bf16x8*)(St + r16 * LDSTR + 32 + 8 * g);
#pragma unroll
        for (int mt = 0; mt < 4; ++mt) {
            const u32x2 nv = *(const u32x2*)(NTg + (vp * 16 + r16) * 64 + mt * 16 + 4 * g);
            f32x4 a = {bf2f(nv.x & 0xffffu), bf2f(nv.x >> 16), bf2f(nv.y & 0xffffu), bf2f(nv.y >> 16)};
            const bf16x8 m0 = *(const bf16x8*)(Mg + (mt * 16 + r16) * 64 + 8 * g), m1 = *(const bf16x8*)(Mg + (mt * 16 + r16) * 64 + 32 + 8 * g);
            a = mfma16(m0, s0, a); a = mfma16(m1, s1, a);
            sacc[mt] = a;
        }
    }
}

__device__ __forceinline__ void phase_dnout(const Params& p, const DnBufs& B) {
    const int tid = threadIdx.x, lane = tid & 63, wave = tid >> 6, G = gridDim.x;
    const int r16 = lane & 15, g = lane >> 4;
    for (int task = blockIdx.x * 8 + wave; task < 8192; task += G * 8) {
        const int w = task & 3, tc = (task >> 2) & 31, bh = task >> 7, h = bh & 7, b = bh >> 3;
        f32x4 acc[4];
#pragma unroll
        for (int vt = 0; vt < 4; ++vt) acc[vt] = (f32x4){0.f, 0.f, 0.f, 0.f};
#pragma unroll
        for (int dir = 0; dir < 2; ++dir) {
            const int cc = dir ? 31 - tc : tc;
            const bf16* Qg = B.QO + ((size_t)((bh * 2 + dir) * 32 + tc)) * 8192; const bf16* OTg = Qg + 4096;
            const bf16* Sg = B.SB + ((size_t)((bh * 2 + dir) * 32 + cc)) * 4096;
            const bf16x8 q0 = *(const bf16x8*)(Qg + (16 * w + r16) * 64 + 8 * g), q1 = *(const bf16x8*)(Qg + (16 * w + r16) * 64 + 32 + 8 * g);
#pragma unroll
            for (int vt = 0; vt < 4; ++vt) {
                const u32x2 ov = *(const u32x2*)(OTg + (vt * 16 + r16) * 64 + 16 * w + 4 * g);
                acc[vt][0] += bf2f(ov.x & 0xffffu); acc[vt][1] += bf2f(ov.x >> 16); acc[vt][2] += bf2f(ov.y & 0xffffu); acc[vt][3] += bf2f(ov.y >> 16);
                const bf16x8 s0 = *(const bf16x8*)(Sg + (vt * 16 + r16) * 64 + 8 * g), s1 = *(const bf16x8*)(Sg + (vt * 16 + r16) * 64 + 32 + 8 * g);
                acc[vt] = mfma16(q0, s0, acc[vt]); acc[vt] = mfma16(q1, s1, acc[vt]);
            }
        }
#pragma unroll
        for (int r = 0; r < 4; ++r) {
            float ss = 0.f;
#pragma unroll
            for (int vt = 0; vt < 4; ++vt) ss = fmaf(acc[vt][r], acc[vt][r], ss);
            ss += __shfl_xor(ss, 1); ss += __shfl_xor(ss, 2); ss += __shfl_xor(ss, 4); ss += __shfl_xor(ss, 8);
            const float rn = rsqrtf(ss * (1.f / 64.f) + RMS_EPS);
            const int t = tc * 64 + 16 * w + 4 * g + r;
#pragma unroll
            for (int vt = 0; vt < 4; ++vt) {
                const int v = vt * 16 + r16;
                const float z = bf2f(p.Z[((size_t)bh * 2048 + t) * 64 + v]);
                p.DNOUT[((size_t)b * 2048 + t) * 512 + h * 64 + v] = (bf16)f2bf(acc[vt][r] * rn * p.norm_w[v] * z);
            }
        }
    }
}

__global__ void __launch_bounds__(NT, 2) k_dnprep(Params p, DnBufs B) {
    extern __shared__ __attribute__((aligned(16))) unsigned char lds_raw[];
    phase_dnprep(p, B, (LAS unsigned char*)lds_raw);
}
__global__ void __launch_bounds__(NT, 2) k_dnscan(Params p, DnBufs B) {
    extern __shared__ __attribute__((aligned(16))) unsigned char lds_raw[];
    phase_dnscan(p, B, (LAS unsigned char*)lds_raw);
}
__global__ void __launch_bounds__(NT, 2) k_dnout(Params p, DnBufs B) {
    phase_dnout(p, B);
}
struct MixBufs { bf16* GB; bf16* MERGED; float* V; };
template <int MODE>
struct EpiMerge {
    static constexpr bool PERM = true, AFTER_DRAIN = false;
    bf16* GB; bf16* MG;
    __device__ __forceinline__ void operator()(const pg8::f32x4 (&acc)[2][2][4][2], const pg8::Unit& u, int wr, int wc, int fr, int fq) const {
#pragma unroll
        for (int ai = 0; ai < 2; ++ai)
#pragma unroll
            for (int m = 0; m < 4; ++m) {
                const size_t row = (size_t)u.pm * 256 + ai * 128 + wr * 64 + m * 16 + fr;
#pragma unroll
                for (int bj = 0; bj < 2; ++bj) {
                    const int col = u.pn * 256 + bj * 128 + wc * 32 + 8 * fq;
                    const pg8::f32x4 v0 = acc[ai][bj][m][0], v1 = acc[ai][bj][m][1];
                    float e[8] = {v0[0], v0[1], v0[2], v0[3], v1[0], v1[1], v1[2], v1[3]};
                    if (MODE == 0) {
#pragma unroll
                        for (int j = 0; j < 8; ++j) e[j] = sigmoidf_(e[j]);
                    } else {
                        const u32x4 gw = *(const u32x4*)(GB + row * 1024 + col);
                        const unsigned gws[4] = {gw.x, gw.y, gw.z, gw.w};
#pragma unroll
                        for (int j = 0; j < 4; ++j) { e[2 * j] *= bf2f(gws[j] & 0xffffu); e[2 * j + 1] *= bf2f(gws[j] >> 16); }
                        if (MODE == 2) {
                            const u32x4 mw = *(const u32x4*)(MG + row * 1024 + col);
                            const unsigned mws[4] = {mw.x, mw.y, mw.z, mw.w};
#pragma unroll
                            for (int j = 0; j < 4; ++j) { e[2 * j] += bf2f(mws[j] & 0xffffu); e[2 * j + 1] += bf2f(mws[j] >> 16); }
                        }
                    }
                    u32x4 w; w.x = pk2(e[0], e[1]); w.y = pk2(e[2], e[3]); w.z = pk2(e[4], e[5]); w.w = pk2(e[6], e[7]);
                    *(u32x4*)((MODE == 0 ? GB : MG) + row * 1024 + col) = w;
                }
            }
    }
};
struct EpiOutProj {
    static constexpr bool PERM = false, AFTER_DRAIN = false;
    const float* x; float* V;
    __device__ __forceinline__ void operator()(const pg8::f32x4 (&acc)[2][2][4][2], const pg8::Unit& u, int wr, int wc, int fr, int fq) const {
#pragma unroll
        for (int ai = 0; ai < 2; ++ai)
#pragma unroll
            for (int m = 0; m < 4; ++m) {
                const size_t row = (size_t)u.pm * 256 + ai * 128 + wr * 64 + m * 16 + fr;
#pragma unroll
                for (int bj = 0; bj < 2; ++bj)
#pragma unroll
                    for (int n = 0; n < 2; ++n) {
                        const int col = u.pn * 256 + bj * 128 + wc * 32 + 16 * n + 4 * fq;
                        const f32x4 xv = *(const f32x4*)(x + row * 1024 + col);
                        const pg8::f32x4 a = acc[ai][bj][m][n];
                        f32x4 o = {ALPHA * xv[0] + a[0], ALPHA * xv[1] + a[1], ALPHA * xv[2] + a[2], ALPHA * xv[3] + a[3]};
                        *(f32x4*)(V + row * 1024 + col) = o;
                    }
            }
    }
};
__device__ __forceinline__ void phase_merge(const Params& p, const MixBufs& B, LAS unsigned char* lds) {
    pg8::StaticOrder S; S.init(NTOK, 1024, gridDim.x, (int)blockIdx.x);
    { pg8::Gemm g{p.XB, p.WG, NTOK, 1024, 1024}; EpiMerge<0> E{B.GB, B.MERGED}; pg8::gemm_phase<EpiMerge<0>, pg8::StaticOrder, true, true>(lds, g, S, E); }
    { pg8::Gemm g{p.NAOUT, p.WPNA, NTOK, 1024, 512}; EpiMerge<1> E{B.GB, B.MERGED}; pg8::gemm_phase<EpiMerge<1>, pg8::StaticOrder, true, true>(lds, g, S, E); }
    { pg8::Gemm g{p.XB, p.WG + (size_t)1024 * 1024, NTOK, 1024, 1024}; EpiMerge<0> E{B.GB, B.MERGED}; pg8::gemm_phase<EpiMerge<0>, pg8::StaticOrder, true, true>(lds, g, S, E); }
    { pg8::Gemm g{p.DNOUT, p.WPDN, NTOK, 1024, 512}; EpiMerge<2> E{B.GB, B.MERGED}; pg8::gemm_phase<EpiMerge<2>, pg8::StaticOrder, true, true>(lds, g, S, E); }
}
__device__ __forceinline__ void phase_outproj(const Params& p, const MixBufs& B, LAS unsigned char* lds) {
    pg8::StaticOrder S; S.init(NTOK, 1024, gridDim.x, (int)blockIdx.x);
    pg8::Gemm g{B.MERGED, p.WOUT, NTOK, 1024, 1024}; EpiOutProj E{p.x, B.V};
    pg8::gemm_phase<EpiOutProj, pg8::StaticOrder, true, true>(lds, g, S, E);
}
__global__ void __launch_bounds__(NT, 2) k_merge(Params p, MixBufs B) {
    extern __shared__ __attribute__((aligned(16))) unsigned char lds_raw[];
    phase_merge(p, B, (LAS unsigned char*)lds_raw);
}
__global__ void __launch_bounds__(NT, 2) k_outproj(Params p, MixBufs B) {
    extern __shared__ __attribute__((aligned(16))) unsigned char lds_raw[];
    phase_outproj(p, B, (LAS unsigned char*)lds_raw);
}
struct MoeBufs {
    const float* V;
    bf16 *X1B, *XS, *HID, *YPART;
    bf16 *RWH, *RWL;
    int* CNT;
    int* ROUTE;
    float* ROUTEP;
    int* ROWINFO;
    float* ROWPW;
    float* STATS;
    int kdown, pad0;
};
#define XSTR 1032
#define TAB_OFF 131072

__device__ __forceinline__ void phase0_router(const Params& p, const MoeBufs& B) {
    const size_t gt = (size_t)blockIdx.x * NT + threadIdx.x, GT = (size_t)gridDim.x * NT;
    for (size_t i = gt; i < 48 * 1024; i += GT) {
        const int n = (int)(i >> 10), k = (int)(i & 1023);
        const float w = n < 4 ? p.wrg[k * 4 + n] : (n < 36 ? p.wre[k * 32 + n - 4] : 0.f);
        const unsigned hi = f2bf(w); const float lo = w - bf2f(hi);
        B.RWH[i] = (bf16)hi; B.RWL[i] = (bf16)f2bf(lo);
    }
}

__device__ __forceinline__ float wave_sum64(float v) {
#pragma unroll
    for (int o = 1; o < 64; o <<= 1) v += __shfl_xor(v, o);
    return v;
}

__device__ __forceinline__ void phase_ln1(const Params& p, const MoeBufs& B, LAS unsigned char* lds) {
    const int tid = threadIdx.x, lane = tid & 63, wave = tid >> 6;
    const int r16 = lane & 15, g = lane >> 4;
    LAS bf16* XH = (LAS bf16*)lds;
    LAS bf16* XL = (LAS bf16*)(lds + 16 * XSTR * 2);
    LAS float* PART = (LAS float*)(lds + 2 * 16 * XSTR * 2);
    LAS float* LOG = PART + 8 * 16 * 48;
    LAS int* hist = (LAS int*)(LOG + 16 * 36);
    if (tid < 32) hist[tid] = 0;
    for (int i = blockIdx.x * NT + tid; i < 40960; i += gridDim.x * NT) B.ROWINFO[i] = -1;
    for (int blk = blockIdx.x; blk < 256; blk += gridDim.x) {
        for (int itn = 0; itn < 4; ++itn) {
            __syncthreads();
#pragma unroll
            for (int q = 0; q < 2; ++q) {
                const int lt = 2 * wave + q; const size_t tg = (size_t)blk * 64 + itn * 16 + lt;
                f32x4 v[4]; float s = 0.f;
#pragma unroll
                for (int j = 0; j < 4; ++j) { v[j] = *(const f32x4*)(B.V + tg * 1024 + 4 * lane + 256 * j); s += (v[j][0] + v[j][1]) + (v[j][2] + v[j][3]); }
                const float mu = wave_sum64(s) * (1.f / 1024.f);
                float qq = 0.f;
#pragma unroll
                for (int j = 0; j < 4; ++j) { v[j] = v[j] - mu; qq += (v[j][0] * v[j][0] + v[j][1] * v[j][1]) + (v[j][2] * v[j][2] + v[j][3] * v[j][3]); }
                const float rstd = rsqrtf(wave_sum64(qq) * (1.f / 1024.f) + LN_EPS);
                if (lane == 0) { B.STATS[tg * 2] = mu; B.STATS[tg * 2 + 1] = rstd; }
#pragma unroll
                for (int j = 0; j < 4; ++j) {
                    const int c = 4 * lane + 256 * j;
                    const f32x4 gg = *(const f32x4*)(p.ln1_g + c), bb = *(const f32x4*)(p.ln1_b + c);
                    float y[4]; unsigned hi[4]; float lo[4];
#pragma unroll
                    for (int e = 0; e < 4; ++e) { y[e] = v[j][e] * rstd * gg[e] + bb[e]; hi[e] = f2bf(y[e]); lo[e] = y[e] - bf2f(hi[e]); }
                    u32x2 hw; hw.x = hi[0] | (hi[1] << 16); hw.y = hi[2] | (hi[3] << 16);
                    u32x2 lw; lw.x = pk2(lo[0], lo[1]); lw.y = pk2(lo[2], lo[3]);
                    *(u32x2*)(B.X1B + tg * 1024 + c) = hw;
                    *(LAS u32x2*)(XH + lt * XSTR + c) = hw; *(LAS u32x2*)(XL + lt * XSTR + c) = lw;
                }
            }
            __syncthreads();
            {
                f32x4 acc[3];
#pragma unroll
                for (int nt = 0; nt < 3; ++nt) acc[nt] = (f32x4){0.f, 0.f, 0.f, 0.f};
#pragma unroll
                for (int ks = 0; ks < 4; ++ks) {
                    const int k0 = wave * 128 + ks * 32 + 8 * g;
                    const bf16x8 ah = *(const LAS bf16x8*)(XH + r16 * XSTR + k0), al = *(const LAS bf16x8*)(XL + r16 * XSTR + k0);
#pragma unroll
                    for (int nt = 0; nt < 3; ++nt) {
                        const bf16x8 bh = *(const bf16x8*)(B.RWH + (size_t)(nt * 16 + r16) * 1024 + k0), bl = *(const bf16x8*)(B.RWL + (size_t)(nt * 16 + r16) * 1024 + k0);
                        acc[nt] = mfma16(ah, bh, acc[nt]); acc[nt] = mfma16(ah, bl, acc[nt]); acc[nt] = mfma16(al, bh, acc[nt]);
                    }
                }
#pragma unroll
                for (int nt = 0; nt < 3; ++nt)
#pragma unroll
                    for (int r = 0; r < 4; ++r) PART[(wave * 16 + 4 * g + r) * 48 + nt * 16 + r16] = acc[nt][r];
            }
            __syncthreads();
            for (int idx = tid; idx < 16 * 36; idx += NT) {
                const int tk = idx / 36, n = idx % 36;
                float a = n < 4 ? p.brg[n] : p.bre[n - 4];
#pragma unroll
                for (int w2 = 0; w2 < 8; ++w2) a += PART[(w2 * 16 + tk) * 48 + n];
                LOG[tk * 36 + n] = a;
            }
            __syncthreads();
            if (tid < 16) {
                const LAS float* lg = LOG + tid * 36; const size_t tg = (size_t)blk * 64 + itn * 16 + tid;
                int gi = 0; float gm = lg[0];
                for (int q = 1; q < 4; ++q) if (lg[q] > gm) { gm = lg[q]; gi = q; }
                float gs = 0.f;
                for (int q = 0; q < 4; ++q) gs += expf(lg[q] - gm);
                const float gp = 1.f / gs;
                const LAS float* el = lg + 4 + gi * 8;
                int i1 = 0; float l1 = el[0];
                for (int e = 1; e < 8; ++e) if (el[e] > l1) { l1 = el[e]; i1 = e; }
                int i2 = -1; float l2 = -3.0e38f;
                for (int e = 0; e < 8; ++e) if (e != i1 && el[e] > l2) { l2 = el[e]; i2 = e; }
                const float e2 = expf(l2 - l1);
                const int e0 = gi * 8 + i1, e1 = gi * 8 + i2;
                const int r0 = atomicAdd((int*)&hist[e0], 1), r1 = atomicAdd((int*)&hist[e1], 1);
                B.ROUTE[tg * 4] = e0; B.ROUTE[tg * 4 + 1] = e1; B.ROUTE[tg * 4 + 2] = r0; B.ROUTE[tg * 4 + 3] = r1;
                B.ROUTEP[tg * 2] = gp / (1.f + e2); B.ROUTEP[tg * 2 + 1] = gp * e2 / (1.f + e2);
            }
        }
        __syncthreads();
        if (tid < 32) { B.CNT[blk * 32 + tid] = hist[tid]; hist[tid] = 0; }
    }
}

__device__ __forceinline__ void moe_tables(const MoeBufs& B, LAS unsigned char* lds, int nj, int blk) {
    const int tid = threadIdx.x;
    LAS int* tab = (LAS int*)(lds + TAB_OFF);
    LAS int* scr = tab + 160;
    {
        const int e = tid & 31, q = tid >> 5; int tot = 0, pre = 0;
        for (int b2 = q * 16; b2 < q * 16 + 16; ++b2) { const int c = B.CNT[b2 * 32 + e]; tot += c; if (b2 < blk) pre += c; }
        scr[q * 64 + e] = tot; scr[q * 64 + 32 + e] = pre;
    }
    __syncthreads();
    if (tid < 32) { int tot = 0, pre = 0; for (int q = 0; q < 16; ++q) { tot += scr[q * 64 + tid]; pre += scr[q * 64 + 32 + tid]; } tab[66 + tid] = tot; tab[99 + tid] = pre; }
    __syncthreads();
    if (tid == 0) { int cum = 0, off = 0; for (int e = 0; e < 32; ++e) { tab[e] = cum; tab[33 + e] = off; const int nrt = (tab[66 + e] + 255) >> 8; cum += nrt * nj; off += nrt; } tab[32] = cum; }
    __syncthreads();
}

__device__ __forceinline__ void phase_gather(const Params& p, const MoeBufs& B, LAS unsigned char* lds) {
    const int tid = threadIdx.x, lane = tid & 63, wave = tid >> 6;
    LAS int* tab = (LAS int*)(lds + TAB_OFF);
    for (int blk = blockIdx.x; blk < 256; blk += gridDim.x) {
    moe_tables(B, lds, 2, blk);
    for (int sl = wave; sl < 128; sl += 8) {
        const int lt = sl >> 1, k = sl & 1; const size_t tg = (size_t)blk * 64 + lt;
        const int e = B.ROUTE[tg * 4 + k], lr = B.ROUTE[tg * 4 + 2 + k];
        const size_t row = (size_t)tab[33 + e] * 256 + tab[99 + e] + lr;
        const u32x4 a = *(const u32x4*)(B.X1B + tg * 1024 + lane * 8), b2 = *(const u32x4*)(B.X1B + tg * 1024 + 512 + lane * 8);
        *(u32x4*)(B.XS + row * 1024 + lane * 8) = a; *(u32x4*)(B.XS + row * 1024 + 512 + lane * 8) = b2;
        if (lane == 0) { B.ROWINFO[row] = (int)tg * 2 + k; B.ROWPW[row] = B.ROUTEP[tg * 2 + k]; }
    }
    __syncthreads();
    }
}

struct MoeSched {
    const LAS int* tab; int G, c, nj;
    __device__ __forceinline__ bool next(int i, pg8::Unit& u) const {
        const int L = i * G + c; if (L >= tab[32]) return false;
        int e = 0;
#pragma unroll
        for (int k = 1; k < 32; ++k) e += (L >= tab[k]) ? 1 : 0;
        const int rem = L - tab[e], j = rem % nj, rt = rem / nj;
        u.pm = tab[33 + e] + rt; u.pn = e * nj + j; return true;
    }
    __device__ __forceinline__ void a_ready(const pg8::Unit&) const {}
    __device__ __forceinline__ void done(const pg8::Unit&) const {}
};
struct EpiGateUp {
    static constexpr bool PERM = true, AFTER_DRAIN = false;
    bf16* HID; const float* ROWPW;
    __device__ __forceinline__ void operator()(const pg8::f32x4 (&acc)[2][2][4][2], const pg8::Unit& u, int wr, int wc, int fr, int fq) const {
#pragma unroll
        for (int ai = 0; ai < 2; ++ai)
#pragma unroll
            for (int m = 0; m < 4; ++m) {
                const size_t row = (size_t)u.pm * 256 + ai * 128 + wr * 64 + m * 16 + fr;
                const float pw = ROWPW[row];
                const int f = (u.pn & 1) * 128 + wc * 32 + 8 * fq;
                const pg8::f32x4 g0 = acc[ai][0][m][0], g1 = acc[ai][0][m][1], u0 = acc[ai][1][m][0], u1 = acc[ai][1][m][1];
                float e[8];
#pragma unroll
                for (int j = 0; j < 4; ++j) { e[j] = siluf_(g0[j]) * u0[j] * pw; e[4 + j] = siluf_(g1[j]) * u1[j] * pw; }
                u32x4 w; w.x = pk2(e[0], e[1]); w.y = pk2(e[2], e[3]); w.z = pk2(e[4], e[5]); w.w = pk2(e[6], e[7]);
                *(u32x4*)(HID + row * 256 + f) = w;
            }
    }
};
struct EpiDown {
    static constexpr bool PERM = true, AFTER_DRAIN = false;
    bf16* YPART; const int* ROWINFO;
    __device__ __forceinline__ void operator()(const pg8::f32x4 (&acc)[2][2][4][2], const pg8::Unit& u, int wr, int wc, int fr, int fq) const {
        const int j = u.pn & 3;
#pragma unroll
        for (int ai = 0; ai < 2; ++ai)
#pragma unroll
            for (int m = 0; m < 4; ++m) {
                const int row = u.pm * 256 + ai * 128 + wr * 64 + m * 16 + fr;
                asm volatile("" ::: "memory");
                const int info = ROWINFO[row];
                if (info >= 0) {
                    const size_t tg = (size_t)(info >> 1); const int k = info & 1;
#pragma unroll
                    for (int bj = 0; bj < 2; ++bj) {
                        const int col = j * 256 + bj * 128 + wc * 32 + 8 * fq;
                        const pg8::f32x4 v0 = acc[ai][bj][m][0], v1 = acc[ai][bj][m][1];
                        u32x4 w; w.x = pk2(v0[0], v0[1]); w.y = pk2(v0[2], v0[3]); w.z = pk2(v1[0], v1[1]); w.w = pk2(v1[2], v1[3]);
                        *(u32x4*)(YPART + ((size_t)k * NTOK + tg) * 1024 + col) = w;
                    }
                }
            }
    }
};
__device__ __forceinline__ void phase_moe1(const Params& p, const MoeBufs& B, LAS unsigned char* lds) {
    moe_tables(B, lds, 2, 0);
    MoeSched S{(const LAS int*)(lds + TAB_OFF), (int)gridDim.x, (int)blockIdx.x, 2};
    pg8::Gemm g{B.XS, p.WGU, 0, 0, 1024}; EpiGateUp E{B.HID, B.ROWPW};
    pg8::gemm_phase<EpiGateUp, MoeSched, true, true>(lds, g, S, E);
}
__device__ __forceinline__ void phase_moe2(const Params& p, const MoeBufs& B, LAS unsigned char* lds) {
    moe_tables(B, lds, 4, 0);
    MoeSched S{(const LAS int*)(lds + TAB_OFF), (int)gridDim.x, (int)blockIdx.x, 4};
    pg8::Gemm g{B.HID, p.WD, 0, 0, B.kdown}; EpiDown E{B.YPART, B.ROWINFO};
    pg8::gemm_phase<EpiDown, MoeSched, true, true>(lds, g, S, E);
}
__device__ __forceinline__ void phase_ln2(const Params& p, const MoeBufs& B) {
    const int tid = threadIdx.x, lane = tid & 63, wave = tid >> 6;
    for (size_t tg = (size_t)blockIdx.x * 8 + wave; tg < NTOK; tg += (size_t)gridDim.x * 8) {
        const float mu1 = B.STATS[tg * 2], rstd1 = B.STATS[tg * 2 + 1];
        f32x4 v[4]; float s = 0.f;
#pragma unroll
        for (int j = 0; j < 4; ++j) {
            const int c = 4 * lane + 256 * j;
            const f32x4 x = *(const f32x4*)(B.V + tg * 1024 + c);
            const f32x4 gg = *(const f32x4*)(p.ln1_g + c), bb = *(const f32x4*)(p.ln1_b + c);
            const u32x2 y0 = *(const u32x2*)(B.YPART + tg * 1024 + c), y1 = *(const u32x2*)(B.YPART + ((size_t)NTOK + tg) * 1024 + c);
            const float ya[4] = {bf2f(y0.x & 0xffffu) + bf2f(y1.x & 0xffffu), bf2f(y0.x >> 16) + bf2f(y1.x >> 16), bf2f(y0.y & 0xffffu) + bf2f(y1.y & 0xffffu), bf2f(y0.y >> 16) + bf2f(y1.y >> 16)};
#pragma unroll
            for (int e = 0; e < 4; ++e) { v[j][e] = ALPHA * ((x[e] - mu1) * rstd1 * gg[e] + bb[e]) + ya[e]; s += v[j][e]; }
        }
        const float mu = wave_sum64(s) * (1.f / 1024.f);
        float qq = 0.f;
#pragma unroll
        for (int j = 0; j < 4; ++j) { v[j] = v[j] - mu; qq += (v[j][0] * v[j][0] + v[j][1] * v[j][1]) + (v[j][2] * v[j][2] + v[j][3] * v[j][3]); }
        const float rstd = rsqrtf(wave_sum64(qq) * (1.f / 1024.f) + LN_EPS);
#pragma unroll
        for (int j = 0; j < 4; ++j) {
            const int c = 4 * lane + 256 * j;
            const f32x4 gg = *(const f32x4*)(p.ln2_g + c), bb = *(const f32x4*)(p.ln2_b + c);
            f32x4 o;
#pragma unroll
            for (int e = 0; e < 4; ++e) o[e] = v[j][e] * rstd * gg[e] + bb[e];
            *(f32x4*)(p.out + tg * 1024 + c) = o;
        }
    }
}
__global__ void __launch_bounds__(NT, 2) k_router_w(Params p, MoeBufs B) { phase0_router(p, B); }
__global__ void __launch_bounds__(NT, 2) k_ln1(Params p, MoeBufs B) {
    extern __shared__ __attribute__((aligned(16))) unsigned char lds_raw[];
    phase_ln1(p, B, (LAS unsigned char*)lds_raw);
}
__global__ void __launch_bounds__(NT, 2) k_gather(Params p, MoeBufs B) {
    extern __shared__ __attribute__((aligned(16))) unsigned char lds_raw[];
    phase_gather(p, B, (LAS unsigned char*)lds_raw);
}
__global__ void __launch_bounds__(NT, 2) k_moe1(Params p, MoeBufs B) {
    extern __shared__ __attribute__((aligned(16))) unsigned char lds_raw[];
    phase_moe1(p, B, (LAS unsigned char*)lds_raw);
}
__global__ void __launch_bounds__(NT, 2) k_moe2(Params p, MoeBufs B) {
    extern __shared__ __attribute__((aligned(16))) unsigned char lds_raw[];
    phase_moe2(p, B, (LAS unsigned char*)lds_raw);
}
__global__ void __launch_bounds__(NT, 2) k_ln2(Params p, MoeBufs B) { phase_ln2(p, B); }
template <bool ABF16>
__global__ void __launch_bounds__(256) gemm_f32_kernel(const void* __restrict__ Av, const float* __restrict__ B, float* __restrict__ C,
                                                       int M, int N, int K, int lda, int ldb, int ldc) {
    __shared__ float As[16][68];
    __shared__ float Bs[16][68];
    const int tx = threadIdx.x & 15, ty = threadIdx.x >> 4;
    const int m0 = blockIdx.y * 64, n0 = blockIdx.x * 64;
    float acc[4][4];
#pragma unroll
    for (int i = 0; i < 4; ++i)
#pragma unroll
        for (int j = 0; j < 4; ++j) acc[i][j] = 0.f;
    for (int k0 = 0; k0 < K; k0 += 16) {
#pragma unroll
        for (int i = 0; i < 4; ++i) {
            const int e = threadIdx.x + i * 256;
            const int m = e >> 4, k = e & 15;
            float v = 0.f;
            if (m0 + m < M) v = ABF16 ? bf2f(((const bf16*)Av)[(size_t)(m0 + m) * lda + k0 + k]) : ((const float*)Av)[(size_t)(m0 + m) * lda + k0 + k];
            As[k][m] = v;
        }
#pragma unroll
        for (int i = 0; i < 4; ++i) {
            const int e = threadIdx.x + i * 256;
            const int k = e >> 6, n = e & 63;
            Bs[k][n] = (n0 + n < N) ? B[(size_t)(k0 + k) * ldb + n0 + n] : 0.f;
        }
        __syncthreads();
#pragma unroll
        for (int k = 0; k < 16; ++k) {
            float a[4], b[4];
#pragma unroll
            for (int i = 0; i < 4; ++i) a[i] = As[k][ty * 4 + i];
#pragma unroll
            for (int j = 0; j < 4; ++j) b[j] = Bs[k][tx * 4 + j];
#pragma unroll
            for (int i = 0; i < 4; ++i)
#pragma unroll
                for (int j = 0; j < 4; ++j) acc[i][j] = fmaf(a[i], b[j], acc[i][j]);
        }
        __syncthreads();
    }
#pragma unroll
    for (int i = 0; i < 4; ++i)
#pragma unroll
        for (int j = 0; j < 4; ++j) {
            const int m = m0 + ty * 4 + i, n = n0 + tx * 4 + j;
            if (m < M && n < N) C[(size_t)m * ldc + n] = acc[i][j];
        }
}

__global__ void __launch_bounds__(256) ref_inproj_epi_kernel(Params p, const float* __restrict__ h, int b) {
    const int t = blockIdx.x;
    const float* hr = h + (size_t)t * D_IN;
    for (int c = threadIdx.x; c < 3584; c += 256) {
        const int sec = c >> 9, head = (c >> 6) & 7, d = c & 63;
        const size_t hm = ((size_t)(b * 8 + head) * 2048 + t) * 64 + d;
        const float v = hr[c];
        if (sec == 0) p.QNA[hm] = (bf16)f2bf(v * 0.125f);
        else if (sec == 1) p.KNA[hm] = (bf16)f2bf(v);
        else if (sec == 2) p.VNAT[((size_t)(b * 8 + head) * 64 + d) * 2048 + t] = (bf16)f2bf(v);
        else if (sec < 6) p.QKVDN[(size_t)(sec - 3) * NTOK * 512 + hm] = (bf16)f2bf(v);
        else p.Z[hm] = (bf16)f2bf(siluf_(v));
    }
    if (threadIdx.x < 32) {
        const int type = threadIdx.x >> 3, j = threadIdx.x & 7;
        const float e = hr[3584 + threadIdx.x];
        float val;
        if (type < 2) val = sigmoidf_(e);
        else if (type == 2) val = -expf(p.a_log_f[j]) * softplusf_(e + p.dtb_f[j]);
        else val = -expf(p.a_log_b[j]) * softplusf_(e + p.dtb_b[j]);
        p.GATES[(size_t)type * NTOK * 8 + ((size_t)b * 8 + j) * 2048 + t] = val;
    }
}

__global__ void __launch_bounds__(128) ref_na_attn_kernel(Params p) {
    const int tg = blockIdx.x, hd = blockIdx.y;
    const int b = tg >> 11, t = tg & 2047;
    const int r = t >> 6, c = t & 63;
    int rs = r - 4; rs = rs < 0 ? 0 : (rs > 24 ? 24 : rs);
    int cs = c - 8; cs = cs < 0 ? 0 : (cs > 48 ? 48 : cs);
    __shared__ float qs[64];
    __shared__ float ps[128];
    __shared__ float red[128];
    const int j = threadIdx.x;
    const size_t hb = (size_t)(b * 8 + hd) * 2048;
    if (j < 64) qs[j] = bf2f(p.QNA[(hb + t) * 64 + j]);
    __syncthreads();
    const int kr = rs + (j >> 4), kc = cs + (j & 15);
    const int kt = kr * 64 + kc;
    const bf16* kp = p.KNA + (hb + kt) * 64;
    float s = 0.f;
    for (int d = 0; d < 64; ++d) s = fmaf(qs[d], bf2f(kp[d]), s);
    s += p.rpb[(hd * 15 + (kr - r + 7)) * 31 + (kc - c + 15)];
    red[j] = s;
    __syncthreads();
    for (int o = 64; o > 0; o >>= 1) { if (j < o) red[j] = fmaxf(red[j], red[j + o]); __syncthreads(); }
    const float mx = red[0];
    __syncthreads();
    const float pe = expf(s - mx);
    red[j] = pe;
    __syncthreads();
    for (int o = 64; o > 0; o >>= 1) { if (j < o) red[j] += red[j + o]; __syncthreads(); }
    const float sum = red[0];
    ps[j] = pe / sum;
    __syncthreads();
    if (j < 64) {
        float o = 0.f;
        const bf16* vp = p.VNAT + ((size_t)(b * 8 + hd) * 64 + j) * 2048;
        for (int jj = 0; jj < 128; ++jj) {
            const int kt2 = (rs + (jj >> 4)) * 64 + cs + (jj & 15);
            o = fmaf(ps[jj], bf2f(vp[kt2]), o);
        }
        p.NAOUT[(size_t)tg * 512 + hd * 64 + j] = (bf16)f2bf(o);
    }
}

__global__ void __launch_bounds__(64) ref_dn_conv_kernel(Params p, int b, float* __restrict__ qc, float* __restrict__ kc, float* __restrict__ vc) {
    const int t = blockIdx.x, hd = blockIdx.y, d = threadIdx.x;
    const int ch = hd * 64 + d;
    const size_t hb = (size_t)(b * 8 + hd) * 2048;
    const bf16* Q = p.QKVDN; const bf16* K = p.QKVDN + (size_t)NTOK * 512; const bf16* V = p.QKVDN + (size_t)2 * NTOK * 512;
    float yq = 0.f, yk = 0.f, yv = 0.f;
#pragma unroll
    for (int j = 0; j < 5; ++j) {
        const int tt = t + j - 2;
        if (tt >= 0 && tt < SEQ) {
            yq = fmaf(bf2f(Q[(hb + tt) * 64 + d]), p.conv_w[j * 1536 + ch], yq);
            yk = fmaf(bf2f(K[(hb + tt) * 64 + d]), p.conv_w[j * 1536 + 512 + ch], yk);
            yv = fmaf(bf2f(V[(hb + tt) * 64 + d]), p.conv_w[j * 1536 + 1024 + ch], yv);
        }
    }
    yq = siluf_(yq); yk = siluf_(yk); yv = siluf_(yv);
    float sq = yq * yq, sk = yk * yk;
#pragma unroll
    for (int o = 1; o < 64; o <<= 1) { sq += __shfl_xor(sq, o); sk += __shfl_xor(sk, o); }
    yq *= rsqrtf(sq + RMS_EPS); yk *= rsqrtf(sk + RMS_EPS);
    qc[(size_t)t * 512 + ch] = yq; kc[(size_t)t * 512 + ch] = yk; vc[(size_t)t * 512 + ch] = yv;
}

__global__ void __launch_bounds__(64) ref_dn_scan_kernel(Params p, int b, const float* __restrict__ qc, const float* __restrict__ kc, const float* __restrict__ vc,
                                                         float* __restrict__ o_f, float* __restrict__ o_b) {
    const int hd = blockIdx.x, dir = blockIdx.y, lane = threadIdx.x;
    __shared__ float ks[64];
    __shared__ float qs[64];
    float S[64];
#pragma unroll
    for (int k = 0; k < 64; ++k) S[k] = 0.f;
    float* op = dir == 0 ? o_f : o_b;
    const float* gb = p.GATES + (size_t)dir * NTOK * 8 + ((size_t)b * 8 + hd) * 2048;
    const float* gg = p.GATES + (size_t)(2 + dir) * NTOK * 8 + ((size_t)b * 8 + hd) * 2048;
    for (int step = 0; step < SEQ; ++step) {
        const int t = dir == 0 ? step : SEQ - 1 - step;
        ks[lane] = kc[(size_t)t * 512 + hd * 64 + lane];
        qs[lane] = qc[(size_t)t * 512 + hd * 64 + lane];
        const float vv = vc[(size_t)t * 512 + hd * 64 + lane];
        const float beta = gb[t], eg = expf(gg[t]);
        __syncthreads();
        float sk = 0.f;
#pragma unroll
        for (int k = 0; k < 64; ++k) sk = fmaf(S[k], ks[k], sk);
        const float dd = beta * (vv - eg * sk);
        float o = 0.f;
#pragma unroll
        for (int k = 0; k < 64; ++k) { S[k] = fmaf(ks[k], dd, eg * S[k]); o = fmaf(S[k], qs[k], o); }
        op[(size_t)t * 512 + hd * 64 + lane] = o * 0.125f;
        __syncthreads();
    }
}

__global__ void __launch_bounds__(64) ref_dn_out_kernel(Params p, int b, const float* __restrict__ o_f, const float* __restrict__ o_b) {
    const int t = blockIdx.x, hd = blockIdx.y, d = threadIdx.x;
    const size_t idx = (size_t)t * 512 + hd * 64 + d;
    float o = o_f[idx] + o_b[idx];
    float ss = o * o;
#pragma unroll
    for (int k = 1; k < 64; k <<= 1) ss += __shfl_xor(ss, k);
    o = o * rsqrtf(ss * (1.f / 64.f) + RMS_EPS) * p.norm_w[d];
    const float z = bf2f(p.Z[((size_t)(b * 8 + hd) * 2048 + t) * 64 + d]);
    p.DNOUT[((size_t)b * 2048 + t) * 512 + hd * 64 + d] = (bf16)f2bf(o * z);
}

__global__ void __launch_bounds__(256) ref_merge_kernel(const float* __restrict__ g, const float* __restrict__ y_na, const float* __restrict__ y_dn, float* __restrict__ merged) {
    const int t = blockIdx.x;
    for (int c = threadIdx.x; c < 1024; c += 256)
        merged[(size_t)t * 1024 + c] = sigmoidf_(g[(size_t)t * 2048 + c]) * y_na[(size_t)t * 1024 + c] + sigmoidf_(g[(size_t)t * 2048 + 1024 + c]) * y_dn[(size_t)t * 1024 + c];
}

__device__ __forceinline__ float block_sum_256(float v, float* red) {
#pragma unroll
    for (int o = 1; o < 64; o <<= 1) v += __shfl_xor(v, o);
    __syncthreads();
    if ((threadIdx.x & 63) == 0) red[threadIdx.x >> 6] = v;
    __syncthreads();
    return red[0] + red[1] + red[2] + red[3];
}

__global__ void __launch_bounds__(256) ref_ln1_router_kernel(Params p, const float* __restrict__ x, const float* __restrict__ mix,
                                                             float* __restrict__ x1, int* __restrict__ route_e, float* __restrict__ route_p) {
    const int t = blockIdx.x, tid = threadIdx.x;
    __shared__ float xs[1024];
    __shared__ float red[4];
    __shared__ float logits[36];
    float v[4]; float s = 0.f;
#pragma unroll
    for (int i = 0; i < 4; ++i) { const int c = tid + 256 * i; v[i] = mix ? ALPHA * x[(size_t)t * 1024 + c] + mix[(size_t)t * 1024 + c] : x[(size_t)t * 1024 + c]; s += v[i]; }
    const float mu = block_sum_256(s, red) * (1.f / 1024.f);
    float q = 0.f;
#pragma unroll
    for (int i = 0; i < 4; ++i) { const float d = v[i] - mu; q += d * d; }
    const float var = block_sum_256(q, red) * (1.f / 1024.f);
    const float rstd = rsqrtf(var + LN_EPS);
#pragma unroll
    for (int i = 0; i < 4; ++i) { const int c = tid + 256 * i; const float y = (v[i] - mu) * rstd * p.ln1_g[c] + p.ln1_b[c]; xs[c] = y; x1[(size_t)t * 1024 + c] = y; }
    __syncthreads();
    if (tid < 36) {
        float a = 0.f;
        if (tid < 4) { for (int c = 0; c < 1024; ++c) a = fmaf(xs[c], p.wrg[c * 4 + tid], a); a += p.brg[tid]; }
        else { const int e = tid - 4; for (int c = 0; c < 1024; ++c) a = fmaf(xs[c], p.wre[c * 32 + e], a); a += p.bre[e]; }
        logits[tid] = a;
    }
    __syncthreads();
    if (tid == 0) {
        int gi = 0; float gm = logits[0];
        for (int g = 1; g < 4; ++g) if (logits[g] > gm) { gm = logits[g]; gi = g; }
        float gs = 0.f;
        for (int g = 0; g < 4; ++g) gs += expf(logits[g] - gm);
        const float gp = 1.f / gs;
        const float* el = logits + 4 + gi * 8;
        int i1 = 0; float l1 = el[0];
        for (int e = 1; e < 8; ++e) if (el[e] > l1) { l1 = el[e]; i1 = e; }
        int i2 = -1; float l2 = -3.0e38f;
        for (int e = 0; e < 8; ++e) if (e != i1 && el[e] > l2) { l2 = el[e]; i2 = e; }
        const float e2 = expf(l2 - l1);
        const float p1 = 1.f / (1.f + e2), p2 = e2 / (1.f + e2);
        route_e[t * 2 + 0] = gi * 8 + i1; route_e[t * 2 + 1] = gi * 8 + i2;
        route_p[t * 2 + 0] = p1 * gp; route_p[t * 2 + 1] = p2 * gp;
    }
}

__global__ void __launch_bounds__(256) ref_moe_ln2_kernel(Params p, const float* __restrict__ x1, const int* __restrict__ route_e, const float* __restrict__ route_p, float* __restrict__ out) {
    const int t = blockIdx.x, tid = threadIdx.x;
    __shared__ float xs[1024];
    __shared__ float hid[512];
    __shared__ float red[4];
#pragma unroll
    for (int i = 0; i < 4; ++i) xs[tid + 256 * i] = x1[(size_t)t * 1024 + tid + 256 * i];
    __syncthreads();
    const int e0 = route_e[t * 2], e1 = route_e[t * 2 + 1];
#pragma unroll
    for (int kk = 0; kk < 2; ++kk) {
        const float* W = p.wgu + (size_t)(kk == 0 ? e0 : e1) * 1024 * 512;
        float a = 0.f, u = 0.f;
        for (int d = 0; d < 1024; ++d) { a = fmaf(xs[d], W[(size_t)d * 512 + tid], a); u = fmaf(xs[d], W[(size_t)d * 512 + 256 + tid], u); }
        hid[kk * 256 + tid] = siluf_(a) * u * route_p[t * 2 + kk];
    }
    __syncthreads();
    float y[4];
#pragma unroll
    for (int i = 0; i < 4; ++i) y[i] = 0.f;
#pragma unroll
    for (int kk = 0; kk < 2; ++kk) {
        const float* W = p.wd + (size_t)(kk == 0 ? e0 : e1) * 256 * 1024;
        for (int f = 0; f < 256; ++f) {
            const float hv = hid[kk * 256 + f];
#pragma unroll
            for (int i = 0; i < 4; ++i) y[i] = fmaf(hv, W[(size_t)f * 1024 + tid + 256 * i], y[i]);
        }
    }
    float v[4]; float s = 0.f;
#pragma unroll
    for (int i = 0; i < 4; ++i) { v[i] = ALPHA * xs[tid + 256 * i] + y[i]; s += v[i]; }
    const float mu = block_sum_256(s, red) * (1.f / 1024.f);
    float q = 0.f;
#pragma unroll
    for (int i = 0; i < 4; ++i) { const float d = v[i] - mu; q += d * d; }
    const float var = block_sum_256(q, red) * (1.f / 1024.f);
    const float rstd = rsqrtf(var + LN_EPS);
#pragma unroll
    for (int i = 0; i < 4; ++i) { const int c = tid + 256 * i; out[(size_t)t * 1024 + c] = (v[i] - mu) * rstd * p.ln2_g[c] + p.ln2_b[c]; }
}

static void gemm_ref(const void* A, bool abf16, const float* B, float* C, int M, int N, int K, int lda, int ldb, int ldc, hipStream_t s) {
    dim3 grid((N + 63) / 64, (M + 63) / 64);
    if (abf16) hipLaunchKernelGGL(gemm_f32_kernel<true>, grid, dim3(256), 0, s, A, B, C, M, N, K, lda, ldb, ldc);
    else hipLaunchKernelGGL(gemm_f32_kernel<false>, grid, dim3(256), 0, s, A, B, C, M, N, K, lda, ldb, ldc);
}
#ifndef NEW_P1
#define NEW_P1 1
#endif
#ifndef NEW_NA
#define NEW_NA 1
#endif
#ifndef NEW_DN
#define NEW_DN 1
#endif
#ifndef NEW_MIX
#define NEW_MIX 1
#endif
#ifndef NEW_MOE
#define NEW_MOE 1
#endif
#define MB(x) ((size_t)(x) << 20)

extern "C" void kernel_launch(void* const* d_in, const int* in_sizes, int n_in, void* d_out, int out_size, void* d_ws, size_t ws_size, hipStream_t stream) {
    Params p{};
    p.x = (const float*)d_in[0]; p.w_in = (const float*)d_in[1]; p.rpb = (const float*)d_in[2]; p.conv_w = (const float*)d_in[3];
    p.a_log_f = (const float*)d_in[4]; p.a_log_b = (const float*)d_in[5]; p.dtb_f = (const float*)d_in[6]; p.dtb_b = (const float*)d_in[7];
    p.norm_w = (const float*)d_in[8]; p.w_proj_na = (const float*)d_in[9]; p.w_proj_dn = (const float*)d_in[10]; p.w_out = (const float*)d_in[11];
    p.ln1_g = (const float*)d_in[12]; p.ln1_b = (const float*)d_in[13]; p.wrg = (const float*)d_in[14]; p.brg = (const float*)d_in[15];
    p.wre = (const float*)d_in[16]; p.bre = (const float*)d_in[17]; p.wgu = (const float*)d_in[18]; p.wd = (const float*)d_in[19];
    p.ln2_g = (const float*)d_in[20]; p.ln2_b = (const float*)d_in[21];
    p.out = (float*)d_out;
    char* ws = (char*)d_ws;
    p.ctl = (unsigned*)ws;
    p.WIN = (bf16*)(ws + MB(1)); p.WG = (bf16*)(ws + MB(9)); p.WPNA = (bf16*)(ws + MB(13)); p.WPDN = (bf16*)(ws + MB(14)); p.WOUT = (bf16*)(ws + MB(15));
    p.XB = (bf16*)(ws + MB(17)); p.WGU = (bf16*)(ws + MB(49)); p.WD = (bf16*)(ws + MB(81));
    p.QNA = (bf16*)(ws + MB(97)); p.KNA = (bf16*)(ws + MB(113)); p.VNAT = (bf16*)(ws + MB(129)); p.QKVDN = (bf16*)(ws + MB(145));
    p.Z = (bf16*)(ws + MB(193)); p.GATES = (float*)(ws + MB(209)); p.NAOUT = (bf16*)(ws + MB(211)); p.DNOUT = (bf16*)(ws + MB(227));

    static int inited = 0;
    if (!inited) {
        hipFuncSetAttribute((const void*)k_p0, hipFuncAttributeMaxDynamicSharedMemorySize, LDS_BYTES);
        hipFuncSetAttribute((const void*)k_p1, hipFuncAttributeMaxDynamicSharedMemorySize, LDS_BYTES);
        hipFuncSetAttribute((const void*)k_merge, hipFuncAttributeMaxDynamicSharedMemorySize, LDS_BYTES);
        hipFuncSetAttribute((const void*)k_outproj, hipFuncAttributeMaxDynamicSharedMemorySize, LDS_BYTES);
        hipFuncSetAttribute((const void*)k_ln1, hipFuncAttributeMaxDynamicSharedMemorySize, LDS_BYTES);
        hipFuncSetAttribute((const void*)k_gather, hipFuncAttributeMaxDynamicSharedMemorySize, LDS_BYTES);
        hipFuncSetAttribute((const void*)k_moe1, hipFuncAttributeMaxDynamicSharedMemorySize, LDS_BYTES);
        hipFuncSetAttribute((const void*)k_moe2, hipFuncAttributeMaxDynamicSharedMemorySize, LDS_BYTES);
        hipFuncSetAttribute((const void*)k_na, hipFuncAttributeMaxDynamicSharedMemorySize, LDS_BYTES);
        hipFuncSetAttribute((const void*)k_p0moe, hipFuncAttributeMaxDynamicSharedMemorySize, LDS_BYTES);
        hipFuncSetAttribute((const void*)k_dnprep, hipFuncAttributeMaxDynamicSharedMemorySize, LDS_BYTES);
        hipFuncSetAttribute((const void*)k_dnscan, hipFuncAttributeMaxDynamicSharedMemorySize, LDS_BYTES);
        inited = 1;
    }
    const int G = 256;
    char* tmp = (char*)d_out;
#if NEW_P1
    hipLaunchKernelGGL(k_p0, dim3(G), dim3(NT), LDS_BYTES, stream, p);
    hipLaunchKernelGGL(k_p1, dim3(G), dim3(NT), LDS_BYTES, stream, p);
#else
    for (int b = 0; b < BATCH; ++b) {
        float* h = (float*)tmp;
        gemm_ref(p.x + (size_t)b * SEQ * 1024, false, p.w_in, h, SEQ, D_IN, 1024, 1024, D_IN, D_IN, stream);
        hipLaunchKernelGGL(ref_inproj_epi_kernel, dim3(SEQ), dim3(256), 0, stream, p, (const float*)h, b);
    }
#endif
#if NEW_NA
    hipLaunchKernelGGL(k_na, dim3(G), dim3(NT), LDS_BYTES, stream, p);
#else
    hipLaunchKernelGGL(ref_na_attn_kernel, dim3(NTOK, 8), dim3(128), 0, stream, p);
#endif
#if NEW_DN
    {
        DnBufs B; B.MN = (bf16*)d_out; B.QO = (bf16*)(ws + MB(49)); B.SB = (bf16*)(ws + MB(113));
        hipLaunchKernelGGL(k_dnprep, dim3(G), dim3(NT), LDS_BYTES, stream, p, B);
        hipLaunchKernelGGL(k_dnscan, dim3(G), dim3(NT), LDS_BYTES, stream, p, B);
        hipLaunchKernelGGL(k_dnout, dim3(G), dim3(NT), 0, stream, p, B);
    }
#else
    for (int b = 0; b < BATCH; ++b) {
        float* qc = (float*)tmp; float* kc = qc + SEQ * 512; float* vc = kc + SEQ * 512; float* o_f = vc + SEQ * 512; float* o_b = o_f + SEQ * 512;
        hipLaunchKernelGGL(ref_dn_conv_kernel, dim3(SEQ, 8), dim3(64), 0, stream, p, b, qc, kc, vc);
        hipLaunchKernelGGL(ref_dn_scan_kernel, dim3(8, 2), dim3(64), 0, stream, p, b, (const float*)qc, (const float*)kc, (const float*)vc, o_f, o_b);
        hipLaunchKernelGGL(ref_dn_out_kernel, dim3(SEQ, 8), dim3(64), 0, stream, p, b, (const float*)o_f, (const float*)o_b);
    }
#endif
    hipLaunchKernelGGL(k_p0moe, dim3(G), dim3(NT), LDS_BYTES, stream, p);
#if NEW_MIX
    MixBufs MB_; MB_.GB = (bf16*)(ws + MB(97)); MB_.MERGED = (bf16*)(ws + MB(129)); MB_.V = (float*)d_out;
    hipLaunchKernelGGL(k_merge, dim3(G), dim3(NT), LDS_BYTES, stream, p, MB_);
    hipLaunchKernelGGL(k_outproj, dim3(G), dim3(NT), LDS_BYTES, stream, p, MB_);
#endif
#if NEW_MOE
    {
        MoeBufs Q{}; Q.kdown = 256; Q.V = (const float*)d_out; Q.X1B = (bf16*)(ws + MB(181)); Q.XS = (bf16*)(ws + MB(97)); Q.HID = (bf16*)(ws + MB(213)); Q.YPART = (bf16*)(ws + MB(97));
        char* tb = ws + MB(243);
        Q.CNT = (int*)tb; Q.ROUTE = (int*)(tb + (64 << 10)); Q.ROUTEP = (float*)(tb + (384 << 10)); Q.ROWINFO = (int*)(tb + (576 << 10)); Q.ROWPW = (float*)(tb + (768 << 10));
        Q.STATS = (float*)(tb + (960 << 10)); Q.RWH = (bf16*)(tb + (1152 << 10)); Q.RWL = (bf16*)(tb + (1280 << 10));
        hipLaunchKernelGGL(k_router_w, dim3(G), dim3(NT), 0, stream, p, Q);
        hipLaunchKernelGGL(k_ln1, dim3(G), dim3(NT), LDS_BYTES, stream, p, Q);
        hipLaunchKernelGGL(k_gather, dim3(G), dim3(NT), LDS_BYTES, stream, p, Q);
        hipLaunchKernelGGL(k_moe1, dim3(G), dim3(NT), LDS_BYTES, stream, p, Q);
        hipLaunchKernelGGL(k_moe2, dim3(G), dim3(NT), LDS_BYTES, stream, p, Q);
        hipLaunchKernelGGL(k_ln2, dim3(G), dim3(NT), 0, stream, p, Q);
    }
#else
    for (int b = 0; b < BATCH; ++b) {
        char* t2 = ws + MB(161);
        float* g = (float*)t2; float* y_na = (float*)(t2 + MB(16)); float* y_dn = (float*)(t2 + MB(24)); float* merged = (float*)(t2 + MB(32));
        float* mix = (float*)(t2 + MB(40)); float* x1 = (float*)(t2 + MB(48)); int* route_e = (int*)(t2 + MB(56)); float* route_p = (float*)(t2 + MB(57));
        const float* xb = p.x + (size_t)b * SEQ * 1024;
#if NEW_MIX
        hipLaunchKernelGGL(ref_ln1_router_kernel, dim3(SEQ), dim3(256), 0, stream, p, (const float*)(MB_.V + (size_t)b * SEQ * 1024), (const float*)nullptr, x1, route_e, route_p);
#else
        gemm_ref(xb, false, p.w_in + 3616, g, SEQ, 2048, 1024, 1024, D_IN, 2048, stream);
        gemm_ref(p.NAOUT + (size_t)b * SEQ * 512, true, p.w_proj_na, y_na, SEQ, 1024, 512, 512, 1024, 1024, stream);
        gemm_ref(p.DNOUT + (size_t)b * SEQ * 512, true, p.w_proj_dn, y_dn, SEQ, 1024, 512, 512, 1024, 1024, stream);
        hipLaunchKernelGGL(ref_merge_kernel, dim3(SEQ), dim3(256), 0, stream, (const float*)g, (const float*)y_na, (const float*)y_dn, merged);
        gemm_ref(merged, false, p.w_out, mix, SEQ, 1024, 1024, 1024, 1024, 1024, stream);
        hipLaunchKernelGGL(ref_ln1_router_kernel, dim3(SEQ), dim3(256), 0, stream, p, xb, (const float*)mix, x1, route_e, route_p);
#endif
        hipLaunchKernelGGL(ref_moe_ln2_kernel, dim3(SEQ), dim3(256), 0, stream, p, (const float*)x1, (const int*)route_e, (const float*)route_p, p.out + (size_t)b * SEQ * 1024);
    }
#endif
}
```

```cpp
#include <hip/hip_runtime.h>
#include <math.h>
#include <stdint.h>
#include <stddef.h>
#include <stdio.h>
namespace pg8 {
#define PG8_LAS __attribute__((address_space(3)))
typedef unsigned short bf16_t;
typedef short bf16x8 __attribute__((ext_vector_type(8)));
typedef float f32x4 __attribute__((ext_vector_type(4)));
typedef unsigned u32x4 __attribute__((ext_vector_type(4)));
constexpr int BM = 256, BK = 64, HALF = 128, HTB = HALF * BK * 2  , STAGE_BYTES = 8 * HTB, NXCD = 8, WGM = 8;

__host__ __device__ __forceinline__ int lds_byte(int r, int c) { const int st = (r >> 4) * 2 + (c >> 5), rr = r & 15, cc = c & 31, ob = rr * 64 + cc * 2; return st * 1024 + (ob ^ (((ob >> 9) & 1) << 5)); }
__host__ __device__ __forceinline__ void stage_rc(int b, int& R, int& C) { const int st = b / 1024, sb = b % 1024, swz = sb ^ (((sb >> 9) & 1) << 5); R = (st >> 1) * 16 + swz / 64; C = (st & 1) * 32 + (swz % 64) / 2; }
__host__ __device__ __forceinline__ int perm32(int rho) { const int n = rho >> 4, i = rho & 15; return 8 * (i >> 2) + 4 * n + (i & 3); }

struct Unit { int pm, pn; };
struct Gemm { const bf16_t* A; const bf16_t* Bt; int M, N, K; };

struct StaticOrder {
    int nM, nN, nwg, G, c;
    __host__ __device__ __forceinline__ void init(int M, int N, int G_, int c_) { nM = M / BM; nN = N / BM; nwg = nM * nN; G = G_; c = c_; }
    __host__ __device__ __forceinline__ bool next(int i, Unit& u) const {
        const long L = (long)i * G + c; if (L >= nwg) return false;
        int wgid = (int)L; { const int q = nwg / NXCD, r = nwg % NXCD, xcd = wgid % NXCD, off = wgid / NXCD; wgid = (xcd < r ? xcd * (q + 1) : r * (q + 1) + (xcd - r) * q) + off; }
        const int nig = WGM * nN, gid = wgid / nig, fm = gid * WGM, gsz = (nM - fm) < WGM ? (nM - fm) : WGM;
        u.pm = fm + ((wgid % nig) % gsz); u.pn = (wgid % nig) / gsz; return true;
    }
    __device__ __forceinline__ void a_ready(const Unit&) const {}
    __device__ __forceinline__ void done(const Unit&) const {}
};
__device__ __forceinline__ unsigned cvt_pk_bf16(float lo, float hi) { unsigned r; asm volatile("v_cvt_pk_bf16_f32 %0, %1, %2" : "=v"(r) : "v"(lo), "v"(hi)); return r; }

template <class Epi, class Sched, bool ALIGN_EPI = false, bool SP2 = false>
__device__ __forceinline__ void gemm_phase(PG8_LAS unsigned char* lds, const Gemm g, const Sched& S, const Epi& E) {
    int tid_ = threadIdx.x; asm volatile("" : "+v"(tid_));
    const int tid = tid_, wid = __builtin_amdgcn_readfirstlane(tid >> 6), lane = tid & 63, wr = wid >> 2, wc = wid & 3, fr = lane & 15, fq = lane >> 4;
    const int K = g.K, nt = K / BK;
    unsigned voffA[2], voffB[2];
#pragma unroll
    for (int i = 0; i < 2; ++i) { int R, C; stage_rc(tid * 16 + i * 8192, R, C); const int Rb = Epi::PERM ? ((R & ~31) + perm32(R & 31)) : R;
        voffA[i] = (unsigned)(R * K + C) * 2u; voffB[i] = (unsigned)(Rb * K + C) * 2u; }
    const size_t kstep = (size_t)(BK * 2);
    const size_t hstep = (size_t)HALF * K * 2;
    const size_t tstep = 2 * hstep;
    const unsigned ldsw = (unsigned)wid * 1024u;
    const int aoff = lds_byte(wr * 64 + fr, fq * 8), boff = lds_byte(wc * 32 + fr, fq * 8);
#define PG8_SA(b, h) (((b) * 2 + (h)) * HTB)
#define PG8_SB(b, h) ((4 + (b) * 2 + (h)) * HTB)
#define PG8_STAGE(bufoff, gbase, voff) do { _Pragma("unroll") for (int _i = 0; _i < 2; ++_i) \
        __builtin_amdgcn_global_load_lds((const unsigned*)((const char*)(gbase) + (voff)[_i]), (PG8_LAS unsigned*)(lds + (bufoff) + ldsw + _i * 8192), 16, 0, 0); } while (0)
#define PG8_LDA(dst, b, h) do { _Pragma("unroll") for (int m = 0; m < 4; ++m) _Pragma("unroll") for (int k = 0; k < 2; ++k) dst[m][k] = *(const PG8_LAS bf16x8*)(lds + PG8_SA(b, h) + aoff + m * 2048 + k * 1024); } while (0)
#define PG8_LDB(dst, b, h) do { _Pragma("unroll") for (int n = 0; n < 2; ++n) _Pragma("unroll") for (int k = 0; k < 2; ++k) dst[n][k] = *(const PG8_LAS bf16x8*)(lds + PG8_SB(b, h) + boff + n * 2048 + k * 1024); } while (0)
#define PG8_MMA(ai, bj, At, Bt) do { __builtin_amdgcn_s_setprio(1); _Pragma("unroll") for (int m = 0; m < 4; ++m) _Pragma("unroll") for (int n = 0; n < 2; ++n) _Pragma("unroll") for (int k = 0; k < 2; ++k) \
        acc[ai][bj][m][n] = __builtin_amdgcn_mfma_f32_16x16x32_bf16(Bt[n][k], At[m][k], acc[ai][bj][m][n], 0, 0, 0); __builtin_amdgcn_s_setprio(0); } while (0)
#define PG8_WAIT_V(n) asm volatile("s_waitcnt vmcnt(" #n ")" ::: "memory")
#define PG8_WAIT_L(n) asm volatile("s_waitcnt lgkmcnt(" #n ")" ::: "memory")
#define PG8_BAR __builtin_amdgcn_s_barrier()
#define PG8_SCHED __builtin_amdgcn_sched_barrier(0)
    Unit cur, nxt; int ui = 0;
    if (!S.next(0, cur)) return;
    f32x4 acc[2][2][4][2];
#pragma unroll
    for (int a = 0; a < 2; ++a)
#pragma unroll
        for (int b = 0; b < 2; ++b)
#pragma unroll
            for (int m = 0; m < 4; ++m)
#pragma unroll
                for (int n = 0; n < 2; ++n) acc[a][b][m][n] = (f32x4){0.f, 0.f, 0.f, 0.f};
    bf16x8 At[4][2], B0[2][2], B1[2][2];
    const char* cA = (const char*)g.A + (size_t)cur.pm * tstep; const char* cB = (const char*)g.Bt + (size_t)cur.pn * tstep;
    S.a_ready(cur);
    if constexpr (SP2) {
        PG8_STAGE(PG8_SB(0, 0), cB, voffB); PG8_STAGE(PG8_SB(0, 1), cB + hstep, voffB); PG8_STAGE(PG8_SA(0, 0), cA, voffA); PG8_STAGE(PG8_SA(0, 1), cA + hstep, voffA);
        if (wr == 1) PG8_BAR;
        PG8_WAIT_V(2); PG8_BAR;
        PG8_STAGE(PG8_SB(1, 0), cB + kstep, voffB); PG8_STAGE(PG8_SA(1, 0), cA + kstep, voffA); PG8_STAGE(PG8_SB(1, 1), cB + hstep + kstep, voffB);
        PG8_WAIT_V(6); PG8_BAR;
    } else {
        PG8_STAGE(PG8_SB(0, 0), cB, voffB); PG8_STAGE(PG8_SA(0, 0), cA, voffA); PG8_STAGE(PG8_SB(0, 1), cB + hstep, voffB); PG8_STAGE(PG8_SA(0, 1), cA + hstep, voffA);
        if (wr == 1) PG8_BAR;
        PG8_WAIT_V(4); PG8_BAR;
        PG8_STAGE(PG8_SB(1, 0), cB + kstep, voffB); PG8_STAGE(PG8_SA(1, 0), cA + kstep, voffA); PG8_STAGE(PG8_SB(1, 1), cB + hstep + kstep, voffB);
        PG8_WAIT_V(6); PG8_BAR;
    }
    for (;;) {
        const bool has_next = S.next(ui + 1, nxt);
        const char* nA = has_next ? (const char*)g.A + (size_t)nxt.pm * tstep : cA; const char* nB = has_next ? (const char*)g.Bt + (size_t)nxt.pn * tstep : cB;
        for (int t = 0; t < nt; t += 2) {
            const bool last = (t == nt - 2);
            const char* a1 = cA + (size_t)(t + 1) * kstep;
            const char* a2 = last ? nA : cA + (size_t)(t + 2) * kstep; const char* b2 = last ? nB : cB + (size_t)(t + 2) * kstep;
            const char* a3 = a2 + kstep; const char* b3 = b2 + kstep;
            if (last && has_next) S.a_ready(nxt);
            if constexpr (SP2) {
            PG8_LDB(B0, 0, 0); PG8_LDB(B1, 0, 1); PG8_SCHED; PG8_LDA(At, 0, 0); PG8_STAGE(PG8_SA(1, 1), a1 + hstep, voffA);
            PG8_WAIT_V(8); PG8_WAIT_L(0); PG8_BAR; PG8_MMA(0, 0, At, B0); PG8_MMA(0, 1, At, B1); PG8_BAR; PG8_SCHED;
            PG8_LDA(At, 0, 1); PG8_STAGE(PG8_SB(0, 0), b2, voffB); PG8_STAGE(PG8_SB(0, 1), b2 + hstep, voffB); PG8_STAGE(PG8_SA(0, 0), a2, voffA);
            PG8_WAIT_V(8); PG8_WAIT_L(0); PG8_BAR; PG8_MMA(1, 0, At, B0); PG8_MMA(1, 1, At, B1); PG8_BAR; PG8_SCHED;
            PG8_LDB(B0, 1, 0); PG8_LDB(B1, 1, 1); PG8_SCHED; PG8_LDA(At, 1, 0); PG8_STAGE(PG8_SA(0, 1), a2 + hstep, voffA);
            PG8_WAIT_V(8); PG8_WAIT_L(0); PG8_BAR; PG8_MMA(0, 0, At, B0); PG8_MMA(0, 1, At, B1); PG8_BAR; PG8_SCHED;
            PG8_LDA(At, 1, 1); PG8_STAGE(PG8_SB(1, 0), b3, voffB); PG8_STAGE(PG8_SB(1, 1), b3 + hstep, voffB); PG8_STAGE(PG8_SA(1, 0), a3, voffA);
            PG8_WAIT_V(8); PG8_WAIT_L(0); PG8_BAR; PG8_MMA(1, 0, At, B0); PG8_MMA(1, 1, At, B1); PG8_BAR; PG8_SCHED;
            } else {
            PG8_LDB(B0, 0, 0); PG8_SCHED; PG8_LDA(At, 0, 0); PG8_STAGE(PG8_SA(1, 1), a1 + hstep, voffA);
            PG8_WAIT_L(8); PG8_BAR; PG8_WAIT_L(0); PG8_MMA(0, 0, At, B0); PG8_BAR; PG8_SCHED;
            PG8_LDB(B1, 0, 1); PG8_STAGE(PG8_SB(0, 0), b2, voffB);
            PG8_BAR; PG8_WAIT_L(0); PG8_MMA(0, 1, At, B1); PG8_BAR;
            PG8_LDA(At, 0, 1); PG8_STAGE(PG8_SA(0, 0), a2, voffA);
            PG8_BAR; PG8_WAIT_L(0); PG8_MMA(1, 0, At, B0); PG8_BAR; PG8_SCHED;
            PG8_STAGE(PG8_SB(0, 1), b2 + hstep, voffB);
            PG8_WAIT_V(6); PG8_BAR; PG8_MMA(1, 1, At, B1); PG8_BAR;
            PG8_LDB(B0, 1, 0); PG8_SCHED; PG8_LDA(At, 1, 0); PG8_STAGE(PG8_SA(0, 1), a2 + hstep, voffA);
            PG8_WAIT_L(8); PG8_BAR; PG8_WAIT_L(0); PG8_MMA(0, 0, At, B0); PG8_BAR; PG8_SCHED;
            PG8_LDB(B1, 1, 1); PG8_STAGE(PG8_SB(1, 0), b3, voffB);
            PG8_BAR; PG8_WAIT_L(0); PG8_MMA(0, 1, At, B1); PG8_BAR;
            PG8_LDA(At, 1, 1); PG8_STAGE(PG8_SA(1, 0), a3, voffA);
            PG8_BAR; PG8_WAIT_L(0); PG8_MMA(1, 0, At, B0); PG8_BAR; PG8_SCHED;
            PG8_STAGE(PG8_SB(1, 1), b3 + hstep, voffB);
            PG8_WAIT_V(6); PG8_BAR; PG8_MMA(1, 1, At, B1); PG8_BAR;
            }
        }
        if constexpr (ALIGN_EPI) { if (wr == 0) PG8_BAR; }
        if constexpr (!Epi::AFTER_DRAIN) { E(acc, cur, wr, wc, fr, fq); S.done(cur); }
        if (!has_next) break;
#pragma unroll
        for (int a = 0; a < 2; ++a)
#pragma unroll
            for (int b = 0; b < 2; ++b)
#pragma unroll
                for (int m = 0; m < 4; ++m)
#pragma unroll
                    for (int n = 0; n < 2; ++n) acc[a][b][m][n] = (f32x4){0.f, 0.f, 0.f, 0.f};
        cur = nxt; cA = nA; cB = nB; ++ui;
        if constexpr (ALIGN_EPI) { if (wr == 1) PG8_BAR; }
    }
    PG8_WAIT_V(0);
    if constexpr (!ALIGN_EPI) { if (wr == 0) PG8_BAR; }
    PG8_BAR;
    if constexpr (Epi::AFTER_DRAIN) { E.fused(acc, cur, wr, wc, fr, fq, lds, wid, lane); S.done(cur); }
#undef PG8_SA
#undef PG8_SB
#undef PG8_STAGE
#undef PG8_LDA
#undef PG8_LDB
#undef PG8_MMA
#undef PG8_WAIT_V
#undef PG8_WAIT_L
#undef PG8_BAR
#undef PG8_SCHED
}
}
typedef unsigned short bf16;
#define LAS __attribute__((address_space(3)))
typedef float f32x4 __attribute__((ext_vector_type(4)));
typedef short bf16x8 __attribute__((ext_vector_type(8)));
typedef unsigned u32x4 __attribute__((ext_vector_type(4)));
typedef unsigned u32x2 __attribute__((ext_vector_type(2)));

#define D_MODEL 1024
#define BATCH 8
#define SEQ 2048
#define D_IN 5664
#define NTOK (BATCH * SEQ)
#define ALPHA 1.189207115002721f
#define LN_EPS 1e-5f
#define RMS_EPS 1e-6f
#define NWIN 3840
#define NT 512
#define LDS_BYTES 147456

#define LDS_WAIT() asm volatile("s_waitcnt lgkmcnt(0)" ::: "memory")
#define VM_WAIT() asm volatile("s_waitcnt vmcnt(0)" ::: "memory")

__device__ __forceinline__ int fresh_tid() { int t = threadIdx.x; asm volatile("" : "+v"(t)); return t; }
__device__ __forceinline__ unsigned f2bf(float f) { unsigned u = __builtin_bit_cast(unsigned, f); return (u + 0x7fffu + ((u >> 16) & 1u)) >> 16; }
__device__ __forceinline__ unsigned pk2(float lo, float hi) { return f2bf(lo) | (f2bf(hi) << 16); }
__device__ __forceinline__ float bf2f(unsigned h) { return __builtin_bit_cast(float, (h & 0xffffu) << 16); }
__device__ __forceinline__ float sigmoidf_(float x) { return 1.f / (1.f + __expf(-x)); }
__device__ __forceinline__ float siluf_(float x) { return x / (1.f + __expf(-x)); }
__device__ __forceinline__ float softplusf_(float x) { return x > 20.f ? x : log1pf(expf(x)); }

struct Params {
    const float *x, *w_in, *rpb, *conv_w, *a_log_f, *a_log_b, *dtb_f, *dtb_b, *norm_w, *w_proj_na, *w_proj_dn, *w_out, *ln1_g, *ln1_b;
    const float *wrg, *brg, *wre, *bre, *wgu, *wd, *ln2_g, *ln2_b;
    float* out;
    char* ws;
    unsigned* bar;
    int kdown, pad0;
#define WSP(T, mb) ((T*)(ws + ((size_t)(mb) << 20)))
    __device__ __forceinline__ bf16* WIN() const { return WSP(bf16, 1); }
    __device__ __forceinline__ bf16* WG() const { return WSP(bf16, 9); }
    __device__ __forceinline__ bf16* WPNA() const { return WSP(bf16, 13); }
    __device__ __forceinline__ bf16* WPDN() const { return WSP(bf16, 14); }
    __device__ __forceinline__ bf16* WOUT() const { return WSP(bf16, 15); }
    __device__ __forceinline__ bf16* XB() const { return WSP(bf16, 17); }
    __device__ __forceinline__ bf16* WGU() const { return WSP(bf16, 49); }
    __device__ __forceinline__ bf16* WD() const { return WSP(bf16, 81); }
    __device__ __forceinline__ bf16* QNA() const { return WSP(bf16, 49); }
    __device__ __forceinline__ bf16* KNA() const { return WSP(bf16, 65); }
    __device__ __forceinline__ bf16* VNAT() const { return WSP(bf16, 81); }
    __device__ __forceinline__ bf16* QKVDN() const { return WSP(bf16, 97); }
    __device__ __forceinline__ bf16* Z() const { return WSP(bf16, 145); }
    __device__ __forceinline__ float* GATES() const { return WSP(float, 161); }
    __device__ __forceinline__ bf16* NAOUT() const { return WSP(bf16, 163); }
    __device__ __forceinline__ bf16* DNOUT() const { return WSP(bf16, 129); }
};

__device__ __forceinline__ void transpose_item(const float* W, size_t ldW, bf16* WT, int Kdst, int k0, int n0, int rowdst0, LAS float* scr, int lane) {
#pragma unroll 8
    for (int i = 0; i < 32; ++i) { const int kk = 2 * i + (lane >> 5); scr[kk * 33 + (lane & 31)] = W[(size_t)(k0 + kk) * ldW + n0 + (lane & 31)]; }
    LDS_WAIT(); asm volatile("" ::: "memory");
    const int c = lane & 7;
#pragma unroll
    for (int j = 0; j < 4; ++j) { const int n = (lane >> 3) + 8 * j; const LAS float* s = scr + (8 * c) * 33 + n;
        u32x4 o; o.x = pk2(s[0 * 33], s[1 * 33]); o.y = pk2(s[2 * 33], s[3 * 33]); o.z = pk2(s[4 * 33], s[5 * 33]); o.w = pk2(s[6 * 33], s[7 * 33]);
        *(u32x4*)(WT + (size_t)(rowdst0 + n) * Kdst + k0 + 8 * c) = o; }
    LDS_WAIT(); asm volatile("" ::: "memory");
}

#define IT_WIN (16 * 113)
#define IT_WG (16 * 64)
#define IT_WPNA (8 * 32)
#define IT_WPDN (8 * 32)
#define IT_WOUT (16 * 32)
#define IT_SMALL (IT_WIN + IT_WG + IT_WPNA + IT_WPDN + IT_WOUT)
#define IT_WGU (32 * 16 * 16)
#define IT_WD (32 * 4 * 32)

__device__ __forceinline__ void p0_small_item(const Params& p, int r, LAS float* scr, int lane) {
    if (r < IT_WIN) { const int kb = r / 113, nb = r % 113; transpose_item(p.w_in, D_IN, p.WIN(), 1024, kb * 64, nb * 32, nb * 32, scr, lane); return; } r -= IT_WIN;
    if (r < IT_WG) { const int kb = r / 64, nb = r % 64; transpose_item(p.w_in + 3616, D_IN, p.WG(), 1024, kb * 64, nb * 32, nb * 32, scr, lane); return; } r -= IT_WG;
    if (r < IT_WPNA) { const int kb = r / 32, nb = r % 32; transpose_item(p.w_proj_na, 1024, p.WPNA(), 512, kb * 64, nb * 32, nb * 32, scr, lane); return; } r -= IT_WPNA;
    if (r < IT_WPDN) { const int kb = r / 32, nb = r % 32; transpose_item(p.w_proj_dn, 1024, p.WPDN(), 512, kb * 64, nb * 32, nb * 32, scr, lane); return; } r -= IT_WPDN;
    { const int kb = r / 32, nb = r % 32; transpose_item(p.w_out, 1024, p.WOUT(), 1024, kb * 64, nb * 32, nb * 32, scr, lane); }
}
__device__ __forceinline__ void p0_moe_item(const Params& p, int r, LAS float* scr, int lane) {
    if (r < IT_WGU) { const int e = r / 256, q = r % 256, kb = q / 16, nb = q % 16;
        const int n0 = nb * 32, up = n0 >= 256, f0 = n0 - (up ? 256 : 0);
        transpose_item(p.wgu + (size_t)e * 1024 * 512, 512, p.WGU(), 1024, kb * 64, n0, e * 512 + (f0 / 128) * 256 + (up ? 128 : 0) + (f0 % 128), scr, lane); return; }
    r -= IT_WGU;
    { const int e = r / 128, q = r % 128, kb = q / 32, nb = q % 32;
        transpose_item(p.wd + (size_t)e * 256 * 1024, 1024, p.WD(), 256, kb * 64, nb * 32, e * 1024 + nb * 32, scr, lane); }
}

__device__ __forceinline__ void phase0_moe(const Params& p, LAS unsigned char* lds, int gw, int NGW) {
    const int tid = fresh_tid(), lane = tid & 63, wave = tid >> 6;
    LAS float* scr = (LAS float*)(lds + wave * 16384);
    for (int it = gw; it < IT_WGU + IT_WD; it += NGW) p0_moe_item(p, it, scr, lane);
}
__device__ __forceinline__ void phase0(const Params& p, LAS unsigned char* lds) {
    const int tid = fresh_tid(), lane = tid & 63, wave = tid >> 6, G = gridDim.x;
    LAS float* scr = (LAS float*)(lds + wave * 16384);
    const int gw = blockIdx.x * 8 + wave, NGW = G * 8;
    for (int it = gw; it < IT_SMALL; it += NGW) p0_small_item(p, it, scr, lane);
    const size_t gt = (size_t)blockIdx.x * NT + tid, GT = (size_t)G * NT;
    for (size_t i = gt; i < (size_t)NTOK * 1024 / 8; i += GT) {
        const f32x4 a = *(const f32x4*)(p.x + i * 8), b = *(const f32x4*)(p.x + i * 8 + 4);
        u32x4 o; o.x = pk2(a.x, a.y); o.y = pk2(a.z, a.w); o.z = pk2(b.x, b.y); o.w = pk2(b.z, b.w);
        *(u32x4*)(p.XB() + i * 8) = o;
    }
    for (size_t i = gt; i < (size_t)(NWIN - 3616) * 1024 / 8; i += GT) *(u32x4*)(p.WIN() + (size_t)3616 * 1024 + i * 8) = (u32x4){0u, 0u, 0u, 0u};
}

struct EpiInProj {
    static constexpr bool PERM = true, AFTER_DRAIN = false;
    struct Mini { char* ws; const float *a_log_f, *a_log_b, *dtb_f, *dtb_b;
        __device__ __forceinline__ bf16* QNA() const { return WSP(bf16, 49); }
        __device__ __forceinline__ bf16* KNA() const { return WSP(bf16, 65); }
        __device__ __forceinline__ bf16* VNAT() const { return WSP(bf16, 81); }
        __device__ __forceinline__ bf16* QKVDN() const { return WSP(bf16, 97); }
        __device__ __forceinline__ bf16* Z() const { return WSP(bf16, 145); }
        __device__ __forceinline__ float* GATES() const { return WSP(float, 161); } } p;
    __device__ __forceinline__ void operator()(const pg8::f32x4 (&acc)[2][2][4][2], const pg8::Unit& u, int wr, int wc, int fr, int fq) const {
        const int pn = u.pn;
#pragma unroll
        for (int ai = 0; ai < 2; ++ai)
#pragma unroll
            for (int m = 0; m < 4; ++m) {
                const int row = u.pm * 256 + ai * 128 + wr * 64 + m * 16 + fr;
                const int b = row >> 11, t = row & 2047;
#pragma unroll
                for (int bj = 0; bj < 2; ++bj) {
                    const pg8::f32x4 v0 = acc[ai][bj][m][0], v1 = acc[ai][bj][m][1];
                    const int head = (pn & 1) * 4 + bj * 2 + (wc >> 1), d0 = (wc & 1) * 32 + 8 * fq;
                    const size_t hm = ((size_t)(b * 8 + head) * 2048 + t) * 64 + d0;
                    if (pn < 4 || (pn >= 6 && pn < 14)) {
                        bf16* dst; float sc = 1.f; bool act = false;
                        if (pn < 2) { dst = p.QNA(); sc = 0.125f; }
                        else if (pn < 4) dst = p.KNA();
                        else if (pn < 12) dst = p.QKVDN() + (size_t)((pn - 6) >> 1) * ((size_t)NTOK * 512);
                        else { dst = p.Z(); act = true; }
                        float e[8] = {v0[0], v0[1], v0[2], v0[3], v1[0], v1[1], v1[2], v1[3]};
#pragma unroll
                        for (int j = 0; j < 8; ++j) e[j] = act ? siluf_(e[j]) : e[j] * sc;
                        u32x4 w; w.x = pk2(e[0], e[1]); w.y = pk2(e[2], e[3]); w.z = pk2(e[4], e[5]); w.w = pk2(e[6], e[7]);
                        *(u32x4*)(dst + hm) = w;
                    } else if (pn < 6) {
                        bf16* dst = p.VNAT() + ((size_t)(b * 8 + head) * 64 + d0) * 2048 + t;
                        const float e[8] = {v0[0], v0[1], v0[2], v0[3], v1[0], v1[1], v1[2], v1[3]};
#pragma unroll
                        for (int j = 0; j < 8; ++j) dst[(size_t)j * 2048] = (bf16)f2bf(e[j]);
                    } else {
                        if (bj == 0 && wc == 0) {
                            const float e[8] = {v0[0], v0[1], v0[2], v0[3], v1[0], v1[1], v1[2], v1[3]};
                            float* g = p.GATES() + (size_t)fq * NTOK * 8 + (size_t)b * 8 * 2048 + t;
#pragma unroll
                            for (int j = 0; j < 8; ++j) {
                                float val;
                                if (fq < 2) val = sigmoidf_(e[j]);
                                else if (fq == 2) val = -expf(p.a_log_f[j]) * softplusf_(e[j] + p.dtb_f[j]);
                                else val = -expf(p.a_log_b[j]) * softplusf_(e[j] + p.dtb_b[j]);
                                g[(size_t)j * 2048] = val;
                            }
                        }
                    }
                }
            }
    }
};

__device__ __forceinline__ void phase1(const Params& p, LAS unsigned char* lds) {
    pg8::Gemm g{p.XB(), p.WIN(), NTOK, NWIN, 1024};
    pg8::StaticOrder S; S.init(NTOK, NWIN, gridDim.x, (int)blockIdx.x);
    EpiInProj E{{p.ws, p.a_log_f, p.a_log_b, p.dtb_f, p.dtb_b}};
    pg8::gemm_phase<EpiInProj, pg8::StaticOrder, true, true>(lds, g, S, E);
}

#define XB_TMO      128
#define XB_XCNT(j)  (256  + 64 * (j))
#define XB_XSUB(j)  (1280 + 64 * (j))
#define XB_XGEN(j)  (2304 + 64 * (j))
#define XB_TOP      3328
#define XB_TOPGEN   3392
#define XCD_BAR_WORDS 3456
#define XB_SPIN_CAP (1u << 18)


__device__ __forceinline__ unsigned xb_ld(unsigned* p)              { return __hip_atomic_load(p, __ATOMIC_RELAXED, __HIP_MEMORY_SCOPE_AGENT); }
__device__ __forceinline__ unsigned xb_add(unsigned* p, unsigned v) { return __hip_atomic_fetch_add(p, v, __ATOMIC_RELAXED, __HIP_MEMORY_SCOPE_AGENT); }
__device__ __forceinline__ unsigned xb_xcc_id() { return (unsigned)__builtin_amdgcn_s_getreg((3 << 11) | 20) & 0xFu; }
#define XB_SPIN(cond, bar) do { unsigned _sp = 0; while (cond) { __builtin_amdgcn_s_sleep(1); \
    if ((++_sp & 255u) == 0u) { if (xb_ld(&(bar)[XB_TMO])) break; if (_sp > XB_SPIN_CAP) { atomicAdd(&(bar)[XB_TMO], 1u); break; } } } } while (0)

struct XcdBarrier {
    unsigned* bar; unsigned x;
    volatile LAS unsigned* st;
};

__device__ __forceinline__ XcdBarrier xcd_barrier_post(unsigned* bar, volatile LAS unsigned* st) {
    XcdBarrier b; b.bar = bar; b.x = xb_xcc_id(); b.st = st;
    if (threadIdx.x == 0) (void)xb_add(&bar[XB_XCNT(b.x)], 1u);
    return b;
}
__device__ __forceinline__ void xcd_barrier_complete(unsigned* bar, unsigned x, unsigned& nloc, unsigned& nx) {
    const unsigned G = gridDim.x * gridDim.y * gridDim.z;
    unsigned sum, cnt, mine, sp = 0u;
    for (;;) {
        sum = 0u; cnt = 0u; mine = 0u;
#pragma unroll
        for (unsigned j = 0; j < 16; ++j) { const unsigned c = xb_ld(&bar[XB_XCNT(j)]); sum += c; cnt += (c > 0u) ? 1u : 0u; mine = (j == x) ? c : mine; }
        if (sum == G) break;
        __builtin_amdgcn_s_sleep(1);
        if ((++sp & 255u) == 0u) { if (xb_ld(&bar[XB_TMO])) break; if (sp > XB_SPIN_CAP) { atomicAdd(&bar[XB_TMO], 1u); break; } }
    }
    nloc = mine > 0u ? mine : 1u; nx = cnt > 0u ? cnt : 1u;
}

__device__ __forceinline__ void xcd_barrier(const XcdBarrier& b) {
    asm volatile("s_waitcnt vmcnt(0)" ::: "memory");
    __syncthreads();
    if (threadIdx.x == 0) {
        unsigned* bar = b.bar;
        __builtin_amdgcn_s_waitcnt(0);
        unsigned nloc = b.st[0], nx = b.st[1];
        if (nloc == 0u) { xcd_barrier_complete(bar, b.x, nloc, nx); b.st[0] = nloc; b.st[1] = nx; }
        const unsigned old = xb_add(&bar[XB_XSUB(b.x)], 1u);
        const unsigned gen = old / nloc;
        if (old + 1u == (gen + 1u) * nloc) {
            __builtin_amdgcn_fence(__ATOMIC_RELEASE, "agent");
            asm volatile("s_waitcnt vmcnt(0)" ::: "memory");
            const unsigned og = xb_add(&bar[XB_TOP], 1u);
            const unsigned tg = og / nx;
            if (og + 1u == (tg + 1u) * nx) xb_add(&bar[XB_TOPGEN], 1u);
            else XB_SPIN(xb_ld(&bar[XB_TOPGEN]) == tg, bar);
            __builtin_amdgcn_fence(__ATOMIC_ACQUIRE, "agent");
            xb_add(&bar[XB_XGEN(b.x)], 1u);
            asm volatile("s_waitcnt vmcnt(0)" ::: "memory");
        } else {
            XB_SPIN(xb_ld(&bar[XB_XGEN(b.x)]) == gen, bar);
            __builtin_amdgcn_fence(__ATOMIC_ACQUIRE, "agent");
            asm volatile("s_waitcnt vmcnt(0)" ::: "memory");
        }
    }
    __syncthreads();
}
typedef short s16x4 __attribute__((ext_vector_type(4)));
__device__ __forceinline__ void phase_na(const Params& p, LAS unsigned char* lds) {
    const int tid = fresh_tid(), lane = tid & 63, wave = tid >> 6, G = gridDim.x;
    const int vcu = (G % 8 == 0) ? ((int)blockIdx.x % 8) * (G / 8) + (int)blockIdx.x / 8 : (int)blockIdx.x;
    LAS float* rpb_s = (LAS float*)lds;
    const int qi = lane & 15, g = lane >> 4;
    for (int it = vcu; it < 1024; it += G) {
        const int bh = it >> 4, rp = it & 15;
        const int h = bh & 7, b = bh >> 3;
        __syncthreads();
        for (int i = tid; i < 465; i += NT) rpb_s[i] = p.rpb[h * 465 + i];
        __syncthreads();
        const int r = rp * 2 + (wave >> 2), c0 = (wave & 3) * 16;
        int rs = r - 4; rs = rs < 0 ? 0 : (rs > 24 ? 24 : rs);
        int cs0 = c0 - 8; cs0 = cs0 < 0 ? 0 : (cs0 > 32 ? 32 : cs0);
        const int c = c0 + qi;
        int csq = c - 8; csq = csq < 0 ? 0 : (csq > 48 ? 48 : csq);
        const size_t hb = (size_t)(b * 8 + h) * 2048;
        bf16x8 qf[2];
#pragma unroll
        for (int ks = 0; ks < 2; ++ks) qf[ks] = *(const bf16x8*)(p.QNA() + (hb + r * 64 + c) * 64 + ks * 32 + 8 * g);
        float s[16][4];
#pragma unroll
        for (int j = 0; j < 8; ++j)
#pragma unroll
            for (int ct = 0; ct < 2; ++ct) {
                const int kt = (rs + j) * 64 + cs0 + ct * 16 + qi;
                f32x4 a = {0.f, 0.f, 0.f, 0.f};
#pragma unroll
                for (int ks = 0; ks < 2; ++ks) {
                    const bf16x8 kf = *(const bf16x8*)(p.KNA() + (hb + kt) * 64 + ks * 32 + 8 * g);
                    a = __builtin_amdgcn_mfma_f32_16x16x32_bf16(kf, qf[ks], a, 0, 0, 0);
                }
                const LAS float* brow = rpb_s + (rs + j - r + 7) * 31;
#pragma unroll
                for (int rr = 0; rr < 4; ++rr) {
                    const int kc = cs0 + ct * 16 + 4 * g + rr;
                    const bool valid = (kc >= csq) && (kc < csq + 16);
                    int dc = kc - c + 15; dc = dc < 0 ? 0 : (dc > 30 ? 30 : dc);
                    s[j * 2 + ct][rr] = valid ? a[rr] + brow[dc] : -1e30f;
                }
            }
        float mx = -3e38f;
#pragma unroll
        for (int i = 0; i < 16; ++i)
#pragma unroll
            for (int rr = 0; rr < 4; ++rr) mx = fmaxf(mx, s[i][rr]);
        mx = fmaxf(mx, __shfl_xor(mx, 16)); mx = fmaxf(mx, __shfl_xor(mx, 32));
        float sum = 0.f;
#pragma unroll
        for (int i = 0; i < 16; ++i)
#pragma unroll
            for (int rr = 0; rr < 4; ++rr) { s[i][rr] = __expf(s[i][rr] - mx); sum += s[i][rr]; }
        sum += __shfl_xor(sum, 16); sum += __shfl_xor(sum, 32);
        const float inv = 1.f / sum;
        f32x4 o[4];
#pragma unroll
        for (int dt = 0; dt < 4; ++dt) o[dt] = (f32x4){0.f, 0.f, 0.f, 0.f};
#pragma unroll
        for (int kk = 0; kk < 8; ++kk) {
            u32x4 pw; pw.x = pk2(s[2 * kk][0] * inv, s[2 * kk][1] * inv); pw.y = pk2(s[2 * kk][2] * inv, s[2 * kk][3] * inv);
            pw.z = pk2(s[2 * kk + 1][0] * inv, s[2 * kk + 1][1] * inv); pw.w = pk2(s[2 * kk + 1][2] * inv, s[2 * kk + 1][3] * inv);
            const bf16x8 pf = __builtin_bit_cast(bf16x8, pw);
            const int tk = (rs + kk) * 64 + cs0 + 4 * g;
#pragma unroll
            for (int dt = 0; dt < 4; ++dt) {
                const bf16* vp = p.VNAT() + ((size_t)(b * 8 + h) * 64 + dt * 16 + qi) * 2048 + tk;
                const s16x4 lo = *(const s16x4*)vp, hi = *(const s16x4*)(vp + 16);
                const bf16x8 vf = __builtin_shufflevector(lo, hi, 0, 1, 2, 3, 4, 5, 6, 7);
                o[dt] = __builtin_amdgcn_mfma_f32_16x16x32_bf16(pf, vf, o[dt], 0, 0, 0);
            }
        }
#pragma unroll
        for (int dt = 0; dt < 4; ++dt)
#pragma unroll
            for (int rr = 0; rr < 4; ++rr) {
                const size_t tg = (size_t)b * 2048 + r * 64 + c0 + 4 * g + rr;
                p.NAOUT()[tg * 512 + h * 64 + dt * 16 + qi] = (bf16)f2bf(o[dt][rr]);
            }
    }
}
#define LDSTR 72
#define MATB (64 * LDSTR * 2)
__device__ __forceinline__ f32x4 mfma16(bf16x8 a, bf16x8 b, f32x4 c) { return __builtin_amdgcn_mfma_f32_16x16x32_bf16(a, b, c, 0, 0, 0); }

__device__ __forceinline__ void slab_mma(const LAS bf16* A, const LAS bf16* Bt, int w, int lane, f32x4 (&acc)[4]) {
    const int r16 = lane & 15, g = lane >> 4;
    const bf16x8 a0 = *(const LAS bf16x8*)(A + (16 * w + r16) * LDSTR + 8 * g);
    const bf16x8 a1 = *(const LAS bf16x8*)(A + (16 * w + r16) * LDSTR + 32 + 8 * g);
#pragma unroll
    for (int nt = 0; nt < 4; ++nt) {
        const bf16x8 b0 = *(const LAS bf16x8*)(Bt + (nt * 16 + r16) * LDSTR + 8 * g);
        const bf16x8 b1 = *(const LAS bf16x8*)(Bt + (nt * 16 + r16) * LDSTR + 32 + 8 * g);
        acc[nt] = mfma16(a0, b0, acc[nt]); acc[nt] = mfma16(a1, b1, acc[nt]);
    }
}

struct DnBufs { char* ws; char* out;
    __device__ __forceinline__ bf16* MN() const { return (bf16*)out; }
    __device__ __forceinline__ bf16* QO() const { return WSP(bf16, 179); }
    __device__ __forceinline__ bf16* SB() const { return WSP(bf16, 97); } };

__device__ __forceinline__ void conv16(const Params& p, const bf16* src, size_t hb, int t, int d0, int wch, float (&y)[16]) {
#pragma unroll
    for (int d = 0; d < 16; ++d) y[d] = 0.f;
#pragma unroll
    for (int j = 0; j < 5; ++j) {
        const int tt = t + j - 2;
        if (tt >= 0 && tt < SEQ) {
            const bf16x8 x0 = *(const bf16x8*)(src + (hb + tt) * 64 + d0), x1 = *(const bf16x8*)(src + (hb + tt) * 64 + d0 + 8);
            const float* cw = p.conv_w + j * 1536 + wch + d0;
#pragma unroll
            for (int d = 0; d < 8; ++d) { y[d] = fmaf(bf2f((unsigned short)x0[d]), cw[d], y[d]); y[8 + d] = fmaf(bf2f((unsigned short)x1[d]), cw[8 + d], y[8 + d]); }
        }
    }
#pragma unroll
    for (int d = 0; d < 16; ++d) y[d] = siluf_(y[d]);
}

__device__ __forceinline__ void phase_dnprep(const Params& p, const DnBufs& B, LAS unsigned char* lds) {
    const int tid = fresh_tid(), lane = tid & 63, wave = tid >> 6, team = wave >> 2, w = wave & 3, tt = tid & 255, G = gridDim.x;
    const int r16 = lane & 15, g = lane >> 4;
    LAS unsigned char* base = lds + team * 71680;
    LAS bf16* Kr = (LAS bf16*)(base);
    LAS bf16* Qr = (LAS bf16*)(base + MATB);
    LAS bf16* KdT = (LAS bf16*)(base + 2 * MATB);
    LAS bf16* KbT = (LAS bf16*)(base + 3 * MATB);
    LAS bf16* VbT = (LAS bf16*)(base + 4 * MATB);
    LAS bf16* IN = (LAS bf16*)(base + 5 * MATB);
    LAS float* Lm = (LAS float*)(base + 6 * MATB);
    LAS bf16* Tm = Kr; LAS bf16* WT = (LAS bf16*)Lm; LAS bf16* UT = KbT;
    LAS float* sm = (LAS float*)(lds + 143360 + team * 1024);
    LAS float* beta_s = sm; LAS float* gc_s = sm + 64;
    for (int it = blockIdx.x * 2 + team; it < 4096; it += G * 2) {
        const int cc = it & 31, dir = (it >> 5) & 1, bh = it >> 6, h = bh & 7, b = bh >> 3;
        const size_t hb = (size_t)bh * 2048;
        __syncthreads();
        if (w == 0) {
            const int s = cc * 64 + lane, t = dir ? 2047 - s : s;
            const float be = p.GATES()[(size_t)dir * NTOK * 8 + hb + t];
            float gv = p.GATES()[(size_t)(2 + dir) * NTOK * 8 + hb + t];
#pragma unroll
            for (int o = 1; o < 64; o <<= 1) { const float n = __shfl_up(gv, o); if (lane >= o) gv += n; }
            beta_s[lane] = be; gc_s[lane] = gv;
        }
        __syncthreads();
        {
            const int i = tt >> 2, d0 = (tt & 3) * 16;
            const int s = cc * 64 + i, t = dir ? 2047 - s : s;
            const float be = beta_s[i], gci = gc_s[i], gl = gc_s[63];
            const float e_gc = __expf(gci), e_kd = __expf(gl - gci);
            float y[16];
            conv16(p, p.QKVDN() + (size_t)NTOK * 512, hb, t, d0, 512 + h * 64, y);
            float ss = 0.f;
#pragma unroll
            for (int d = 0; d < 16; ++d) ss = fmaf(y[d], y[d], ss);
            ss += __shfl_xor(ss, 1); ss += __shfl_xor(ss, 2);
            float rn = rsqrtf(ss + RMS_EPS);
#pragma unroll
            for (int d = 0; d < 16; ++d) y[d] *= rn;
            {
                u32x4 o0, o1; o0.x = pk2(y[0], y[1]); o0.y = pk2(y[2], y[3]); o0.z = pk2(y[4], y[5]); o0.w = pk2(y[6], y[7]);
                o1.x = pk2(y[8], y[9]); o1.y = pk2(y[10], y[11]); o1.z = pk2(y[12], y[13]); o1.w = pk2(y[14], y[15]);
                *(LAS u32x4*)(Kr + i * LDSTR + d0) = o0; *(LAS u32x4*)(Kr + i * LDSTR + d0 + 8) = o1;
            }
#pragma unroll
            for (int d = 0; d < 16; ++d) { KdT[(d0 + d) * LDSTR + i] = (bf16)f2bf(y[d] * e_kd); KbT[(d0 + d) * LDSTR + i] = (bf16)f2bf(y[d] * be * e_gc); }
            conv16(p, p.QKVDN(), hb, t, d0, h * 64, y);
            ss = 0.f;
#pragma unroll
            for (int d = 0; d < 16; ++d) ss = fmaf(y[d], y[d], ss);
            ss += __shfl_xor(ss, 1); ss += __shfl_xor(ss, 2);
            rn = rsqrtf(ss + RMS_EPS);
#pragma unroll
            for (int d = 0; d < 16; ++d) y[d] *= rn;
            {
                u32x4 o0, o1; o0.x = pk2(y[0], y[1]); o0.y = pk2(y[2], y[3]); o0.z = pk2(y[4], y[5]); o0.w = pk2(y[6], y[7]);
                o1.x = pk2(y[8], y[9]); o1.y = pk2(y[10], y[11]); o1.z = pk2(y[12], y[13]); o1.w = pk2(y[14], y[15]);
                *(LAS u32x4*)(Qr + i * LDSTR + d0) = o0; *(LAS u32x4*)(Qr + i * LDSTR + d0 + 8) = o1;
            }
            conv16(p, p.QKVDN() + (size_t)2 * NTOK * 512, hb, t, d0, 1024 + h * 64, y);
#pragma unroll
            for (int d = 0; d < 16; ++d) VbT[(d0 + d) * LDSTR + i] = (bf16)f2bf(y[d] * be);
        }
        __syncthreads();
        {
            f32x4 akk[4], aqk[4];
#pragma unroll
            for (int nt = 0; nt < 4; ++nt) { akk[nt] = (f32x4){0.f, 0.f, 0.f, 0.f}; aqk[nt] = (f32x4){0.f, 0.f, 0.f, 0.f}; }
            slab_mma(Kr, Kr, w, lane, akk);
            slab_mma(Qr, Kr, w, lane, aqk);
#pragma unroll
            for (int nt = 0; nt < 4; ++nt) {
                const int j = nt * 16 + r16; const float gcj = gc_s[j];
#pragma unroll
                for (int r = 0; r < 4; ++r) {
                    const int i = 16 * w + 4 * g + r;
                    const float dec = (j <= i) ? __expf(gc_s[i] - gcj) : 0.f;
                    Lm[i * 64 + j] = (j < i) ? beta_s[i] * akk[nt][r] * dec : 0.f;
                    IN[i * LDSTR + j] = (bf16)f2bf(aqk[nt][r] * 0.125f * dec);
                }
            }
        }
        __syncthreads();
        if (w == 0) {
            float x[64];
#pragma unroll
            for (int i = 0; i < 64; ++i) {
                float a0 = (i == lane) ? 1.f : 0.f, a1 = 0.f, a2 = 0.f, a3 = 0.f;
#pragma unroll
                for (int m = 0; m < i; ++m) {
                    const float l = Lm[i * 64 + m];
                    if ((m & 3) == 0) a0 = fmaf(-l, x[m], a0); else if ((m & 3) == 1) a1 = fmaf(-l, x[m], a1); else if ((m & 3) == 2) a2 = fmaf(-l, x[m], a2); else a3 = fmaf(-l, x[m], a3);
                }
                x[i] = (a0 + a1) + (a2 + a3);
                Tm[i * LDSTR + lane] = (bf16)f2bf(x[i]);
                asm volatile("" ::: "memory");
            }
        }
        __syncthreads();
        {
            f32x4 a[4];
#pragma unroll
            for (int nt = 0; nt < 4; ++nt) a[nt] = (f32x4){0.f, 0.f, 0.f, 0.f};
            slab_mma(Tm, KbT, w, lane, a);
#pragma unroll
            for (int nt = 0; nt < 4; ++nt) { u32x2 o; o.x = pk2(a[nt][0], a[nt][1]); o.y = pk2(a[nt][2], a[nt][3]); *(LAS u32x2*)(WT + (nt * 16 + r16) * LDSTR + 16 * w + 4 * g) = o; }
        }
        __syncthreads();
        {
            f32x4 a[4];
#pragma unroll
            for (int nt = 0; nt < 4; ++nt) a[nt] = (f32x4){0.f, 0.f, 0.f, 0.f};
            slab_mma(Tm, VbT, w, lane, a);
#pragma unroll
            for (int nt = 0; nt < 4; ++nt) { u32x2 o; o.x = pk2(a[nt][0], a[nt][1]); o.y = pk2(a[nt][2], a[nt][3]); *(LAS u32x2*)(UT + (nt * 16 + r16) * LDSTR + 16 * w + 4 * g) = o; }
        }
        __syncthreads();
        {
            const float egl = __expf(gc_s[63]);
            bf16* Mg = B.MN() + (size_t)it * 8192; bf16* NTg = Mg + 4096;
            const int tc = dir ? 31 - cc : cc;
            bf16* Qg = B.QO() + ((size_t)((bh * 2 + dir) * 32 + tc)) * 8192; bf16* OTg = Qg + 4096;
            f32x4 a[4];
#pragma unroll
            for (int nt = 0; nt < 4; ++nt) a[nt] = (f32x4){0.f, 0.f, 0.f, 0.f};
            slab_mma(KdT, WT, w, lane, a);
#pragma unroll
            for (int nt = 0; nt < 4; ++nt)
#pragma unroll
                for (int r = 0; r < 4; ++r) { const int ra = 16 * w + 4 * g + r, cb = nt * 16 + r16; Mg[ra * 64 + cb] = (bf16)f2bf((ra == cb ? egl : 0.f) - a[nt][r]); }
#pragma unroll
            for (int nt = 0; nt < 4; ++nt) a[nt] = (f32x4){0.f, 0.f, 0.f, 0.f};
            slab_mma(KdT, UT, w, lane, a);
#pragma unroll
            for (int nt = 0; nt < 4; ++nt) { u32x2 o; o.x = pk2(a[nt][0], a[nt][1]); o.y = pk2(a[nt][2], a[nt][3]); *(u32x2*)(NTg + (nt * 16 + r16) * 64 + 16 * w + 4 * g) = o; }
#pragma unroll
            for (int nt = 0; nt < 4; ++nt) a[nt] = (f32x4){0.f, 0.f, 0.f, 0.f};
            slab_mma(IN, WT, w, lane, a);
#pragma unroll
            for (int nt = 0; nt < 4; ++nt)
#pragma unroll
                for (int r = 0; r < 4; ++r) { const int i = 16 * w + 4 * g + r, cb = nt * 16 + r16; const int ro = dir ? 63 - i : i;
                    const float qd = bf2f(Qr[i * LDSTR + cb]) * 0.125f * __expf(gc_s[i]);
                    Qg[ro * 64 + cb] = (bf16)f2bf(qd - a[nt][r]); }
#pragma unroll
            for (int nt = 0; nt < 4; ++nt) a[nt] = (f32x4){0.f, 0.f, 0.f, 0.f};
            slab_mma(IN, UT, w, lane, a);
#pragma unroll
            for (int nt = 0; nt < 4; ++nt) { const int i0 = 16 * w + 4 * g; u32x2 o;
                if (dir) { o.x = pk2(a[nt][3], a[nt][2]); o.y = pk2(a[nt][1], a[nt][0]); *(u32x2*)(OTg + (nt * 16 + r16) * 64 + 60 - i0) = o; }
                else { o.x = pk2(a[nt][0], a[nt][1]); o.y = pk2(a[nt][2], a[nt][3]); *(u32x2*)(OTg + (nt * 16 + r16) * 64 + i0) = o; } }
        }
    }
}

__device__ __forceinline__ void phase_dnscan(const Params& p, const DnBufs& B, LAS unsigned char* lds) {
    const int tid = fresh_tid(), lane = tid & 63, wave = tid >> 6;
    const int r16 = lane & 15, g = lane >> 4;
    if (wave < 4) {
    const int vp = wave;
    LAS bf16* St = (LAS bf16*)(lds + wave * (16 * LDSTR * 2));
    for (int chain = blockIdx.x; chain < 128; chain += gridDim.x) {
    f32x4 sacc[4];
#pragma unroll
    for (int mt = 0; mt < 4; ++mt) sacc[mt] = (f32x4){0.f, 0.f, 0.f, 0.f};
    for (int cc = 0; cc < 32; ++cc) {
        const size_t item = (size_t)chain * 32 + cc;
        const bf16* Mg = B.MN() + item * 8192; const bf16* NTg = Mg + 4096;
        bf16* Sg = B.SB() + item * 4096;
#pragma unroll
        for (int mt = 0; mt < 4; ++mt) { u32x2 o; o.x = pk2(sacc[mt][0], sacc[mt][1]); o.y = pk2(sacc[mt][2], sacc[mt][3]);
            *(u32x2*)(Sg + (vp * 16 + r16) * 64 + mt * 16 + 4 * g) = o; *(LAS u32x2*)(St + r16 * LDSTR + mt * 16 + 4 * g) = o; }
        LDS_WAIT();
        const bf16x8 s0 = *(const LAS bf16x8*)(St + r16 * LDSTR + 8 * g), s1 = *(const LAS bf16x8*)(St + r16 * LDSTR + 32 + 8 * g);
#pragma unroll
        for (int mt = 0; mt < 4; ++mt) {
            const u32x2 nv = *(const u32x2*)(NTg + (vp * 16 + r16) * 64 + mt * 16 + 4 * g);
            f32x4 a = {bf2f(nv.x & 0xffffu), bf2f(nv.x >> 16), bf2f(nv.y & 0xffffu), bf2f(nv.y >> 16)};
            const bf16x8 m0 = *(const bf16x8*)(Mg + (mt * 16 + r16) * 64 + 8 * g), m1 = *(const bf16x8*)(Mg + (mt * 16 + r16) * 64 + 32 + 8 * g);
            a = mfma16(m0, s0, a); a = mfma16(m1, s1, a);
            sacc[mt] = a;
        }
        LDS_WAIT();
    }
    }
    }
}

__device__ __forceinline__ void phase_dnout(const Params& p, const DnBufs& B) {
    const int tid = fresh_tid(), lane = tid & 63, wave = tid >> 6, G = gridDim.x;
    const int r16 = lane & 15, g = lane >> 4;
    for (int task = blockIdx.x * 8 + wave; task < 8192; task += G * 8) {
        const int w = task & 3, tc = (task >> 2) & 31, bh = task >> 7, h = bh & 7, b = bh >> 3;
        f32x4 acc[4];
#pragma unroll
        for (int vt = 0; vt < 4; ++vt) acc[vt] = (f32x4){0.f, 0.f, 0.f, 0.f};
#pragma unroll
        for (int dir = 0; dir < 2; ++dir) {
            const int cc = dir ? 31 - tc : tc;
            const bf16* Qg = B.QO() + ((size_t)((bh * 2 + dir) * 32 + tc)) * 8192; const bf16* OTg = Qg + 4096;
            const bf16* Sg = B.SB() + ((size_t)((bh * 2 + dir) * 32 + cc)) * 4096;
            const bf16x8 q0 = *(const bf16x8*)(Qg + (16 * w + r16) * 64 + 8 * g), q1 = *(const bf16x8*)(Qg + (16 * w + r16) * 64 + 32 + 8 * g);
#pragma unroll
            for (int vt = 0; vt < 4; ++vt) {
                const u32x2 ov = *(const u32x2*)(OTg + (vt * 16 + r16) * 64 + 16 * w + 4 * g);
                acc[vt][0] += bf2f(ov.x & 0xffffu); acc[vt][1] += bf2f(ov.x >> 16); acc[vt][2] += bf2f(ov.y & 0xffffu); acc[vt][3] += bf2f(ov.y >> 16);
                const bf16x8 s0 = *(const bf16x8*)(Sg + (vt * 16 + r16) * 64 + 8 * g), s1 = *(const bf16x8*)(Sg + (vt * 16 + r16) * 64 + 32 + 8 * g);
                acc[vt] = mfma16(q0, s0, acc[vt]); acc[vt] = mfma16(q1, s1, acc[vt]);
            }
        }
#pragma unroll
        for (int r = 0; r < 4; ++r) {
            float ss = 0.f;
#pragma unroll
            for (int vt = 0; vt < 4; ++vt) ss = fmaf(acc[vt][r], acc[vt][r], ss);
            ss += __shfl_xor(ss, 1); ss += __shfl_xor(ss, 2); ss += __shfl_xor(ss, 4); ss += __shfl_xor(ss, 8);
            const float rn = rsqrtf(ss * (1.f / 64.f) + RMS_EPS);
            const int t = tc * 64 + 16 * w + 4 * g + r;
#pragma unroll
            for (int vt = 0; vt < 4; ++vt) {
                const int v = vt * 16 + r16;
                const float z = bf2f(p.Z()[((size_t)bh * 2048 + t) * 64 + v]);
                p.DNOUT()[((size_t)b * 2048 + t) * 512 + h * 64 + v] = (bf16)f2bf(acc[vt][r] * rn * p.norm_w[v] * z);
            }
        }
    }
}

struct MixBufs { char* ws; char* out;
    __device__ __forceinline__ bf16* GB() const { return WSP(bf16, 179); }
    __device__ __forceinline__ bf16* MERGED() const { return WSP(bf16, 211); }
    __device__ __forceinline__ float* V() const { return (float*)out; } };
template <int MODE>
struct EpiMerge {
    static constexpr bool PERM = true, AFTER_DRAIN = false;
    bf16* GB; bf16* MG;
    __device__ __forceinline__ void operator()(const pg8::f32x4 (&acc)[2][2][4][2], const pg8::Unit& u, int wr, int wc, int fr, int fq) const {
#pragma unroll
        for (int ai = 0; ai < 2; ++ai)
#pragma unroll
            for (int m = 0; m < 4; ++m) {
                const size_t row = (size_t)u.pm * 256 + ai * 128 + wr * 64 + m * 16 + fr;
#pragma unroll
                for (int bj = 0; bj < 2; ++bj) {
                    const int col = u.pn * 256 + bj * 128 + wc * 32 + 8 * fq;
                    const pg8::f32x4 v0 = acc[ai][bj][m][0], v1 = acc[ai][bj][m][1];
                    float e[8] = {v0[0], v0[1], v0[2], v0[3], v1[0], v1[1], v1[2], v1[3]};
                    if (MODE == 0) {
#pragma unroll
                        for (int j = 0; j < 8; ++j) e[j] = sigmoidf_(e[j]);
                    } else {
                        const u32x4 gw = *(const u32x4*)(GB + row * 1024 + col);
                        const unsigned gws[4] = {gw.x, gw.y, gw.z, gw.w};
#pragma unroll
                        for (int j = 0; j < 4; ++j) { e[2 * j] *= bf2f(gws[j] & 0xffffu); e[2 * j + 1] *= bf2f(gws[j] >> 16); }
                        if (MODE == 2) {
                            const u32x4 mw = *(const u32x4*)(MG + row * 1024 + col);
                            const unsigned mws[4] = {mw.x, mw.y, mw.z, mw.w};
#pragma unroll
                            for (int j = 0; j < 4; ++j) { e[2 * j] += bf2f(mws[j] & 0xffffu); e[2 * j + 1] += bf2f(mws[j] >> 16); }
                        }
                    }
                    u32x4 w; w.x = pk2(e[0], e[1]); w.y = pk2(e[2], e[3]); w.z = pk2(e[4], e[5]); w.w = pk2(e[6], e[7]);
                    *(u32x4*)((MODE == 0 ? GB : MG) + row * 1024 + col) = w;
                }
            }
    }
};
struct EpiOutProj {
    static constexpr bool PERM = false, AFTER_DRAIN = false;
    const float* x; float* V;
    __device__ __forceinline__ void operator()(const pg8::f32x4 (&acc)[2][2][4][2], const pg8::Unit& u, int wr, int wc, int fr, int fq) const {
#pragma unroll
        for (int ai = 0; ai < 2; ++ai)
#pragma unroll
            for (int m = 0; m < 4; ++m) {
                const size_t row = (size_t)u.pm * 256 + ai * 128 + wr * 64 + m * 16 + fr;
#pragma unroll
                for (int bj = 0; bj < 2; ++bj)
#pragma unroll
                    for (int n = 0; n < 2; ++n) {
                        const int col = u.pn * 256 + bj * 128 + wc * 32 + 16 * n + 4 * fq;
                        const f32x4 xv = *(const f32x4*)(x + row * 1024 + col);
                        const pg8::f32x4 a = acc[ai][bj][m][n];
                        f32x4 o = {ALPHA * xv[0] + a[0], ALPHA * xv[1] + a[1], ALPHA * xv[2] + a[2], ALPHA * xv[3] + a[3]};
                        *(f32x4*)(V + row * 1024 + col) = o;
                    }
            }
    }
};
__device__ __forceinline__ void phase_merge(const Params& p, const MixBufs& B, LAS unsigned char* lds) {
    pg8::StaticOrder S; S.init(NTOK, 1024, gridDim.x, (int)blockIdx.x);
    { pg8::Gemm g{p.XB(), p.WG(), NTOK, 1024, 1024}; EpiMerge<0> E{B.GB(), B.MERGED()}; pg8::gemm_phase<EpiMerge<0>, pg8::StaticOrder, true, true>(lds, g, S, E); }
    { pg8::Gemm g{p.NAOUT(), p.WPNA(), NTOK, 1024, 512}; EpiMerge<1> E{B.GB(), B.MERGED()}; pg8::gemm_phase<EpiMerge<1>, pg8::StaticOrder, true, true>(lds, g, S, E); }
    { pg8::Gemm g{p.XB(), p.WG() + (size_t)1024 * 1024, NTOK, 1024, 1024}; EpiMerge<0> E{B.GB(), B.MERGED()}; pg8::gemm_phase<EpiMerge<0>, pg8::StaticOrder, true, true>(lds, g, S, E); }
    { pg8::Gemm g{p.DNOUT(), p.WPDN(), NTOK, 1024, 512}; EpiMerge<2> E{B.GB(), B.MERGED()}; pg8::gemm_phase<EpiMerge<2>, pg8::StaticOrder, true, true>(lds, g, S, E); }
}
__device__ __forceinline__ void phase_outproj(const Params& p, const MixBufs& B, LAS unsigned char* lds) {
    pg8::StaticOrder S; S.init(NTOK, 1024, gridDim.x, (int)blockIdx.x);
    pg8::Gemm g{B.MERGED(), p.WOUT(), NTOK, 1024, 1024}; EpiOutProj E{p.x, B.V()};
    pg8::gemm_phase<EpiOutProj, pg8::StaticOrder, true, true>(lds, g, S, E);
}
struct MoeBufs { char* ws; char* out; int kdown;
#define TBP(T, kb) ((T*)(ws + ((size_t)243 << 20) + ((size_t)(kb) << 10)))
    __device__ __forceinline__ const float* V() const { return (const float*)out; }
    __device__ __forceinline__ bf16* X1B() const { return WSP(bf16, 17); }
    __device__ __forceinline__ bf16* XS() const { return WSP(bf16, 97); }
    __device__ __forceinline__ bf16* HID() const { return WSP(bf16, 211); }
    __device__ __forceinline__ bf16* YPART() const { return WSP(bf16, 97); }
    __device__ __forceinline__ int* CNT() const { return TBP(int, 0); }
    __device__ __forceinline__ int* ROUTE() const { return TBP(int, 64); }
    __device__ __forceinline__ float* ROUTEP() const { return TBP(float, 384); }
    __device__ __forceinline__ int* ROWINFO() const { return TBP(int, 576); }
    __device__ __forceinline__ float* ROWPW() const { return TBP(float, 768); }
    __device__ __forceinline__ float* STATS() const { return TBP(float, 960); }
    __device__ __forceinline__ bf16* RWH() const { return TBP(bf16, 1152); }
    __device__ __forceinline__ bf16* RWL() const { return TBP(bf16, 1280); }
};
#define XSTR 1032
#define TAB_OFF 131072

__device__ __forceinline__ void phase0_router(const Params& p, const MoeBufs& B) {
    const size_t gt = (size_t)blockIdx.x * NT + fresh_tid(), GT = (size_t)gridDim.x * NT;
    for (size_t i = gt; i < 48 * 1024; i += GT) {
        const int n = (int)(i >> 10), k = (int)(i & 1023);
        const float w = n < 4 ? p.wrg[k * 4 + n] : (n < 36 ? p.wre[k * 32 + n - 4] : 0.f);
        const unsigned hi = f2bf(w); const float lo = w - bf2f(hi);
        B.RWH()[i] = (bf16)hi; B.RWL()[i] = (bf16)f2bf(lo);
    }
}

__device__ __forceinline__ float wave_sum64(float v) {
#pragma unroll
    for (int o = 1; o < 64; o <<= 1) v += __shfl_xor(v, o);
    return v;
}

__device__ __forceinline__ void phase_ln1(const Params& p, const MoeBufs& B, LAS unsigned char* lds) {
    const int tid = fresh_tid(), lane = tid & 63, wave = tid >> 6;
    const int r16 = lane & 15, g = lane >> 4;
    LAS bf16* XH = (LAS bf16*)lds;
    LAS bf16* XL = (LAS bf16*)(lds + 16 * XSTR * 2);
    LAS float* PART = (LAS float*)(lds + 2 * 16 * XSTR * 2);
    LAS float* LOG = PART + 8 * 16 * 48;
    LAS int* hist = (LAS int*)(LOG + 16 * 36);
    if (tid < 32) hist[tid] = 0;
    for (int i = blockIdx.x * NT + tid; i < 40960; i += gridDim.x * NT) B.ROWINFO()[i] = -1;
    for (int blk = blockIdx.x; blk < 256; blk += gridDim.x) {
        for (int itn = 0; itn < 4; ++itn) {
            __syncthreads();
#pragma unroll
            for (int q = 0; q < 2; ++q) {
                const int lt = 2 * wave + q; const size_t tg = (size_t)blk * 64 + itn * 16 + lt;
                f32x4 v[4]; float s = 0.f;
#pragma unroll
                for (int j = 0; j < 4; ++j) { v[j] = *(const f32x4*)(B.V() + tg * 1024 + 4 * lane + 256 * j); s += (v[j][0] + v[j][1]) + (v[j][2] + v[j][3]); }
                const float mu = wave_sum64(s) * (1.f / 1024.f);
                float qq = 0.f;
#pragma unroll
                for (int j = 0; j < 4; ++j) { v[j] = v[j] - mu; qq += (v[j][0] * v[j][0] + v[j][1] * v[j][1]) + (v[j][2] * v[j][2] + v[j][3] * v[j][3]); }
                const float rstd = rsqrtf(wave_sum64(qq) * (1.f / 1024.f) + LN_EPS);
                if (lane == 0) { B.STATS()[tg * 2] = mu; B.STATS()[tg * 2 + 1] = rstd; }
#pragma unroll
                for (int j = 0; j < 4; ++j) {
                    const int c = 4 * lane + 256 * j;
                    const f32x4 gg = *(const f32x4*)(p.ln1_g + c), bb = *(const f32x4*)(p.ln1_b + c);
                    float y[4]; unsigned hi[4]; float lo[4];
#pragma unroll
                    for (int e = 0; e < 4; ++e) { y[e] = v[j][e] * rstd * gg[e] + bb[e]; hi[e] = f2bf(y[e]); lo[e] = y[e] - bf2f(hi[e]); }
                    u32x2 hw; hw.x = hi[0] | (hi[1] << 16); hw.y = hi[2] | (hi[3] << 16);
                    u32x2 lw; lw.x = pk2(lo[0], lo[1]); lw.y = pk2(lo[2], lo[3]);
                    *(u32x2*)(B.X1B() + tg * 1024 + c) = hw;
                    *(LAS u32x2*)(XH + lt * XSTR + c) = hw; *(LAS u32x2*)(XL + lt * XSTR + c) = lw;
                }
            }
            __syncthreads();
            {
                f32x4 acc[3];
#pragma unroll
                for (int nt = 0; nt < 3; ++nt) acc[nt] = (f32x4){0.f, 0.f, 0.f, 0.f};
#pragma unroll
                for (int ks = 0; ks < 4; ++ks) {
                    const int k0 = wave * 128 + ks * 32 + 8 * g;
                    const bf16x8 ah = *(const LAS bf16x8*)(XH + r16 * XSTR + k0), al = *(const LAS bf16x8*)(XL + r16 * XSTR + k0);
#pragma unroll
                    for (int nt = 0; nt < 3; ++nt) {
                        const bf16x8 bh = *(const bf16x8*)(B.RWH() + (size_t)(nt * 16 + r16) * 1024 + k0), bl = *(const bf16x8*)(B.RWL() + (size_t)(nt * 16 + r16) * 1024 + k0);
                        acc[nt] = mfma16(ah, bh, acc[nt]); acc[nt] = mfma16(ah, bl, acc[nt]); acc[nt] = mfma16(al, bh, acc[nt]);
                    }
                }
#pragma unroll
                for (int nt = 0; nt < 3; ++nt)
#pragma unroll
                    for (int r = 0; r < 4; ++r) PART[(wave * 16 + 4 * g + r) * 48 + nt * 16 + r16] = acc[nt][r];
            }
            __syncthreads();
            for (int idx = tid; idx < 16 * 36; idx += NT) {
                const int tk = idx / 36, n = idx % 36;
                float a = n < 4 ? p.brg[n] : p.bre[n - 4];
#pragma unroll
                for (int w2 = 0; w2 < 8; ++w2) a += PART[(w2 * 16 + tk) * 48 + n];
                LOG[tk * 36 + n] = a;
            }
            __syncthreads();
            if (tid < 16) {
                const LAS float* lg = LOG + tid * 36; const size_t tg = (size_t)blk * 64 + itn * 16 + tid;
                int gi = 0; float gm = lg[0];
                for (int q = 1; q < 4; ++q) if (lg[q] > gm) { gm = lg[q]; gi = q; }
                float gs = 0.f;
                for (int q = 0; q < 4; ++q) gs += expf(lg[q] - gm);
                const float gp = 1.f / gs;
                const LAS float* el = lg + 4 + gi * 8;
                int i1 = 0; float l1 = el[0];
                for (int e = 1; e < 8; ++e) if (el[e] > l1) { l1 = el[e]; i1 = e; }
                int i2 = -1; float l2 = -3.0e38f;
                for (int e = 0; e < 8; ++e) if (e != i1 && el[e] > l2) { l2 = el[e]; i2 = e; }
                const float e2 = expf(l2 - l1);
                const int e0 = gi * 8 + i1, e1 = gi * 8 + i2;
                const int r0 = atomicAdd((int*)&hist[e0], 1), r1 = atomicAdd((int*)&hist[e1], 1);
                B.ROUTE()[tg * 4] = e0; B.ROUTE()[tg * 4 + 1] = e1; B.ROUTE()[tg * 4 + 2] = r0; B.ROUTE()[tg * 4 + 3] = r1;
                B.ROUTEP()[tg * 2] = gp / (1.f + e2); B.ROUTEP()[tg * 2 + 1] = gp * e2 / (1.f + e2);
            }
        }
        __syncthreads();
        if (tid < 32) { B.CNT()[blk * 32 + tid] = hist[tid]; hist[tid] = 0; }
    }
}

__device__ __forceinline__ void moe_tables(const MoeBufs& B, LAS unsigned char* lds, int nj, int blk) {
    const int tid = fresh_tid();
    LAS int* tab = (LAS int*)(lds + TAB_OFF);
    LAS int* scr = tab + 160;
    {
        const int e = tid & 31, q = tid >> 5; int tot = 0, pre = 0;
        for (int b2 = q * 16; b2 < q * 16 + 16; ++b2) { const int c = B.CNT()[b2 * 32 + e]; tot += c; if (b2 < blk) pre += c; }
        scr[q * 64 + e] = tot; scr[q * 64 + 32 + e] = pre;
    }
    __syncthreads();
    if (tid < 32) { int tot = 0, pre = 0; for (int q = 0; q < 16; ++q) { tot += scr[q * 64 + tid]; pre += scr[q * 64 + 32 + tid]; } tab[66 + tid] = tot; tab[99 + tid] = pre; }
    __syncthreads();
    if (tid == 0) { int cum = 0, off = 0; for (int e = 0; e < 32; ++e) { tab[e] = cum; tab[33 + e] = off; const int nrt = (tab[66 + e] + 255) >> 8; cum += nrt * nj; off += nrt; } tab[32] = cum; }
    __syncthreads();
}

__device__ __forceinline__ void phase_gather(const Params& p, const MoeBufs& B, LAS unsigned char* lds) {
    const int tid = fresh_tid(), lane = tid & 63, wave = tid >> 6;
    LAS int* tab = (LAS int*)(lds + TAB_OFF);
    for (int blk = blockIdx.x; blk < 256; blk += gridDim.x) {
    moe_tables(B, lds, 2, blk);
    for (int sl = wave; sl < 128; sl += 8) {
        const int lt = sl >> 1, k = sl & 1; const size_t tg = (size_t)blk * 64 + lt;
        const int e = B.ROUTE()[tg * 4 + k], lr = B.ROUTE()[tg * 4 + 2 + k];
        const size_t row = (size_t)tab[33 + e] * 256 + tab[99 + e] + lr;
        const u32x4 a = *(const u32x4*)(B.X1B() + tg * 1024 + lane * 8), b2 = *(const u32x4*)(B.X1B() + tg * 1024 + 512 + lane * 8);
        *(u32x4*)(B.XS() + row * 1024 + lane * 8) = a; *(u32x4*)(B.XS() + row * 1024 + 512 + lane * 8) = b2;
        if (lane == 0) { B.ROWINFO()[row] = (int)tg * 2 + k; B.ROWPW()[row] = B.ROUTEP()[tg * 2 + k]; }
    }
    __syncthreads();
    }
}

struct MoeSched {
    const LAS int* tab; int G, c, nj;
    __device__ __forceinline__ bool next(int i, pg8::Unit& u) const {
        const int L = i * G + c; if (L >= tab[32]) return false;
        int e = 0;
#pragma unroll
        for (int k = 1; k < 32; ++k) e += (L >= tab[k]) ? 1 : 0;
        const int rem = L - tab[e], j = rem % nj, rt = rem / nj;
        u.pm = tab[33 + e] + rt; u.pn = e * nj + j; return true;
    }
    __device__ __forceinline__ void a_ready(const pg8::Unit&) const {}
    __device__ __forceinline__ void done(const pg8::Unit&) const {}
};
struct EpiGateUp {
    static constexpr bool PERM = true, AFTER_DRAIN = false;
    bf16* HID; const float* ROWPW;
    __device__ __forceinline__ void operator()(const pg8::f32x4 (&acc)[2][2][4][2], const pg8::Unit& u, int wr, int wc, int fr, int fq) const {
#pragma unroll
        for (int ai = 0; ai < 2; ++ai)
#pragma unroll
            for (int m = 0; m < 4; ++m) {
                const size_t row = (size_t)u.pm * 256 + ai * 128 + wr * 64 + m * 16 + fr;
                const float pw = ROWPW[row];
                const int f = (u.pn & 1) * 128 + wc * 32 + 8 * fq;
                const pg8::f32x4 g0 = acc[ai][0][m][0], g1 = acc[ai][0][m][1], u0 = acc[ai][1][m][0], u1 = acc[ai][1][m][1];
                float e[8];
#pragma unroll
                for (int j = 0; j < 4; ++j) { e[j] = siluf_(g0[j]) * u0[j] * pw; e[4 + j] = siluf_(g1[j]) * u1[j] * pw; }
                u32x4 w; w.x = pk2(e[0], e[1]); w.y = pk2(e[2], e[3]); w.z = pk2(e[4], e[5]); w.w = pk2(e[6], e[7]);
                *(u32x4*)(HID + row * 256 + f) = w;
            }
    }
};
struct EpiDown {
    static constexpr bool PERM = true, AFTER_DRAIN = false;
    bf16* YPART; const int* ROWINFO;
    __device__ __forceinline__ void operator()(const pg8::f32x4 (&acc)[2][2][4][2], const pg8::Unit& u, int wr, int wc, int fr, int fq) const {
        const int j = u.pn & 3;
#pragma unroll
        for (int ai = 0; ai < 2; ++ai)
#pragma unroll
            for (int m = 0; m < 4; ++m) {
                const int row = u.pm * 256 + ai * 128 + wr * 64 + m * 16 + fr;
                asm volatile("" ::: "memory");
                const int info = ROWINFO[row];
                if (info >= 0) {
                    const size_t tg = (size_t)(info >> 1); const int k = info & 1;
#pragma unroll
                    for (int bj = 0; bj < 2; ++bj) {
                        const int col = j * 256 + bj * 128 + wc * 32 + 8 * fq;
                        const pg8::f32x4 v0 = acc[ai][bj][m][0], v1 = acc[ai][bj][m][1];
                        u32x4 w; w.x = pk2(v0[0], v0[1]); w.y = pk2(v0[2], v0[3]); w.z = pk2(v1[0], v1[1]); w.w = pk2(v1[2], v1[3]);
                        *(u32x4*)(YPART + ((size_t)k * NTOK + tg) * 1024 + col) = w;
                    }
                }
            }
    }
};
__device__ __forceinline__ void phase_moe1(const Params& p, const MoeBufs& B, LAS unsigned char* lds) {
    moe_tables(B, lds, 2, 0);
    MoeSched S{(const LAS int*)(lds + TAB_OFF), (int)gridDim.x, (int)blockIdx.x, 2};
    pg8::Gemm g{B.XS(), p.WGU(), 0, 0, 1024}; EpiGateUp E{B.HID(), B.ROWPW()};
    pg8::gemm_phase<EpiGateUp, MoeSched, true, true>(lds, g, S, E);
}
__device__ __forceinline__ void phase_moe2(const Params& p, const MoeBufs& B, LAS unsigned char* lds) {
    moe_tables(B, lds, 4, 0);
    MoeSched S{(const LAS int*)(lds + TAB_OFF), (int)gridDim.x, (int)blockIdx.x, 4};
    pg8::Gemm g{B.HID(), p.WD(), 0, 0, B.kdown}; EpiDown E{B.YPART(), B.ROWINFO()};
    pg8::gemm_phase<EpiDown, MoeSched, true, true>(lds, g, S, E);
}
__device__ __forceinline__ void phase_ln2(const Params& p, const MoeBufs& B) {
    const int tid = fresh_tid(), lane = tid & 63, wave = tid >> 6;
    for (size_t tg = (size_t)blockIdx.x * 8 + wave; tg < NTOK; tg += (size_t)gridDim.x * 8) {
        const float mu1 = B.STATS()[tg * 2], rstd1 = B.STATS()[tg * 2 + 1];
        f32x4 v[4]; float s = 0.f;
#pragma unroll
        for (int j = 0; j < 4; ++j) {
            const int c = 4 * lane + 256 * j;
            const f32x4 x = *(const f32x4*)(B.V() + tg * 1024 + c);
            const f32x4 gg = *(const f32x4*)(p.ln1_g + c), bb = *(const f32x4*)(p.ln1_b + c);
            const u32x2 y0 = *(const u32x2*)(B.YPART() + tg * 1024 + c), y1 = *(const u32x2*)(B.YPART() + ((size_t)NTOK + tg) * 1024 + c);
            const float ya[4] = {bf2f(y0.x & 0xffffu) + bf2f(y1.x & 0xffffu), bf2f(y0.x >> 16) + bf2f(y1.x >> 16), bf2f(y0.y & 0xffffu) + bf2f(y1.y & 0xffffu), bf2f(y0.y >> 16) + bf2f(y1.y >> 16)};
#pragma unroll
            for (int e = 0; e < 4; ++e) { v[j][e] = ALPHA * ((x[e] - mu1) * rstd1 * gg[e] + bb[e]) + ya[e]; s += v[j][e]; }
        }
        const float mu = wave_sum64(s) * (1.f / 1024.f);
        float qq = 0.f;
#pragma unroll
        for (int j = 0; j < 4; ++j) { v[j] = v[j] - mu; qq += (v[j][0] * v[j][0] + v[j][1] * v[j][1]) + (v[j][2] * v[j][2] + v[j][3] * v[j][3]); }
        const float rstd = rsqrtf(wave_sum64(qq) * (1.f / 1024.f) + LN_EPS);
#pragma unroll
        for (int j = 0; j < 4; ++j) {
            const int c = 4 * lane + 256 * j;
            const f32x4 gg = *(const f32x4*)(p.ln2_g + c), bb = *(const f32x4*)(p.ln2_b + c);
            f32x4 o;
#pragma unroll
            for (int e = 0; e < 4; ++e) o[e] = v[j][e] * rstd * gg[e] + bb[e];
            *(f32x4*)(p.out + tg * 1024 + c) = o;
        }
    }
}
#ifndef PH_MASK
#define PH_MASK 8191
#endif
#define BAR_LDS_OFF (LDS_BYTES - 64)
struct MegaArgs { Params p; };
#define CAS __attribute__((address_space(4)))
__device__ __forceinline__ Params load_params(const CAS char* kp) {
    Params p; const CAS unsigned long long* src = (const CAS unsigned long long*)kp; unsigned long long* dst = (unsigned long long*)&p;
#pragma unroll
    for (unsigned i = 0; i < sizeof(Params) / 8; ++i) dst[i] = src[i];
    return p;
}
#define FRESH_P(name) const CAS char* name##_kp = kptr; asm volatile("" : "+s"(name##_kp)); const Params name = load_params(name##_kp)
#define GRID_BAR() do { const CAS char* b_kp = kptr; asm volatile("" : "+s"(b_kp)); XcdBarrier bar; bar.bar = *(unsigned* const CAS*)(b_kp + offsetof(Params, bar)); bar.x = xb_xcc_id(); \
        bar.st = (volatile LAS unsigned*)(lds + BAR_LDS_OFF); xcd_barrier(bar); } while (0)
__global__ void __launch_bounds__(NT, 2) mega_fwd(MegaArgs) {
    extern __shared__ __attribute__((aligned(16))) unsigned char lds_raw[];
    LAS unsigned char* lds = (LAS unsigned char*)lds_raw;
    const CAS char* kptr = (const CAS char*)__builtin_amdgcn_kernarg_segment_ptr();
    if (threadIdx.x < 16) ((LAS unsigned*)(lds + BAR_LDS_OFF))[threadIdx.x] = 0u;
    __syncthreads();
    { FRESH_P(p); (void)xcd_barrier_post(p.bar, (volatile LAS unsigned*)(lds + BAR_LDS_OFF)); }
#if PH_MASK & 1
    { FRESH_P(p); const MoeBufs Q{p.ws, (char*)p.out, p.kdown}; phase0(p, lds); phase0_router(p, Q); }
#endif
    GRID_BAR();
#if PH_MASK & 2
    { FRESH_P(p); phase1(p, lds); }
#endif
    GRID_BAR();
#if PH_MASK & 4
    { FRESH_P(p); phase_na(p, lds); }
#endif
#if PH_MASK & 8
    { FRESH_P(p); const DnBufs D{p.ws, (char*)p.out}; phase_dnprep(p, D, lds); }
#endif
    GRID_BAR();
#if PH_MASK & 16
    {
        FRESH_P(p); const DnBufs D{p.ws, (char*)p.out};
        const int wave = fresh_tid() >> 6, nb = (int)gridDim.x;
        if ((int)blockIdx.x >= 128) phase0_moe(p, lds, ((int)blockIdx.x - 128) * 8 + wave, (nb - 128) * 8 + 128 * 4);
        else if (wave >= 4) phase0_moe(p, lds, (nb - 128) * 8 + (int)blockIdx.x * 4 + (wave - 4), (nb - 128) * 8 + 128 * 4);
        phase_dnscan(p, D, lds);
    }
#endif
    GRID_BAR();
#if PH_MASK & 32
    { FRESH_P(p); const DnBufs D{p.ws, (char*)p.out}; phase_dnout(p, D); }
#endif
    GRID_BAR();
#if PH_MASK & 64
    { FRESH_P(p); const MixBufs X{p.ws, (char*)p.out}; phase_merge(p, X, lds); }
#endif
    GRID_BAR();
#if PH_MASK & 128
    { FRESH_P(p); const MixBufs X{p.ws, (char*)p.out}; phase_outproj(p, X, lds); }
#endif
    GRID_BAR();
#if PH_MASK & 256
    { FRESH_P(p); const MoeBufs Q{p.ws, (char*)p.out, p.kdown}; phase_ln1(p, Q, lds); }
#endif
    GRID_BAR();
#if PH_MASK & 512
    { FRESH_P(p); const MoeBufs Q{p.ws, (char*)p.out, p.kdown}; phase_gather(p, Q, lds); }
#endif
    GRID_BAR();
#if PH_MASK & 1024
    { FRESH_P(p); const MoeBufs Q{p.ws, (char*)p.out, p.kdown}; phase_moe1(p, Q, lds); }
#endif
    GRID_BAR();
#if PH_MASK & 2048
    { FRESH_P(p); const MoeBufs Q{p.ws, (char*)p.out, p.kdown}; phase_moe2(p, Q, lds); }
#endif
    GRID_BAR();
#if PH_MASK & 4096
    { FRESH_P(p); const MoeBufs Q{p.ws, (char*)p.out, p.kdown}; phase_ln2(p, Q); }
#endif
}

#define MB(x) ((size_t)(x) << 20)
extern "C" void kernel_launch(void* const* d_in, const int* in_sizes, int n_in, void* d_out, int out_size, void* d_ws, size_t ws_size, hipStream_t stream) {
    MegaArgs a{};
    Params& p = a.p;
    p.x = (const float*)d_in[0]; p.w_in = (const float*)d_in[1]; p.rpb = (const float*)d_in[2]; p.conv_w = (const float*)d_in[3];
    p.a_log_f = (const float*)d_in[4]; p.a_log_b = (const float*)d_in[5]; p.dtb_f = (const float*)d_in[6]; p.dtb_b = (const float*)d_in[7];
    p.norm_w = (const float*)d_in[8]; p.w_proj_na = (const float*)d_in[9]; p.w_proj_dn = (const float*)d_in[10]; p.w_out = (const float*)d_in[11];
    p.ln1_g = (const float*)d_in[12]; p.ln1_b = (const float*)d_in[13]; p.wrg = (const float*)d_in[14]; p.brg = (const float*)d_in[15];
    p.wre = (const float*)d_in[16]; p.bre = (const float*)d_in[17]; p.wgu = (const float*)d_in[18]; p.wd = (const float*)d_in[19];
    p.ln2_g = (const float*)d_in[20]; p.ln2_b = (const float*)d_in[21];
    p.out = (float*)d_out;
    p.ws = (char*)d_ws; p.bar = (unsigned*)d_ws; p.kdown = 256;

    static int grid = 0;
    if (grid == 0) {
        int dev = 0, cus = 0, per_cu = 0;
        hipGetDevice(&dev);
        hipDeviceGetAttribute(&cus, hipDeviceAttributeMultiprocessorCount, dev);
        hipFuncSetAttribute((const void*)mega_fwd, hipFuncAttributeMaxDynamicSharedMemorySize, LDS_BYTES);
        hipOccupancyMaxActiveBlocksPerMultiprocessor(&per_cu, (const void*)mega_fwd, NT, LDS_BYTES);
        if (per_cu < 1) { fprintf(stderr, "kernel_launch: occupancy query reports %d workgroups per CU\n", per_cu); per_cu = 1; }
        if (per_cu > 1) per_cu = 1;
        grid = cus * per_cu;
        if (grid > 256) grid = 256;
        (void)hipGetLastError();
    }
    hipMemsetAsync(p.bar, 0, XCD_BAR_WORDS * sizeof(unsigned), stream);
    hipLaunchKernelGGL(mega_fwd, dim3(grid), dim3(NT), LDS_BYTES, stream, a);
}
```

```cpp
#include <hip/hip_runtime.h>
#include <math.h>
#include <stdint.h>
#include <stddef.h>
#include <stdio.h>
namespace pg8 {
#define PG8_LAS __attribute__((address_space(3)))
typedef unsigned short bf16_t;
typedef short bf16x8 __attribute__((ext_vector_type(8)));
typedef float f32x4 __attribute__((ext_vector_type(4)));
typedef unsigned u32x4 __attribute__((ext_vector_type(4)));
constexpr int BM = 256, BK = 64, HALF = 128, HTB = HALF * BK * 2  , STAGE_BYTES = 8 * HTB, NXCD = 8, WGM = 8;

__host__ __device__ __forceinline__ int lds_byte(int r, int c) { const int st = (r >> 4) * 2 + (c >> 5), rr = r & 15, cc = c & 31, ob = rr * 64 + cc * 2; return st * 1024 + (ob ^ (((ob >> 9) & 1) << 5)); }
__host__ __device__ __forceinline__ void stage_rc(int b, int& R, int& C) { const int st = b / 1024, sb = b % 1024, swz = sb ^ (((sb >> 9) & 1) << 5); R = (st >> 1) * 16 + swz / 64; C = (st & 1) * 32 + (swz % 64) / 2; }
__host__ __device__ __forceinline__ int perm32(int rho) { const int n = rho >> 4, i = rho & 15; return 8 * (i >> 2) + 4 * n + (i & 3); }

struct Unit { int pm, pn; };
struct Gemm { const bf16_t* A; const bf16_t* Bt; int M, N, K; };

struct StaticOrder {
    int nM, nN, nwg, G, c;
    __host__ __device__ __forceinline__ void init(int M, int N, int G_, int c_) { nM = M / BM; nN = N / BM; nwg = nM * nN; G = G_; c = c_; }
    __host__ __device__ __forceinline__ bool next(int i, Unit& u) const {
        const long L = (long)i * G + c; if (L >= nwg) return false;
        int wgid = (int)L; { const int q = nwg / NXCD, r = nwg % NXCD, xcd = wgid % NXCD, off = wgid / NXCD; wgid = (xcd < r ? xcd * (q + 1) : r * (q + 1) + (xcd - r) * q) + off; }
        const int nig = WGM * nN, gid = wgid / nig, fm = gid * WGM, gsz = (nM - fm) < WGM ? (nM - fm) : WGM;
        u.pm = fm + ((wgid % nig) % gsz); u.pn = (wgid % nig) / gsz; return true;
    }
    __device__ __forceinline__ void a_ready(const Unit&) const {}
    __device__ __forceinline__ void done(const Unit&) const {}
};
__device__ __forceinline__ unsigned cvt_pk_bf16(float lo, float hi) { unsigned r; asm volatile("v_cvt_pk_bf16_f32 %0, %1, %2" : "=v"(r) : "v"(lo), "v"(hi)); return r; }

template <class Epi, class Sched, bool ALIGN_EPI = false, bool SP2 = false>
__device__ __forceinline__ void gemm_phase(PG8_LAS unsigned char* lds, const Gemm g, const Sched& S, const Epi& E) {
    int tid_ = threadIdx.x; asm volatile("" : "+v"(tid_));
    const int tid = tid_, wid = __builtin_amdgcn_readfirstlane(tid >> 6), lane = tid & 63, wr = wid >> 2, wc = wid & 3, fr = lane & 15, fq = lane >> 4;
    const int K = g.K, nt = K / BK;
    unsigned voffA[2], voffB[2];
#pragma unroll
    for (int i = 0; i < 2; ++i) { int R, C; stage_rc(tid * 16 + i * 8192, R, C); const int Rb = Epi::PERM ? ((R & ~31) + perm32(R & 31)) : R;
        voffA[i] = (unsigned)(R * K + C) * 2u; voffB[i] = (unsigned)(Rb * K + C) * 2u; }
    const size_t kstep = (size_t)(BK * 2);
    const size_t hstep = (size_t)HALF * K * 2;
    const size_t tstep = 2 * hstep;
    const unsigned ldsw = (unsigned)wid * 1024u;
    const int aoff = lds_byte(wr * 64 + fr, fq * 8), boff = lds_byte(wc * 32 + fr, fq * 8);
#define PG8_SA(b, h) (((b) * 2 + (h)) * HTB)
#define PG8_SB(b, h) ((4 + (b) * 2 + (h)) * HTB)
#define PG8_STAGE(bufoff, gbase, voff) do { _Pragma("unroll") for (int _i = 0; _i < 2; ++_i) \
        __builtin_amdgcn_global_load_lds((const unsigned*)((const char*)(gbase) + (voff)[_i]), (PG8_LAS unsigned*)(lds + (bufoff) + ldsw + _i * 8192), 16, 0, 0); } while (0)
#define PG8_LDA(dst, b, h) do { _Pragma("unroll") for (int m = 0; m < 4; ++m) _Pragma("unroll") for (int k = 0; k < 2; ++k) dst[m][k] = *(const PG8_LAS bf16x8*)(lds + PG8_SA(b, h) + aoff + m * 2048 + k * 1024); } while (0)
#define PG8_LDB(dst, b, h) do { _Pragma("unroll") for (int n = 0; n < 2; ++n) _Pragma("unroll") for (int k = 0; k < 2; ++k) dst[n][k] = *(const PG8_LAS bf16x8*)(lds + PG8_SB(b, h) + boff + n * 2048 + k * 1024); } while (0)
#define PG8_MMA(ai, bj, At, Bt) do { __builtin_amdgcn_s_setprio(1); _Pragma("unroll") for (int m = 0; m < 4; ++m) _Pragma("unroll") for (int n = 0; n < 2; ++n) _Pragma("unroll") for (int k = 0; k < 2; ++k) \
        acc[ai][bj][m][n] = __builtin_amdgcn_mfma_f32_16x16x32_bf16(Bt[n][k], At[m][k], acc[ai][bj][m][n], 0, 0, 0); __builtin_amdgcn_s_setprio(0); } while (0)
#define PG8_WAIT_V(n) asm volatile("s_waitcnt vmcnt(" #n ")" ::: "memory")
#define PG8_WAIT_L(n) asm volatile("s_waitcnt lgkmcnt(" #n ")" ::: "memory")
#define PG8_BAR __builtin_amdgcn_s_barrier()
#define PG8_SCHED __builtin_amdgcn_sched_barrier(0)
    Unit cur, nxt; int ui = 0;
    if (!S.next(0, cur)) return;
    f32x4 acc[2][2][4][2];
#pragma unroll
    for (int a = 0; a < 2; ++a)
#pragma unroll
        for (int b = 0; b < 2; ++b)
#pragma unroll
            for (int m = 0; m < 4; ++m)
#pragma unroll
                for (int n = 0; n < 2; ++n) acc[a][b][m][n] = (f32x4){0.f, 0.f, 0.f, 0.f};
    bf16x8 At[4][2], B0[2][2], B1[2][2];
    const char* cA = (const char*)g.A + (size_t)cur.pm * tstep; const char* cB = (const char*)g.Bt + (size_t)cur.pn * tstep;
    S.a_ready(cur);
    if constexpr (SP2) {
        PG8_STAGE(PG8_SB(0, 0), cB, voffB); PG8_STAGE(PG8_SB(0, 1), cB + hstep, voffB); PG8_STAGE(PG8_SA(0, 0), cA, voffA); PG8_STAGE(PG8_SA(0, 1), cA + hstep, voffA);
        if (wr == 1) PG8_BAR;
        PG8_WAIT_V(2); PG8_BAR;
        PG8_STAGE(PG8_SB(1, 0), cB + kstep, voffB); PG8_STAGE(PG8_SA(1, 0), cA + kstep, voffA); PG8_STAGE(PG8_SB(1, 1), cB + hstep + kstep, voffB);
        PG8_WAIT_V(6); PG8_BAR;
    } else {
        PG8_STAGE(PG8_SB(0, 0), cB, voffB); PG8_STAGE(PG8_SA(0, 0), cA, voffA); PG8_STAGE(PG8_SB(0, 1), cB + hstep, voffB); PG8_STAGE(PG8_SA(0, 1), cA + hstep, voffA);
        if (wr == 1) PG8_BAR;
        PG8_WAIT_V(4); PG8_BAR;
        PG8_STAGE(PG8_SB(1, 0), cB + kstep, voffB); PG8_STAGE(PG8_SA(1, 0), cA + kstep, voffA); PG8_STAGE(PG8_SB(1, 1), cB + hstep + kstep, voffB);
        PG8_WAIT_V(6); PG8_BAR;
    }
    for (;;) {
        const bool has_next = S.next(ui + 1, nxt);
        const char* nA = has_next ? (const char*)g.A + (size_t)nxt.pm * tstep : cA; const char* nB = has_next ? (const char*)g.Bt + (size_t)nxt.pn * tstep : cB;
        for (int t = 0; t < nt; t += 2) {
            const bool last = (t == nt - 2);
            const char* a1 = cA + (size_t)(t + 1) * kstep;
            const char* a2 = last ? nA : cA + (size_t)(t + 2) * kstep; const char* b2 = last ? nB : cB + (size_t)(t + 2) * kstep;
            const char* a3 = a2 + kstep; const char* b3 = b2 + kstep;
            if (last && has_next) S.a_ready(nxt);
            if constexpr (SP2) {
            PG8_LDB(B0, 0, 0); PG8_LDB(B1, 0, 1); PG8_SCHED; PG8_LDA(At, 0, 0); PG8_STAGE(PG8_SA(1, 1), a1 + hstep, voffA);
            PG8_WAIT_V(8); PG8_WAIT_L(0); PG8_BAR; PG8_MMA(0, 0, At, B0); PG8_MMA(0, 1, At, B1); PG8_BAR; PG8_SCHED;
            PG8_LDA(At, 0, 1); PG8_STAGE(PG8_SB(0, 0), b2, voffB); PG8_STAGE(PG8_SB(0, 1), b2 + hstep, voffB); PG8_STAGE(PG8_SA(0, 0), a2, voffA);
            PG8_WAIT_V(8); PG8_WAIT_L(0); PG8_BAR; PG8_MMA(1, 0, At, B0); PG8_MMA(1, 1, At, B1); PG8_BAR; PG8_SCHED;
            PG8_LDB(B0, 1, 0); PG8_LDB(B1, 1, 1); PG8_SCHED; PG8_LDA(At, 1, 0); PG8_STAGE(PG8_SA(0, 1), a2 + hstep, voffA);
            PG8_WAIT_V(8); PG8_WAIT_L(0); PG8_BAR; PG8_MMA(0, 0, At, B0); PG8_MMA(0, 1, At, B1); PG8_BAR; PG8_SCHED;
            PG8_LDA(At, 1, 1); PG8_STAGE(PG8_SB(1, 0), b3, voffB); PG8_STAGE(PG8_SB(1, 1), b3 + hstep, voffB); PG8_STAGE(PG8_SA(1, 0), a3, voffA);
            PG8_WAIT_V(8); PG8_WAIT_L(0); PG8_BAR; PG8_MMA(1, 0, At, B0); PG8_MMA(1, 1, At, B1); PG8_BAR; PG8_SCHED;
            } else {
            PG8_LDB(B0, 0, 0); PG8_SCHED; PG8_LDA(At, 0, 0); PG8_STAGE(PG8_SA(1, 1), a1 + hstep, voffA);
            PG8_WAIT_L(8); PG8_BAR; PG8_WAIT_L(0); PG8_MMA(0, 0, At, B0); PG8_BAR; PG8_SCHED;
            PG8_LDB(B1, 0, 1); PG8_STAGE(PG8_SB(0, 0), b2, voffB);
            PG8_BAR; PG8_WAIT_L(0); PG8_MMA(0, 1, At, B1); PG8_BAR;
            PG8_LDA(At, 0, 1); PG8_STAGE(PG8_SA(0, 0), a2, voffA);
            PG8_BAR; PG8_WAIT_L(0); PG8_MMA(1, 0, At, B0); PG8_BAR; PG8_SCHED;
            PG8_STAGE(PG8_SB(0, 1), b2 + hstep, voffB);
            PG8_WAIT_V(6); PG8_BAR; PG8_MMA(1, 1, At, B1); PG8_BAR;
            PG8_LDB(B0, 1, 0); PG8_SCHED; PG8_LDA(At, 1, 0); PG8_STAGE(PG8_SA(0, 1), a2 + hstep, voffA);
            PG8_WAIT_L(8); PG8_BAR; PG8_WAIT_L(0); PG8_MMA(0, 0, At, B0); PG8_BAR; PG8_SCHED;
            PG8_LDB(B1, 1, 1); PG8_STAGE(PG8_SB(1, 0), b3, voffB);
            PG8_BAR; PG8_WAIT_L(0); PG8_MMA(0, 1, At, B1); PG8_BAR;
            PG8_LDA(At, 1, 1); PG8_STAGE(PG8_SA(1, 0), a3, voffA);
            PG8_BAR; PG8_WAIT_L(0); PG8_MMA(1, 0, At, B0); PG8_BAR; PG8_SCHED;
            PG8_STAGE(PG8_SB(1, 1), b3 + hstep, voffB);
            PG8_WAIT_V(6); PG8_BAR; PG8_MMA(1, 1, At, B1); PG8_BAR;
            }
        }
        if constexpr (ALIGN_EPI) { if (wr == 0) PG8_BAR; }
        if constexpr (!Epi::AFTER_DRAIN) { E(acc, cur, wr, wc, fr, fq); S.done(cur); }
        if (!has_next) break;
#pragma unroll
        for (int a = 0; a < 2; ++a)
#pragma unroll
            for (int b = 0; b < 2; ++b)
#pragma unroll
                for (int m = 0; m < 4; ++m)
#pragma unroll
                    for (int n = 0; n < 2; ++n) acc[a][b][m][n] = (f32x4){0.f, 0.f, 0.f, 0.f};
        cur = nxt; cA = nA; cB = nB; ++ui;
        if constexpr (ALIGN_EPI) { if (wr == 1) PG8_BAR; }
    }
    PG8_WAIT_V(0);
    if constexpr (!ALIGN_EPI) { if (wr == 0) PG8_BAR; }
    PG8_BAR;
    if constexpr (Epi::AFTER_DRAIN) { E.fused(acc, cur, wr, wc, fr, fq, lds, wid, lane); S.done(cur); }
#undef PG8_SA
#undef PG8_SB
#undef PG8_STAGE
#undef PG8_LDA
#undef PG8_LDB
#undef PG8_MMA
#undef PG8_WAIT_V
#undef PG8_WAIT_L
#undef PG8_BAR
#undef PG8_SCHED
}
}
typedef unsigned short bf16;
#define LAS __attribute__((address_space(3)))
typedef float f32x4 __attribute__((ext_vector_type(4)));
typedef short bf16x8 __attribute__((ext_vector_type(8)));
typedef unsigned u32x4 __attribute__((ext_vector_type(4)));
typedef unsigned u32x2 __attribute__((ext_vector_type(2)));

#define D_MODEL 1024
#define BATCH 8
#define SEQ 2048
#define D_IN 5664
#define NTOK (BATCH * SEQ)
#define ALPHA 1.189207115002721f
#define LN_EPS 1e-5f
#define RMS_EPS 1e-6f
#define NWIN 3072
#define NT 512
#define LDS_BYTES 147456

#define LDS_WAIT() asm volatile("s_waitcnt lgkmcnt(0)" ::: "memory")
#define VM_WAIT() asm volatile("s_waitcnt vmcnt(0)" ::: "memory")

__device__ __forceinline__ int fresh_tid() { int t = threadIdx.x; asm volatile("" : "+v"(t)); return t; }
__device__ __forceinline__ unsigned f2bf(float f) { unsigned u = __builtin_bit_cast(unsigned, f); return (u + 0x7fffu + ((u >> 16) & 1u)) >> 16; }
__device__ __forceinline__ unsigned pk2(float lo, float hi) { return f2bf(lo) | (f2bf(hi) << 16); }
__device__ __forceinline__ float bf2f(unsigned h) { return __builtin_bit_cast(float, (h & 0xffffu) << 16); }
__device__ __forceinline__ float sigmoidf_(float x) { return 1.f / (1.f + __expf(-x)); }
__device__ __forceinline__ float siluf_(float x) { return x / (1.f + __expf(-x)); }
__device__ __forceinline__ float softplusf_(float x) { return x > 20.f ? x : log1pf(expf(x)); }

struct Params {
    const float *x, *w_in, *rpb, *conv_w, *a_log_f, *a_log_b, *dtb_f, *dtb_b, *norm_w, *w_proj_na, *w_proj_dn, *w_out, *ln1_g, *ln1_b;
    const float *wrg, *brg, *wre, *bre, *wgu, *wd, *ln2_g, *ln2_b;
    float* out;
    char* ws;
    unsigned* bar;
    int kdown, pad0;
#define WSP(T, mb) ((T*)(ws + ((size_t)(mb) << 20)))
    __device__ __forceinline__ bf16* WIN() const { return WSP(bf16, 1); }
    __device__ __forceinline__ bf16* WG() const { return WSP(bf16, 9); }
    __device__ __forceinline__ bf16* WPNA() const { return WSP(bf16, 13); }
    __device__ __forceinline__ bf16* WPDN() const { return WSP(bf16, 14); }
    __device__ __forceinline__ bf16* WOUT() const { return WSP(bf16, 15); }
    __device__ __forceinline__ bf16* XB() const { return WSP(bf16, 17); }
    __device__ __forceinline__ bf16* WGU() const { return WSP(bf16, 49); }
    __device__ __forceinline__ bf16* WD() const { return WSP(bf16, 81); }
    __device__ __forceinline__ bf16* QNA() const { return WSP(bf16, 49); }
    __device__ __forceinline__ bf16* KNA() const { return WSP(bf16, 65); }
    __device__ __forceinline__ bf16* VNAT() const { return WSP(bf16, 81); }
    __device__ __forceinline__ bf16* QKVDN() const { return WSP(bf16, 97); }
    __device__ __forceinline__ bf16* Z() const { return WSP(bf16, 145); }
    __device__ __forceinline__ float* GATES() const { return WSP(float, 161); }
    __device__ __forceinline__ bf16* NAOUT() const { return WSP(bf16, 163); }
    __device__ __forceinline__ bf16* DNOUT() const { return WSP(bf16, 129); }
};

__device__ __forceinline__ void transpose_item(const float* W, size_t ldW, bf16* WT, int Kdst, int k0, int n0, int rowdst0, LAS float*  , int lane) {
    const int m = lane & 15, g = lane >> 4;
    bf16x8 idb[2];
#pragma unroll
    for (int half = 0; half < 2; ++half)
#pragma unroll
        for (int j = 0; j < 8; ++j) idb[half][j] = (8 * g + j == m + 16 * half) ? (short)0x3F80 : (short)0;
#pragma unroll
    for (int kg = 0; kg < 2; ++kg) {
        f32x4 d[2][2];
#pragma unroll
        for (int q = 0; q < 2; ++q) {
            const float* src = W + (size_t)(k0 + 32 * kg + 8 * (m >> 2) + 4 * q + (m & 3)) * ldW + n0 + 8 * g;
            const f32x4 a0 = *(const f32x4*)src, a1 = *(const f32x4*)(src + 4);
            u32x4 aw; aw.x = pk2(a0[0], a0[1]); aw.y = pk2(a0[2], a0[3]); aw.z = pk2(a1[0], a1[1]); aw.w = pk2(a1[2], a1[3]);
            const bf16x8 af = __builtin_bit_cast(bf16x8, aw);
#pragma unroll
            for (int half = 0; half < 2; ++half) d[q][half] = __builtin_amdgcn_mfma_f32_16x16x32_bf16(af, idb[half], (f32x4){0.f, 0.f, 0.f, 0.f}, 0, 0, 0);
        }
#pragma unroll
        for (int half = 0; half < 2; ++half) {
            u32x4 o; o.x = pk2(d[0][half][0], d[0][half][1]); o.y = pk2(d[0][half][2], d[0][half][3]); o.z = pk2(d[1][half][0], d[1][half][1]); o.w = pk2(d[1][half][2], d[1][half][3]);
            *(u32x4*)(WT + (size_t)(rowdst0 + 16 * half + m) * Kdst + k0 + 32 * kg + 8 * g) = o;
        }
    }
}

#define IT_WIN (16 * 113)
#define IT_WG (16 * 64)
#define IT_WPNA (8 * 32)
#define IT_WPDN (8 * 32)
#define IT_WOUT (16 * 32)
#define IT_SMALL (IT_WIN + IT_WG + IT_WPNA + IT_WPDN + IT_WOUT)
#define IT_WGU (32 * 16 * 16)
#define IT_WD (32 * 4 * 32)

__device__ __forceinline__ void p0_small_item(const Params& p, int r, LAS float* scr, int lane) {
    if (r < IT_WIN) { const int kb = r / 113, nb = r % 113; transpose_item(p.w_in, D_IN, p.WIN(), 1024, kb * 64, nb * 32, nb * 32, scr, lane); return; } r -= IT_WIN;
    if (r < IT_WG) { const int kb = r / 64, nb = r % 64; transpose_item(p.w_in + 3616, D_IN, p.WG(), 1024, kb * 64, nb * 32, nb * 32, scr, lane); return; } r -= IT_WG;
    if (r < IT_WPNA) { const int kb = r / 32, nb = r % 32; transpose_item(p.w_proj_na, 1024, p.WPNA(), 512, kb * 64, nb * 32, nb * 32, scr, lane); return; } r -= IT_WPNA;
    if (r < IT_WPDN) { const int kb = r / 32, nb = r % 32; transpose_item(p.w_proj_dn, 1024, p.WPDN(), 512, kb * 64, nb * 32, nb * 32, scr, lane); return; } r -= IT_WPDN;
    { const int kb = r / 32, nb = r % 32; transpose_item(p.w_out, 1024, p.WOUT(), 1024, kb * 64, nb * 32, nb * 32, scr, lane); }
}
__device__ __forceinline__ void p0_moe_item(const Params& p, int r, LAS float* scr, int lane) {
    if (r < IT_WGU) { const int e = r / 256, q = r % 256, kb = q / 16, nb = q % 16;
        const int n0 = nb * 32, up = n0 >= 256, f0 = n0 - (up ? 256 : 0);
        transpose_item(p.wgu + (size_t)e * 1024 * 512, 512, p.WGU(), 1024, kb * 64, n0, e * 512 + (f0 / 128) * 256 + (up ? 128 : 0) + (f0 % 128), scr, lane); return; }
    r -= IT_WGU;
    { const int e = r / 128, q = r % 128, kb = q / 32, nb = q % 32;
        transpose_item(p.wd + (size_t)e * 256 * 1024, 1024, p.WD(), 256, kb * 64, nb * 32, e * 1024 + nb * 32, scr, lane); }
}

__device__ __forceinline__ void phase0_moe(const Params& p, unsigned* counter) {
    const int lane = fresh_tid() & 63;
    for (;;) {
        unsigned base = 0;
        if (lane == 0) base = __hip_atomic_fetch_add(counter, 4u, __ATOMIC_RELAXED, __HIP_MEMORY_SCOPE_AGENT);
        base = (unsigned)__builtin_amdgcn_readfirstlane((int)base);
        if (base >= (unsigned)(IT_WGU + IT_WD)) break;
#pragma unroll 1
        for (int k = 0; k < 4; ++k) p0_moe_item(p, (int)base + k, nullptr, lane);
    }
}
__device__ __forceinline__ void phase0(const Params& p, LAS unsigned char* lds) {
    const int tid = fresh_tid(), lane = tid & 63, wave = tid >> 6, G = gridDim.x;
    LAS float* scr = (LAS float*)(lds + wave * 16384);
    const int gw = blockIdx.x * 8 + wave, NGW = G * 8;
    for (int it = gw; it < IT_SMALL; it += NGW) p0_small_item(p, it, scr, lane);
    const size_t gt = (size_t)blockIdx.x * NT + tid, GT = (size_t)G * NT;
    for (size_t i = gt; i < (size_t)NTOK * 1024 / 8; i += GT) {
        const f32x4 a = *(const f32x4*)(p.x + i * 8), b = *(const f32x4*)(p.x + i * 8 + 4);
        u32x4 o; o.x = pk2(a.x, a.y); o.y = pk2(a.z, a.w); o.z = pk2(b.x, b.y); o.w = pk2(b.z, b.w);
        *(u32x4*)(p.XB() + i * 8) = o;
    }
}

struct EpiInProj {
    static constexpr bool PERM = true, AFTER_DRAIN = false;
    struct Mini { char* ws;
        __device__ __forceinline__ bf16* QNA() const { return WSP(bf16, 49); }
        __device__ __forceinline__ bf16* KNA() const { return WSP(bf16, 65); }
        __device__ __forceinline__ bf16* VNAT() const { return WSP(bf16, 81); }
        __device__ __forceinline__ bf16* QKVDN() const { return WSP(bf16, 97); }
    } p;
    __device__ __forceinline__ void operator()(const pg8::f32x4 (&acc)[2][2][4][2], const pg8::Unit& u, int wr, int wc, int fr, int fq) const {
        const int pn = u.pn;
#pragma unroll
        for (int ai = 0; ai < 2; ++ai)
#pragma unroll
            for (int m = 0; m < 4; ++m) {
                const int row = u.pm * 256 + ai * 128 + wr * 64 + m * 16 + fr;
                const int b = row >> 11, t = row & 2047;
#pragma unroll
                for (int bj = 0; bj < 2; ++bj) {
                    const pg8::f32x4 v0 = acc[ai][bj][m][0], v1 = acc[ai][bj][m][1];
                    const int head = (pn & 1) * 4 + bj * 2 + (wc >> 1), d0 = (wc & 1) * 32 + 8 * fq;
                    const size_t hm = ((size_t)(b * 8 + head) * 2048 + t) * 64 + d0;
                    if (pn < 4 || pn >= 6) {
                        bf16* dst; float sc = 1.f;
                        if (pn < 2) { dst = p.QNA(); sc = 0.125f; }
                        else if (pn < 4) dst = p.KNA();
                        else dst = p.QKVDN() + (size_t)((pn - 6) >> 1) * ((size_t)NTOK * 512);
                        float e[8] = {v0[0], v0[1], v0[2], v0[3], v1[0], v1[1], v1[2], v1[3]};
#pragma unroll
                        for (int j = 0; j < 8; ++j) e[j] *= sc;
                        u32x4 w; w.x = pk2(e[0], e[1]); w.y = pk2(e[2], e[3]); w.z = pk2(e[4], e[5]); w.w = pk2(e[6], e[7]);
                        *(u32x4*)(dst + hm) = w;
                    } else {
                        bf16* dst = p.VNAT() + ((size_t)(b * 8 + head) * 64 + d0) * 2048 + t;
                        const float e[8] = {v0[0], v0[1], v0[2], v0[3], v1[0], v1[1], v1[2], v1[3]};
#pragma unroll
                        for (int j = 0; j < 8; ++j) dst[(size_t)j * 2048] = (bf16)f2bf(e[j]);
                    }
                }
            }
    }
};
struct EpiZ {
    static constexpr bool PERM = true, AFTER_DRAIN = false;
    bf16* Z;
    __device__ __forceinline__ void operator()(const pg8::f32x4 (&acc)[2][2][4][2], const pg8::Unit& u, int wr, int wc, int fr, int fq) const {
#pragma unroll
        for (int ai = 0; ai < 2; ++ai)
#pragma unroll
            for (int m = 0; m < 4; ++m) {
                const int row = u.pm * 256 + ai * 128 + wr * 64 + m * 16 + fr;
                const int b = row >> 11, t = row & 2047;
#pragma unroll
                for (int bj = 0; bj < 2; ++bj) {
                    const pg8::f32x4 v0 = acc[ai][bj][m][0], v1 = acc[ai][bj][m][1];
                    const int head = (u.pn & 1) * 4 + bj * 2 + (wc >> 1), d0 = (wc & 1) * 32 + 8 * fq;
                    float e[8] = {v0[0], v0[1], v0[2], v0[3], v1[0], v1[1], v1[2], v1[3]};
#pragma unroll
                    for (int j = 0; j < 8; ++j) e[j] = siluf_(e[j]);
                    u32x4 w; w.x = pk2(e[0], e[1]); w.y = pk2(e[2], e[3]); w.z = pk2(e[4], e[5]); w.w = pk2(e[6], e[7]);
                    *(u32x4*)(Z + ((size_t)(b * 8 + head) * 2048 + t) * 64 + d0) = w;
                }
            }
    }
};
__device__ __forceinline__ void gates_minigemm(const Params& p) {
    const int tid = fresh_tid(), lane = tid & 63, wave = tid >> 6, r16 = lane & 15, g = lane >> 4;
    for (int blk = blockIdx.x; blk < 256; blk += gridDim.x) {
        const int mt = wave & 3, nt = wave >> 2;
        const bf16* A = p.XB() + ((size_t)blk * 64 + mt * 16 + r16) * 1024 + 8 * g;
        const bf16* Bt = p.WIN() + ((size_t)3584 + nt * 16 + r16) * 1024 + 8 * g;
        f32x4 acc0 = {0.f, 0.f, 0.f, 0.f}, acc1 = {0.f, 0.f, 0.f, 0.f};
#pragma unroll 8
        for (int ks = 0; ks < 32; ks += 2) {
            acc0 = __builtin_amdgcn_mfma_f32_16x16x32_bf16(*(const bf16x8*)(A + ks * 32), *(const bf16x8*)(Bt + ks * 32), acc0, 0, 0, 0);
            acc1 = __builtin_amdgcn_mfma_f32_16x16x32_bf16(*(const bf16x8*)(A + ks * 32 + 32), *(const bf16x8*)(Bt + ks * 32 + 32), acc1, 0, 0, 0);
        }
        const int col = nt * 16 + r16, type = col >> 3, hd = col & 7;
        const size_t tg0 = (size_t)blk * 64 + mt * 16 + 4 * g; const int b = (int)(tg0 >> 11), t = (int)(tg0 & 2047);
        f32x4 o;
#pragma unroll
        for (int r = 0; r < 4; ++r) {
            const float e = acc0[r] + acc1[r];
            o[r] = type < 2 ? sigmoidf_(e) : (type == 2 ? -expf(p.a_log_f[hd]) * softplusf_(e + p.dtb_f[hd]) : -expf(p.a_log_b[hd]) * softplusf_(e + p.dtb_b[hd]));
        }
        *(f32x4*)(p.GATES() + (size_t)type * NTOK * 8 + ((size_t)b * 8 + hd) * 2048 + t) = o;
    }
}

__device__ __forceinline__ void phase1(const Params& p, LAS unsigned char* lds) {
    pg8::Gemm g{p.XB(), p.WIN(), NTOK, NWIN, 1024};
    pg8::StaticOrder S; S.init(NTOK, NWIN, gridDim.x, (int)blockIdx.x);
    EpiInProj E{{p.ws}};
    pg8::gemm_phase<EpiInProj, pg8::StaticOrder, true, true>(lds, g, S, E);
    gates_minigemm(p);
}
__device__ __forceinline__ void phase_zgemm(const Params& p, LAS unsigned char* lds, int nb, int c) {
    pg8::Gemm g{p.XB(), p.WIN() + (size_t)3072 * 1024, NTOK, 512, 1024};
    pg8::StaticOrder S; S.init(NTOK, 512, nb, c);
    EpiZ E{p.Z()};
    pg8::gemm_phase<EpiZ, pg8::StaticOrder, true, true>(lds, g, S, E);
}

#define XB_TMO      128
#define XB_XCNT(j)  (256  + 64 * (j))
#define XB_XSUB(j)  (1280 + 64 * (j))
#define XB_XGEN(j)  (2304 + 64 * (j))
#define XB_TOP      3328
#define XB_TOPGEN   3392
#define XCD_BAR_WORDS 3456
#define XB_SPIN_CAP (1u << 18)


__device__ __forceinline__ unsigned xb_ld(unsigned* p)              { return __hip_atomic_load(p, __ATOMIC_RELAXED, __HIP_MEMORY_SCOPE_AGENT); }
__device__ __forceinline__ unsigned xb_add(unsigned* p, unsigned v) { return __hip_atomic_fetch_add(p, v, __ATOMIC_RELAXED, __HIP_MEMORY_SCOPE_AGENT); }
__device__ __forceinline__ unsigned xb_xcc_id() { return (unsigned)__builtin_amdgcn_s_getreg((3 << 11) | 20) & 0xFu; }
#define XB_SPIN(cond, bar) do { unsigned _sp = 0; while (cond) { __builtin_amdgcn_s_sleep(1); \
    if ((++_sp & 255u) == 0u) { if (xb_ld(&(bar)[XB_TMO])) break; if (_sp > XB_SPIN_CAP) { atomicAdd(&(bar)[XB_TMO], 1u); break; } } } } while (0)

struct XcdBarrier {
    unsigned* bar; unsigned x;
    volatile LAS unsigned* st;
};

__device__ __forceinline__ XcdBarrier xcd_barrier_post(unsigned* bar, volatile LAS unsigned* st) {
    XcdBarrier b; b.bar = bar; b.x = xb_xcc_id(); b.st = st;
    if (threadIdx.x == 0) (void)xb_add(&bar[XB_XCNT(b.x)], 1u);
    return b;
}
__device__ __forceinline__ void xcd_barrier_complete(unsigned* bar, unsigned x, unsigned& nloc, unsigned& nx) {
    const unsigned G = gridDim.x * gridDim.y * gridDim.z;
    unsigned sum, cnt, mine, sp = 0u;
    for (;;) {
        sum = 0u; cnt = 0u; mine = 0u;
#pragma unroll
        for (unsigned j = 0; j < 16; ++j) { const unsigned c = xb_ld(&bar[XB_XCNT(j)]); sum += c; cnt += (c > 0u) ? 1u : 0u; mine = (j == x) ? c : mine; }
        if (sum == G) break;
        __builtin_amdgcn_s_sleep(1);
        if ((++sp & 255u) == 0u) { if (xb_ld(&bar[XB_TMO])) break; if (sp > XB_SPIN_CAP) { atomicAdd(&bar[XB_TMO], 1u); break; } }
    }
    nloc = mine > 0u ? mine : 1u; nx = cnt > 0u ? cnt : 1u;
}

__device__ __forceinline__ void xcd_barrier(const XcdBarrier& b) {
    asm volatile("s_waitcnt vmcnt(0)" ::: "memory");
    __syncthreads();
    if (threadIdx.x == 0) {
        unsigned* bar = b.bar;
        __builtin_amdgcn_s_waitcnt(0);
        unsigned nloc = b.st[0], nx = b.st[1];
        if (nloc == 0u) { xcd_barrier_complete(bar, b.x, nloc, nx); b.st[0] = nloc; b.st[1] = nx; }
        const unsigned old = xb_add(&bar[XB_XSUB(b.x)], 1u);
        const unsigned gen = old / nloc;
        if (old + 1u == (gen + 1u) * nloc) {
            __builtin_amdgcn_fence(__ATOMIC_RELEASE, "agent");
            asm volatile("s_waitcnt vmcnt(0)" ::: "memory");
            const unsigned og = xb_add(&bar[XB_TOP], 1u);
            const unsigned tg = og / nx;
            if (og + 1u == (tg + 1u) * nx) xb_add(&bar[XB_TOPGEN], 1u);
            else XB_SPIN(xb_ld(&bar[XB_TOPGEN]) == tg, bar);
            __builtin_amdgcn_fence(__ATOMIC_ACQUIRE, "agent");
            xb_add(&bar[XB_XGEN(b.x)], 1u);
            asm volatile("s_waitcnt vmcnt(0)" ::: "memory");
        } else {
            XB_SPIN(xb_ld(&bar[XB_XGEN(b.x)]) == gen, bar);
            __builtin_amdgcn_fence(__ATOMIC_ACQUIRE, "agent");
            asm volatile("s_waitcnt vmcnt(0)" ::: "memory");
        }
    }
    __syncthreads();
}
typedef short s16x4 __attribute__((ext_vector_type(4)));
__device__ __forceinline__ void phase_na(const Params& p, LAS unsigned char* lds) {
    const int tid = fresh_tid(), lane = tid & 63, wave = tid >> 6, G = gridDim.x;
    const int vcu = (G % 8 == 0) ? ((int)blockIdx.x % 8) * (G / 8) + (int)blockIdx.x / 8 : (int)blockIdx.x;
    LAS float* rpb_s = (LAS float*)lds;
    const int qi = lane & 15, g = lane >> 4;
    for (int it = vcu; it < 1024; it += G) {
        const int bh = it >> 4, rp = it & 15;
        const int h = bh & 7, b = bh >> 3;
        __syncthreads();
        for (int i = tid; i < 465; i += NT) rpb_s[i] = p.rpb[h * 465 + i];
        __syncthreads();
        const int r = rp * 2 + (wave >> 2), c0 = (wave & 3) * 16;
        int rs = r - 4; rs = rs < 0 ? 0 : (rs > 24 ? 24 : rs);
        int cs0 = c0 - 8; cs0 = cs0 < 0 ? 0 : (cs0 > 32 ? 32 : cs0);
        const int c = c0 + qi;
        int csq = c - 8; csq = csq < 0 ? 0 : (csq > 48 ? 48 : csq);
        const size_t hb = (size_t)(b * 8 + h) * 2048;
        bf16x8 qf[2];
#pragma unroll
        for (int ks = 0; ks < 2; ++ks) qf[ks] = *(const bf16x8*)(p.QNA() + (hb + r * 64 + c) * 64 + ks * 32 + 8 * g);
        float s[16][4];
#pragma unroll
        for (int j = 0; j < 8; ++j)
#pragma unroll
            for (int ct = 0; ct < 2; ++ct) {
                const int kt = (rs + j) * 64 + cs0 + ct * 16 + qi;
                f32x4 a = {0.f, 0.f, 0.f, 0.f};
#pragma unroll
                for (int ks = 0; ks < 2; ++ks) {
                    const bf16x8 kf = *(const bf16x8*)(p.KNA() + (hb + kt) * 64 + ks * 32 + 8 * g);
                    a = __builtin_amdgcn_mfma_f32_16x16x32_bf16(kf, qf[ks], a, 0, 0, 0);
                }
                const LAS float* brow = rpb_s + (rs + j - r + 7) * 31;
#pragma unroll
                for (int rr = 0; rr < 4; ++rr) {
                    const int kc = cs0 + ct * 16 + 4 * g + rr;
                    const bool valid = (kc >= csq) && (kc < csq + 16);
                    int dc = kc - c + 15; dc = dc < 0 ? 0 : (dc > 30 ? 30 : dc);
                    s[j * 2 + ct][rr] = valid ? a[rr] + brow[dc] : -1e30f;
                }
            }
        float mx = -3e38f;
#pragma unroll
        for (int i = 0; i < 16; ++i)
#pragma unroll
            for (int rr = 0; rr < 4; ++rr) mx = fmaxf(mx, s[i][rr]);
        mx = fmaxf(mx, __shfl_xor(mx, 16)); mx = fmaxf(mx, __shfl_xor(mx, 32));
        float sum = 0.f;
#pragma unroll
        for (int i = 0; i < 16; ++i)
#pragma unroll
            for (int rr = 0; rr < 4; ++rr) { s[i][rr] = __expf(s[i][rr] - mx); sum += s[i][rr]; }
        sum += __shfl_xor(sum, 16); sum += __shfl_xor(sum, 32);
        const float inv = 1.f / sum;
        f32x4 o[4];
#pragma unroll
        for (int dt = 0; dt < 4; ++dt) o[dt] = (f32x4){0.f, 0.f, 0.f, 0.f};
#pragma unroll
        for (int kk = 0; kk < 8; ++kk) {
            u32x4 pw; pw.x = pk2(s[2 * kk][0] * inv, s[2 * kk][1] * inv); pw.y = pk2(s[2 * kk][2] * inv, s[2 * kk][3] * inv);
            pw.z = pk2(s[2 * kk + 1][0] * inv, s[2 * kk + 1][1] * inv); pw.w = pk2(s[2 * kk + 1][2] * inv, s[2 * kk + 1][3] * inv);
            const bf16x8 pf = __builtin_bit_cast(bf16x8, pw);
            const int tk = (rs + kk) * 64 + cs0 + 4 * g;
#pragma unroll
            for (int dt = 0; dt < 4; ++dt) {
                const bf16* vp = p.VNAT() + ((size_t)(b * 8 + h) * 64 + dt * 16 + qi) * 2048 + tk;
                const s16x4 lo = *(const s16x4*)vp, hi = *(const s16x4*)(vp + 16);
                const bf16x8 vf = __builtin_shufflevector(lo, hi, 0, 1, 2, 3, 4, 5, 6, 7);
                o[dt] = __builtin_amdgcn_mfma_f32_16x16x32_bf16(pf, vf, o[dt], 0, 0, 0);
            }
        }
#pragma unroll
        for (int dt = 0; dt < 4; ++dt)
#pragma unroll
            for (int rr = 0; rr < 4; ++rr) {
                const size_t tg = (size_t)b * 2048 + r * 64 + c0 + 4 * g + rr;
                p.NAOUT()[tg * 512 + h * 64 + dt * 16 + qi] = (bf16)f2bf(o[dt][rr]);
            }
    }
}
#define LDSTR 72
#define MATB (64 * LDSTR * 2)
__device__ __forceinline__ f32x4 mfma16(bf16x8 a, bf16x8 b, f32x4 c) { return __builtin_amdgcn_mfma_f32_16x16x32_bf16(a, b, c, 0, 0, 0); }

__device__ __forceinline__ void slab_mma(const LAS bf16* A, const LAS bf16* Bt, int w, int lane, f32x4 (&acc)[4]) {
    const int r16 = lane & 15, g = lane >> 4;
    const bf16x8 a0 = *(const LAS bf16x8*)(A + (16 * w + r16) * LDSTR + 8 * g);
    const bf16x8 a1 = *(const LAS bf16x8*)(A + (16 * w + r16) * LDSTR + 32 + 8 * g);
#pragma unroll
    for (int nt = 0; nt < 4; ++nt) {
        const bf16x8 b0 = *(const LAS bf16x8*)(Bt + (nt * 16 + r16) * LDSTR + 8 * g);
        const bf16x8 b1 = *(const LAS bf16x8*)(Bt + (nt * 16 + r16) * LDSTR + 32 + 8 * g);
        acc[nt] = mfma16(a0, b0, acc[nt]); acc[nt] = mfma16(a1, b1, acc[nt]);
    }
}

struct DnBufs { char* ws; char* out;
    __device__ __forceinline__ bf16* MN() const { return (bf16*)out; }
    __device__ __forceinline__ bf16* QO() const { return WSP(bf16, 179); }
    __device__ __forceinline__ bf16* SB() const { return WSP(bf16, 97); } };

__device__ __forceinline__ void conv8(const float* conv_w, const bf16* src, size_t hb, int t, int c0, int wch, float (&y)[8]) {
#pragma unroll
    for (int d = 0; d < 8; ++d) y[d] = 0.f;
#pragma unroll
    for (int j = 0; j < 5; ++j) {
        const int tt = t + j - 2;
        if (tt >= 0 && tt < SEQ) {
            const bf16x8 x0 = *(const bf16x8*)(src + (hb + tt) * 64 + c0);
            const f32x4 w0 = *(const f32x4*)(conv_w + j * 1536 + wch + c0), w1 = *(const f32x4*)(conv_w + j * 1536 + wch + c0 + 4);
#pragma unroll
            for (int d = 0; d < 4; ++d) { y[d] = fmaf(bf2f((unsigned short)x0[d]), w0[d], y[d]); y[4 + d] = fmaf(bf2f((unsigned short)x0[4 + d]), w1[d], y[4 + d]); }
        }
    }
#pragma unroll
    for (int d = 0; d < 8; ++d) y[d] = siluf_(y[d]);
}
__device__ __forceinline__ u32x4 pack8(const float (&y)[8]) { u32x4 o; o.x = pk2(y[0], y[1]); o.y = pk2(y[2], y[3]); o.z = pk2(y[4], y[5]); o.w = pk2(y[6], y[7]); return o; }

#define TEAM_BYTES 71680
#define XSTR2 40
__device__ __forceinline__ void phase_dnprep(const Params& p, const DnBufs& B, LAS unsigned char* lds) {
    const int tid = fresh_tid(), lane = tid & 63, wave = tid >> 6, team = wave >> 2, w = wave & 3, G = gridDim.x;
    const int r16 = lane & 15, g = lane >> 4;
    LAS unsigned char* base = lds + team * TEAM_BYTES;
    LAS bf16* Kr = (LAS bf16*)(base);
    LAS bf16* Qr = (LAS bf16*)(base + MATB);
    LAS bf16* KdT = (LAS bf16*)(base + 2 * MATB);
    LAS bf16* KbT = (LAS bf16*)(base + 3 * MATB);
    LAS bf16* VbT = (LAS bf16*)(base + 4 * MATB);
    LAS bf16* IN = (LAS bf16*)(base + 5 * MATB);
    LAS bf16* Lb = (LAS bf16*)(base + 6 * MATB);
    LAS bf16* TTa = Lb + 64 * LDSTR; LAS bf16* T22T = TTa + 32 * XSTR2; LAS bf16* XT = T22T + 16 * XSTR2;
    LAS bf16* Tm = Kr; LAS bf16* WT = Lb; LAS bf16* UT = KbT;
    LAS float* beta_s = (LAS float*)(lds + 143360 + team * 1024); LAS float* gc_s = beta_s + 64;
    for (int pi = blockIdx.x; pi < 2048; pi += G) {
        const int tc = pi & 31, bh = pi >> 5, h = bh & 7, dir = team, cc = dir ? 31 - tc : tc;
        const int it = (bh * 2 + dir) * 32 + cc;
        const size_t hb = (size_t)bh * 2048;
        __syncthreads();
        if (w == 0) {
            const int s = cc * 64 + lane, t = dir ? 2047 - s : s;
            const float be = p.GATES()[(size_t)dir * NTOK * 8 + hb + t];
            float gv = p.GATES()[(size_t)(2 + dir) * NTOK * 8 + hb + t];
#pragma unroll
            for (int o = 1; o < 64; o <<= 1) { const float n = __shfl_up(gv, o); if (lane >= o) gv += n; }
            beta_s[lane] = be; gc_s[lane] = gv;
        }
        __syncthreads();
        {
            const int tau = tid >> 3, c0 = (tid & 7) * 8, t = tc * 64 + tau;
            float yk[8], yq[8], yv[8];
            conv8(p.conv_w, p.QKVDN() + (size_t)NTOK * 512, hb, t, c0, 512 + h * 64, yk);
            asm volatile("" ::: "memory");
            conv8(p.conv_w, p.QKVDN(), hb, t, c0, h * 64, yq);
            asm volatile("" ::: "memory");
            conv8(p.conv_w, p.QKVDN() + (size_t)2 * NTOK * 512, hb, t, c0, 1024 + h * 64, yv);
            asm volatile("" ::: "memory");
            float sk = 0.f, sq = 0.f;
#pragma unroll
            for (int d = 0; d < 8; ++d) { sk = fmaf(yk[d], yk[d], sk); sq = fmaf(yq[d], yq[d], sq); }
            sk += __shfl_xor(sk, 1); sq += __shfl_xor(sq, 1); sk += __shfl_xor(sk, 2); sq += __shfl_xor(sq, 2); sk += __shfl_xor(sk, 4); sq += __shfl_xor(sq, 4);
            const float rk = rsqrtf(sk + RMS_EPS), rq = rsqrtf(sq + RMS_EPS);
#pragma unroll
            for (int d = 0; d < 8; ++d) { yk[d] *= rk; yq[d] *= rq; }
            const u32x4 kp = pack8(yk), qp = pack8(yq);
#pragma unroll
            for (int dd = 0; dd < 2; ++dd) {
                LAS unsigned char* tb = lds + dd * TEAM_BYTES;
                const LAS float* bs = (const LAS float*)(lds + 143360 + dd * 1024); const LAS float* gs = bs + 64;
                const int i = dd ? 63 - tau : tau;
                const float be = bs[i], gci = gs[i], gl = gs[63];
                const float e_gc = __expf(gci), e_kd = __expf(gl - gci), bg = be * e_gc;
                *(LAS u32x4*)((LAS bf16*)tb + i * LDSTR + c0) = kp;
                *(LAS u32x4*)((LAS bf16*)(tb + MATB) + i * LDSTR + c0) = qp;
                LAS bf16* kd = (LAS bf16*)(tb + 2 * MATB); LAS bf16* kb = (LAS bf16*)(tb + 3 * MATB); LAS bf16* vb = (LAS bf16*)(tb + 4 * MATB);
#pragma unroll
                for (int d = 0; d < 8; ++d) { kd[(c0 + d) * LDSTR + i] = (bf16)f2bf(yk[d] * e_kd); kb[(c0 + d) * LDSTR + i] = (bf16)f2bf(yk[d] * bg); vb[(c0 + d) * LDSTR + i] = (bf16)f2bf(yv[d] * be); }
            }
        }
        __syncthreads();
        {
            f32x4 akk[4], aqk[4];
#pragma unroll
            for (int nt = 0; nt < 4; ++nt) { akk[nt] = (f32x4){0.f, 0.f, 0.f, 0.f}; aqk[nt] = (f32x4){0.f, 0.f, 0.f, 0.f}; }
            slab_mma(Kr, Kr, w, lane, akk);
            slab_mma(Qr, Kr, w, lane, aqk);
#pragma unroll
            for (int nt = 0; nt < 4; ++nt) {
                const int j = nt * 16 + r16; const float gcj = gc_s[j];
#pragma unroll
                for (int r = 0; r < 4; ++r) {
                    const int i = 16 * w + 4 * g + r;
                    const float dec = (j <= i) ? __expf(gc_s[i] - gcj) : 0.f;
                    Lb[i * LDSTR + j] = (bf16)f2bf((j < i) ? beta_s[i] * akk[nt][r] * dec : 0.f);
                    IN[i * LDSTR + j] = (bf16)f2bf(aqk[nt][r] * 0.125f * dec);
                }
            }
        }
        __syncthreads();
        if (w == 0) {
            const u32x4 z4 = {0u, 0u, 0u, 0u};
#pragma unroll
            for (int q = 0; q < 9; ++q) { const int idx = lane + 64 * q; *(LAS u32x4*)(Tm + (idx / 9) * LDSTR + (idx % 9) * 8) = z4; }
            const int blk = lane >> 4, j = lane & 15;
            float x[16];
#pragma unroll
            for (int i = 0; i < 16; ++i) {
                float a = (i == j) ? 1.f : 0.f;
#pragma unroll
                for (int m = 0; m < i; ++m) a = fmaf(-bf2f(Lb[(16 * blk + i) * LDSTR + 16 * blk + m]), x[m], a);
                x[i] = a;
            }
#pragma unroll
            for (int i = 0; i < 16; ++i) Tm[(16 * blk + i) * LDSTR + 16 * blk + j] = (bf16)f2bf(x[i]);
            {
                u32x4 lo, hi; lo.x = pk2(x[0], x[1]); lo.y = pk2(x[2], x[3]); lo.z = pk2(x[4], x[5]); lo.w = pk2(x[6], x[7]);
                hi.x = pk2(x[8], x[9]); hi.y = pk2(x[10], x[11]); hi.z = pk2(x[12], x[13]); hi.w = pk2(x[14], x[15]);
                if (blk < 2) { LAS bf16* dst = TTa + (16 * blk + j) * XSTR2 + 16 * blk; *(LAS u32x4*)dst = lo; *(LAS u32x4*)(dst + 8) = hi;
                    if (blk == 1) { *(LAS u32x4*)(TTa + (16 + j) * XSTR2) = z4; *(LAS u32x4*)(TTa + (16 + j) * XSTR2 + 8) = z4; } }
                else if (blk == 2) { *(LAS u32x4*)(T22T + j * XSTR2) = lo; *(LAS u32x4*)(T22T + j * XSTR2 + 8) = hi; }
            }
            LDS_WAIT();
            const bf16x8 zf = {0, 0, 0, 0, 0, 0, 0, 0};
            const f32x4 z0 = {0.f, 0.f, 0.f, 0.f};
            const bool lo2 = g < 2;
            {
                const bf16x8 aA = lo2 ? *(const LAS bf16x8*)(Lb + (16 + r16) * LDSTR + 8 * g) : zf, bA = lo2 ? *(const LAS bf16x8*)(TTa + r16 * XSTR2 + 8 * g) : zf;
                const bf16x8 aB = lo2 ? *(const LAS bf16x8*)(Lb + (48 + r16) * LDSTR + 32 + 8 * g) : zf, bB = lo2 ? *(const LAS bf16x8*)(T22T + r16 * XSTR2 + 8 * g) : zf;
                const f32x4 xa = mfma16(aA, bA, z0), xb = mfma16(aB, bB, z0);
                u32x2 o; o.x = pk2(xa[0], xa[1]); o.y = pk2(xa[2], xa[3]); *(LAS u32x2*)(XT + r16 * XSTR2 + 4 * g) = o;
                o.x = pk2(xb[0], xb[1]); o.y = pk2(xb[2], xb[3]); *(LAS u32x2*)(XT + (16 + r16) * XSTR2 + 4 * g) = o;
            }
            LDS_WAIT();
            {
                const bf16x8 aA = lo2 ? *(const LAS bf16x8*)(Tm + (16 + r16) * LDSTR + 16 + 8 * g) : zf, bA = lo2 ? *(const LAS bf16x8*)(XT + r16 * XSTR2 + 8 * g) : zf;
                const bf16x8 aB = lo2 ? *(const LAS bf16x8*)(Tm + (48 + r16) * LDSTR + 48 + 8 * g) : zf, bB = lo2 ? *(const LAS bf16x8*)(XT + (16 + r16) * XSTR2 + 8 * g) : zf;
                const f32x4 ta = mfma16(aA, bA, z0), tb2 = mfma16(aB, bB, z0);
#pragma unroll
                for (int r = 0; r < 4; ++r) { Tm[(16 + 4 * g + r) * LDSTR + r16] = (bf16)f2bf(-ta[r]); Tm[(48 + 4 * g + r) * LDSTR + 32 + r16] = (bf16)f2bf(-tb2[r]); }
                u32x2 o; o.x = pk2(-ta[0], -ta[1]); o.y = pk2(-ta[2], -ta[3]); *(LAS u32x2*)(TTa + r16 * XSTR2 + 16 + 4 * g) = o;
            }
            LDS_WAIT();
            {
                f32x4 x2[2][2];
#pragma unroll
                for (int mt = 0; mt < 2; ++mt) {
                    const bf16x8 a = *(const LAS bf16x8*)(Lb + (32 + 16 * mt + r16) * LDSTR + 8 * g);
#pragma unroll
                    for (int nt = 0; nt < 2; ++nt) { const bf16x8 b2 = *(const LAS bf16x8*)(TTa + (16 * nt + r16) * XSTR2 + 8 * g); x2[mt][nt] = mfma16(a, b2, z0); }
                }
#pragma unroll
                for (int mt = 0; mt < 2; ++mt)
#pragma unroll
                    for (int nt = 0; nt < 2; ++nt) { u32x2 o; o.x = pk2(x2[mt][nt][0], x2[mt][nt][1]); o.y = pk2(x2[mt][nt][2], x2[mt][nt][3]); *(LAS u32x2*)(XT + (16 * nt + r16) * XSTR2 + 16 * mt + 4 * g) = o; }
            }
            LDS_WAIT();
            {
#pragma unroll
                for (int mt = 0; mt < 2; ++mt) {
                    const bf16x8 a = *(const LAS bf16x8*)(Tm + (32 + 16 * mt + r16) * LDSTR + 32 + 8 * g);
#pragma unroll
                    for (int nt = 0; nt < 2; ++nt) {
                        const bf16x8 b2 = *(const LAS bf16x8*)(XT + (16 * nt + r16) * XSTR2 + 8 * g);
                        const f32x4 tv = mfma16(a, b2, z0);
#pragma unroll
                        for (int r = 0; r < 4; ++r) Tm[(32 + 16 * mt + 4 * g + r) * LDSTR + 16 * nt + r16] = (bf16)f2bf(-tv[r]);
                    }
                }
            }
        }
        __syncthreads();
        {
            f32x4 a[4];
#pragma unroll
            for (int nt = 0; nt < 4; ++nt) a[nt] = (f32x4){0.f, 0.f, 0.f, 0.f};
            slab_mma(Tm, KbT, w, lane, a);
#pragma unroll
            for (int nt = 0; nt < 4; ++nt) { u32x2 o; o.x = pk2(a[nt][0], a[nt][1]); o.y = pk2(a[nt][2], a[nt][3]); *(LAS u32x2*)(WT + (nt * 16 + r16) * LDSTR + 16 * w + 4 * g) = o; }
        }
        __syncthreads();
        {
            f32x4 a[4];
#pragma unroll
            for (int nt = 0; nt < 4; ++nt) a[nt] = (f32x4){0.f, 0.f, 0.f, 0.f};
            slab_mma(Tm, VbT, w, lane, a);
#pragma unroll
            for (int nt = 0; nt < 4; ++nt) { u32x2 o; o.x = pk2(a[nt][0], a[nt][1]); o.y = pk2(a[nt][2], a[nt][3]); *(LAS u32x2*)(UT + (nt * 16 + r16) * LDSTR + 16 * w + 4 * g) = o; }
        }
        __syncthreads();
        {
            const float egl = __expf(gc_s[63]);
            bf16* Mg = B.MN() + (size_t)it * 8192; bf16* NTg = Mg + 4096;
            bf16* Qg = B.QO() + ((size_t)((bh * 2 + dir) * 32 + tc)) * 8192; bf16* OTg = Qg + 4096;
            f32x4 a[4];
#pragma unroll
            for (int nt = 0; nt < 4; ++nt) a[nt] = (f32x4){0.f, 0.f, 0.f, 0.f};
            slab_mma(KdT, WT, w, lane, a);
#pragma unroll
            for (int nt = 0; nt < 4; ++nt)
#pragma unroll
                for (int r = 0; r < 4; ++r) { const int ra = 16 * w + 4 * g + r, cb = nt * 16 + r16; Mg[ra * 64 + cb] = (bf16)f2bf((ra == cb ? egl : 0.f) - a[nt][r]); }
#pragma unroll
            for (int nt = 0; nt < 4; ++nt) a[nt] = (f32x4){0.f, 0.f, 0.f, 0.f};
            slab_mma(KdT, UT, w, lane, a);
#pragma unroll
            for (int nt = 0; nt < 4; ++nt) { u32x2 o; o.x = pk2(a[nt][0], a[nt][1]); o.y = pk2(a[nt][2], a[nt][3]); *(u32x2*)(NTg + (nt * 16 + r16) * 64 + 16 * w + 4 * g) = o; }
#pragma unroll
            for (int nt = 0; nt < 4; ++nt) a[nt] = (f32x4){0.f, 0.f, 0.f, 0.f};
            slab_mma(IN, WT, w, lane, a);
#pragma unroll
            for (int nt = 0; nt < 4; ++nt)
#pragma unroll
                for (int r = 0; r < 4; ++r) { const int i = 16 * w + 4 * g + r, cb = nt * 16 + r16; const int ro = dir ? 63 - i : i;
                    const float qd = bf2f(Qr[i * LDSTR + cb]) * 0.125f * __expf(gc_s[i]);
                    Qg[ro * 64 + cb] = (bf16)f2bf(qd - a[nt][r]); }
#pragma unroll
            for (int nt = 0; nt < 4; ++nt) a[nt] = (f32x4){0.f, 0.f, 0.f, 0.f};
            slab_mma(IN, UT, w, lane, a);
#pragma unroll
            for (int nt = 0; nt < 4; ++nt) { const int i0 = 16 * w + 4 * g; u32x2 o;
                if (dir) { o.x = pk2(a[nt][3], a[nt][2]); o.y = pk2(a[nt][1], a[nt][0]); *(u32x2*)(OTg + (nt * 16 + r16) * 64 + 60 - i0) = o; }
                else { o.x = pk2(a[nt][0], a[nt][1]); o.y = pk2(a[nt][2], a[nt][3]); *(u32x2*)(OTg + (nt * 16 + r16) * 64 + i0) = o; } }
        }
    }
}

__device__ __forceinline__ void phase_dnscan(const Params& p, const DnBufs& B, LAS unsigned char* lds) {
    const int tid = fresh_tid(), lane = tid & 63, wave = tid >> 6;
    const int r16 = lane & 15, g = lane >> 4;
    if (wave < 4) {
    const int vp = wave;
    LAS bf16* St = (LAS bf16*)(lds + wave * (16 * LDSTR * 2));
    for (int chain = blockIdx.x; chain < 128; chain += gridDim.x) {
    f32x4 sacc[4];
#pragma unroll
    for (int mt = 0; mt < 4; ++mt) sacc[mt] = (f32x4){0.f, 0.f, 0.f, 0.f};
    bf16x8 mf[4][4][2]; u32x2 nf[4][4];
    const bf16* MN0 = B.MN() + (size_t)chain * 32 * 8192;
    bf16* SB0 = B.SB() + (size_t)chain * 32 * 4096;
#define SCAN_LOAD(slot, step) do { const bf16* Mg_ = MN0 + (size_t)(step) * 8192; const bf16* NTg_ = Mg_ + 4096; \
        _Pragma("unroll") for (int mt = 0; mt < 4; ++mt) { mf[slot][mt][0] = *(const bf16x8*)(Mg_ + (mt * 16 + r16) * 64 + 8 * g); mf[slot][mt][1] = *(const bf16x8*)(Mg_ + (mt * 16 + r16) * 64 + 32 + 8 * g); \
            nf[slot][mt] = *(const u32x2*)(NTg_ + (vp * 16 + r16) * 64 + mt * 16 + 4 * g); } } while (0)
#define SCAN_STEP(slot, step) do { bf16* Sg_ = SB0 + (size_t)(step) * 4096; \
        _Pragma("unroll") for (int mt = 0; mt < 4; ++mt) { u32x2 o; o.x = pk2(sacc[mt][0], sacc[mt][1]); o.y = pk2(sacc[mt][2], sacc[mt][3]); \
            *(u32x2*)(Sg_ + (vp * 16 + r16) * 64 + mt * 16 + 4 * g) = o; *(LAS u32x2*)(St + r16 * LDSTR + mt * 16 + 4 * g) = o; } \
        LDS_WAIT(); \
        const bf16x8 s0 = *(const LAS bf16x8*)(St + r16 * LDSTR + 8 * g), s1 = *(const LAS bf16x8*)(St + r16 * LDSTR + 32 + 8 * g); \
        _Pragma("unroll") for (int mt = 0; mt < 4; ++mt) { const u32x2 nv = nf[slot][mt]; \
            f32x4 a = {bf2f(nv.x & 0xffffu), bf2f(nv.x >> 16), bf2f(nv.y & 0xffffu), bf2f(nv.y >> 16)}; \
            a = mfma16(mf[slot][mt][0], s0, a); a = mfma16(mf[slot][mt][1], s1, a); sacc[mt] = a; } \
        LDS_WAIT(); } while (0)
    SCAN_LOAD(0, 0); SCAN_LOAD(1, 1); SCAN_LOAD(2, 2);
    for (int c0 = 0; c0 < 32; c0 += 4) {
        SCAN_LOAD(3, c0 + 3);
        SCAN_STEP(0, c0);
        if (c0 + 4 < 32) SCAN_LOAD(0, c0 + 4);
        SCAN_STEP(1, c0 + 1);
        if (c0 + 5 < 32) SCAN_LOAD(1, c0 + 5);
        SCAN_STEP(2, c0 + 2);
        if (c0 + 6 < 32) SCAN_LOAD(2, c0 + 6);
        SCAN_STEP(3, c0 + 3);
    }
#undef SCAN_LOAD
#undef SCAN_STEP
    }
    }
}

__device__ __forceinline__ void phase_dnout(const Params& p, const DnBufs& B) {
    const int tid = fresh_tid(), lane = tid & 63, wave = tid >> 6, G = gridDim.x;
    const int r16 = lane & 15, g = lane >> 4;
    for (int task = blockIdx.x * 8 + wave; task < 8192; task += G * 8) {
        const int w = task & 3, tc = (task >> 2) & 31, bh = task >> 7, h = bh & 7, b = bh >> 3;
        f32x4 acc[4];
#pragma unroll
        for (int vt = 0; vt < 4; ++vt) acc[vt] = (f32x4){0.f, 0.f, 0.f, 0.f};
#pragma unroll
        for (int dir = 0; dir < 2; ++dir) {
            const int cc = dir ? 31 - tc : tc;
            const bf16* Qg = B.QO() + ((size_t)((bh * 2 + dir) * 32 + tc)) * 8192; const bf16* OTg = Qg + 4096;
            const bf16* Sg = B.SB() + ((size_t)((bh * 2 + dir) * 32 + cc)) * 4096;
            const bf16x8 q0 = *(const bf16x8*)(Qg + (16 * w + r16) * 64 + 8 * g), q1 = *(const bf16x8*)(Qg + (16 * w + r16) * 64 + 32 + 8 * g);
#pragma unroll
            for (int vt = 0; vt < 4; ++vt) {
                const u32x2 ov = *(const u32x2*)(OTg + (vt * 16 + r16) * 64 + 16 * w + 4 * g);
                acc[vt][0] += bf2f(ov.x & 0xffffu); acc[vt][1] += bf2f(ov.x >> 16); acc[vt][2] += bf2f(ov.y & 0xffffu); acc[vt][3] += bf2f(ov.y >> 16);
                const bf16x8 s0 = *(const bf16x8*)(Sg + (vt * 16 + r16) * 64 + 8 * g), s1 = *(const bf16x8*)(Sg + (vt * 16 + r16) * 64 + 32 + 8 * g);
                acc[vt] = mfma16(q0, s0, acc[vt]); acc[vt] = mfma16(q1, s1, acc[vt]);
            }
        }
#pragma unroll
        for (int r = 0; r < 4; ++r) {
            float ss = 0.f;
#pragma unroll
            for (int vt = 0; vt < 4; ++vt) ss = fmaf(acc[vt][r], acc[vt][r], ss);
            ss += __shfl_xor(ss, 1); ss += __shfl_xor(ss, 2); ss += __shfl_xor(ss, 4); ss += __shfl_xor(ss, 8);
            const float rn = rsqrtf(ss * (1.f / 64.f) + RMS_EPS);
            const int t = tc * 64 + 16 * w + 4 * g + r;
#pragma unroll
            for (int vt = 0; vt < 4; ++vt) {
                const int v = vt * 16 + r16;
                const float z = bf2f(p.Z()[((size_t)bh * 2048 + t) * 64 + v]);
                p.DNOUT()[((size_t)b * 2048 + t) * 512 + h * 64 + v] = (bf16)f2bf(acc[vt][r] * rn * p.norm_w[v] * z);
            }
        }
    }
}

struct MixBufs { char* ws; char* out;
    __device__ __forceinline__ bf16* GB() const { return WSP(bf16, 179); }
    __device__ __forceinline__ bf16* MERGED() const { return WSP(bf16, 211); }
    __device__ __forceinline__ float* V() const { return (float*)out; } };
template <int MODE>
struct EpiMerge {
    static constexpr bool PERM = true, AFTER_DRAIN = false;
    bf16* GB; bf16* MG;
    __device__ __forceinline__ void operator()(const pg8::f32x4 (&acc)[2][2][4][2], const pg8::Unit& u, int wr, int wc, int fr, int fq) const {
#pragma unroll
        for (int ai = 0; ai < 2; ++ai)
#pragma unroll
            for (int m = 0; m < 4; ++m) {
                const size_t row = (size_t)u.pm * 256 + ai * 128 + wr * 64 + m * 16 + fr;
#pragma unroll
                for (int bj = 0; bj < 2; ++bj) {
                    const int col = u.pn * 256 + bj * 128 + wc * 32 + 8 * fq;
                    const pg8::f32x4 v0 = acc[ai][bj][m][0], v1 = acc[ai][bj][m][1];
                    float e[8] = {v0[0], v0[1], v0[2], v0[3], v1[0], v1[1], v1[2], v1[3]};
                    if (MODE == 0) {
#pragma unroll
                        for (int j = 0; j < 8; ++j) e[j] = sigmoidf_(e[j]);
                    } else {
                        const u32x4 gw = *(const u32x4*)(GB + row * 1024 + col);
                        const unsigned gws[4] = {gw.x, gw.y, gw.z, gw.w};
#pragma unroll
                        for (int j = 0; j < 4; ++j) { e[2 * j] *= bf2f(gws[j] & 0xffffu); e[2 * j + 1] *= bf2f(gws[j] >> 16); }
                        if (MODE == 2) {
                            const u32x4 mw = *(const u32x4*)(MG + row * 1024 + col);
                            const unsigned mws[4] = {mw.x, mw.y, mw.z, mw.w};
#pragma unroll
                            for (int j = 0; j < 4; ++j) { e[2 * j] += bf2f(mws[j] & 0xffffu); e[2 * j + 1] += bf2f(mws[j] >> 16); }
                        }
                    }
                    u32x4 w; w.x = pk2(e[0], e[1]); w.y = pk2(e[2], e[3]); w.z = pk2(e[4], e[5]); w.w = pk2(e[6], e[7]);
                    *(u32x4*)((MODE == 0 ? GB : MG) + row * 1024 + col) = w;
                }
            }
    }
};
struct EpiOutProj {
    static constexpr bool PERM = false, AFTER_DRAIN = false;
    const float* x; float* V;
    __device__ __forceinline__ void operator()(const pg8::f32x4 (&acc)[2][2][4][2], const pg8::Unit& u, int wr, int wc, int fr, int fq) const {
#pragma unroll
        for (int ai = 0; ai < 2; ++ai)
#pragma unroll
            for (int m = 0; m < 4; ++m) {
                const size_t row = (size_t)u.pm * 256 + ai * 128 + wr * 64 + m * 16 + fr;
#pragma unroll
                for (int bj = 0; bj < 2; ++bj)
#pragma unroll
                    for (int n = 0; n < 2; ++n) {
                        const int col = u.pn * 256 + bj * 128 + wc * 32 + 16 * n + 4 * fq;
                        const f32x4 xv = *(const f32x4*)(x + row * 1024 + col);
                        const pg8::f32x4 a = acc[ai][bj][m][n];
                        f32x4 o = {ALPHA * xv[0] + a[0], ALPHA * xv[1] + a[1], ALPHA * xv[2] + a[2], ALPHA * xv[3] + a[3]};
                        *(f32x4*)(V + row * 1024 + col) = o;
                    }
            }
    }
};
__device__ __forceinline__ void phase_merge(const Params& p, const MixBufs& B, LAS unsigned char* lds) {
    pg8::StaticOrder S; S.init(NTOK, 1024, gridDim.x, (int)blockIdx.x);
    { pg8::Gemm g{p.XB(), p.WG(), NTOK, 1024, 1024}; EpiMerge<0> E{B.GB(), B.MERGED()}; pg8::gemm_phase<EpiMerge<0>, pg8::StaticOrder, true, true>(lds, g, S, E); }
    { pg8::Gemm g{p.NAOUT(), p.WPNA(), NTOK, 1024, 512}; EpiMerge<1> E{B.GB(), B.MERGED()}; pg8::gemm_phase<EpiMerge<1>, pg8::StaticOrder, true, true>(lds, g, S, E); }
    { pg8::Gemm g{p.XB(), p.WG() + (size_t)1024 * 1024, NTOK, 1024, 1024}; EpiMerge<0> E{B.GB(), B.MERGED()}; pg8::gemm_phase<EpiMerge<0>, pg8::StaticOrder, true, true>(lds, g, S, E); }
    { pg8::Gemm g{p.DNOUT(), p.WPDN(), NTOK, 1024, 512}; EpiMerge<2> E{B.GB(), B.MERGED()}; pg8::gemm_phase<EpiMerge<2>, pg8::StaticOrder, true, true>(lds, g, S, E); }
}
__device__ __forceinline__ void phase_outproj(const Params& p, const MixBufs& B, LAS unsigned char* lds) {
    pg8::StaticOrder S; S.init(NTOK, 1024, gridDim.x, (int)blockIdx.x);
    pg8::Gemm g{B.MERGED(), p.WOUT(), NTOK, 1024, 1024}; EpiOutProj E{p.x, B.V()};
    pg8::gemm_phase<EpiOutProj, pg8::StaticOrder, true, true>(lds, g, S, E);
}
struct MoeBufs { char* ws; char* out; int kdown;
#define TBP(T, kb) ((T*)(ws + ((size_t)243 << 20) + ((size_t)(kb) << 10)))
    __device__ __forceinline__ const float* V() const { return (const float*)out; }
    __device__ __forceinline__ bf16* X1B() const { return WSP(bf16, 17); }
    __device__ __forceinline__ bf16* XS() const { return WSP(bf16, 97); }
    __device__ __forceinline__ bf16* HID() const { return WSP(bf16, 211); }
    __device__ __forceinline__ bf16* YPART() const { return WSP(bf16, 97); }
    __device__ __forceinline__ int* CNT() const { return TBP(int, 0); }
    __device__ __forceinline__ int* ROUTE() const { return TBP(int, 64); }
    __device__ __forceinline__ float* ROUTEP() const { return TBP(float, 384); }
    __device__ __forceinline__ int* ROWINFO() const { return TBP(int, 576); }
    __device__ __forceinline__ float* ROWPW() const { return TBP(float, 768); }
    __device__ __forceinline__ float* STATS() const { return TBP(float, 960); }
    __device__ __forceinline__ bf16* RWH() const { return TBP(bf16, 1152); }
    __device__ __forceinline__ bf16* RWL() const { return TBP(bf16, 1280); }
};
#define XSTR 1032
#define TAB_OFF 131072

__device__ __forceinline__ void phase0_router(const Params& p, const MoeBufs& B) {
    const size_t gt = (size_t)blockIdx.x * NT + fresh_tid(), GT = (size_t)gridDim.x * NT;
    for (size_t i = gt; i < 48 * 1024; i += GT) {
        const int n = (int)(i >> 10), k = (int)(i & 1023);
        const float w = n < 4 ? p.wrg[k * 4 + n] : (n < 36 ? p.wre[k * 32 + n - 4] : 0.f);
        const unsigned hi = f2bf(w); const float lo = w - bf2f(hi);
        B.RWH()[i] = (bf16)hi; B.RWL()[i] = (bf16)f2bf(lo);
    }
}

__device__ __forceinline__ float wave_sum64(float v) {
#pragma unroll
    for (int o = 1; o < 64; o <<= 1) v += __shfl_xor(v, o);
    return v;
}

__device__ __forceinline__ void phase_ln1(const Params& p, const MoeBufs& B, LAS unsigned char* lds) {
    const int tid = fresh_tid(), lane = tid & 63, wave = tid >> 6;
    const int r16 = lane & 15, g = lane >> 4;
    LAS bf16* XH = (LAS bf16*)lds;
    LAS bf16* XL = (LAS bf16*)(lds + 16 * XSTR * 2);
    LAS float* PART = (LAS float*)(lds + 2 * 16 * XSTR * 2);
    LAS float* LOG = PART + 8 * 16 * 48;
    LAS int* hist = (LAS int*)(LOG + 16 * 36);
    if (tid < 32) hist[tid] = 0;
    for (int i = blockIdx.x * NT + tid; i < 40960; i += gridDim.x * NT) B.ROWINFO()[i] = -1;
    for (int blk = blockIdx.x; blk < 256; blk += gridDim.x) {
        for (int itn = 0; itn < 4; ++itn) {
            __syncthreads();
#pragma unroll
            for (int q = 0; q < 2; ++q) {
                const int lt = 2 * wave + q; const size_t tg = (size_t)blk * 64 + itn * 16 + lt;
                f32x4 v[4]; float s = 0.f;
#pragma unroll
                for (int j = 0; j < 4; ++j) { v[j] = *(const f32x4*)(B.V() + tg * 1024 + 4 * lane + 256 * j); s += (v[j][0] + v[j][1]) + (v[j][2] + v[j][3]); }
                const float mu = wave_sum64(s) * (1.f / 1024.f);
                float qq = 0.f;
#pragma unroll
                for (int j = 0; j < 4; ++j) { v[j] = v[j] - mu; qq += (v[j][0] * v[j][0] + v[j][1] * v[j][1]) + (v[j][2] * v[j][2] + v[j][3] * v[j][3]); }
                const float rstd = rsqrtf(wave_sum64(qq) * (1.f / 1024.f) + LN_EPS);
                if (lane == 0) { B.STATS()[tg * 2] = mu; B.STATS()[tg * 2 + 1] = rstd; }
#pragma unroll
                for (int j = 0; j < 4; ++j) {
                    const int c = 4 * lane + 256 * j;
                    const f32x4 gg = *(const f32x4*)(p.ln1_g + c), bb = *(const f32x4*)(p.ln1_b + c);
                    float y[4]; unsigned hi[4]; float lo[4];
#pragma unroll
                    for (int e = 0; e < 4; ++e) { y[e] = v[j][e] * rstd * gg[e] + bb[e]; hi[e] = f2bf(y[e]); lo[e] = y[e] - bf2f(hi[e]); }
                    u32x2 hw; hw.x = hi[0] | (hi[1] << 16); hw.y = hi[2] | (hi[3] << 16);
                    u32x2 lw; lw.x = pk2(lo[0], lo[1]); lw.y = pk2(lo[2], lo[3]);
                    *(u32x2*)(B.X1B() + tg * 1024 + c) = hw;
                    *(LAS u32x2*)(XH + lt * XSTR + c) = hw; *(LAS u32x2*)(XL + lt * XSTR + c) = lw;
                }
            }
            __syncthreads();
            {
                f32x4 acc[3];
#pragma unroll
                for (int nt = 0; nt < 3; ++nt) acc[nt] = (f32x4){0.f, 0.f, 0.f, 0.f};
#pragma unroll
                for (int ks = 0; ks < 4; ++ks) {
                    const int k0 = wave * 128 + ks * 32 + 8 * g;
                    const bf16x8 ah = *(const LAS bf16x8*)(XH + r16 * XSTR + k0), al = *(const LAS bf16x8*)(XL + r16 * XSTR + k0);
#pragma unroll
                    for (int nt = 0; nt < 3; ++nt) {
                        const bf16x8 bh = *(const bf16x8*)(B.RWH() + (size_t)(nt * 16 + r16) * 1024 + k0), bl = *(const bf16x8*)(B.RWL() + (size_t)(nt * 16 + r16) * 1024 + k0);
                        acc[nt] = mfma16(ah, bh, acc[nt]); acc[nt] = mfma16(ah, bl, acc[nt]); acc[nt] = mfma16(al, bh, acc[nt]);
                    }
                }
#pragma unroll
                for (int nt = 0; nt < 3; ++nt)
#pragma unroll
                    for (int r = 0; r < 4; ++r) PART[(wave * 16 + 4 * g + r) * 48 + nt * 16 + r16] = acc[nt][r];
            }
            __syncthreads();
            for (int idx = tid; idx < 16 * 36; idx += NT) {
                const int tk = idx / 36, n = idx % 36;
                float a = n < 4 ? p.brg[n] : p.bre[n - 4];
#pragma unroll
                for (int w2 = 0; w2 < 8; ++w2) a += PART[(w2 * 16 + tk) * 48 + n];
                LOG[tk * 36 + n] = a;
            }
            __syncthreads();
            if (tid < 16) {
                const LAS float* lg = LOG + tid * 36; const size_t tg = (size_t)blk * 64 + itn * 16 + tid;
                int gi = 0; float gm = lg[0];
                for (int q = 1; q < 4; ++q) if (lg[q] > gm) { gm = lg[q]; gi = q; }
                float gs = 0.f;
                for (int q = 0; q < 4; ++q) gs += expf(lg[q] - gm);
                const float gp = 1.f / gs;
                const LAS float* el = lg + 4 + gi * 8;
                int i1 = 0; float l1 = el[0];
                for (int e = 1; e < 8; ++e) if (el[e] > l1) { l1 = el[e]; i1 = e; }
                int i2 = -1; float l2 = -3.0e38f;
                for (int e = 0; e < 8; ++e) if (e != i1 && el[e] > l2) { l2 = el[e]; i2 = e; }
                const float e2 = expf(l2 - l1);
                const int e0 = gi * 8 + i1, e1 = gi * 8 + i2;
                const int r0 = atomicAdd((int*)&hist[e0], 1), r1 = atomicAdd((int*)&hist[e1], 1);
                B.ROUTE()[tg * 4] = e0; B.ROUTE()[tg * 4 + 1] = e1; B.ROUTE()[tg * 4 + 2] = r0; B.ROUTE()[tg * 4 + 3] = r1;
                B.ROUTEP()[tg * 2] = gp / (1.f + e2); B.ROUTEP()[tg * 2 + 1] = gp * e2 / (1.f + e2);
            }
        }
        __syncthreads();
        if (tid < 32) { B.CNT()[blk * 32 + tid] = hist[tid]; hist[tid] = 0; }
    }
}

__device__ __forceinline__ void moe_tables(const MoeBufs& B, LAS unsigned char* lds, int nj, int blk) {
    const int tid = fresh_tid();
    LAS int* tab = (LAS int*)(lds + TAB_OFF);
    LAS int* scr = tab + 160;
    {
        const int e = tid & 31, q = tid >> 5; int tot = 0, pre = 0;
        for (int b2 = q * 16; b2 < q * 16 + 16; ++b2) { const int c = B.CNT()[b2 * 32 + e]; tot += c; if (b2 < blk) pre += c; }
        scr[q * 64 + e] = tot; scr[q * 64 + 32 + e] = pre;
    }
    __syncthreads();
    if (tid < 32) { int tot = 0, pre = 0; for (int q = 0; q < 16; ++q) { tot += scr[q * 64 + tid]; pre += scr[q * 64 + 32 + tid]; } tab[66 + tid] = tot; tab[99 + tid] = pre; }
    __syncthreads();
    if (tid == 0) { int cum = 0, off = 0; for (int e = 0; e < 32; ++e) { tab[e] = cum; tab[33 + e] = off; const int nrt = (tab[66 + e] + 255) >> 8; cum += nrt * nj; off += nrt; } tab[32] = cum; }
    __syncthreads();
}

__device__ __forceinline__ void phase_gather(const Params& p, const MoeBufs& B, LAS unsigned char* lds) {
    const int tid = fresh_tid(), lane = tid & 63, wave = tid >> 6;
    LAS int* tab = (LAS int*)(lds + TAB_OFF);
    for (int blk = blockIdx.x; blk < 256; blk += gridDim.x) {
    moe_tables(B, lds, 2, blk);
    for (int sl = wave; sl < 128; sl += 8) {
        const int lt = sl >> 1, k = sl & 1; const size_t tg = (size_t)blk * 64 + lt;
        const int e = B.ROUTE()[tg * 4 + k], lr = B.ROUTE()[tg * 4 + 2 + k];
        const size_t row = (size_t)tab[33 + e] * 256 + tab[99 + e] + lr;
        const u32x4 a = *(const u32x4*)(B.X1B() + tg * 1024 + lane * 8), b2 = *(const u32x4*)(B.X1B() + tg * 1024 + 512 + lane * 8);
        *(u32x4*)(B.XS() + row * 1024 + lane * 8) = a; *(u32x4*)(B.XS() + row * 1024 + 512 + lane * 8) = b2;
        if (lane == 0) { B.ROWINFO()[row] = (int)tg * 2 + k; B.ROWPW()[row] = B.ROUTEP()[tg * 2 + k]; }
    }
    __syncthreads();
    }
}

struct MoeSched {
    const LAS int* tab; int G, c, nj;
    __device__ __forceinline__ bool next(int i, pg8::Unit& u) const {
        const int L = i * G + c; if (L >= tab[32]) return false;
        int e = 0;
#pragma unroll
        for (int k = 1; k < 32; ++k) e += (L >= tab[k]) ? 1 : 0;
        const int rem = L - tab[e], j = rem % nj, rt = rem / nj;
        u.pm = tab[33 + e] + rt; u.pn = e * nj + j; return true;
    }
    __device__ __forceinline__ void a_ready(const pg8::Unit&) const {}
    __device__ __forceinline__ void done(const pg8::Unit&) const {}
};
struct EpiGateUp {
    static constexpr bool PERM = true, AFTER_DRAIN = false;
    bf16* HID; const float* ROWPW;
    __device__ __forceinline__ void operator()(const pg8::f32x4 (&acc)[2][2][4][2], const pg8::Unit& u, int wr, int wc, int fr, int fq) const {
#pragma unroll
        for (int ai = 0; ai < 2; ++ai)
#pragma unroll
            for (int m = 0; m < 4; ++m) {
                const size_t row = (size_t)u.pm * 256 + ai * 128 + wr * 64 + m * 16 + fr;
                const float pw = ROWPW[row];
                const int f = (u.pn & 1) * 128 + wc * 32 + 8 * fq;
                const pg8::f32x4 g0 = acc[ai][0][m][0], g1 = acc[ai][0][m][1], u0 = acc[ai][1][m][0], u1 = acc[ai][1][m][1];
                float e[8];
#pragma unroll
                for (int j = 0; j < 4; ++j) { e[j] = siluf_(g0[j]) * u0[j] * pw; e[4 + j] = siluf_(g1[j]) * u1[j] * pw; }
                u32x4 w; w.x = pk2(e[0], e[1]); w.y = pk2(e[2], e[3]); w.z = pk2(e[4], e[5]); w.w = pk2(e[6], e[7]);
                *(u32x4*)(HID + row * 256 + f) = w;
            }
    }
};
struct EpiDown {
    static constexpr bool PERM = true, AFTER_DRAIN = false;
    bf16* YPART; const int* ROWINFO;
    __device__ __forceinline__ void operator()(const pg8::f32x4 (&acc)[2][2][4][2], const pg8::Unit& u, int wr, int wc, int fr, int fq) const {
        const int j = u.pn & 3;
#pragma unroll
        for (int ai = 0; ai < 2; ++ai)
#pragma unroll
            for (int m = 0; m < 4; ++m) {
                const int row = u.pm * 256 + ai * 128 + wr * 64 + m * 16 + fr;
                asm volatile("" ::: "memory");
                const int info = ROWINFO[row];
                if (info >= 0) {
                    const size_t tg = (size_t)(info >> 1); const int k = info & 1;
#pragma unroll
                    for (int bj = 0; bj < 2; ++bj) {
                        const int col = j * 256 + bj * 128 + wc * 32 + 8 * fq;
                        const pg8::f32x4 v0 = acc[ai][bj][m][0], v1 = acc[ai][bj][m][1];
                        u32x4 w; w.x = pk2(v0[0], v0[1]); w.y = pk2(v0[2], v0[3]); w.z = pk2(v1[0], v1[1]); w.w = pk2(v1[2], v1[3]);
                        *(u32x4*)(YPART + ((size_t)k * NTOK + tg) * 1024 + col) = w;
                    }
                }
            }
    }
};
__device__ __forceinline__ void phase_moe1(const Params& p, const MoeBufs& B, LAS unsigned char* lds) {
    moe_tables(B, lds, 2, 0);
    MoeSched S{(const LAS int*)(lds + TAB_OFF), (int)gridDim.x, (int)blockIdx.x, 2};
    pg8::Gemm g{B.XS(), p.WGU(), 0, 0, 1024}; EpiGateUp E{B.HID(), B.ROWPW()};
    pg8::gemm_phase<EpiGateUp, MoeSched, true, true>(lds, g, S, E);
}
__device__ __forceinline__ void phase_moe2(const Params& p, const MoeBufs& B, LAS unsigned char* lds) {
    moe_tables(B, lds, 4, 0);
    MoeSched S{(const LAS int*)(lds + TAB_OFF), (int)gridDim.x, (int)blockIdx.x, 4};
    pg8::Gemm g{B.HID(), p.WD(), 0, 0, B.kdown}; EpiDown E{B.YPART(), B.ROWINFO()};
    pg8::gemm_phase<EpiDown, MoeSched, true, true>(lds, g, S, E);
}
__device__ __forceinline__ void phase_ln2(const Params& p, const MoeBufs& B) {
    const int tid = fresh_tid(), lane = tid & 63, wave = tid >> 6;
    for (size_t tg = (size_t)blockIdx.x * 8 + wave; tg < NTOK; tg += (size_t)gridDim.x * 8) {
        const float mu1 = B.STATS()[tg * 2], rstd1 = B.STATS()[tg * 2 + 1];
        f32x4 v[4]; float s = 0.f;
#pragma unroll
        for (int j = 0; j < 4; ++j) {
            const int c = 4 * lane + 256 * j;
            const f32x4 x = *(const f32x4*)(B.V() + tg * 1024 + c);
            const f32x4 gg = *(const f32x4*)(p.ln1_g + c), bb = *(const f32x4*)(p.ln1_b + c);
            const u32x2 y0 = *(const u32x2*)(B.YPART() + tg * 1024 + c), y1 = *(const u32x2*)(B.YPART() + ((size_t)NTOK + tg) * 1024 + c);
            const float ya[4] = {bf2f(y0.x & 0xffffu) + bf2f(y1.x & 0xffffu), bf2f(y0.x >> 16) + bf2f(y1.x >> 16), bf2f(y0.y & 0xffffu) + bf2f(y1.y & 0xffffu), bf2f(y0.y >> 16) + bf2f(y1.y >> 16)};
#pragma unroll
            for (int e = 0; e < 4; ++e) { v[j][e] = ALPHA * ((x[e] - mu1) * rstd1 * gg[e] + bb[e]) + ya[e]; s += v[j][e]; }
        }
        const float mu = wave_sum64(s) * (1.f / 1024.f);
        float qq = 0.f;
#pragma unroll
        for (int j = 0; j < 4; ++j) { v[j] = v[j] - mu; qq += (v[j][0] * v[j][0] + v[j][1] * v[j][1]) + (v[j][2] * v[j][2] + v[j][3] * v[j][3]); }
        const float rstd = rsqrtf(wave_sum64(qq) * (1.f / 1024.f) + LN_EPS);
#pragma unroll
        for (int j = 0; j < 4; ++j) {
            const int c = 4 * lane + 256 * j;
            const f32x4 gg = *(const f32x4*)(p.ln2_g + c), bb = *(const f32x4*)(p.ln2_b + c);
            f32x4 o;
#pragma unroll
            for (int e = 0; e < 4; ++e) o[e] = v[j][e] * rstd * gg[e] + bb[e];
            *(f32x4*)(p.out + tg * 1024 + c) = o;
        }
    }
}
#ifndef PH_DUP
#define PH_DUP 0
#endif
#ifndef PH_MASK
#define PH_MASK 8191
#endif
#define BAR_LDS_OFF (LDS_BYTES - 64)
struct MegaArgs { Params p; };
#define CAS __attribute__((address_space(4)))
__device__ __forceinline__ Params load_params(const CAS char* kp) {
    Params p; const CAS unsigned long long* src = (const CAS unsigned long long*)kp; unsigned long long* dst = (unsigned long long*)&p;
#pragma unroll
    for (unsigned i = 0; i < sizeof(Params) / 8; ++i) dst[i] = src[i];
    return p;
}
#define FRESH_P(name) const CAS char* name##_kp = kptr; asm volatile("" : "+s"(name##_kp)); const Params name = load_params(name##_kp)
#define GRID_BAR() do { const CAS char* b_kp = kptr; asm volatile("" : "+s"(b_kp)); XcdBarrier bar; bar.bar = *(unsigned* const CAS*)(b_kp + offsetof(Params, bar)); bar.x = xb_xcc_id(); \
        bar.st = (volatile LAS unsigned*)(lds + BAR_LDS_OFF); xcd_barrier(bar); } while (0)
__global__ void __launch_bounds__(NT, 2) mega_fwd(MegaArgs) {
    extern __shared__ __attribute__((aligned(16))) unsigned char lds_raw[];
    LAS unsigned char* lds = (LAS unsigned char*)lds_raw;
    const CAS char* kptr = (const CAS char*)__builtin_amdgcn_kernarg_segment_ptr();
    if (threadIdx.x < 16) ((LAS unsigned*)(lds + BAR_LDS_OFF))[threadIdx.x] = 0u;
    __syncthreads();
    { FRESH_P(p); (void)xcd_barrier_post(p.bar, (volatile LAS unsigned*)(lds + BAR_LDS_OFF)); }
#if PH_MASK & 1
    { FRESH_P(p); const MoeBufs Q{p.ws, (char*)p.out, p.kdown}; phase0(p, lds); phase0_router(p, Q); }
#endif
#if PH_DUP & 1
    GRID_BAR();
    { FRESH_P(p); const MoeBufs Q{p.ws, (char*)p.out, p.kdown}; phase0(p, lds); phase0_router(p, Q); }
#endif
    GRID_BAR();
#if PH_MASK & 2
    { FRESH_P(p); phase1(p, lds); }
#endif
#if PH_DUP & 2
    GRID_BAR();
    { FRESH_P(p); phase1(p, lds); }
#endif
    GRID_BAR();
#if PH_MASK & 4
    { FRESH_P(p); phase_na(p, lds); }
#endif
#if PH_DUP & 4
    GRID_BAR();
    { FRESH_P(p); phase_na(p, lds); }
    GRID_BAR();
#endif
#if PH_MASK & 8
    { FRESH_P(p); const DnBufs D{p.ws, (char*)p.out}; phase_dnprep(p, D, lds); }
#endif
#if PH_DUP & 8
    GRID_BAR();
    { FRESH_P(p); const DnBufs D{p.ws, (char*)p.out}; phase_dnprep(p, D, lds); }
    GRID_BAR();
#endif
    GRID_BAR();
#if PH_MASK & 16
    {
        FRESH_P(p); const DnBufs D{p.ws, (char*)p.out};
        const int nb = (int)gridDim.x;
        unsigned* counter = p.bar + XCD_BAR_WORDS;
        if ((int)blockIdx.x >= 128) phase_zgemm(p, lds, nb - 128, (int)blockIdx.x - 128);
        else if ((fresh_tid() >> 6) >= 4) phase0_moe(p, counter);
        if ((int)blockIdx.x < 128) phase_dnscan(p, D, lds);
        if ((int)blockIdx.x >= 128 || (fresh_tid() >> 6) < 4) phase0_moe(p, counter);
    }
#endif
#if PH_DUP & 16
    GRID_BAR();
    {
        FRESH_P(p); const DnBufs D{p.ws, (char*)p.out};
        const int nb = (int)gridDim.x;
        unsigned* counter = p.bar + XCD_BAR_WORDS;
        if ((int)blockIdx.x >= 128) phase_zgemm(p, lds, nb - 128, (int)blockIdx.x - 128);
        else if ((fresh_tid() >> 6) >= 4) phase0_moe(p, counter);
        if ((int)blockIdx.x < 128) phase_dnscan(p, D, lds);
        if ((int)blockIdx.x >= 128 || (fresh_tid() >> 6) < 4) phase0_moe(p, counter);
    }
#endif
    GRID_BAR();
#if PH_MASK & 32
    { FRESH_P(p); const DnBufs D{p.ws, (char*)p.out}; phase_dnout(p, D); }
#endif
#if PH_DUP & 32
    GRID_BAR();
    { FRESH_P(p); const DnBufs D{p.ws, (char*)p.out}; phase_dnout(p, D); }
#endif
    GRID_BAR();
#if PH_MASK & 64
    { FRESH_P(p); const MixBufs X{p.ws, (char*)p.out}; phase_merge(p, X, lds); }
#endif
#if PH_DUP & 64
    GRID_BAR();
    { FRESH_P(p); const MixBufs X{p.ws, (char*)p.out}; phase_merge(p, X, lds); }
#endif
    GRID_BAR();
#if PH_MASK & 128
    { FRESH_P(p); const MixBufs X{p.ws, (char*)p.out}; phase_outproj(p, X, lds); }
#endif
#if PH_DUP & 128
    GRID_BAR();
    { FRESH_P(p); const MixBufs X{p.ws, (char*)p.out}; phase_outproj(p, X, lds); }
#endif
    GRID_BAR();
#if PH_MASK & 256
    { FRESH_P(p); const MoeBufs Q{p.ws, (char*)p.out, p.kdown}; phase_ln1(p, Q, lds); }
#endif
#if PH_DUP & 256
    GRID_BAR();
    { FRESH_P(p); const MoeBufs Q{p.ws, (char*)p.out, p.kdown}; phase_ln1(p, Q, lds); }
#endif
    GRID_BAR();
#if PH_MASK & 512
    { FRESH_P(p); const MoeBufs Q{p.ws, (char*)p.out, p.kdown}; phase_gather(p, Q, lds); }
#endif
#if PH_DUP & 512
    GRID_BAR();
    { FRESH_P(p); const MoeBufs Q{p.ws, (char*)p.out, p.kdown}; phase_gather(p, Q, lds); }
#endif
    GRID_BAR();
#if PH_MASK & 1024
    { FRESH_P(p); const MoeBufs Q{p.ws, (char*)p.out, p.kdown}; phase_moe1(p, Q, lds); }
#endif
#if PH_DUP & 1024
    GRID_BAR();
    { FRESH_P(p); const MoeBufs Q{p.ws, (char*)p.out, p.kdown}; phase_moe1(p, Q, lds); }
#endif
    GRID_BAR();
#if PH_MASK & 2048
    { FRESH_P(p); const MoeBufs Q{p.ws, (char*)p.out, p.kdown}; phase_moe2(p, Q, lds); }
#endif
#if PH_DUP & 2048
    GRID_BAR();
    { FRESH_P(p); const MoeBufs Q{p.ws, (char*)p.out, p.kdown}; phase_moe2(p, Q, lds); }
#endif
    GRID_BAR();
#if PH_MASK & 4096
    { FRESH_P(p); const MoeBufs Q{p.ws, (char*)p.out, p.kdown}; phase_ln2(p, Q); }
#endif
}

#define MB(x) ((size_t)(x) << 20)
extern "C" void kernel_launch(void* const* d_in, const int* in_sizes, int n_in, void* d_out, int out_size, void* d_ws, size_t ws_size, hipStream_t stream) {
    MegaArgs a{};
    Params& p = a.p;
    p.x = (const float*)d_in[0]; p.w_in = (const float*)d_in[1]; p.rpb = (const float*)d_in[2]; p.conv_w = (const float*)d_in[3];
    p.a_log_f = (const float*)d_in[4]; p.a_log_b = (const float*)d_in[5]; p.dtb_f = (const float*)d_in[6]; p.dtb_b = (const float*)d_in[7];
    p.norm_w = (const float*)d_in[8]; p.w_proj_na = (const float*)d_in[9]; p.w_proj_dn = (const float*)d_in[10]; p.w_out = (const float*)d_in[11];
    p.ln1_g = (const float*)d_in[12]; p.ln1_b = (const float*)d_in[13]; p.wrg = (const float*)d_in[14]; p.brg = (const float*)d_in[15];
    p.wre = (const float*)d_in[16]; p.bre = (const float*)d_in[17]; p.wgu = (const float*)d_in[18]; p.wd = (const float*)d_in[19];
    p.ln2_g = (const float*)d_in[20]; p.ln2_b = (const float*)d_in[21];
    p.out = (float*)d_out;
    p.ws = (char*)d_ws; p.bar = (unsigned*)d_ws; p.kdown = 256;

    static int grid = 0;
    if (grid == 0) {
        int dev = 0, cus = 0, per_cu = 0;
        hipGetDevice(&dev);
        hipDeviceGetAttribute(&cus, hipDeviceAttributeMultiprocessorCount, dev);
        hipFuncSetAttribute((const void*)mega_fwd, hipFuncAttributeMaxDynamicSharedMemorySize, LDS_BYTES);
        hipOccupancyMaxActiveBlocksPerMultiprocessor(&per_cu, (const void*)mega_fwd, NT, LDS_BYTES);
        if (per_cu < 1) { fprintf(stderr, "kernel_launch: occupancy query reports %d workgroups per CU\n", per_cu); per_cu = 1; }
        if (per_cu > 1) per_cu = 1;
        grid = cus * per_cu;
        if (grid > 256) grid = 256;
        (void)hipGetLastError();
    }
    hipMemsetAsync(p.bar, 0, (XCD_BAR_WORDS + 64) * sizeof(unsigned), stream);
    hipLaunchKernelGGL(mega_fwd, dim3(grid), dim3(NT), LDS_BYTES, stream, a);
}
```

```cpp
#include <hip/hip_runtime.h>
#include <math.h>
#include <stdint.h>
#include <stddef.h>
#include <stdio.h>
namespace pg8 {
#define PG8_LAS __attribute__((address_space(3)))
typedef unsigned short bf16_t;
typedef short bf16x8 __attribute__((ext_vector_type(8)));
typedef float f32x4 __attribute__((ext_vector_type(4)));
typedef unsigned u32x4 __attribute__((ext_vector_type(4)));
constexpr int BM = 256, BK = 64, HALF = 128, HTB = HALF * BK * 2  , STAGE_BYTES = 8 * HTB, NXCD = 8, WGM = 8;

__host__ __device__ __forceinline__ int lds_byte(int r, int c) { const int st = (r >> 4) * 2 + (c >> 5), rr = r & 15, cc = c & 31, ob = rr * 64 + cc * 2; return st * 1024 + (ob ^ (((ob >> 9) & 1) << 5)); }
__host__ __device__ __forceinline__ void stage_rc(int b, int& R, int& C) { const int st = b / 1024, sb = b % 1024, swz = sb ^ (((sb >> 9) & 1) << 5); R = (st >> 1) * 16 + swz / 64; C = (st & 1) * 32 + (swz % 64) / 2; }
__host__ __device__ __forceinline__ int perm32(int rho) { const int n = rho >> 4, i = rho & 15; return 8 * (i >> 2) + 4 * n + (i & 3); }

struct Unit { int pm, pn; };
struct Gemm { const bf16_t* A; const bf16_t* Bt; int M, N, K; };

struct StaticOrder {
    int nM, nN, nwg, G, c;
    __host__ __device__ __forceinline__ void init(int M, int N, int G_, int c_) { nM = M / BM; nN = N / BM; nwg = nM * nN; G = G_; c = c_; }
    __host__ __device__ __forceinline__ bool next(int i, Unit& u) const {
        const long L = (long)i * G + c; if (L >= nwg) return false;
        int wgid = (int)L; { const int q = nwg / NXCD, r = nwg % NXCD, xcd = wgid % NXCD, off = wgid / NXCD; wgid = (xcd < r ? xcd * (q + 1) : r * (q + 1) + (xcd - r) * q) + off; }
        const int nig = WGM * nN, gid = wgid / nig, fm = gid * WGM, gsz = (nM - fm) < WGM ? (nM - fm) : WGM;
        u.pm = fm + ((wgid % nig) % gsz); u.pn = (wgid % nig) / gsz; return true;
    }
    __device__ __forceinline__ void a_ready(const Unit&) const {}
    __device__ __forceinline__ void done(const Unit&) const {}
};
__device__ __forceinline__ unsigned cvt_pk_bf16(float lo, float hi) { unsigned r; asm volatile("v_cvt_pk_bf16_f32 %0, %1, %2" : "=v"(r) : "v"(lo), "v"(hi)); return r; }

template <class Epi, class Sched, bool ALIGN_EPI = false, bool SP2 = false>
__device__ __forceinline__ void gemm_phase(PG8_LAS unsigned char* lds, const Gemm g, const Sched& S, const Epi& E) {
    int tid_ = threadIdx.x; asm volatile("" : "+v"(tid_));
    const int tid = tid_, wid = __builtin_amdgcn_readfirstlane(tid >> 6), lane = tid & 63, wr = wid >> 2, wc = wid & 3, fr = lane & 15, fq = lane >> 4;
    const int K = g.K, nt = K / BK;
    unsigned voffA[2], voffB[2];
#pragma unroll
    for (int i = 0; i < 2; ++i) { int R, C; stage_rc(tid * 16 + i * 8192, R, C); const int Rb = Epi::PERM ? ((R & ~31) + perm32(R & 31)) : R;
        voffA[i] = (unsigned)(R * K + C) * 2u; voffB[i] = (unsigned)(Rb * K + C) * 2u; }
    const size_t kstep = (size_t)(BK * 2);
    const size_t hstep = (size_t)HALF * K * 2;
    const size_t tstep = 2 * hstep;
    const unsigned ldsw = (unsigned)wid * 1024u;
    const int aoff = lds_byte(wr * 64 + fr, fq * 8), boff = lds_byte(wc * 32 + fr, fq * 8);
#define PG8_SA(b, h) (((b) * 2 + (h)) * HTB)
#define PG8_SB(b, h) ((4 + (b) * 2 + (h)) * HTB)
#define PG8_STAGE(bufoff, gbase, voff) do { _Pragma("unroll") for (int _i = 0; _i < 2; ++_i) \
        __builtin_amdgcn_global_load_lds((const unsigned*)((const char*)(gbase) + (voff)[_i]), (PG8_LAS unsigned*)(lds + (bufoff) + ldsw + _i * 8192), 16, 0, 0); } while (0)
#define PG8_LDA(dst, b, h) do { _Pragma("unroll") for (int m = 0; m < 4; ++m) _Pragma("unroll") for (int k = 0; k < 2; ++k) dst[m][k] = *(const PG8_LAS bf16x8*)(lds + PG8_SA(b, h) + aoff + m * 2048 + k * 1024); } while (0)
#define PG8_LDB(dst, b, h) do { _Pragma("unroll") for (int n = 0; n < 2; ++n) _Pragma("unroll") for (int k = 0; k < 2; ++k) dst[n][k] = *(const PG8_LAS bf16x8*)(lds + PG8_SB(b, h) + boff + n * 2048 + k * 1024); } while (0)
#define PG8_MMA(ai, bj, At, Bt) do { __builtin_amdgcn_s_setprio(1); _Pragma("unroll") for (int m = 0; m < 4; ++m) _Pragma("unroll") for (int n = 0; n < 2; ++n) _Pragma("unroll") for (int k = 0; k < 2; ++k) \
        acc[ai][bj][m][n] = __builtin_amdgcn_mfma_f32_16x16x32_bf16(Bt[n][k], At[m][k], acc[ai][bj][m][n], 0, 0, 0); __builtin_amdgcn_s_setprio(0); } while (0)
#define PG8_WAIT_V(n) asm volatile("s_waitcnt vmcnt(" #n ")" ::: "memory")
#define PG8_WAIT_L(n) asm volatile("s_waitcnt lgkmcnt(" #n ")" ::: "memory")
#define PG8_BAR __builtin_amdgcn_s_barrier()
#define PG8_SCHED __builtin_amdgcn_sched_barrier(0)
    Unit cur, nxt; int ui = 0;
    if (!S.next(0, cur)) return;
    f32x4 acc[2][2][4][2];
#pragma unroll
    for (int a = 0; a < 2; ++a)
#pragma unroll
        for (int b = 0; b < 2; ++b)
#pragma unroll
            for (int m = 0; m < 4; ++m)
#pragma unroll
                for (int n = 0; n < 2; ++n) acc[a][b][m][n] = (f32x4){0.f, 0.f, 0.f, 0.f};
    bf16x8 At[4][2], B0[2][2], B1[2][2];
    const char* cA = (const char*)g.A + (size_t)cur.pm * tstep; const char* cB = (const char*)g.Bt + (size_t)cur.pn * tstep;
    S.a_ready(cur);
    if constexpr (SP2) {
        PG8_STAGE(PG8_SB(0, 0), cB, voffB); PG8_STAGE(PG8_SB(0, 1), cB + hstep, voffB); PG8_STAGE(PG8_SA(0, 0), cA, voffA); PG8_STAGE(PG8_SA(0, 1), cA + hstep, voffA);
        if (wr == 1) PG8_BAR;
        PG8_WAIT_V(2); PG8_BAR;
        PG8_STAGE(PG8_SB(1, 0), cB + kstep, voffB); PG8_STAGE(PG8_SA(1, 0), cA + kstep, voffA); PG8_STAGE(PG8_SB(1, 1), cB + hstep + kstep, voffB);
        PG8_WAIT_V(6); PG8_BAR;
    } else {
        PG8_STAGE(PG8_SB(0, 0), cB, voffB); PG8_STAGE(PG8_SA(0, 0), cA, voffA); PG8_STAGE(PG8_SB(0, 1), cB + hstep, voffB); PG8_STAGE(PG8_SA(0, 1), cA + hstep, voffA);
        if (wr == 1) PG8_BAR;
        PG8_WAIT_V(4); PG8_BAR;
        PG8_STAGE(PG8_SB(1, 0), cB + kstep, voffB); PG8_STAGE(PG8_SA(1, 0), cA + kstep, voffA); PG8_STAGE(PG8_SB(1, 1), cB + hstep + kstep, voffB);
        PG8_WAIT_V(6); PG8_BAR;
    }
    for (;;) {
        const bool has_next = S.next(ui + 1, nxt);
        const char* nA = has_next ? (const char*)g.A + (size_t)nxt.pm * tstep : cA; const char* nB = has_next ? (const char*)g.Bt + (size_t)nxt.pn * tstep : cB;
        for (int t = 0; t < nt; t += 2) {
            const bool last = (t == nt - 2);
            const char* a1 = cA + (size_t)(t + 1) * kstep;
            const char* a2 = last ? nA : cA + (size_t)(t + 2) * kstep; const char* b2 = last ? nB : cB + (size_t)(t + 2) * kstep;
            const char* a3 = a2 + kstep; const char* b3 = b2 + kstep;
            if (last && has_next) S.a_ready(nxt);
            if constexpr (SP2) {
            PG8_LDB(B0, 0, 0); PG8_LDB(B1, 0, 1); PG8_SCHED; PG8_LDA(At, 0, 0); PG8_STAGE(PG8_SA(1, 1), a1 + hstep, voffA);
            PG8_WAIT_V(8); PG8_WAIT_L(0); PG8_BAR; PG8_MMA(0, 0, At, B0); PG8_MMA(0, 1, At, B1); PG8_BAR; PG8_SCHED;
            PG8_LDA(At, 0, 1); PG8_STAGE(PG8_SB(0, 0), b2, voffB); PG8_STAGE(PG8_SB(0, 1), b2 + hstep, voffB); PG8_STAGE(PG8_SA(0, 0), a2, voffA);
            PG8_WAIT_V(8); PG8_WAIT_L(0); PG8_BAR; PG8_MMA(1, 0, At, B0); PG8_MMA(1, 1, At, B1); PG8_BAR; PG8_SCHED;
            PG8_LDB(B0, 1, 0); PG8_LDB(B1, 1, 1); PG8_SCHED; PG8_LDA(At, 1, 0); PG8_STAGE(PG8_SA(0, 1), a2 + hstep, voffA);
            PG8_WAIT_V(8); PG8_WAIT_L(0); PG8_BAR; PG8_MMA(0, 0, At, B0); PG8_MMA(0, 1, At, B1); PG8_BAR; PG8_SCHED;
            PG8_LDA(At, 1, 1); PG8_STAGE(PG8_SB(1, 0), b3, voffB); PG8_STAGE(PG8_SB(1, 1), b3 + hstep, voffB); PG8_STAGE(PG8_SA(1, 0), a3, voffA);
            PG8_WAIT_V(8); PG8_WAIT_L(0); PG8_BAR; PG8_MMA(1, 0, At, B0); PG8_MMA(1, 1, At, B1); PG8_BAR; PG8_SCHED;
            } else {
            PG8_LDB(B0, 0, 0); PG8_SCHED; PG8_LDA(At, 0, 0); PG8_STAGE(PG8_SA(1, 1), a1 + hstep, voffA);
            PG8_WAIT_L(8); PG8_BAR; PG8_WAIT_L(0); PG8_MMA(0, 0, At, B0); PG8_BAR; PG8_SCHED;
            PG8_LDB(B1, 0, 1); PG8_STAGE(PG8_SB(0, 0), b2, voffB);
            PG8_BAR; PG8_WAIT_L(0); PG8_MMA(0, 1, At, B1); PG8_BAR;
            PG8_LDA(At, 0, 1); PG8_STAGE(PG8_SA(0, 0), a2, voffA);
            PG8_BAR; PG8_WAIT_L(0); PG8_MMA(1, 0, At, B0); PG8_BAR; PG8_SCHED;
            PG8_STAGE(PG8_SB(0, 1), b2 + hstep, voffB);
            PG8_WAIT_V(6); PG8_BAR; PG8_MMA(1, 1, At, B1); PG8_BAR;
            PG8_LDB(B0, 1, 0); PG8_SCHED; PG8_LDA(At, 1, 0); PG8_STAGE(PG8_SA(0, 1), a2 + hstep, voffA);
            PG8_WAIT_L(8); PG8_BAR; PG8_WAIT_L(0); PG8_MMA(0, 0, At, B0); PG8_BAR; PG8_SCHED;
            PG8_LDB(B1, 1, 1); PG8_STAGE(PG8_SB(1, 0), b3, voffB);
            PG8_BAR; PG8_WAIT_L(0); PG8_MMA(0, 1, At, B1); PG8_BAR;
            PG8_LDA(At, 1, 1); PG8_STAGE(PG8_SA(1, 0), a3, voffA);
            PG8_BAR; PG8_WAIT_L(0); PG8_MMA(1, 0, At, B0); PG8_BAR; PG8_SCHED;
            PG8_STAGE(PG8_SB(1, 1), b3 + hstep, voffB);
            PG8_WAIT_V(6); PG8_BAR; PG8_MMA(1, 1, At, B1); PG8_BAR;
            }
        }
        if constexpr (ALIGN_EPI) { if (wr == 0) PG8_BAR; }
        if constexpr (!Epi::AFTER_DRAIN) { E(acc, cur, wr, wc, fr, fq); S.done(cur); }
        if (!has_next) break;
#pragma unroll
        for (int a = 0; a < 2; ++a)
#pragma unroll
            for (int b = 0; b < 2; ++b)
#pragma unroll
                for (int m = 0; m < 4; ++m)
#pragma unroll
                    for (int n = 0; n < 2; ++n) acc[a][b][m][n] = (f32x4){0.f, 0.f, 0.f, 0.f};
        cur = nxt; cA = nA; cB = nB; ++ui;
        if constexpr (ALIGN_EPI) { if (wr == 1) PG8_BAR; }
    }
    PG8_WAIT_V(0);
    if constexpr (!ALIGN_EPI) { if (wr == 0) PG8_BAR; }
    PG8_BAR;
    if constexpr (Epi::AFTER_DRAIN) { E.fused(acc, cur, wr, wc, fr, fq, lds, wid, lane); S.done(cur); }
#undef PG8_SA
#undef PG8_SB
#undef PG8_STAGE
#undef PG8_LDA
#undef PG8_LDB
#undef PG8_MMA
#undef PG8_WAIT_V
#undef PG8_WAIT_L
#undef PG8_BAR
#undef PG8_SCHED
}
}
typedef unsigned short bf16;
#define LAS __attribute__((address_space(3)))
typedef float f32x4 __attribute__((ext_vector_type(4)));
typedef short bf16x8 __attribute__((ext_vector_type(8)));
typedef unsigned u32x4 __attribute__((ext_vector_type(4)));
typedef unsigned u32x2 __attribute__((ext_vector_type(2)));

#define D_MODEL 1024
#define BATCH 8
#define SEQ 2048
#define D_IN 5664
#define NTOK (BATCH * SEQ)
#define ALPHA 1.189207115002721f
#define LN_EPS 1e-5f
#define RMS_EPS 1e-6f
#define NWIN 3072
#define NT 512
#define LDS_BYTES 147456

#define LDS_WAIT() asm volatile("s_waitcnt lgkmcnt(0)" ::: "memory")
#define VM_WAIT() asm volatile("s_waitcnt vmcnt(0)" ::: "memory")

__device__ __forceinline__ int fresh_tid() { int t = threadIdx.x; asm volatile("" : "+v"(t)); return t; }
typedef float f32x2_t __attribute__((ext_vector_type(2)));
typedef __bf16 bf16x2_t __attribute__((ext_vector_type(2)));
__device__ __forceinline__ unsigned pk2(float lo, float hi) { const f32x2_t v = {lo, hi}; const bf16x2_t b = __builtin_convertvector(v, bf16x2_t); return __builtin_bit_cast(unsigned, b); }
__device__ __forceinline__ unsigned f2bf(float f) { return pk2(f, 0.f) & 0xffffu; }
__device__ __forceinline__ float bf2f(unsigned h) { return __builtin_bit_cast(float, (h & 0xffffu) << 16); }
__device__ __forceinline__ float sigmoidf_(float x) { return __builtin_amdgcn_rcpf(1.f + __expf(-x)); }
__device__ __forceinline__ float siluf_(float x) { return x * __builtin_amdgcn_rcpf(1.f + __expf(-x)); }
__device__ __forceinline__ float softplusf_(float x) { return x > 20.f ? x : log1pf(expf(x)); }

struct Params {
    const float *x, *w_in, *rpb, *conv_w, *a_log_f, *a_log_b, *dtb_f, *dtb_b, *norm_w, *w_proj_na, *w_proj_dn, *w_out, *ln1_g, *ln1_b;
    const float *wrg, *brg, *wre, *bre, *wgu, *wd, *ln2_g, *ln2_b;
    float* out;
    char* ws;
    unsigned* bar;
    int kdown, pad0;
#define WSP(T, mb) ((T*)(ws + ((size_t)(mb) << 20)))
    __device__ __forceinline__ bf16* WIN() const { return WSP(bf16, 1); }
    __device__ __forceinline__ bf16* WG() const { return WSP(bf16, 9); }
    __device__ __forceinline__ bf16* WPNA() const { return WSP(bf16, 13); }
    __device__ __forceinline__ bf16* WPDN() const { return WSP(bf16, 14); }
    __device__ __forceinline__ bf16* WOUT() const { return WSP(bf16, 15); }
    __device__ __forceinline__ bf16* XB() const { return WSP(bf16, 17); }
    __device__ __forceinline__ bf16* WGU() const { return WSP(bf16, 49); }
    __device__ __forceinline__ bf16* WD() const { return WSP(bf16, 81); }
    __device__ __forceinline__ bf16* QNA() const { return WSP(bf16, 49); }
    __device__ __forceinline__ bf16* KNA() const { return WSP(bf16, 65); }
    __device__ __forceinline__ bf16* VNAT() const { return WSP(bf16, 81); }
    __device__ __forceinline__ bf16* QKVDN() const { return WSP(bf16, 97); }
    __device__ __forceinline__ bf16* Z() const { return WSP(bf16, 145); }
    __device__ __forceinline__ float* GATES() const { return WSP(float, 161); }
    __device__ __forceinline__ bf16* NAOUT() const { return WSP(bf16, 163); }
    __device__ __forceinline__ bf16* DNOUT() const { return WSP(bf16, 129); }
};

__device__ __forceinline__ void transpose_item(const float* W, size_t ldW, bf16* WT, int Kdst, int k0, int n0, int rowdst0, LAS float*  , int lane) {
    const int m = lane & 15, g = lane >> 4;
    bf16x8 idb[2];
#pragma unroll
    for (int half = 0; half < 2; ++half)
#pragma unroll
        for (int j = 0; j < 8; ++j) idb[half][j] = (8 * g + j == m + 16 * half) ? (short)0x3F80 : (short)0;
#pragma unroll
    for (int kg = 0; kg < 2; ++kg) {
        f32x4 d[2][2];
#pragma unroll
        for (int q = 0; q < 2; ++q) {
            const float* src = W + (size_t)(k0 + 32 * kg + 8 * (m >> 2) + 4 * q + (m & 3)) * ldW + n0 + 8 * g;
            const f32x4 a0 = *(const f32x4*)src, a1 = *(const f32x4*)(src + 4);
            u32x4 aw; aw.x = pk2(a0[0], a0[1]); aw.y = pk2(a0[2], a0[3]); aw.z = pk2(a1[0], a1[1]); aw.w = pk2(a1[2], a1[3]);
            const bf16x8 af = __builtin_bit_cast(bf16x8, aw);
#pragma unroll
            for (int half = 0; half < 2; ++half) d[q][half] = __builtin_amdgcn_mfma_f32_16x16x32_bf16(af, idb[half], (f32x4){0.f, 0.f, 0.f, 0.f}, 0, 0, 0);
        }
#pragma unroll
        for (int half = 0; half < 2; ++half) {
            u32x4 o; o.x = pk2(d[0][half][0], d[0][half][1]); o.y = pk2(d[0][half][2], d[0][half][3]); o.z = pk2(d[1][half][0], d[1][half][1]); o.w = pk2(d[1][half][2], d[1][half][3]);
            *(u32x4*)(WT + (size_t)(rowdst0 + 16 * half + m) * Kdst + k0 + 32 * kg + 8 * g) = o;
        }
    }
}

#define IT_WIN (16 * 113)
#define IT_WG (16 * 64)
#define IT_WPNA (8 * 32)
#define IT_WPDN (8 * 32)
#define IT_WOUT (16 * 32)
#define IT_SMALL (IT_WIN + IT_WG + IT_WPNA + IT_WPDN + IT_WOUT)
#define IT_WGU (32 * 16 * 16)
#define IT_WD (32 * 4 * 32)

__device__ __forceinline__ void p0_small_item(const Params& p, int r, LAS float* scr, int lane) {
    if (r < IT_WIN) { const int kb = r / 113, nb = r % 113; transpose_item(p.w_in, D_IN, p.WIN(), 1024, kb * 64, nb * 32, nb * 32, scr, lane); return; } r -= IT_WIN;
    if (r < IT_WG) { const int kb = r / 64, nb = r % 64; transpose_item(p.w_in + 3616, D_IN, p.WG(), 1024, kb * 64, nb * 32, nb * 32, scr, lane); return; } r -= IT_WG;
    if (r < IT_WPNA) { const int kb = r / 32, nb = r % 32; transpose_item(p.w_proj_na, 1024, p.WPNA(), 512, kb * 64, nb * 32, nb * 32, scr, lane); return; } r -= IT_WPNA;
    if (r < IT_WPDN) { const int kb = r / 32, nb = r % 32; transpose_item(p.w_proj_dn, 1024, p.WPDN(), 512, kb * 64, nb * 32, nb * 32, scr, lane); return; } r -= IT_WPDN;
    { const int kb = r / 32, nb = r % 32; transpose_item(p.w_out, 1024, p.WOUT(), 1024, kb * 64, nb * 32, nb * 32, scr, lane); }
}
__device__ __forceinline__ void p0_moe_item(const Params& p, int r, LAS float* scr, int lane) {
    if (r < IT_WGU) { const int e = r / 256, q = r % 256, kb = q / 16, nb = q % 16;
        const int n0 = nb * 32, up = n0 >= 256, f0 = n0 - (up ? 256 : 0);
        transpose_item(p.wgu + (size_t)e * 1024 * 512, 512, p.WGU(), 1024, kb * 64, n0, e * 512 + (f0 / 128) * 256 + (up ? 128 : 0) + (f0 % 128), scr, lane); return; }
    r -= IT_WGU;
    { const int e = r / 128, q = r % 128, kb = q / 32, nb = q % 32;
        transpose_item(p.wd + (size_t)e * 256 * 1024, 1024, p.WD(), 256, kb * 64, nb * 32, e * 1024 + nb * 32, scr, lane); }
}

__device__ __forceinline__ void phase0_moe(const Params& p, unsigned* counter) {
    const int lane = fresh_tid() & 63;
    for (;;) {
        unsigned base = 0;
        if (lane == 0) base = __hip_atomic_fetch_add(counter, 4u, __ATOMIC_RELAXED, __HIP_MEMORY_SCOPE_AGENT);
        base = (unsigned)__builtin_amdgcn_readfirstlane((int)base);
        if (base >= (unsigned)(IT_WGU + IT_WD)) break;
#pragma unroll 1
        for (int k = 0; k < 4; ++k) p0_moe_item(p, (int)base + k, nullptr, lane);
    }
}
__device__ __forceinline__ void phase0(const Params& p, LAS unsigned char* lds) {
    const int tid = fresh_tid(), lane = tid & 63, wave = tid >> 6, G = gridDim.x;
    LAS float* scr = (LAS float*)(lds + wave * 16384);
    const int gw = blockIdx.x * 8 + wave, NGW = G * 8;
    for (int it = gw; it < IT_SMALL; it += NGW) p0_small_item(p, it, scr, lane);
    const size_t gt = (size_t)blockIdx.x * NT + tid, GT = (size_t)G * NT;
    for (size_t i = gt; i < (size_t)NTOK * 1024 / 8; i += GT) {
        const f32x4 a = *(const f32x4*)(p.x + i * 8), b = *(const f32x4*)(p.x + i * 8 + 4);
        u32x4 o; o.x = pk2(a.x, a.y); o.y = pk2(a.z, a.w); o.z = pk2(b.x, b.y); o.w = pk2(b.z, b.w);
        *(u32x4*)(p.XB() + i * 8) = o;
    }
}

struct EpiInProj {
    static constexpr bool PERM = true, AFTER_DRAIN = false;
    struct Mini { char* ws;
        __device__ __forceinline__ bf16* QNA() const { return WSP(bf16, 49); }
        __device__ __forceinline__ bf16* KNA() const { return WSP(bf16, 65); }
        __device__ __forceinline__ bf16* VNAT() const { return WSP(bf16, 81); }
        __device__ __forceinline__ bf16* QKVDN() const { return WSP(bf16, 97); }
    } p;
    __device__ __forceinline__ void operator()(const pg8::f32x4 (&acc)[2][2][4][2], const pg8::Unit& u, int wr, int wc, int fr, int fq) const {
        const int pn = u.pn;
#pragma unroll
        for (int ai = 0; ai < 2; ++ai)
#pragma unroll
            for (int m = 0; m < 4; ++m) {
                const int row = u.pm * 256 + ai * 128 + wr * 64 + m * 16 + fr;
                const int b = row >> 11, t = row & 2047;
#pragma unroll
                for (int bj = 0; bj < 2; ++bj) {
                    const pg8::f32x4 v0 = acc[ai][bj][m][0], v1 = acc[ai][bj][m][1];
                    const int head = (pn & 1) * 4 + bj * 2 + (wc >> 1), d0 = (wc & 1) * 32 + 8 * fq;
                    const size_t hm = ((size_t)(b * 8 + head) * 2048 + t) * 64 + d0;
                    if (pn < 4 || pn >= 6) {
                        bf16* dst; float sc = 1.f;
                        if (pn < 2) { dst = p.QNA(); sc = 0.125f; }
                        else if (pn < 4) dst = p.KNA();
                        else dst = p.QKVDN() + (size_t)((pn - 6) >> 1) * ((size_t)NTOK * 512);
                        float e[8] = {v0[0], v0[1], v0[2], v0[3], v1[0], v1[1], v1[2], v1[3]};
#pragma unroll
                        for (int j = 0; j < 8; ++j) e[j] *= sc;
                        u32x4 w; w.x = pk2(e[0], e[1]); w.y = pk2(e[2], e[3]); w.z = pk2(e[4], e[5]); w.w = pk2(e[6], e[7]);
                        *(u32x4*)(dst + hm) = w;
                    } else {
                        bf16* dst = p.VNAT() + ((size_t)(b * 8 + head) * 64 + d0) * 2048 + t;
                        const float e[8] = {v0[0], v0[1], v0[2], v0[3], v1[0], v1[1], v1[2], v1[3]};
#pragma unroll
                        for (int j = 0; j < 8; ++j) dst[(size_t)j * 2048] = (bf16)f2bf(e[j]);
                    }
                }
            }
    }
};
struct EpiZ {
    static constexpr bool PERM = true, AFTER_DRAIN = false;
    bf16* Z;
    __device__ __forceinline__ void operator()(const pg8::f32x4 (&acc)[2][2][4][2], const pg8::Unit& u, int wr, int wc, int fr, int fq) const {
#pragma unroll
        for (int ai = 0; ai < 2; ++ai)
#pragma unroll
            for (int m = 0; m < 4; ++m) {
                const int row = u.pm * 256 + ai * 128 + wr * 64 + m * 16 + fr;
                const int b = row >> 11, t = row & 2047;
#pragma unroll
                for (int bj = 0; bj < 2; ++bj) {
                    const pg8::f32x4 v0 = acc[ai][bj][m][0], v1 = acc[ai][bj][m][1];
                    const int head = (u.pn & 1) * 4 + bj * 2 + (wc >> 1), d0 = (wc & 1) * 32 + 8 * fq;
                    float e[8] = {v0[0], v0[1], v0[2], v0[3], v1[0], v1[1], v1[2], v1[3]};
#pragma unroll
                    for (int j = 0; j < 8; ++j) e[j] = siluf_(e[j]);
                    u32x4 w; w.x = pk2(e[0], e[1]); w.y = pk2(e[2], e[3]); w.z = pk2(e[4], e[5]); w.w = pk2(e[6], e[7]);
                    *(u32x4*)(Z + ((size_t)(b * 8 + head) * 2048 + t) * 64 + d0) = w;
                }
            }
    }
};
__device__ __forceinline__ void gates_minigemm(const Params& p) {
    const int tid = fresh_tid(), lane = tid & 63, wave = tid >> 6, r16 = lane & 15, g = lane >> 4;
    for (int blk = blockIdx.x; blk < 256; blk += gridDim.x) {
        const int mt = wave & 3, nt = wave >> 2;
        const bf16* A = p.XB() + ((size_t)blk * 64 + mt * 16 + r16) * 1024 + 8 * g;
        const bf16* Bt = p.WIN() + ((size_t)3584 + nt * 16 + r16) * 1024 + 8 * g;
        f32x4 acc0 = {0.f, 0.f, 0.f, 0.f}, acc1 = {0.f, 0.f, 0.f, 0.f};
#pragma unroll 8
        for (int ks = 0; ks < 32; ks += 2) {
            acc0 = __builtin_amdgcn_mfma_f32_16x16x32_bf16(*(const bf16x8*)(A + ks * 32), *(const bf16x8*)(Bt + ks * 32), acc0, 0, 0, 0);
            acc1 = __builtin_amdgcn_mfma_f32_16x16x32_bf16(*(const bf16x8*)(A + ks * 32 + 32), *(const bf16x8*)(Bt + ks * 32 + 32), acc1, 0, 0, 0);
        }
        const int col = nt * 16 + r16, type = col >> 3, hd = col & 7;
        const size_t tg0 = (size_t)blk * 64 + mt * 16 + 4 * g; const int b = (int)(tg0 >> 11), t = (int)(tg0 & 2047);
        f32x4 o;
#pragma unroll
        for (int r = 0; r < 4; ++r) {
            const float e = acc0[r] + acc1[r];
            o[r] = type < 2 ? sigmoidf_(e) : (type == 2 ? -expf(p.a_log_f[hd]) * softplusf_(e + p.dtb_f[hd]) : -expf(p.a_log_b[hd]) * softplusf_(e + p.dtb_b[hd]));
        }
        *(f32x4*)(p.GATES() + (size_t)type * NTOK * 8 + ((size_t)b * 8 + hd) * 2048 + t) = o;
    }
}

__device__ __forceinline__ void phase1(const Params& p, LAS unsigned char* lds) {
    pg8::Gemm g{p.XB(), p.WIN(), NTOK, NWIN, 1024};
    pg8::StaticOrder S; S.init(NTOK, NWIN, gridDim.x, (int)blockIdx.x);
    EpiInProj E{{p.ws}};
    pg8::gemm_phase<EpiInProj, pg8::StaticOrder, true, true>(lds, g, S, E);
    gates_minigemm(p);
}
__device__ __forceinline__ void phase_zgemm(const Params& p, LAS unsigned char* lds, int nb, int c) {
    pg8::Gemm g{p.XB(), p.WIN() + (size_t)3072 * 1024, NTOK, 512, 1024};
    pg8::StaticOrder S; S.init(NTOK, 512, nb, c);
    EpiZ E{p.Z()};
    pg8::gemm_phase<EpiZ, pg8::StaticOrder, true, true>(lds, g, S, E);
}

#define XB_TMO      128
#define XB_XCNT(j)  (256  + 64 * (j))
#define XB_XSUB(j)  (1280 + 64 * (j))
#define XB_XGEN(j)  (2304 + 64 * (j))
#define XB_TOP      3328
#define XB_TOPGEN   3392
#define XCD_BAR_WORDS 3456
#define XB_SPIN_CAP (1u << 18)


__device__ __forceinline__ unsigned xb_ld(unsigned* p)              { return __hip_atomic_load(p, __ATOMIC_RELAXED, __HIP_MEMORY_SCOPE_AGENT); }
__device__ __forceinline__ unsigned xb_add(unsigned* p, unsigned v) { return __hip_atomic_fetch_add(p, v, __ATOMIC_RELAXED, __HIP_MEMORY_SCOPE_AGENT); }
__device__ __forceinline__ unsigned xb_xcc_id() { return (unsigned)__builtin_amdgcn_s_getreg((3 << 11) | 20) & 0xFu; }
#define XB_SPIN(cond, bar) do { unsigned _sp = 0; while (cond) { __builtin_amdgcn_s_sleep(1); \
    if ((++_sp & 255u) == 0u) { if (xb_ld(&(bar)[XB_TMO])) break; if (_sp > XB_SPIN_CAP) { atomicAdd(&(bar)[XB_TMO], 1u); break; } } } } while (0)

struct XcdBarrier {
    unsigned* bar; unsigned x;
    volatile LAS unsigned* st;
};

__device__ __forceinline__ XcdBarrier xcd_barrier_post(unsigned* bar, volatile LAS unsigned* st) {
    XcdBarrier b; b.bar = bar; b.x = xb_xcc_id(); b.st = st;
    if (threadIdx.x == 0) (void)xb_add(&bar[XB_XCNT(b.x)], 1u);
    return b;
}
__device__ __forceinline__ void xcd_barrier_complete(unsigned* bar, unsigned x, unsigned& nloc, unsigned& nx) {
    const unsigned G = gridDim.x * gridDim.y * gridDim.z;
    unsigned sum, cnt, mine, sp = 0u;
    for (;;) {
        sum = 0u; cnt = 0u; mine = 0u;
#pragma unroll
        for (unsigned j = 0; j < 16; ++j) { const unsigned c = xb_ld(&bar[XB_XCNT(j)]); sum += c; cnt += (c > 0u) ? 1u : 0u; mine = (j == x) ? c : mine; }
        if (sum == G) break;
        __builtin_amdgcn_s_sleep(1);
        if ((++sp & 255u) == 0u) { if (xb_ld(&bar[XB_TMO])) break; if (sp > XB_SPIN_CAP) { atomicAdd(&bar[XB_TMO], 1u); break; } }
    }
    nloc = mine > 0u ? mine : 1u; nx = cnt > 0u ? cnt : 1u;
}

__device__ __forceinline__ void xcd_barrier(const XcdBarrier& b) {
    asm volatile("s_waitcnt vmcnt(0)" ::: "memory");
    __syncthreads();
    if (threadIdx.x == 0) {
        unsigned* bar = b.bar;
        __builtin_amdgcn_s_waitcnt(0);
        unsigned nloc = b.st[0], nx = b.st[1];
        if (nloc == 0u) { xcd_barrier_complete(bar, b.x, nloc, nx); b.st[0] = nloc; b.st[1] = nx; }
        const unsigned old = xb_add(&bar[XB_XSUB(b.x)], 1u);
        const unsigned gen = old / nloc;
        if (old + 1u == (gen + 1u) * nloc) {
            __builtin_amdgcn_fence(__ATOMIC_RELEASE, "agent");
            asm volatile("s_waitcnt vmcnt(0)" ::: "memory");
            const unsigned og = xb_add(&bar[XB_TOP], 1u);
            const unsigned tg = og / nx;
            if (og + 1u == (tg + 1u) * nx) xb_add(&bar[XB_TOPGEN], 1u);
            else XB_SPIN(xb_ld(&bar[XB_TOPGEN]) == tg, bar);
            __builtin_amdgcn_fence(__ATOMIC_ACQUIRE, "agent");
            xb_add(&bar[XB_XGEN(b.x)], 1u);
            asm volatile("s_waitcnt vmcnt(0)" ::: "memory");
        } else {
            XB_SPIN(xb_ld(&bar[XB_XGEN(b.x)]) == gen, bar);
            __builtin_amdgcn_fence(__ATOMIC_ACQUIRE, "agent");
            asm volatile("s_waitcnt vmcnt(0)" ::: "memory");
        }
    }
    __syncthreads();
}
#define NA_VSTR 520
#define NA_V_OFF 65536
#define NA_RPB_OFF (65536 + 64 * NA_VSTR * 2)
__device__ __forceinline__ void phase_na(const Params& p, LAS unsigned char* lds) {
    const int tid = fresh_tid(), lane = tid & 63, wave = tid >> 6, G = gridDim.x;
    const int vcu = (G % 8 == 0) ? ((int)blockIdx.x % 8) * (G / 8) + (int)blockIdx.x / 8 : (int)blockIdx.x;
    LAS unsigned char* Kl = lds;
    LAS bf16* Vl = (LAS bf16*)(lds + NA_V_OFF);
    LAS float* rpb_s = (LAS float*)(lds + NA_RPB_OFF);
    const int qi = lane & 15, g = lane >> 4, qg = wave & 3, dh = wave >> 2;
    const int c0 = qg * 16, c = c0 + qi;
    int cs0 = c0 - 8; cs0 = cs0 < 0 ? 0 : (cs0 > 32 ? 32 : cs0);
    int csq = c - 8; csq = csq < 0 ? 0 : (csq > 48 ? 48 : csq);
    for (int task = vcu; task < 256; task += G) {
        const int bh = task >> 2, r0 = (task & 3) * 8, h = bh & 7, b = bh >> 3;
        const size_t hb = (size_t)bh * 2048;
        const bf16* Kg = p.KNA() + hb * 64;
        const bf16* Vg = p.VNAT() + (size_t)bh * 64 * 2048;
        __syncthreads();
        for (int i = tid; i < 465; i += NT) rpb_s[i] = p.rpb[h * 465 + i];
        {
            int rs0 = r0 - 4; rs0 = rs0 < 0 ? 0 : (rs0 > 24 ? 24 : rs0);
#pragma unroll
            for (int q = 0; q < 8; ++q) {
                const int pc = tid + q * NT;
                const int krow = pc >> 9, col = (pc >> 3) & 63, ch = pc & 7, kr = rs0 + krow, sl = kr & 7;
                const u32x4 kv = *(const u32x4*)(Kg + ((size_t)kr * 64 + col) * 64 + ch * 8);
                *(LAS u32x4*)(Kl + (sl * 64 + col) * 128 + ((ch ^ (col & 7)) << 4)) = kv;
                const int d = (pc >> 3) & 63, vch = pc & 7;
                const u32x4 vv = *(const u32x4*)(Vg + (size_t)d * 2048 + kr * 64 + vch * 8);
                *(LAS u32x4*)(Vl + d * NA_VSTR + sl * 64 + vch * 8) = vv;
            }
        }
        __syncthreads();
        float bt[16][4];
        int bt_delta = 1000;
        bf16x8 qn[2];
#pragma unroll
        for (int ks = 0; ks < 2; ++ks) qn[ks] = *(const bf16x8*)(p.QNA() + (hb + r0 * 64 + c) * 64 + ks * 32 + 8 * g);
        for (int ri = 0; ri < 8; ++ri) {
            const int r = r0 + ri;
            int rs = r - 4; rs = rs < 0 ? 0 : (rs > 24 ? 24 : rs);
            int rsn = r + 1 - 4; rsn = rsn < 0 ? 0 : (rsn > 24 ? 24 : rsn);
            const bool add = (ri < 7) && (rsn != rs);
            u32x4 pk = {0u, 0u, 0u, 0u}, pv = {0u, 0u, 0u, 0u};
            const int ncol = tid >> 3, nch = tid & 7, nkr = rsn + 7;
            if (add) { pk = *(const u32x4*)(Kg + ((size_t)nkr * 64 + ncol) * 64 + nch * 8); pv = *(const u32x4*)(Vg + (size_t)ncol * 2048 + nkr * 64 + nch * 8); }
            bf16x8 qf[2]; qf[0] = qn[0]; qf[1] = qn[1];
            if (ri < 7) {
#pragma unroll
                for (int ks = 0; ks < 2; ++ks) qn[ks] = *(const bf16x8*)(p.QNA() + (hb + (r + 1) * 64 + c) * 64 + ks * 32 + 8 * g);
            }
            if (rs - r != bt_delta) {
                bt_delta = rs - r;
#pragma unroll
                for (int j = 0; j < 8; ++j)
#pragma unroll
                    for (int ct = 0; ct < 2; ++ct)
#pragma unroll
                        for (int rr = 0; rr < 4; ++rr) {
                            const int kc = cs0 + 8 * g + 4 * ct + rr;
                            const bool valid = (kc >= csq) && (kc < csq + 16);
                            int dc = kc - c + 15; dc = dc < 0 ? 0 : (dc > 30 ? 30 : dc);
                            bt[j * 2 + ct][rr] = valid ? rpb_s[(bt_delta + j + 7) * 31 + dc] : -1e30f;
                        }
            }
            float s[16][4];
#pragma unroll
            for (int j = 0; j < 8; ++j) {
                const int sl = (rs + j) & 7;
#pragma unroll
                for (int ct = 0; ct < 2; ++ct) {
                    const int col = cs0 + 8 * (qi >> 2) + 4 * ct + (qi & 3);
                    const LAS unsigned char* kp = Kl + (sl * 64 + col) * 128;
                    f32x4 a = {0.f, 0.f, 0.f, 0.f};
#pragma unroll
                    for (int ks = 0; ks < 2; ++ks) {
                        const bf16x8 kf = *(const LAS bf16x8*)(kp + (((4 * ks + g) ^ (col & 7)) << 4));
                        a = __builtin_amdgcn_mfma_f32_16x16x32_bf16(kf, qf[ks], a, 0, 0, 0);
                    }
#pragma unroll
                    for (int rr = 0; rr < 4; ++rr) s[j * 2 + ct][rr] = a[rr] + bt[j * 2 + ct][rr];
                }
            }
            float mx = -3e38f;
#pragma unroll
            for (int i = 0; i < 16; ++i)
#pragma unroll
                for (int rr = 0; rr < 4; ++rr) mx = fmaxf(mx, s[i][rr]);
            mx = fmaxf(mx, __shfl_xor(mx, 16)); mx = fmaxf(mx, __shfl_xor(mx, 32));
            float sum = 0.f;
#pragma unroll
            for (int i = 0; i < 16; ++i)
#pragma unroll
                for (int rr = 0; rr < 4; ++rr) { s[i][rr] = __expf(s[i][rr] - mx); sum += s[i][rr]; }
            sum += __shfl_xor(sum, 16); sum += __shfl_xor(sum, 32);
            const float inv = __builtin_amdgcn_rcpf(sum);
            f32x4 o[2];
            o[0] = (f32x4){0.f, 0.f, 0.f, 0.f}; o[1] = (f32x4){0.f, 0.f, 0.f, 0.f};
#pragma unroll
            for (int kk = 0; kk < 8; ++kk) {
                u32x4 pw; pw.x = pk2(s[2 * kk][0] * inv, s[2 * kk][1] * inv); pw.y = pk2(s[2 * kk][2] * inv, s[2 * kk][3] * inv);
                pw.z = pk2(s[2 * kk + 1][0] * inv, s[2 * kk + 1][1] * inv); pw.w = pk2(s[2 * kk + 1][2] * inv, s[2 * kk + 1][3] * inv);
                const bf16x8 pf = __builtin_bit_cast(bf16x8, pw);
                const int sl = (rs + kk) & 7;
#pragma unroll
                for (int dd = 0; dd < 2; ++dd) {
                    const bf16x8 vf = *(const LAS bf16x8*)(Vl + ((2 * dh + dd) * 16 + qi) * NA_VSTR + sl * 64 + cs0 + 8 * g);
                    o[dd] = __builtin_amdgcn_mfma_f32_16x16x32_bf16(vf, pf, o[dd], 0, 0, 0);
                }
            }
            {
                const size_t tg = (size_t)b * 2048 + r * 64 + c;
#pragma unroll
                for (int dd = 0; dd < 2; ++dd) { u32x2 ov; ov.x = pk2(o[dd][0], o[dd][1]); ov.y = pk2(o[dd][2], o[dd][3]);
                    *(u32x2*)(p.NAOUT() + tg * 512 + h * 64 + (2 * dh + dd) * 16 + 4 * g) = ov; }
            }
            __syncthreads();
            if (add) { const int sl = nkr & 7;
                *(LAS u32x4*)(Kl + (sl * 64 + ncol) * 128 + ((nch ^ (ncol & 7)) << 4)) = pk;
                *(LAS u32x4*)(Vl + ncol * NA_VSTR + sl * 64 + nch * 8) = pv; }
            __syncthreads();
        }
    }
}
#define LDSTR 72
#define MATB (64 * LDSTR * 2)
__device__ __forceinline__ f32x4 mfma16(bf16x8 a, bf16x8 b, f32x4 c) { return __builtin_amdgcn_mfma_f32_16x16x32_bf16(a, b, c, 0, 0, 0); }

__device__ __forceinline__ void slab_mma(const LAS bf16* A, const LAS bf16* Bt, int w, int lane, f32x4 (&acc)[4]) {
    const int r16 = lane & 15, g = lane >> 4;
    const bf16x8 a0 = *(const LAS bf16x8*)(A + (16 * w + r16) * LDSTR + 8 * g);
    const bf16x8 a1 = *(const LAS bf16x8*)(A + (16 * w + r16) * LDSTR + 32 + 8 * g);
#pragma unroll
    for (int nt = 0; nt < 4; ++nt) {
        const bf16x8 b0 = *(const LAS bf16x8*)(Bt + (nt * 16 + r16) * LDSTR + 8 * g);
        const bf16x8 b1 = *(const LAS bf16x8*)(Bt + (nt * 16 + r16) * LDSTR + 32 + 8 * g);
        acc[nt] = mfma16(a0, b0, acc[nt]); acc[nt] = mfma16(a1, b1, acc[nt]);
    }
}

struct DnBufs { char* ws; char* out;
    __device__ __forceinline__ bf16* MN() const { return (bf16*)out; }
    __device__ __forceinline__ bf16* QO() const { return WSP(bf16, 179); }
    __device__ __forceinline__ bf16* SB() const { return WSP(bf16, 97); } };

__device__ __forceinline__ void conv8(const float* conv_w, const bf16* src, size_t hb, int t, int c0, int wch, float (&y)[8]) {
#pragma unroll
    for (int d = 0; d < 8; ++d) y[d] = 0.f;
#pragma unroll
    for (int j = 0; j < 5; ++j) {
        const int tt = t + j - 2;
        if (tt >= 0 && tt < SEQ) {
            const bf16x8 x0 = *(const bf16x8*)(src + (hb + tt) * 64 + c0);
            const f32x4 w0 = *(const f32x4*)(conv_w + j * 1536 + wch + c0), w1 = *(const f32x4*)(conv_w + j * 1536 + wch + c0 + 4);
#pragma unroll
            for (int d = 0; d < 4; ++d) { y[d] = fmaf(bf2f((unsigned short)x0[d]), w0[d], y[d]); y[4 + d] = fmaf(bf2f((unsigned short)x0[4 + d]), w1[d], y[4 + d]); }
        }
    }
#pragma unroll
    for (int d = 0; d < 8; ++d) y[d] = siluf_(y[d]);
}
__device__ __forceinline__ u32x4 pack8(const float (&y)[8]) { u32x4 o; o.x = pk2(y[0], y[1]); o.y = pk2(y[2], y[3]); o.z = pk2(y[4], y[5]); o.w = pk2(y[6], y[7]); return o; }

#ifndef DN_STEP_DUP
#define DN_STEP_DUP 0
#endif
#define TEAM_BYTES 71680
#define XSTR2 40
__device__ __forceinline__ void phase_dnprep(const Params& p, const DnBufs& B, LAS unsigned char* lds) {
    const int tid = fresh_tid(), lane = tid & 63, wave = tid >> 6, team = wave >> 2, w = wave & 3, G = gridDim.x;
    const int r16 = lane & 15, g = lane >> 4;
    LAS unsigned char* base = lds + team * TEAM_BYTES;
    LAS bf16* Kr = (LAS bf16*)(base);
    LAS bf16* Qr = (LAS bf16*)(base + MATB);
    LAS bf16* KdT = (LAS bf16*)(base + 2 * MATB);
    LAS bf16* KbT = (LAS bf16*)(base + 3 * MATB);
    LAS bf16* VbT = (LAS bf16*)(base + 4 * MATB);
    LAS bf16* IN = (LAS bf16*)(base + 5 * MATB);
    LAS bf16* Lb = (LAS bf16*)(base + 6 * MATB);
    LAS bf16* TTa = Lb + 64 * LDSTR; LAS bf16* T22T = TTa + 32 * XSTR2; LAS bf16* XT = T22T + 16 * XSTR2;
    LAS bf16* Tm = Kr; LAS bf16* WT = Lb; LAS bf16* UT = KbT;
    LAS float* beta_s = (LAS float*)(lds + 143360 + team * 1024); LAS float* gc_s = beta_s + 64;
    for (int pi = blockIdx.x; pi < 2048; pi += G) {
        const int tc = pi & 31, bh = pi >> 5, h = bh & 7, dir = team, cc = dir ? 31 - tc : tc;
        const int it = (bh * 2 + dir) * 32 + cc;
        const size_t hb = (size_t)bh * 2048;
        __syncthreads();
        if (w == 0) {
            const int s = cc * 64 + lane, t = dir ? 2047 - s : s;
            const float be = p.GATES()[(size_t)dir * NTOK * 8 + hb + t];
            float gv = p.GATES()[(size_t)(2 + dir) * NTOK * 8 + hb + t];
#pragma unroll
            for (int o = 1; o < 64; o <<= 1) { const float n = __shfl_up(gv, o); if (lane >= o) gv += n; }
            beta_s[lane] = be; gc_s[lane] = gv;
        }
        __syncthreads();
        for (int rep1 = 0; rep1 < 1 + (DN_STEP_DUP & 1); ++rep1) {
            const int tau = tid >> 3, c0 = (tid & 7) * 8, t = tc * 64 + tau;
            float yk[8], yq[8], yv[8];
            conv8(p.conv_w, p.QKVDN() + (size_t)NTOK * 512, hb, t, c0, 512 + h * 64, yk);
            asm volatile("" ::: "memory");
            conv8(p.conv_w, p.QKVDN(), hb, t, c0, h * 64, yq);
            asm volatile("" ::: "memory");
            conv8(p.conv_w, p.QKVDN() + (size_t)2 * NTOK * 512, hb, t, c0, 1024 + h * 64, yv);
            asm volatile("" ::: "memory");
            float sk = 0.f, sq = 0.f;
#pragma unroll
            for (int d = 0; d < 8; ++d) { sk = fmaf(yk[d], yk[d], sk); sq = fmaf(yq[d], yq[d], sq); }
            sk += __shfl_xor(sk, 1); sq += __shfl_xor(sq, 1); sk += __shfl_xor(sk, 2); sq += __shfl_xor(sq, 2); sk += __shfl_xor(sk, 4); sq += __shfl_xor(sq, 4);
            const float rk = rsqrtf(sk + RMS_EPS), rq = rsqrtf(sq + RMS_EPS);
#pragma unroll
            for (int d = 0; d < 8; ++d) { yk[d] *= rk; yq[d] *= rq; }
            const u32x4 kp = pack8(yk), qp = pack8(yq);
#pragma unroll
            for (int dd = 0; dd < 2; ++dd) {
                LAS unsigned char* tb = lds + dd * TEAM_BYTES;
                const LAS float* bs = (const LAS float*)(lds + 143360 + dd * 1024); const LAS float* gs = bs + 64;
                const int i = dd ? 63 - tau : tau;
                const float be = bs[i], gci = gs[i], gl = gs[63];
                const float e_gc = __expf(gci), e_kd = __expf(gl - gci), bg = be * e_gc;
                *(LAS u32x4*)((LAS bf16*)tb + i * LDSTR + c0) = kp;
                *(LAS u32x4*)((LAS bf16*)(tb + MATB) + i * LDSTR + c0) = qp;
                LAS bf16* kd = (LAS bf16*)(tb + 2 * MATB); LAS bf16* kb = (LAS bf16*)(tb + 3 * MATB); LAS bf16* vb = (LAS bf16*)(tb + 4 * MATB);
#pragma unroll
                for (int d = 0; d < 8; ++d) { kd[(c0 + d) * LDSTR + i] = (bf16)f2bf(yk[d] * e_kd); kb[(c0 + d) * LDSTR + i] = (bf16)f2bf(yk[d] * bg); vb[(c0 + d) * LDSTR + i] = (bf16)f2bf(yv[d] * be); }
            }
        }
        __syncthreads();
        {
            f32x4 akk[4], aqk[4];
#pragma unroll
            for (int nt = 0; nt < 4; ++nt) { akk[nt] = (f32x4){0.f, 0.f, 0.f, 0.f}; aqk[nt] = (f32x4){0.f, 0.f, 0.f, 0.f}; }
            slab_mma(Kr, Kr, w, lane, akk);
            slab_mma(Qr, Kr, w, lane, aqk);
#pragma unroll
            for (int nt = 0; nt < 4; ++nt) {
                const int j = nt * 16 + r16; const float gcj = gc_s[j];
#pragma unroll
                for (int r = 0; r < 4; ++r) {
                    const int i = 16 * w + 4 * g + r;
                    const float dec = (j <= i) ? __expf(gc_s[i] - gcj) : 0.f;
                    Lb[i * LDSTR + j] = (bf16)f2bf((j < i) ? beta_s[i] * akk[nt][r] * dec : 0.f);
                    IN[i * LDSTR + j] = (bf16)f2bf(aqk[nt][r] * 0.125f * dec);
                }
            }
        }
        __syncthreads();
        for (int rep3 = 0; rep3 < 1 + ((DN_STEP_DUP >> 1) & 1); ++rep3) if (w == 0) {
            const u32x4 z4 = {0u, 0u, 0u, 0u};
#pragma unroll
            for (int q = 0; q < 9; ++q) { const int idx = lane + 64 * q; *(LAS u32x4*)(Tm + (idx / 9) * LDSTR + (idx % 9) * 8) = z4; }
            const int blk = lane >> 4, j = lane & 15;
            float x[16];
#pragma unroll
            for (int i = 0; i < 16; ++i) {
                float a = (i == j) ? 1.f : 0.f;
#pragma unroll
                for (int m = 0; m < i; ++m) a = fmaf(-bf2f(Lb[(16 * blk + i) * LDSTR + 16 * blk + m]), x[m], a);
                x[i] = a;
            }
#pragma unroll
            for (int i = 0; i < 16; ++i) Tm[(16 * blk + i) * LDSTR + 16 * blk + j] = (bf16)f2bf(x[i]);
            {
                u32x4 lo, hi; lo.x = pk2(x[0], x[1]); lo.y = pk2(x[2], x[3]); lo.z = pk2(x[4], x[5]); lo.w = pk2(x[6], x[7]);
                hi.x = pk2(x[8], x[9]); hi.y = pk2(x[10], x[11]); hi.z = pk2(x[12], x[13]); hi.w = pk2(x[14], x[15]);
                if (blk < 2) { LAS bf16* dst = TTa + (16 * blk + j) * XSTR2 + 16 * blk; *(LAS u32x4*)dst = lo; *(LAS u32x4*)(dst + 8) = hi;
                    if (blk == 1) { *(LAS u32x4*)(TTa + (16 + j) * XSTR2) = z4; *(LAS u32x4*)(TTa + (16 + j) * XSTR2 + 8) = z4; } }
                else if (blk == 2) { *(LAS u32x4*)(T22T + j * XSTR2) = lo; *(LAS u32x4*)(T22T + j * XSTR2 + 8) = hi; }
            }
            LDS_WAIT();
            const bf16x8 zf = {0, 0, 0, 0, 0, 0, 0, 0};
            const f32x4 z0 = {0.f, 0.f, 0.f, 0.f};
            const bool lo2 = g < 2;
            {
                const bf16x8 aA = lo2 ? *(const LAS bf16x8*)(Lb + (16 + r16) * LDSTR + 8 * g) : zf, bA = lo2 ? *(const LAS bf16x8*)(TTa + r16 * XSTR2 + 8 * g) : zf;
                const bf16x8 aB = lo2 ? *(const LAS bf16x8*)(Lb + (48 + r16) * LDSTR + 32 + 8 * g) : zf, bB = lo2 ? *(const LAS bf16x8*)(T22T + r16 * XSTR2 + 8 * g) : zf;
                const f32x4 xa = mfma16(aA, bA, z0), xb = mfma16(aB, bB, z0);
                u32x2 o; o.x = pk2(xa[0], xa[1]); o.y = pk2(xa[2], xa[3]); *(LAS u32x2*)(XT + r16 * XSTR2 + 4 * g) = o;
                o.x = pk2(xb[0], xb[1]); o.y = pk2(xb[2], xb[3]); *(LAS u32x2*)(XT + (16 + r16) * XSTR2 + 4 * g) = o;
            }
            LDS_WAIT();
            {
                const bf16x8 aA = lo2 ? *(const LAS bf16x8*)(Tm + (16 + r16) * LDSTR + 16 + 8 * g) : zf, bA = lo2 ? *(const LAS bf16x8*)(XT + r16 * XSTR2 + 8 * g) : zf;
                const bf16x8 aB = lo2 ? *(const LAS bf16x8*)(Tm + (48 + r16) * LDSTR + 48 + 8 * g) : zf, bB = lo2 ? *(const LAS bf16x8*)(XT + (16 + r16) * XSTR2 + 8 * g) : zf;
                const f32x4 ta = mfma16(aA, bA, z0), tb2 = mfma16(aB, bB, z0);
#pragma unroll
                for (int r = 0; r < 4; ++r) { Tm[(16 + 4 * g + r) * LDSTR + r16] = (bf16)f2bf(-ta[r]); Tm[(48 + 4 * g + r) * LDSTR + 32 + r16] = (bf16)f2bf(-tb2[r]); }
                u32x2 o; o.x = pk2(-ta[0], -ta[1]); o.y = pk2(-ta[2], -ta[3]); *(LAS u32x2*)(TTa + r16 * XSTR2 + 16 + 4 * g) = o;
            }
            LDS_WAIT();
            {
                f32x4 x2[2][2];
#pragma unroll
                for (int mt = 0; mt < 2; ++mt) {
                    const bf16x8 a = *(const LAS bf16x8*)(Lb + (32 + 16 * mt + r16) * LDSTR + 8 * g);
#pragma unroll
                    for (int nt = 0; nt < 2; ++nt) { const bf16x8 b2 = *(const LAS bf16x8*)(TTa + (16 * nt + r16) * XSTR2 + 8 * g); x2[mt][nt] = mfma16(a, b2, z0); }
                }
#pragma unroll
                for (int mt = 0; mt < 2; ++mt)
#pragma unroll
                    for (int nt = 0; nt < 2; ++nt) { u32x2 o; o.x = pk2(x2[mt][nt][0], x2[mt][nt][1]); o.y = pk2(x2[mt][nt][2], x2[mt][nt][3]); *(LAS u32x2*)(XT + (16 * nt + r16) * XSTR2 + 16 * mt + 4 * g) = o; }
            }
            LDS_WAIT();
            {
#pragma unroll
                for (int mt = 0; mt < 2; ++mt) {
                    const bf16x8 a = *(const LAS bf16x8*)(Tm + (32 + 16 * mt + r16) * LDSTR + 32 + 8 * g);
#pragma unroll
                    for (int nt = 0; nt < 2; ++nt) {
                        const bf16x8 b2 = *(const LAS bf16x8*)(XT + (16 * nt + r16) * XSTR2 + 8 * g);
                        const f32x4 tv = mfma16(a, b2, z0);
#pragma unroll
                        for (int r = 0; r < 4; ++r) Tm[(32 + 16 * mt + 4 * g + r) * LDSTR + 16 * nt + r16] = (bf16)f2bf(-tv[r]);
                    }
                }
            }
        }
        __syncthreads();
        {
            f32x4 a[4];
#pragma unroll
            for (int nt = 0; nt < 4; ++nt) a[nt] = (f32x4){0.f, 0.f, 0.f, 0.f};
            slab_mma(Tm, KbT, w, lane, a);
#pragma unroll
            for (int nt = 0; nt < 4; ++nt) { u32x2 o; o.x = pk2(a[nt][0], a[nt][1]); o.y = pk2(a[nt][2], a[nt][3]); *(LAS u32x2*)(WT + (nt * 16 + r16) * LDSTR + 16 * w + 4 * g) = o; }
        }
        __syncthreads();
        {
            f32x4 a[4];
#pragma unroll
            for (int nt = 0; nt < 4; ++nt) a[nt] = (f32x4){0.f, 0.f, 0.f, 0.f};
            slab_mma(Tm, VbT, w, lane, a);
#pragma unroll
            for (int nt = 0; nt < 4; ++nt) { u32x2 o; o.x = pk2(a[nt][0], a[nt][1]); o.y = pk2(a[nt][2], a[nt][3]); *(LAS u32x2*)(UT + (nt * 16 + r16) * LDSTR + 16 * w + 4 * g) = o; }
        }
        __syncthreads();
        for (int rep6 = 0; rep6 < 1 + ((DN_STEP_DUP >> 2) & 1); ++rep6) {
            const float egl = __expf(gc_s[63]);
            bf16* Mg = B.MN() + (size_t)it * 8192; bf16* NTg = Mg + 4096;
            bf16* Qg = B.QO() + ((size_t)((bh * 2 + dir) * 32 + tc)) * 8192; bf16* OTg = Qg + 4096;
            f32x4 a[4];
#pragma unroll
            for (int nt = 0; nt < 4; ++nt) a[nt] = (f32x4){0.f, 0.f, 0.f, 0.f};
            slab_mma(WT, KdT, w, lane, a);
#pragma unroll
            for (int nt = 0; nt < 4; ++nt) { const int ra = nt * 16 + r16, cb = 16 * w + 4 * g; u32x2 o;
                o.x = pk2((ra == cb ? egl : 0.f) - a[nt][0], (ra == cb + 1 ? egl : 0.f) - a[nt][1]); o.y = pk2((ra == cb + 2 ? egl : 0.f) - a[nt][2], (ra == cb + 3 ? egl : 0.f) - a[nt][3]);
                *(u32x2*)(Mg + ra * 64 + cb) = o; }
#pragma unroll
            for (int nt = 0; nt < 4; ++nt) a[nt] = (f32x4){0.f, 0.f, 0.f, 0.f};
            slab_mma(KdT, UT, w, lane, a);
#pragma unroll
            for (int nt = 0; nt < 4; ++nt) { u32x2 o; o.x = pk2(a[nt][0], a[nt][1]); o.y = pk2(a[nt][2], a[nt][3]); *(u32x2*)(NTg + (nt * 16 + r16) * 64 + 16 * w + 4 * g) = o; }
#pragma unroll
            for (int nt = 0; nt < 4; ++nt) a[nt] = (f32x4){0.f, 0.f, 0.f, 0.f};
            slab_mma(WT, IN, w, lane, a);
#pragma unroll
            for (int nt = 0; nt < 4; ++nt) { const int i = nt * 16 + r16, cb = 16 * w + 4 * g, ro = dir ? 63 - i : i;
                const float sc = 0.125f * __expf(gc_s[i]);
                const u32x2 qv = *(const LAS u32x2*)(Qr + i * LDSTR + cb);
                u32x2 o; o.x = pk2(bf2f(qv.x & 0xffffu) * sc - a[nt][0], bf2f(qv.x >> 16) * sc - a[nt][1]); o.y = pk2(bf2f(qv.y & 0xffffu) * sc - a[nt][2], bf2f(qv.y >> 16) * sc - a[nt][3]);
                *(u32x2*)(Qg + ro * 64 + cb) = o; }
#pragma unroll
            for (int nt = 0; nt < 4; ++nt) a[nt] = (f32x4){0.f, 0.f, 0.f, 0.f};
            slab_mma(UT, IN, w, lane, a);
#pragma unroll
            for (int nt = 0; nt < 4; ++nt) { const int i = nt * 16 + r16, ro = dir ? 63 - i : i; u32x2 o; o.x = pk2(a[nt][0], a[nt][1]); o.y = pk2(a[nt][2], a[nt][3]);
                *(u32x2*)(OTg + ro * 64 + 16 * w + 4 * g) = o; }
        }
    }
}

__device__ __forceinline__ void phase_dnscan(const Params& p, const DnBufs& B, LAS unsigned char* lds) {
    const int tid = fresh_tid(), lane = tid & 63, wave = tid >> 6;
    const int r16 = lane & 15, g = lane >> 4;
    if (wave < 4) {
    const int vp = wave;
    LAS bf16* St = (LAS bf16*)(lds + wave * (16 * LDSTR * 2));
    for (int chain = blockIdx.x; chain < 128; chain += gridDim.x) {
    f32x4 sacc[4];
#pragma unroll
    for (int mt = 0; mt < 4; ++mt) sacc[mt] = (f32x4){0.f, 0.f, 0.f, 0.f};
    bf16x8 mf[4][4][2]; u32x2 nf[4][4];
    const bf16* MN0 = B.MN() + (size_t)chain * 32 * 8192;
    bf16* SB0 = B.SB() + (size_t)chain * 32 * 4096;
#define SCAN_LOAD(slot, step) do { const bf16* Mg_ = MN0 + (size_t)(step) * 8192; const bf16* NTg_ = Mg_ + 4096; \
        _Pragma("unroll") for (int mt = 0; mt < 4; ++mt) { mf[slot][mt][0] = *(const bf16x8*)(Mg_ + (mt * 16 + r16) * 64 + 8 * g); mf[slot][mt][1] = *(const bf16x8*)(Mg_ + (mt * 16 + r16) * 64 + 32 + 8 * g); \
            nf[slot][mt] = *(const u32x2*)(NTg_ + (vp * 16 + r16) * 64 + mt * 16 + 4 * g); } } while (0)
#define SCAN_STEP(slot, step) do { bf16* Sg_ = SB0 + (size_t)(step) * 4096; \
        _Pragma("unroll") for (int mt = 0; mt < 4; ++mt) { u32x2 o; o.x = pk2(sacc[mt][0], sacc[mt][1]); o.y = pk2(sacc[mt][2], sacc[mt][3]); \
            *(u32x2*)(Sg_ + (vp * 16 + r16) * 64 + mt * 16 + 4 * g) = o; *(LAS u32x2*)(St + r16 * LDSTR + mt * 16 + 4 * g) = o; } \
        LDS_WAIT(); \
        const bf16x8 s0 = *(const LAS bf16x8*)(St + r16 * LDSTR + 8 * g), s1 = *(const LAS bf16x8*)(St + r16 * LDSTR + 32 + 8 * g); \
        _Pragma("unroll") for (int mt = 0; mt < 4; ++mt) { const u32x2 nv = nf[slot][mt]; \
            f32x4 a = {bf2f(nv.x & 0xffffu), bf2f(nv.x >> 16), bf2f(nv.y & 0xffffu), bf2f(nv.y >> 16)}; \
            a = mfma16(mf[slot][mt][0], s0, a); a = mfma16(mf[slot][mt][1], s1, a); sacc[mt] = a; } \
        LDS_WAIT(); } while (0)
#define SCAN_PIN() asm volatile("" ::: "memory")
    SCAN_LOAD(0, 0); SCAN_LOAD(1, 1); SCAN_LOAD(2, 2); SCAN_PIN();
#pragma unroll
    for (int c0 = 0; c0 < 32; c0 += 4) {
        SCAN_LOAD(3, c0 + 3); SCAN_PIN();
        SCAN_STEP(0, c0); SCAN_PIN();
        if (c0 + 4 < 32) { SCAN_LOAD(0, c0 + 4); SCAN_PIN(); }
        SCAN_STEP(1, c0 + 1); SCAN_PIN();
        if (c0 + 5 < 32) { SCAN_LOAD(1, c0 + 5); SCAN_PIN(); }
        SCAN_STEP(2, c0 + 2); SCAN_PIN();
        if (c0 + 6 < 32) { SCAN_LOAD(2, c0 + 6); SCAN_PIN(); }
        SCAN_STEP(3, c0 + 3); SCAN_PIN();
    }
#undef SCAN_PIN
#undef SCAN_LOAD
#undef SCAN_STEP
    }
    }
}

__device__ __forceinline__ void phase_dnout(const Params& p, const DnBufs& B) {
    const int tid = fresh_tid(), lane = tid & 63, wave = tid >> 6, G = gridDim.x;
    const int r16 = lane & 15, g = lane >> 4;
    for (int task = blockIdx.x * 8 + wave; task < 8192; task += G * 8) {
        const int w = task & 3, tc = (task >> 2) & 31, bh = task >> 7, h = bh & 7, b = bh >> 3;
        f32x4 acc[4];
#pragma unroll
        for (int vt = 0; vt < 4; ++vt) acc[vt] = (f32x4){0.f, 0.f, 0.f, 0.f};
#pragma unroll
        for (int dir = 0; dir < 2; ++dir) {
            const int cc = dir ? 31 - tc : tc;
            const bf16* Qg = B.QO() + ((size_t)((bh * 2 + dir) * 32 + tc)) * 8192; const bf16* O0g = Qg + 4096;
            const bf16* Sg = B.SB() + ((size_t)((bh * 2 + dir) * 32 + cc)) * 4096;
            const bf16x8 q0 = *(const bf16x8*)(Qg + (16 * w + r16) * 64 + 8 * g), q1 = *(const bf16x8*)(Qg + (16 * w + r16) * 64 + 32 + 8 * g);
#pragma unroll
            for (int vt = 0; vt < 4; ++vt) {
                const u32x2 ov = *(const u32x2*)(O0g + (16 * w + r16) * 64 + vt * 16 + 4 * g);
                acc[vt][0] += bf2f(ov.x & 0xffffu); acc[vt][1] += bf2f(ov.x >> 16); acc[vt][2] += bf2f(ov.y & 0xffffu); acc[vt][3] += bf2f(ov.y >> 16);
                const bf16x8 s0 = *(const bf16x8*)(Sg + (vt * 16 + r16) * 64 + 8 * g), s1 = *(const bf16x8*)(Sg + (vt * 16 + r16) * 64 + 32 + 8 * g);
                acc[vt] = mfma16(s0, q0, acc[vt]); acc[vt] = mfma16(s1, q1, acc[vt]);
            }
        }
        float ss = 0.f;
#pragma unroll
        for (int vt = 0; vt < 4; ++vt)
#pragma unroll
            for (int r = 0; r < 4; ++r) ss = fmaf(acc[vt][r], acc[vt][r], ss);
        ss += __shfl_xor(ss, 16); ss += __shfl_xor(ss, 32);
        const float rn = rsqrtf(ss * (1.f / 64.f) + RMS_EPS);
        const int t = tc * 64 + 16 * w + r16;
#pragma unroll
        for (int vt = 0; vt < 4; ++vt) {
            const int v = vt * 16 + 4 * g;
            const u32x2 zv = *(const u32x2*)(p.Z() + ((size_t)bh * 2048 + t) * 64 + v);
            const f32x4 nw = *(const f32x4*)(p.norm_w + v);
            u32x2 o; o.x = pk2(acc[vt][0] * rn * nw[0] * bf2f(zv.x & 0xffffu), acc[vt][1] * rn * nw[1] * bf2f(zv.x >> 16));
            o.y = pk2(acc[vt][2] * rn * nw[2] * bf2f(zv.y & 0xffffu), acc[vt][3] * rn * nw[3] * bf2f(zv.y >> 16));
            *(u32x2*)(p.DNOUT() + ((size_t)b * 2048 + t) * 512 + h * 64 + v) = o;
        }
    }
}
struct MixBufs { char* ws; char* out;
    __device__ __forceinline__ bf16* GB() const { return WSP(bf16, 179); }
    __device__ __forceinline__ bf16* MERGED() const { return WSP(bf16, 211); }
    __device__ __forceinline__ float* V() const { return (float*)out; } };
template <int MODE>
struct EpiMerge {
    static constexpr bool PERM = true, AFTER_DRAIN = false;
    bf16* GB; bf16* MG;
    __device__ __forceinline__ void operator()(const pg8::f32x4 (&acc)[2][2][4][2], const pg8::Unit& u, int wr, int wc, int fr, int fq) const {
#pragma unroll
        for (int ai = 0; ai < 2; ++ai)
#pragma unroll
            for (int m = 0; m < 4; ++m) {
                const size_t row = (size_t)u.pm * 256 + ai * 128 + wr * 64 + m * 16 + fr;
#pragma unroll
                for (int bj = 0; bj < 2; ++bj) {
                    const int col = u.pn * 256 + bj * 128 + wc * 32 + 8 * fq;
                    const pg8::f32x4 v0 = acc[ai][bj][m][0], v1 = acc[ai][bj][m][1];
                    float e[8] = {v0[0], v0[1], v0[2], v0[3], v1[0], v1[1], v1[2], v1[3]};
                    if (MODE == 0) {
#pragma unroll
                        for (int j = 0; j < 8; ++j) e[j] = sigmoidf_(e[j]);
                    } else {
                        const u32x4 gw = *(const u32x4*)(GB + row * 1024 + col);
                        const unsigned gws[4] = {gw.x, gw.y, gw.z, gw.w};
#pragma unroll
                        for (int j = 0; j < 4; ++j) { e[2 * j] *= bf2f(gws[j] & 0xffffu); e[2 * j + 1] *= bf2f(gws[j] >> 16); }
                        if (MODE == 2) {
                            const u32x4 mw = *(const u32x4*)(MG + row * 1024 + col);
                            const unsigned mws[4] = {mw.x, mw.y, mw.z, mw.w};
#pragma unroll
                            for (int j = 0; j < 4; ++j) { e[2 * j] += bf2f(mws[j] & 0xffffu); e[2 * j + 1] += bf2f(mws[j] >> 16); }
                        }
                    }
                    u32x4 w; w.x = pk2(e[0], e[1]); w.y = pk2(e[2], e[3]); w.z = pk2(e[4], e[5]); w.w = pk2(e[6], e[7]);
                    *(u32x4*)((MODE == 0 ? GB : MG) + row * 1024 + col) = w;
                }
            }
    }
};
struct EpiOutProj {
    static constexpr bool PERM = false, AFTER_DRAIN = false;
    const float* x; float* V;
    __device__ __forceinline__ void operator()(const pg8::f32x4 (&acc)[2][2][4][2], const pg8::Unit& u, int wr, int wc, int fr, int fq) const {
#pragma unroll
        for (int ai = 0; ai < 2; ++ai)
#pragma unroll
            for (int m = 0; m < 4; ++m) {
                const size_t row = (size_t)u.pm * 256 + ai * 128 + wr * 64 + m * 16 + fr;
#pragma unroll
                for (int bj = 0; bj < 2; ++bj)
#pragma unroll
                    for (int n = 0; n < 2; ++n) {
                        const int col = u.pn * 256 + bj * 128 + wc * 32 + 16 * n + 4 * fq;
                        const f32x4 xv = *(const f32x4*)(x + row * 1024 + col);
                        const pg8::f32x4 a = acc[ai][bj][m][n];
                        f32x4 o = {ALPHA * xv[0] + a[0], ALPHA * xv[1] + a[1], ALPHA * xv[2] + a[2], ALPHA * xv[3] + a[3]};
                        *(f32x4*)(V + row * 1024 + col) = o;
                    }
            }
    }
};
__device__ __forceinline__ void phase_merge(const Params& p, const MixBufs& B, LAS unsigned char* lds) {
    pg8::StaticOrder S; S.init(NTOK, 1024, gridDim.x, (int)blockIdx.x);
    { pg8::Gemm g{p.XB(), p.WG(), NTOK, 1024, 1024}; EpiMerge<0> E{B.GB(), B.MERGED()}; pg8::gemm_phase<EpiMerge<0>, pg8::StaticOrder, true, true>(lds, g, S, E); }
    { pg8::Gemm g{p.NAOUT(), p.WPNA(), NTOK, 1024, 512}; EpiMerge<1> E{B.GB(), B.MERGED()}; pg8::gemm_phase<EpiMerge<1>, pg8::StaticOrder, true, true>(lds, g, S, E); }
    { pg8::Gemm g{p.XB(), p.WG() + (size_t)1024 * 1024, NTOK, 1024, 1024}; EpiMerge<0> E{B.GB(), B.MERGED()}; pg8::gemm_phase<EpiMerge<0>, pg8::StaticOrder, true, true>(lds, g, S, E); }
    { pg8::Gemm g{p.DNOUT(), p.WPDN(), NTOK, 1024, 512}; EpiMerge<2> E{B.GB(), B.MERGED()}; pg8::gemm_phase<EpiMerge<2>, pg8::StaticOrder, true, true>(lds, g, S, E); }
}
__device__ __forceinline__ void phase_outproj(const Params& p, const MixBufs& B, LAS unsigned char* lds) {
    pg8::StaticOrder S; S.init(NTOK, 1024, gridDim.x, (int)blockIdx.x);
    pg8::Gemm g{B.MERGED(), p.WOUT(), NTOK, 1024, 1024}; EpiOutProj E{p.x, B.V()};
    pg8::gemm_phase<EpiOutProj, pg8::StaticOrder, true, true>(lds, g, S, E);
}
struct MoeBufs { char* ws; char* out; int kdown;
#define TBP(T, kb) ((T*)(ws + ((size_t)243 << 20) + ((size_t)(kb) << 10)))
    __device__ __forceinline__ const float* V() const { return (const float*)out; }
    __device__ __forceinline__ bf16* X1B() const { return WSP(bf16, 17); }
    __device__ __forceinline__ bf16* XS() const { return WSP(bf16, 97); }
    __device__ __forceinline__ bf16* HID() const { return WSP(bf16, 211); }
    __device__ __forceinline__ bf16* YPART() const { return WSP(bf16, 97); }
    __device__ __forceinline__ int* CNT() const { return TBP(int, 0); }
    __device__ __forceinline__ int* ROUTE() const { return TBP(int, 64); }
    __device__ __forceinline__ float* ROUTEP() const { return TBP(float, 384); }
    __device__ __forceinline__ int* ROWINFO() const { return TBP(int, 576); }
    __device__ __forceinline__ float* ROWPW() const { return TBP(float, 768); }
    __device__ __forceinline__ float* STATS() const { return TBP(float, 960); }
    __device__ __forceinline__ bf16* RWH() const { return TBP(bf16, 1152); }
    __device__ __forceinline__ bf16* RWL() const { return TBP(bf16, 1280); }
};
#define XSTR 1032
#define TAB_OFF 131072

__device__ __forceinline__ void phase0_router(const Params& p, const MoeBufs& B) {
    const size_t gt = (size_t)blockIdx.x * NT + fresh_tid(), GT = (size_t)gridDim.x * NT;
    for (size_t i = gt; i < 48 * 1024; i += GT) {
        const int n = (int)(i >> 10), k = (int)(i & 1023);
        const float w = n < 4 ? p.wrg[k * 4 + n] : (n < 36 ? p.wre[k * 32 + n - 4] : 0.f);
        const unsigned hi = f2bf(w); const float lo = w - bf2f(hi);
        B.RWH()[i] = (bf16)hi; B.RWL()[i] = (bf16)f2bf(lo);
    }
}

__device__ __forceinline__ float wave_sum64(float v) {
#pragma unroll
    for (int o = 1; o < 64; o <<= 1) v += __shfl_xor(v, o);
    return v;
}

__device__ __forceinline__ void phase_ln1(const Params& p, const MoeBufs& B, LAS unsigned char* lds) {
    const int tid = fresh_tid(), lane = tid & 63, wave = tid >> 6;
    const int r16 = lane & 15, g = lane >> 4;
    LAS bf16* XH = (LAS bf16*)lds;
    LAS bf16* XL = (LAS bf16*)(lds + 16 * XSTR * 2);
    LAS float* PART = (LAS float*)(lds + 2 * 16 * XSTR * 2);
    LAS float* LOG = PART + 8 * 16 * 48;
    LAS int* hist = (LAS int*)(LOG + 16 * 36);
    if (tid < 32) hist[tid] = 0;
    for (int i = blockIdx.x * NT + tid; i < 40960; i += gridDim.x * NT) B.ROWINFO()[i] = -1;
    bf16x8 rbh[4][3], rbl[4][3];
#pragma unroll
    for (int ks = 0; ks < 4; ++ks)
#pragma unroll
        for (int nt = 0; nt < 3; ++nt) { const int k0 = wave * 128 + ks * 32 + 8 * g;
            rbh[ks][nt] = *(const bf16x8*)(B.RWH() + (size_t)(nt * 16 + r16) * 1024 + k0); rbl[ks][nt] = *(const bf16x8*)(B.RWL() + (size_t)(nt * 16 + r16) * 1024 + k0); }
    for (int blk = blockIdx.x; blk < 256; blk += gridDim.x) {
        f32x4 vpre[2][4];
#pragma unroll
        for (int q = 0; q < 2; ++q)
#pragma unroll
            for (int j = 0; j < 4; ++j) vpre[q][j] = *(const f32x4*)(B.V() + ((size_t)blk * 64 + 2 * wave + q) * 1024 + 4 * lane + 256 * j);
        for (int itn = 0; itn < 4; ++itn) {
            __syncthreads();
#pragma unroll
            for (int q = 0; q < 2; ++q) {
                const int lt = 2 * wave + q; const size_t tg = (size_t)blk * 64 + itn * 16 + lt;
                f32x4 v[4]; float s = 0.f;
#pragma unroll
                for (int j = 0; j < 4; ++j) { v[j] = vpre[q][j]; s += (v[j][0] + v[j][1]) + (v[j][2] + v[j][3]); }
                if (itn < 3) {
#pragma unroll
                    for (int j = 0; j < 4; ++j) vpre[q][j] = *(const f32x4*)(B.V() + (tg + 16) * 1024 + 4 * lane + 256 * j);
                }
                const float mu = wave_sum64(s) * (1.f / 1024.f);
                float qq = 0.f;
#pragma unroll
                for (int j = 0; j < 4; ++j) { v[j] = v[j] - mu; qq += (v[j][0] * v[j][0] + v[j][1] * v[j][1]) + (v[j][2] * v[j][2] + v[j][3] * v[j][3]); }
                const float rstd = rsqrtf(wave_sum64(qq) * (1.f / 1024.f) + LN_EPS);
                if (lane == 0) { B.STATS()[tg * 2] = mu; B.STATS()[tg * 2 + 1] = rstd; }
#pragma unroll
                for (int j = 0; j < 4; ++j) {
                    const int c = 4 * lane + 256 * j;
                    const f32x4 gg = *(const f32x4*)(p.ln1_g + c), bb = *(const f32x4*)(p.ln1_b + c);
                    float y[4]; unsigned hi[4]; float lo[4];
#pragma unroll
                    for (int e = 0; e < 4; ++e) { y[e] = v[j][e] * rstd * gg[e] + bb[e]; hi[e] = f2bf(y[e]); lo[e] = y[e] - bf2f(hi[e]); }
                    u32x2 hw; hw.x = hi[0] | (hi[1] << 16); hw.y = hi[2] | (hi[3] << 16);
                    u32x2 lw; lw.x = pk2(lo[0], lo[1]); lw.y = pk2(lo[2], lo[3]);
                    *(u32x2*)(B.X1B() + tg * 1024 + c) = hw;
                    *(LAS u32x2*)(XH + lt * XSTR + c) = hw; *(LAS u32x2*)(XL + lt * XSTR + c) = lw;
                }
            }
            __syncthreads();
            {
                f32x4 acc[3];
#pragma unroll
                for (int nt = 0; nt < 3; ++nt) acc[nt] = (f32x4){0.f, 0.f, 0.f, 0.f};
#pragma unroll
                for (int ks = 0; ks < 4; ++ks) {
                    const int k0 = wave * 128 + ks * 32 + 8 * g;
                    const bf16x8 ah = *(const LAS bf16x8*)(XH + r16 * XSTR + k0), al = *(const LAS bf16x8*)(XL + r16 * XSTR + k0);
#pragma unroll
                    for (int nt = 0; nt < 3; ++nt) {
                        acc[nt] = mfma16(ah, rbh[ks][nt], acc[nt]); acc[nt] = mfma16(ah, rbl[ks][nt], acc[nt]); acc[nt] = mfma16(al, rbh[ks][nt], acc[nt]);
                    }
                }
#pragma unroll
                for (int nt = 0; nt < 3; ++nt)
#pragma unroll
                    for (int r = 0; r < 4; ++r) PART[(wave * 16 + 4 * g + r) * 48 + nt * 16 + r16] = acc[nt][r];
            }
            __syncthreads();
            for (int idx = tid; idx < 16 * 36; idx += NT) {
                const int tk = idx / 36, n = idx % 36;
                float a = n < 4 ? p.brg[n] : p.bre[n - 4];
#pragma unroll
                for (int w2 = 0; w2 < 8; ++w2) a += PART[(w2 * 16 + tk) * 48 + n];
                LOG[tk * 36 + n] = a;
            }
            __syncthreads();
            if (tid < 16) {
                const LAS float* lg = LOG + tid * 36; const size_t tg = (size_t)blk * 64 + itn * 16 + tid;
                int gi = 0; float gm = lg[0];
                for (int q = 1; q < 4; ++q) if (lg[q] > gm) { gm = lg[q]; gi = q; }
                float gs = 0.f;
                for (int q = 0; q < 4; ++q) gs += expf(lg[q] - gm);
                const float gp = 1.f / gs;
                const LAS float* el = lg + 4 + gi * 8;
                int i1 = 0; float l1 = el[0];
                for (int e = 1; e < 8; ++e) if (el[e] > l1) { l1 = el[e]; i1 = e; }
                int i2 = -1; float l2 = -3.0e38f;
                for (int e = 0; e < 8; ++e) if (e != i1 && el[e] > l2) { l2 = el[e]; i2 = e; }
                const float e2 = expf(l2 - l1);
                const int e0 = gi * 8 + i1, e1 = gi * 8 + i2;
                const int r0 = atomicAdd((int*)&hist[e0], 1), r1 = atomicAdd((int*)&hist[e1], 1);
                B.ROUTE()[tg * 4] = e0; B.ROUTE()[tg * 4 + 1] = e1; B.ROUTE()[tg * 4 + 2] = r0; B.ROUTE()[tg * 4 + 3] = r1;
                B.ROUTEP()[tg * 2] = gp / (1.f + e2); B.ROUTEP()[tg * 2 + 1] = gp * e2 / (1.f + e2);
            }
        }
        __syncthreads();
        if (tid < 32) { B.CNT()[blk * 32 + tid] = hist[tid]; hist[tid] = 0; }
    }
}

__device__ __forceinline__ void moe_tables(const MoeBufs& B, LAS unsigned char* lds, int nj, int blk) {
    const int tid = fresh_tid();
    LAS int* tab = (LAS int*)(lds + TAB_OFF);
    LAS int* scr = tab + 160;
    {
        const int e = tid & 31, q = tid >> 5; int tot = 0, pre = 0;
        for (int b2 = q * 16; b2 < q * 16 + 16; ++b2) { const int c = B.CNT()[b2 * 32 + e]; tot += c; if (b2 < blk) pre += c; }
        scr[q * 64 + e] = tot; scr[q * 64 + 32 + e] = pre;
    }
    __syncthreads();
    if (tid < 32) { int tot = 0, pre = 0; for (int q = 0; q < 16; ++q) { tot += scr[q * 64 + tid]; pre += scr[q * 64 + 32 + tid]; } tab[66 + tid] = tot; tab[99 + tid] = pre; }
    __syncthreads();
    if (tid == 0) { int cum = 0, off = 0; for (int e = 0; e < 32; ++e) { tab[e] = cum; tab[33 + e] = off; const int nrt = (tab[66 + e] + 255) >> 8; cum += nrt * nj; off += nrt; } tab[32] = cum; }
    __syncthreads();
}

__device__ __forceinline__ void phase_gather(const Params& p, const MoeBufs& B, LAS unsigned char* lds) {
    const int tid = fresh_tid(), lane = tid & 63, wave = tid >> 6;
    LAS int* tab = (LAS int*)(lds + TAB_OFF);
    for (int blk = blockIdx.x; blk < 256; blk += gridDim.x) {
    moe_tables(B, lds, 2, blk);
    for (int sl = wave; sl < 128; sl += 8) {
        const int lt = sl >> 1, k = sl & 1; const size_t tg = (size_t)blk * 64 + lt;
        const int e = B.ROUTE()[tg * 4 + k], lr = B.ROUTE()[tg * 4 + 2 + k];
        const size_t row = (size_t)tab[33 + e] * 256 + tab[99 + e] + lr;
        const u32x4 a = *(const u32x4*)(B.X1B() + tg * 1024 + lane * 8), b2 = *(const u32x4*)(B.X1B() + tg * 1024 + 512 + lane * 8);
        *(u32x4*)(B.XS() + row * 1024 + lane * 8) = a; *(u32x4*)(B.XS() + row * 1024 + 512 + lane * 8) = b2;
        if (lane == 0) { B.ROWINFO()[row] = (int)tg * 2 + k; B.ROWPW()[row] = B.ROUTEP()[tg * 2 + k]; }
    }
    __syncthreads();
    }
}

struct MoeSched {
    const LAS int* tab; int G, c, nj;
    __device__ __forceinline__ bool next(int i, pg8::Unit& u) const {
        const int L = i * G + c; if (L >= tab[32]) return false;
        int e = 0;
#pragma unroll
        for (int k = 1; k < 32; ++k) e += (L >= tab[k]) ? 1 : 0;
        const int rem = L - tab[e], j = rem % nj, rt = rem / nj;
        u.pm = tab[33 + e] + rt; u.pn = e * nj + j; return true;
    }
    __device__ __forceinline__ void a_ready(const pg8::Unit&) const {}
    __device__ __forceinline__ void done(const pg8::Unit&) const {}
};
struct EpiGateUp {
    static constexpr bool PERM = true, AFTER_DRAIN = false;
    bf16* HID; const float* ROWPW;
    __device__ __forceinline__ void operator()(const pg8::f32x4 (&acc)[2][2][4][2], const pg8::Unit& u, int wr, int wc, int fr, int fq) const {
#pragma unroll
        for (int ai = 0; ai < 2; ++ai)
#pragma unroll
            for (int m = 0; m < 4; ++m) {
                const size_t row = (size_t)u.pm * 256 + ai * 128 + wr * 64 + m * 16 + fr;
                const float pw = ROWPW[row];
                const int f = (u.pn & 1) * 128 + wc * 32 + 8 * fq;
                const pg8::f32x4 g0 = acc[ai][0][m][0], g1 = acc[ai][0][m][1], u0 = acc[ai][1][m][0], u1 = acc[ai][1][m][1];
                float e[8];
#pragma unroll
                for (int j = 0; j < 4; ++j) { e[j] = siluf_(g0[j]) * u0[j] * pw; e[4 + j] = siluf_(g1[j]) * u1[j] * pw; }
                u32x4 w; w.x = pk2(e[0], e[1]); w.y = pk2(e[2], e[3]); w.z = pk2(e[4], e[5]); w.w = pk2(e[6], e[7]);
                *(u32x4*)(HID + row * 256 + f) = w;
            }
    }
};
struct EpiDown {
    static constexpr bool PERM = true, AFTER_DRAIN = false;
    bf16* YPART; const int* ROWINFO;
    __device__ __forceinline__ void operator()(const pg8::f32x4 (&acc)[2][2][4][2], const pg8::Unit& u, int wr, int wc, int fr, int fq) const {
        const int j = u.pn & 3;
#pragma unroll
        for (int ai = 0; ai < 2; ++ai)
#pragma unroll
            for (int m = 0; m < 4; ++m) {
                const int row = u.pm * 256 + ai * 128 + wr * 64 + m * 16 + fr;
                asm volatile("" ::: "memory");
                const int info = ROWINFO[row];
                if (info >= 0) {
                    const size_t tg = (size_t)(info >> 1); const int k = info & 1;
#pragma unroll
                    for (int bj = 0; bj < 2; ++bj) {
                        const int col = j * 256 + bj * 128 + wc * 32 + 8 * fq;
                        const pg8::f32x4 v0 = acc[ai][bj][m][0], v1 = acc[ai][bj][m][1];
                        u32x4 w; w.x = pk2(v0[0], v0[1]); w.y = pk2(v0[2], v0[3]); w.z = pk2(v1[0], v1[1]); w.w = pk2(v1[2], v1[3]);
                        *(u32x4*)(YPART + ((size_t)k * NTOK + tg) * 1024 + col) = w;
                    }
                }
            }
    }
};
__device__ __forceinline__ void phase_moe1(const Params& p, const MoeBufs& B, LAS unsigned char* lds) {
    moe_tables(B, lds, 2, 0);
    MoeSched S{(const LAS int*)(lds + TAB_OFF), (int)gridDim.x, (int)blockIdx.x, 2};
    pg8::Gemm g{B.XS(), p.WGU(), 0, 0, 1024}; EpiGateUp E{B.HID(), B.ROWPW()};
    pg8::gemm_phase<EpiGateUp, MoeSched, true, true>(lds, g, S, E);
}
__device__ __forceinline__ void phase_moe2(const Params& p, const MoeBufs& B, LAS unsigned char* lds) {
    moe_tables(B, lds, 4, 0);
    MoeSched S{(const LAS int*)(lds + TAB_OFF), (int)gridDim.x, (int)blockIdx.x, 4};
    pg8::Gemm g{B.HID(), p.WD(), 0, 0, B.kdown}; EpiDown E{B.YPART(), B.ROWINFO()};
    pg8::gemm_phase<EpiDown, MoeSched, true, true>(lds, g, S, E);
}
__device__ __forceinline__ void phase_ln2(const Params& p, const MoeBufs& B) {
    const int tid = fresh_tid(), lane = tid & 63, wave = tid >> 6;
    for (size_t tg = (size_t)blockIdx.x * 8 + wave; tg < NTOK; tg += (size_t)gridDim.x * 8) {
        const float mu1 = B.STATS()[tg * 2], rstd1 = B.STATS()[tg * 2 + 1];
        f32x4 v[4]; float s = 0.f;
#pragma unroll
        for (int j = 0; j < 4; ++j) {
            const int c = 4 * lane + 256 * j;
            const f32x4 x = *(const f32x4*)(B.V() + tg * 1024 + c);
            const f32x4 gg = *(const f32x4*)(p.ln1_g + c), bb = *(const f32x4*)(p.ln1_b + c);
            const u32x2 y0 = *(const u32x2*)(B.YPART() + tg * 1024 + c), y1 = *(const u32x2*)(B.YPART() + ((size_t)NTOK + tg) * 1024 + c);
            const float ya[4] = {bf2f(y0.x & 0xffffu) + bf2f(y1.x & 0xffffu), bf2f(y0.x >> 16) + bf2f(y1.x >> 16), bf2f(y0.y & 0xffffu) + bf2f(y1.y & 0xffffu), bf2f(y0.y >> 16) + bf2f(y1.y >> 16)};
#pragma unroll
            for (int e = 0; e < 4; ++e) { v[j][e] = ALPHA * ((x[e] - mu1) * rstd1 * gg[e] + bb[e]) + ya[e]; s += v[j][e]; }
        }
        const float mu = wave_sum64(s) * (1.f / 1024.f);
        float qq = 0.f;
#pragma unroll
        for (int j = 0; j < 4; ++j) { v[j] = v[j] - mu; qq += (v[j][0] * v[j][0] + v[j][1] * v[j][1]) + (v[j][2] * v[j][2] + v[j][3] * v[j][3]); }
        const float rstd = rsqrtf(wave_sum64(qq) * (1.f / 1024.f) + LN_EPS);
#pragma unroll
        for (int j = 0; j < 4; ++j) {
            const int c = 4 * lane + 256 * j;
            const f32x4 gg = *(const f32x4*)(p.ln2_g + c), bb = *(const f32x4*)(p.ln2_b + c);
            f32x4 o;
#pragma unroll
            for (int e = 0; e < 4; ++e) o[e] = v[j][e] * rstd * gg[e] + bb[e];
            *(f32x4*)(p.out + tg * 1024 + c) = o;
        }
    }
}
#ifndef PH_DUP
#define PH_DUP 0
#endif
#ifndef PH_MASK
#define PH_MASK 8191
#endif
#define BAR_LDS_OFF (LDS_BYTES - 64)
struct MegaArgs { Params p; };
#define CAS __attribute__((address_space(4)))
#define GASC __attribute__((address_space(1)))
__device__ __forceinline__ Params load_params(const CAS char* kp) {
    Params p; const CAS unsigned long long* src = (const CAS unsigned long long*)kp;
    const float** pf = (const float**)&p;
#pragma unroll
    for (int i = 0; i < 22; ++i) pf[i] = (const float*)(const GASC float*)src[i];
    static_assert(offsetof(Params, out) == 22 * 8 && offsetof(Params, ws) == 23 * 8 && offsetof(Params, bar) == 24 * 8 && offsetof(Params, kdown) == 25 * 8, "Params layout");
    p.out = (float*)(GASC float*)src[22]; p.ws = (char*)(GASC char*)src[23]; p.bar = (unsigned*)(GASC unsigned*)src[24];
    p.kdown = (int)(src[25] & 0xffffffffu); p.pad0 = 0;
    return p;
}
#define FRESH_P(name) const CAS char* name##_kp = kptr; asm volatile("" : "+s"(name##_kp)); const Params name = load_params(name##_kp)
#define GRID_BAR() do { const CAS char* b_kp = kptr; asm volatile("" : "+s"(b_kp)); XcdBarrier bar; bar.bar = (unsigned*)(GASC unsigned*)(*(const CAS unsigned long long*)(b_kp + offsetof(Params, bar))); bar.x = xb_xcc_id(); \
        bar.st = (volatile LAS unsigned*)(lds + BAR_LDS_OFF); xcd_barrier(bar); } while (0)
__global__ void __launch_bounds__(NT, 2) mega_fwd(MegaArgs) {
    extern __shared__ __attribute__((aligned(16))) unsigned char lds_raw[];
    LAS unsigned char* lds = (LAS unsigned char*)lds_raw;
    const CAS char* kptr = (const CAS char*)__builtin_amdgcn_kernarg_segment_ptr();
    if (threadIdx.x < 16) ((LAS unsigned*)(lds + BAR_LDS_OFF))[threadIdx.x] = 0u;
    __syncthreads();
    { FRESH_P(p); (void)xcd_barrier_post(p.bar, (volatile LAS unsigned*)(lds + BAR_LDS_OFF)); }
#if PH_MASK & 1
    { FRESH_P(p); const MoeBufs Q{p.ws, (char*)p.out, p.kdown}; phase0(p, lds); phase0_router(p, Q); }
#endif
#if PH_DUP & 1
    GRID_BAR();
    { FRESH_P(p); const MoeBufs Q{p.ws, (char*)p.out, p.kdown}; phase0(p, lds); phase0_router(p, Q); }
#endif
    GRID_BAR();
#if PH_MASK & 2
    { FRESH_P(p); phase1(p, lds); }
#endif
#if PH_DUP & 2
    GRID_BAR();
    { FRESH_P(p); phase1(p, lds); }
#endif
    GRID_BAR();
#if PH_MASK & 4
    { FRESH_P(p); phase_na(p, lds); }
#endif
#if PH_DUP & 4
    GRID_BAR();
    { FRESH_P(p); phase_na(p, lds); }
    GRID_BAR();
#endif
#if PH_MASK & 8
    { FRESH_P(p); const DnBufs D{p.ws, (char*)p.out}; phase_dnprep(p, D, lds); }
#endif
#if PH_DUP & 8
    GRID_BAR();
    { FRESH_P(p); const DnBufs D{p.ws, (char*)p.out}; phase_dnprep(p, D, lds); }
    GRID_BAR();
#endif
    GRID_BAR();
#if PH_MASK & 16
    {
        FRESH_P(p); const DnBufs D{p.ws, (char*)p.out};
        const int nb = (int)gridDim.x;
        unsigned* counter = p.bar + XCD_BAR_WORDS;
        if ((int)blockIdx.x >= 128) phase_zgemm(p, lds, nb - 128, (int)blockIdx.x - 128);
        else if ((fresh_tid() >> 6) >= 4) phase0_moe(p, counter);
        if ((int)blockIdx.x < 128) phase_dnscan(p, D, lds);
        if ((int)blockIdx.x >= 128 || (fresh_tid() >> 6) < 4) phase0_moe(p, counter);
    }
#endif
#if PH_DUP & 16
    GRID_BAR();
    {
        FRESH_P(p); const DnBufs D{p.ws, (char*)p.out};
        const int nb = (int)gridDim.x;
        unsigned* counter = p.bar + XCD_BAR_WORDS;
#if !(PH_DUP & 8192)
        if ((int)blockIdx.x >= 128) phase_zgemm(p, lds, nb - 128, (int)blockIdx.x - 128);
#endif
        if ((int)blockIdx.x >= 128) {} else if ((fresh_tid() >> 6) >= 4) phase0_moe(p, counter);
#if !(PH_DUP & 16384)
        if ((int)blockIdx.x < 128) phase_dnscan(p, D, lds);
#endif
        if ((int)blockIdx.x >= 128 || (fresh_tid() >> 6) < 4) phase0_moe(p, counter);
    }
#endif
    GRID_BAR();
#if PH_MASK & 32
    { FRESH_P(p); const DnBufs D{p.ws, (char*)p.out}; phase_dnout(p, D); }
#endif
#if PH_DUP & 32
    GRID_BAR();
    { FRESH_P(p); const DnBufs D{p.ws, (char*)p.out}; phase_dnout(p, D); }
#endif
    GRID_BAR();
#if PH_MASK & 64
    { FRESH_P(p); const MixBufs X{p.ws, (char*)p.out}; phase_merge(p, X, lds); }
#endif
#if PH_DUP & 64
    GRID_BAR();
    { FRESH_P(p); const MixBufs X{p.ws, (char*)p.out}; phase_merge(p, X, lds); }
#endif
    GRID_BAR();
#if PH_MASK & 128
    { FRESH_P(p); const MixBufs X{p.ws, (char*)p.out}; phase_outproj(p, X, lds); }
#endif
#if PH_DUP & 128
    GRID_BAR();
    { FRESH_P(p); const MixBufs X{p.ws, (char*)p.out}; phase_outproj(p, X, lds); }
#endif
    GRID_BAR();
#if PH_MASK & 256
    { FRESH_P(p); const MoeBufs Q{p.ws, (char*)p.out, p.kdown}; phase_ln1(p, Q, lds); }
#endif
#if PH_DUP & 256
    GRID_BAR();
    { FRESH_P(p); const MoeBufs Q{p.ws, (char*)p.out, p.kdown}; phase_ln1(p, Q, lds); }
#endif
    GRID_BAR();
#if PH_MASK & 512
    { FRESH_P(p); const MoeBufs Q{p.ws, (char*)p.out, p.kdown}; phase_gather(p, Q, lds); }
#endif
#if PH_DUP & 512
    GRID_BAR();
    { FRESH_P(p); const MoeBufs Q{p.ws, (char*)p.out, p.kdown}; phase_gather(p, Q, lds); }
#endif
    GRID_BAR();
#if PH_MASK & 1024
    { FRESH_P(p); const MoeBufs Q{p.ws, (char*)p.out, p.kdown}; phase_moe1(p, Q, lds); }
#endif
#if PH_DUP & 1024
    GRID_BAR();
    { FRESH_P(p); const MoeBufs Q{p.ws, (char*)p.out, p.kdown}; phase_moe1(p, Q, lds); }
#endif
    GRID_BAR();
#if PH_MASK & 2048
    { FRESH_P(p); const MoeBufs Q{p.ws, (char*)p.out, p.kdown}; phase_moe2(p, Q, lds); }
#endif
#if PH_DUP & 2048
    GRID_BAR();
    { FRESH_P(p); const MoeBufs Q{p.ws, (char*)p.out, p.kdown}; phase_moe2(p, Q, lds); }
#endif
    GRID_BAR();
#if PH_MASK & 4096
    { FRESH_P(p); const MoeBufs Q{p.ws, (char*)p.out, p.kdown}; phase_ln2(p, Q); }
#endif
}

#define MB(x) ((size_t)(x) << 20)
extern "C" void kernel_launch(void* const* d_in, const int* in_sizes, int n_in, void* d_out, int out_size, void* d_ws, size_t ws_size, hipStream_t stream) {
    MegaArgs a{};
    Params& p = a.p;
    p.x = (const float*)d_in[0]; p.w_in = (const float*)d_in[1]; p.rpb = (const float*)d_in[2]; p.conv_w = (const float*)d_in[3];
    p.a_log_f = (const float*)d_in[4]; p.a_log_b = (const float*)d_in[5]; p.dtb_f = (const float*)d_in[6]; p.dtb_b = (const float*)d_in[7];
    p.norm_w = (const float*)d_in[8]; p.w_proj_na = (const float*)d_in[9]; p.w_proj_dn = (const float*)d_in[10]; p.w_out = (const float*)d_in[11];
    p.ln1_g = (const float*)d_in[12]; p.ln1_b = (const float*)d_in[13]; p.wrg = (const float*)d_in[14]; p.brg = (const float*)d_in[15];
    p.wre = (const float*)d_in[16]; p.bre = (const float*)d_in[17]; p.wgu = (const float*)d_in[18]; p.wd = (const float*)d_in[19];
    p.ln2_g = (const float*)d_in[20]; p.ln2_b = (const float*)d_in[21];
    p.out = (float*)d_out;
    p.ws = (char*)d_ws; p.bar = (unsigned*)d_ws; p.kdown = 256;

    static int grid = 0;
    if (grid == 0) {
        int dev = 0, cus = 0, per_cu = 0;
        hipGetDevice(&dev);
        hipDeviceGetAttribute(&cus, hipDeviceAttributeMultiprocessorCount, dev);
        hipFuncSetAttribute((const void*)mega_fwd, hipFuncAttributeMaxDynamicSharedMemorySize, LDS_BYTES);
        hipOccupancyMaxActiveBlocksPerMultiprocessor(&per_cu, (const void*)mega_fwd, NT, LDS_BYTES);
        if (per_cu < 1) { fprintf(stderr, "kernel_launch: occupancy query reports %d workgroups per CU\n", per_cu); per_cu = 1; }
        if (per_cu > 1) per_cu = 1;
        grid = cus * per_cu;
        if (grid > 256) grid = 256;
        (void)hipGetLastError();
    }
    hipMemsetAsync(p.bar, 0, (XCD_BAR_WORDS + 64) * sizeof(unsigned), stream);
    hipLaunchKernelGGL(mega_fwd, dim3(grid), dim3(NT), LDS_BYTES, stream, a);
}
```

```cpp
#include <hip/hip_runtime.h>
#include <math.h>
#include <stdint.h>
#include <stddef.h>
#include <stdio.h>
namespace pg8 {
#define PG8_LAS __attribute__((address_space(3)))
typedef unsigned short bf16_t;
typedef short bf16x8 __attribute__((ext_vector_type(8)));
typedef float f32x4 __attribute__((ext_vector_type(4)));
typedef unsigned u32x4 __attribute__((ext_vector_type(4)));
constexpr int BM = 256, BK = 64, HALF = 128, HTB = HALF * BK * 2  , STAGE_BYTES = 8 * HTB, NXCD = 8, WGM = 8;

__host__ __device__ __forceinline__ int lds_byte(int r, int c) { const int st = (r >> 4) * 2 + (c >> 5), rr = r & 15, cc = c & 31, ob = rr * 64 + cc * 2; return st * 1024 + (ob ^ (((ob >> 9) & 1) << 5)); }
__host__ __device__ __forceinline__ void stage_rc(int b, int& R, int& C) { const int st = b / 1024, sb = b % 1024, swz = sb ^ (((sb >> 9) & 1) << 5); R = (st >> 1) * 16 + swz / 64; C = (st & 1) * 32 + (swz % 64) / 2; }
__host__ __device__ __forceinline__ int perm32(int rho) { const int n = rho >> 4, i = rho & 15; return 8 * (i >> 2) + 4 * n + (i & 3); }

struct Unit { int pm, pn; };
struct Gemm { const bf16_t* A; const bf16_t* Bt; int M, N, K; };

struct StaticOrder {
    int nM, nN, nwg, G, c;
    __host__ __device__ __forceinline__ void init(int M, int N, int G_, int c_) { nM = M / BM; nN = N / BM; nwg = nM * nN; G = G_; c = c_; }
    __host__ __device__ __forceinline__ bool next(int i, Unit& u) const {
        const long L = (long)i * G + c; if (L >= nwg) return false;
        int wgid = (int)L; { const int q = nwg / NXCD, r = nwg % NXCD, xcd = wgid % NXCD, off = wgid / NXCD; wgid = (xcd < r ? xcd * (q + 1) : r * (q + 1) + (xcd - r) * q) + off; }
        const int nig = WGM * nN, gid = wgid / nig, fm = gid * WGM, gsz = (nM - fm) < WGM ? (nM - fm) : WGM;
        u.pm = fm + ((wgid % nig) % gsz); u.pn = (wgid % nig) / gsz; return true;
    }
    __device__ __forceinline__ void a_ready(const Unit&) const {}
    __device__ __forceinline__ void done(const Unit&) const {}
};
__device__ __forceinline__ unsigned cvt_pk_bf16(float lo, float hi) { unsigned r; asm volatile("v_cvt_pk_bf16_f32 %0, %1, %2" : "=v"(r) : "v"(lo), "v"(hi)); return r; }

template <class Epi, class Sched, bool ALIGN_EPI = false, bool SP2 = false>
__device__ __forceinline__ void gemm_phase(PG8_LAS unsigned char* lds, const Gemm g, const Sched& S, const Epi& E) {
    int tid_ = threadIdx.x; asm volatile("" : "+v"(tid_));
    const int tid = tid_, wid = __builtin_amdgcn_readfirstlane(tid >> 6), lane = tid & 63, wr = wid >> 2, wc = wid & 3, fr = lane & 15, fq = lane >> 4;
    const int K = g.K, nt = K / BK;
    unsigned voffA[2], voffB[2];
#pragma unroll
    for (int i = 0; i < 2; ++i) { int R, C; stage_rc(tid * 16 + i * 8192, R, C); const int Rb = Epi::PERM ? ((R & ~31) + perm32(R & 31)) : R;
        voffA[i] = (unsigned)(R * K + C) * 2u; voffB[i] = (unsigned)(Rb * K + C) * 2u; }
    const size_t kstep = (size_t)(BK * 2);
    const size_t hstep = (size_t)HALF * K * 2;
    const size_t tstep = 2 * hstep;
    const unsigned ldsw = (unsigned)wid * 1024u;
    const int aoff = lds_byte(wr * 64 + fr, fq * 8), boff = lds_byte(wc * 32 + fr, fq * 8);
#define PG8_SA(b, h) (((b) * 2 + (h)) * HTB)
#define PG8_SB(b, h) ((4 + (b) * 2 + (h)) * HTB)
#define PG8_STAGE(bufoff, gbase, voff) do { _Pragma("unroll") for (int _i = 0; _i < 2; ++_i) \
        __builtin_amdgcn_global_load_lds((const unsigned*)((const char*)(gbase) + (voff)[_i]), (PG8_LAS unsigned*)(lds + (bufoff) + ldsw + _i * 8192), 16, 0, 0); } while (0)
#define PG8_LDA(dst, b, h) do { _Pragma("unroll") for (int m = 0; m < 4; ++m) _Pragma("unroll") for (int k = 0; k < 2; ++k) dst[m][k] = *(const PG8_LAS bf16x8*)(lds + PG8_SA(b, h) + aoff + m * 2048 + k * 1024); } while (0)
#define PG8_LDB(dst, b, h) do { _Pragma("unroll") for (int n = 0; n < 2; ++n) _Pragma("unroll") for (int k = 0; k < 2; ++k) dst[n][k] = *(const PG8_LAS bf16x8*)(lds + PG8_SB(b, h) + boff + n * 2048 + k * 1024); } while (0)
#define PG8_MMA(ai, bj, At, Bt) do { __builtin_amdgcn_s_setprio(1); _Pragma("unroll") for (int m = 0; m < 4; ++m) _Pragma("unroll") for (int n = 0; n < 2; ++n) _Pragma("unroll") for (int k = 0; k < 2; ++k) \
        acc[ai][bj][m][n] = __builtin_amdgcn_mfma_f32_16x16x32_bf16(Bt[n][k], At[m][k], acc[ai][bj][m][n], 0, 0, 0); __builtin_amdgcn_s_setprio(0); } while (0)
#define PG8_WAIT_V(n) asm volatile("s_waitcnt vmcnt(" #n ")" ::: "memory")
#define PG8_WAIT_L(n) asm volatile("s_waitcnt lgkmcnt(" #n ")" ::: "memory")
#define PG8_BAR __builtin_amdgcn_s_barrier()
#define PG8_SCHED __builtin_amdgcn_sched_barrier(0)
    Unit cur, nxt; int ui = 0;
    if (!S.next(0, cur)) return;
    f32x4 acc[2][2][4][2];
#pragma unroll
    for (int a = 0; a < 2; ++a)
#pragma unroll
        for (int b = 0; b < 2; ++b)
#pragma unroll
            for (int m = 0; m < 4; ++m)
#pragma unroll
                for (int n = 0; n < 2; ++n) acc[a][b][m][n] = (f32x4){0.f, 0.f, 0.f, 0.f};
    bf16x8 At[4][2], B0[2][2], B1[2][2];
    const char* cA = (const char*)g.A + (size_t)cur.pm * tstep; const char* cB = (const char*)g.Bt + (size_t)cur.pn * tstep;
    S.a_ready(cur);
    if constexpr (SP2) {
        PG8_STAGE(PG8_SB(0, 0), cB, voffB); PG8_STAGE(PG8_SB(0, 1), cB + hstep, voffB); PG8_STAGE(PG8_SA(0, 0), cA, voffA); PG8_STAGE(PG8_SA(0, 1), cA + hstep, voffA);
        if (wr == 1) PG8_BAR;
        PG8_WAIT_V(2); PG8_BAR;
        PG8_STAGE(PG8_SB(1, 0), cB + kstep, voffB); PG8_STAGE(PG8_SA(1, 0), cA + kstep, voffA); PG8_STAGE(PG8_SB(1, 1), cB + hstep + kstep, voffB);
        PG8_WAIT_V(6); PG8_BAR;
    } else {
        PG8_STAGE(PG8_SB(0, 0), cB, voffB); PG8_STAGE(PG8_SA(0, 0), cA, voffA); PG8_STAGE(PG8_SB(0, 1), cB + hstep, voffB); PG8_STAGE(PG8_SA(0, 1), cA + hstep, voffA);
        if (wr == 1) PG8_BAR;
        PG8_WAIT_V(4); PG8_BAR;
        PG8_STAGE(PG8_SB(1, 0), cB + kstep, voffB); PG8_STAGE(PG8_SA(1, 0), cA + kstep, voffA); PG8_STAGE(PG8_SB(1, 1), cB + hstep + kstep, voffB);
        PG8_WAIT_V(6); PG8_BAR;
    }
    for (;;) {
        const bool has_next = S.next(ui + 1, nxt);
        const char* nA = has_next ? (const char*)g.A + (size_t)nxt.pm * tstep : cA; const char* nB = has_next ? (const char*)g.Bt + (size_t)nxt.pn * tstep : cB;
        for (int t = 0; t < nt; t += 2) {
            const bool last = (t == nt - 2);
            const char* a1 = cA + (size_t)(t + 1) * kstep;
            const char* a2 = last ? nA : cA + (size_t)(t + 2) * kstep; const char* b2 = last ? nB : cB + (size_t)(t + 2) * kstep;
            const char* a3 = a2 + kstep; const char* b3 = b2 + kstep;
            if (last && has_next) S.a_ready(nxt);
            if constexpr (SP2) {
            PG8_LDB(B0, 0, 0); PG8_LDB(B1, 0, 1); PG8_SCHED; PG8_LDA(At, 0, 0); PG8_STAGE(PG8_SA(1, 1), a1 + hstep, voffA);
            PG8_WAIT_V(8); PG8_WAIT_L(0); PG8_BAR; PG8_MMA(0, 0, At, B0); PG8_MMA(0, 1, At, B1); PG8_BAR; PG8_SCHED;
            PG8_LDA(At, 0, 1); PG8_STAGE(PG8_SB(0, 0), b2, voffB); PG8_STAGE(PG8_SB(0, 1), b2 + hstep, voffB); PG8_STAGE(PG8_SA(0, 0), a2, voffA);
            PG8_WAIT_V(8); PG8_WAIT_L(0); PG8_BAR; PG8_MMA(1, 0, At, B0); PG8_MMA(1, 1, At, B1); PG8_BAR; PG8_SCHED;
            PG8_LDB(B0, 1, 0); PG8_LDB(B1, 1, 1); PG8_SCHED; PG8_LDA(At, 1, 0); PG8_STAGE(PG8_SA(0, 1), a2 + hstep, voffA);
            PG8_WAIT_V(8); PG8_WAIT_L(0); PG8_BAR; PG8_MMA(0, 0, At, B0); PG8_MMA(0, 1, At, B1); PG8_BAR; PG8_SCHED;
            PG8_LDA(At, 1, 1); PG8_STAGE(PG8_SB(1, 0), b3, voffB); PG8_STAGE(PG8_SB(1, 1), b3 + hstep, voffB); PG8_STAGE(PG8_SA(1, 0), a3, voffA);
            PG8_WAIT_V(8); PG8_WAIT_L(0); PG8_BAR; PG8_MMA(1, 0, At, B0); PG8_MMA(1, 1, At, B1); PG8_BAR; PG8_SCHED;
            } else {
            PG8_LDB(B0, 0, 0); PG8_SCHED; PG8_LDA(At, 0, 0); PG8_STAGE(PG8_SA(1, 1), a1 + hstep, voffA);
            PG8_WAIT_L(8); PG8_BAR; PG8_WAIT_L(0); PG8_MMA(0, 0, At, B0); PG8_BAR; PG8_SCHED;
            PG8_LDB(B1, 0, 1); PG8_STAGE(PG8_SB(0, 0), b2, voffB);
            PG8_BAR; PG8_WAIT_L(0); PG8_MMA(0, 1, At, B1); PG8_BAR;
            PG8_LDA(At, 0, 1); PG8_STAGE(PG8_SA(0, 0), a2, voffA);
            PG8_BAR; PG8_WAIT_L(0); PG8_MMA(1, 0, At, B0); PG8_BAR; PG8_SCHED;
            PG8_STAGE(PG8_SB(0, 1), b2 + hstep, voffB);
            PG8_WAIT_V(6); PG8_BAR; PG8_MMA(1, 1, At, B1); PG8_BAR;
            PG8_LDB(B0, 1, 0); PG8_SCHED; PG8_LDA(At, 1, 0); PG8_STAGE(PG8_SA(0, 1), a2 + hstep, voffA);
            PG8_WAIT_L(8); PG8_BAR; PG8_WAIT_L(0); PG8_MMA(0, 0, At, B0); PG8_BAR; PG8_SCHED;
            PG8_LDB(B1, 1, 1); PG8_STAGE(PG8_SB(1, 0), b3, voffB);
            PG8_BAR; PG8_WAIT_L(0); PG8_MMA(0, 1, At, B1); PG8_BAR;
            PG8_LDA(At, 1, 1); PG8_STAGE(PG8_SA(1, 0), a3, voffA);
            PG8_BAR; PG8_WAIT_L(0); PG8_MMA(1, 0, At, B0); PG8_BAR; PG8_SCHED;
            PG8_STAGE(PG8_SB(1, 1), b3 + hstep, voffB);
            PG8_WAIT_V(6); PG8_BAR; PG8_MMA(1, 1, At, B1); PG8_BAR;
            }
        }
        if constexpr (ALIGN_EPI) { if (wr == 0) PG8_BAR; }
        if constexpr (!Epi::AFTER_DRAIN) { E(acc, cur, wr, wc, fr, fq); S.done(cur); }
        if (!has_next) break;
#pragma unroll
        for (int a = 0; a < 2; ++a)
#pragma unroll
            for (int b = 0; b < 2; ++b)
#pragma unroll
                for (int m = 0; m < 4; ++m)
#pragma unroll
                    for (int n = 0; n < 2; ++n) acc[a][b][m][n] = (f32x4){0.f, 0.f, 0.f, 0.f};
        cur = nxt; cA = nA; cB = nB; ++ui;
        if constexpr (ALIGN_EPI) { if (wr == 1) PG8_BAR; }
    }
    PG8_WAIT_V(0);
    if constexpr (!ALIGN_EPI) { if (wr == 0) PG8_BAR; }
    PG8_BAR;
    if constexpr (Epi::AFTER_DRAIN) { E.fused(acc, cur, wr, wc, fr, fq, lds, wid, lane); S.done(cur); }
#undef PG8_SA
#undef PG8_SB
#undef PG8_STAGE
#undef PG8_LDA
#undef PG8_LDB
#undef PG8_MMA
#undef PG8_WAIT_V
#undef PG8_WAIT_L
#undef PG8_BAR
#undef PG8_SCHED
}
}
typedef unsigned short bf16;
#define LAS __attribute__((address_space(3)))
typedef float f32x4 __attribute__((ext_vector_type(4)));
typedef short bf16x8 __attribute__((ext_vector_type(8)));
typedef unsigned u32x4 __attribute__((ext_vector_type(4)));
typedef unsigned u32x2 __attribute__((ext_vector_type(2)));

#define D_MODEL 1024
#define BATCH 8
#define SEQ 2048
#define D_IN 5664
#define NTOK (BATCH * SEQ)
#define ALPHA 1.189207115002721f
#define LN_EPS 1e-5f
#define RMS_EPS 1e-6f
#define NWIN 3072
#define NT 512
#define LDS_BYTES 147456

#define LDS_WAIT() asm volatile("s_waitcnt lgkmcnt(0)" ::: "memory")
#define VM_WAIT() asm volatile("s_waitcnt vmcnt(0)" ::: "memory")

__device__ __forceinline__ int fresh_tid() { int t = threadIdx.x; asm volatile("" : "+v"(t)); return t; }
typedef float f32x2_t __attribute__((ext_vector_type(2)));
typedef __bf16 bf16x2_t __attribute__((ext_vector_type(2)));
__device__ __forceinline__ unsigned pk2(float lo, float hi) { const f32x2_t v = {lo, hi}; const bf16x2_t b = __builtin_convertvector(v, bf16x2_t); return __builtin_bit_cast(unsigned, b); }
__device__ __forceinline__ unsigned f2bf(float f) { return pk2(f, 0.f) & 0xffffu; }
__device__ __forceinline__ float bf2f(unsigned h) { return __builtin_bit_cast(float, (h & 0xffffu) << 16); }
__device__ __forceinline__ float sigmoidf_(float x) { return __builtin_amdgcn_rcpf(1.f + __expf(-x)); }
__device__ __forceinline__ float siluf_(float x) { return x * __builtin_amdgcn_rcpf(1.f + __expf(-x)); }
__device__ __forceinline__ float softplusf_(float x) { return x > 20.f ? x : log1pf(expf(x)); }

struct Params {
    const float *x, *w_in, *rpb, *conv_w, *a_log_f, *a_log_b, *dtb_f, *dtb_b, *norm_w, *w_proj_na, *w_proj_dn, *w_out, *ln1_g, *ln1_b;
    const float *wrg, *brg, *wre, *bre, *wgu, *wd, *ln2_g, *ln2_b;
    float* out;
    char* ws;
    unsigned* bar;
    int kdown, pad0;
#define WSP(T, mb) ((T*)(ws + ((size_t)(mb) << 20)))
    __device__ __forceinline__ bf16* WIN() const { return WSP(bf16, 1); }
    __device__ __forceinline__ bf16* WG() const { return WSP(bf16, 9); }
    __device__ __forceinline__ bf16* WPNA() const { return WSP(bf16, 13); }
    __device__ __forceinline__ bf16* WPDN() const { return WSP(bf16, 14); }
    __device__ __forceinline__ bf16* WOUT() const { return WSP(bf16, 15); }
    __device__ __forceinline__ bf16* XB() const { return WSP(bf16, 17); }
    __device__ __forceinline__ bf16* WGU() const { return WSP(bf16, 49); }
    __device__ __forceinline__ bf16* WD() const { return WSP(bf16, 81); }
    __device__ __forceinline__ bf16* QNA() const { return WSP(bf16, 49); }
    __device__ __forceinline__ bf16* KNA() const { return WSP(bf16, 65); }
    __device__ __forceinline__ bf16* VNAT() const { return WSP(bf16, 81); }
    __device__ __forceinline__ bf16* QKVDN() const { return WSP(bf16, 97); }
    __device__ __forceinline__ bf16* Z() const { return WSP(bf16, 145); }
    __device__ __forceinline__ float* GATES() const { return WSP(float, 161); }
    __device__ __forceinline__ bf16* NAOUT() const { return WSP(bf16, 163); }
    __device__ __forceinline__ bf16* DNOUT() const { return WSP(bf16, 129); }
};

__device__ __forceinline__ void transpose_item(const float* W, size_t ldW, bf16* WT, int Kdst, int k0, int n0, int rowdst0, LAS float*  , int lane) {
    const int m = lane & 15, g = lane >> 4;
    bf16x8 idb[2];
#pragma unroll
    for (int half = 0; half < 2; ++half)
#pragma unroll
        for (int j = 0; j < 8; ++j) idb[half][j] = (8 * g + j == m + 16 * half) ? (short)0x3F80 : (short)0;
#pragma unroll
    for (int kg = 0; kg < 2; ++kg) {
        f32x4 d[2][2];
#pragma unroll
        for (int q = 0; q < 2; ++q) {
            const float* src = W + (size_t)(k0 + 32 * kg + 8 * (m >> 2) + 4 * q + (m & 3)) * ldW + n0 + 8 * g;
            const f32x4 a0 = *(const f32x4*)src, a1 = *(const f32x4*)(src + 4);
            u32x4 aw; aw.x = pk2(a0[0], a0[1]); aw.y = pk2(a0[2], a0[3]); aw.z = pk2(a1[0], a1[1]); aw.w = pk2(a1[2], a1[3]);
            const bf16x8 af = __builtin_bit_cast(bf16x8, aw);
#pragma unroll
            for (int half = 0; half < 2; ++half) d[q][half] = __builtin_amdgcn_mfma_f32_16x16x32_bf16(af, idb[half], (f32x4){0.f, 0.f, 0.f, 0.f}, 0, 0, 0);
        }
#pragma unroll
        for (int half = 0; half < 2; ++half) {
            u32x4 o; o.x = pk2(d[0][half][0], d[0][half][1]); o.y = pk2(d[0][half][2], d[0][half][3]); o.z = pk2(d[1][half][0], d[1][half][1]); o.w = pk2(d[1][half][2], d[1][half][3]);
            *(u32x4*)(WT + (size_t)(rowdst0 + 16 * half + m) * Kdst + k0 + 32 * kg + 8 * g) = o;
        }
    }
}

#define IT_WIN (16 * 113)
#define IT_WG (16 * 64)
#define IT_WPNA (8 * 32)
#define IT_WPDN (8 * 32)
#define IT_WOUT (16 * 32)
#define IT_SMALL (IT_WIN + IT_WG + IT_WPNA + IT_WPDN + IT_WOUT)
#define IT_WGU (32 * 16 * 16)
#define IT_WD (32 * 4 * 32)

__device__ __forceinline__ void p0_small_item(const Params& p, int r, LAS float* scr, int lane) {
    if (r < IT_WIN) { const int kb = r / 113, nb = r % 113; transpose_item(p.w_in, D_IN, p.WIN(), 1024, kb * 64, nb * 32, nb * 32, scr, lane); return; } r -= IT_WIN;
    if (r < IT_WG) { const int kb = r / 64, nb = r % 64; transpose_item(p.w_in + 3616, D_IN, p.WG(), 1024, kb * 64, nb * 32, nb * 32, scr, lane); return; } r -= IT_WG;
    if (r < IT_WPNA) { const int kb = r / 32, nb = r % 32; transpose_item(p.w_proj_na, 1024, p.WPNA(), 512, kb * 64, nb * 32, nb * 32, scr, lane); return; } r -= IT_WPNA;
    if (r < IT_WPDN) { const int kb = r / 32, nb = r % 32; transpose_item(p.w_proj_dn, 1024, p.WPDN(), 512, kb * 64, nb * 32, nb * 32, scr, lane); return; } r -= IT_WPDN;
    { const int kb = r / 32, nb = r % 32; transpose_item(p.w_out, 1024, p.WOUT(), 1024, kb * 64, nb * 32, nb * 32, scr, lane); }
}
__device__ __forceinline__ void p0_moe_item(const Params& p, int r, LAS float* scr, int lane) {
    if (r < IT_WGU) { const int e = r / 256, q = r % 256, kb = q / 16, nb = q % 16;
        const int n0 = nb * 32, up = n0 >= 256, f0 = n0 - (up ? 256 : 0);
        transpose_item(p.wgu + (size_t)e * 1024 * 512, 512, p.WGU(), 1024, kb * 64, n0, e * 512 + (f0 / 128) * 256 + (up ? 128 : 0) + (f0 % 128), scr, lane); return; }
    r -= IT_WGU;
    { const int e = r / 128, q = r % 128, kb = q / 32, nb = q % 32;
        transpose_item(p.wd + (size_t)e * 256 * 1024, 1024, p.WD(), 256, kb * 64, nb * 32, e * 1024 + nb * 32, scr, lane); }
}

__device__ __forceinline__ void phase0_moe(const Params& p, unsigned* counter) {
    const int lane = fresh_tid() & 63;
    for (;;) {
        unsigned base = 0;
        if (lane == 0) base = __hip_atomic_fetch_add(counter, 4u, __ATOMIC_RELAXED, __HIP_MEMORY_SCOPE_AGENT);
        base = (unsigned)__builtin_amdgcn_readfirstlane((int)base);
        if (base >= (unsigned)(IT_WGU + IT_WD)) break;
#pragma unroll 1
        for (int k = 0; k < 4; ++k) p0_moe_item(p, (int)base + k, nullptr, lane);
    }
}
__device__ __forceinline__ void phase0(const Params& p, LAS unsigned char* lds) {
    const int tid = fresh_tid(), lane = tid & 63, wave = tid >> 6, G = gridDim.x;
    LAS float* scr = (LAS float*)(lds + wave * 16384);
    const int gw = blockIdx.x * 8 + wave, NGW = G * 8;
    for (int it = gw; it < IT_SMALL; it += NGW) p0_small_item(p, it, scr, lane);
    const size_t gt = (size_t)blockIdx.x * NT + tid, GT = (size_t)G * NT;
    for (size_t i = gt; i < (size_t)NTOK * 1024 / 8; i += GT) {
        const f32x4 a = *(const f32x4*)(p.x + i * 8), b = *(const f32x4*)(p.x + i * 8 + 4);
        u32x4 o; o.x = pk2(a.x, a.y); o.y = pk2(a.z, a.w); o.z = pk2(b.x, b.y); o.w = pk2(b.z, b.w);
        *(u32x4*)(p.XB() + i * 8) = o;
    }
}

struct EpiInProj {
    static constexpr bool PERM = true, AFTER_DRAIN = false;
    struct Mini { char* ws;
        __device__ __forceinline__ bf16* QNA() const { return WSP(bf16, 49); }
        __device__ __forceinline__ bf16* KNA() const { return WSP(bf16, 65); }
        __device__ __forceinline__ bf16* VNAT() const { return WSP(bf16, 81); }
        __device__ __forceinline__ bf16* QKVDN() const { return WSP(bf16, 97); }
    } p;
    __device__ __forceinline__ void operator()(const pg8::f32x4 (&acc)[2][2][4][2], const pg8::Unit& u, int wr, int wc, int fr, int fq) const {
        const int pn = u.pn;
#pragma unroll
        for (int ai = 0; ai < 2; ++ai)
#pragma unroll
            for (int m = 0; m < 4; ++m) {
                const int row = u.pm * 256 + ai * 128 + wr * 64 + m * 16 + fr;
                const int b = row >> 11, t = row & 2047;
#pragma unroll
                for (int bj = 0; bj < 2; ++bj) {
                    const pg8::f32x4 v0 = acc[ai][bj][m][0], v1 = acc[ai][bj][m][1];
                    const int head = (pn & 1) * 4 + bj * 2 + (wc >> 1), d0 = (wc & 1) * 32 + 8 * fq;
                    const size_t hm = ((size_t)(b * 8 + head) * 2048 + t) * 64 + d0;
                    if (pn < 4 || pn >= 6) {
                        bf16* dst; float sc = 1.f;
                        if (pn < 2) { dst = p.QNA(); sc = 0.125f; }
                        else if (pn < 4) dst = p.KNA();
                        else dst = p.QKVDN() + (size_t)((pn - 6) >> 1) * ((size_t)NTOK * 512);
                        float e[8] = {v0[0], v0[1], v0[2], v0[3], v1[0], v1[1], v1[2], v1[3]};
#pragma unroll
                        for (int j = 0; j < 8; ++j) e[j] *= sc;
                        u32x4 w; w.x = pk2(e[0], e[1]); w.y = pk2(e[2], e[3]); w.z = pk2(e[4], e[5]); w.w = pk2(e[6], e[7]);
                        *(u32x4*)(dst + hm) = w;
                    } else {
                        bf16* dst = p.VNAT() + ((size_t)(b * 8 + head) * 64 + d0) * 2048 + t;
                        const float e[8] = {v0[0], v0[1], v0[2], v0[3], v1[0], v1[1], v1[2], v1[3]};
#pragma unroll
                        for (int j = 0; j < 8; ++j) dst[(size_t)j * 2048] = (bf16)f2bf(e[j]);
                    }
                }
            }
    }
};
struct EpiZ {
    static constexpr bool PERM = true, AFTER_DRAIN = false;
    bf16* Z;
    __device__ __forceinline__ void operator()(const pg8::f32x4 (&acc)[2][2][4][2], const pg8::Unit& u, int wr, int wc, int fr, int fq) const {
#pragma unroll
        for (int ai = 0; ai < 2; ++ai)
#pragma unroll
            for (int m = 0; m < 4; ++m) {
                const int row = u.pm * 256 + ai * 128 + wr * 64 + m * 16 + fr;
                const int b = row >> 11, t = row & 2047;
#pragma unroll
                for (int bj = 0; bj < 2; ++bj) {
                    const pg8::f32x4 v0 = acc[ai][bj][m][0], v1 = acc[ai][bj][m][1];
                    const int head = (u.pn & 1) * 4 + bj * 2 + (wc >> 1), d0 = (wc & 1) * 32 + 8 * fq;
                    float e[8] = {v0[0], v0[1], v0[2], v0[3], v1[0], v1[1], v1[2], v1[3]};
#pragma unroll
                    for (int j = 0; j < 8; ++j) e[j] = siluf_(e[j]);
                    u32x4 w; w.x = pk2(e[0], e[1]); w.y = pk2(e[2], e[3]); w.z = pk2(e[4], e[5]); w.w = pk2(e[6], e[7]);
                    *(u32x4*)(Z + ((size_t)(b * 8 + head) * 2048 + t) * 64 + d0) = w;
                }
            }
    }
};
__device__ __forceinline__ void gates_minigemm(const Params& p) {
    const int tid = fresh_tid(), lane = tid & 63, wave = tid >> 6, r16 = lane & 15, g = lane >> 4;
    for (int blk = blockIdx.x; blk < 256; blk += gridDim.x) {
        const int mt = wave & 3, nt = wave >> 2;
        const bf16* A = p.XB() + ((size_t)blk * 64 + mt * 16 + r16) * 1024 + 8 * g;
        const bf16* Bt = p.WIN() + ((size_t)3584 + nt * 16 + r16) * 1024 + 8 * g;
        f32x4 acc0 = {0.f, 0.f, 0.f, 0.f}, acc1 = {0.f, 0.f, 0.f, 0.f};
#pragma unroll 8
        for (int ks = 0; ks < 32; ks += 2) {
            acc0 = __builtin_amdgcn_mfma_f32_16x16x32_bf16(*(const bf16x8*)(A + ks * 32), *(const bf16x8*)(Bt + ks * 32), acc0, 0, 0, 0);
            acc1 = __builtin_amdgcn_mfma_f32_16x16x32_bf16(*(const bf16x8*)(A + ks * 32 + 32), *(const bf16x8*)(Bt + ks * 32 + 32), acc1, 0, 0, 0);
        }
        const int col = nt * 16 + r16, type = col >> 3, hd = col & 7;
        const size_t tg0 = (size_t)blk * 64 + mt * 16 + 4 * g; const int b = (int)(tg0 >> 11), t = (int)(tg0 & 2047);
        f32x4 o;
#pragma unroll
        for (int r = 0; r < 4; ++r) {
            const float e = acc0[r] + acc1[r];
            o[r] = type < 2 ? sigmoidf_(e) : (type == 2 ? -expf(p.a_log_f[hd]) * softplusf_(e + p.dtb_f[hd]) : -expf(p.a_log_b[hd]) * softplusf_(e + p.dtb_b[hd]));
        }
        *(f32x4*)(p.GATES() + (size_t)type * NTOK * 8 + ((size_t)b * 8 + hd) * 2048 + t) = o;
    }
}

__device__ __forceinline__ void phase1(const Params& p, LAS unsigned char* lds) {
    pg8::Gemm g{p.XB(), p.WIN(), NTOK, NWIN, 1024};
    pg8::StaticOrder S; S.init(NTOK, NWIN, gridDim.x, (int)blockIdx.x);
    EpiInProj E{{p.ws}};
    pg8::gemm_phase<EpiInProj, pg8::StaticOrder, true, true>(lds, g, S, E);
    gates_minigemm(p);
}
__device__ __forceinline__ void phase_zgemm(const Params& p, LAS unsigned char* lds, int nb, int c) {
    pg8::Gemm g{p.XB(), p.WIN() + (size_t)3072 * 1024, NTOK, 512, 1024};
    pg8::StaticOrder S; S.init(NTOK, 512, nb, c);
    EpiZ E{p.Z()};
    pg8::gemm_phase<EpiZ, pg8::StaticOrder, true, true>(lds, g, S, E);
}

#define XB_TMO      128
#define XB_XCNT(j)  (256  + 64 * (j))
#define XB_XSUB(j)  (1280 + 64 * (j))
#define XB_XGEN(j)  (2304 + 64 * (j))
#define XB_TOP      3328
#define XB_TOPGEN   3392
#define XCD_BAR_WORDS 3456
#define XB_SPIN_CAP (1u << 18)


__device__ __forceinline__ unsigned xb_ld(unsigned* p)              { return __hip_atomic_load(p, __ATOMIC_RELAXED, __HIP_MEMORY_SCOPE_AGENT); }
__device__ __forceinline__ unsigned xb_add(unsigned* p, unsigned v) { return __hip_atomic_fetch_add(p, v, __ATOMIC_RELAXED, __HIP_MEMORY_SCOPE_AGENT); }
__device__ __forceinline__ unsigned xb_xcc_id() { return (unsigned)__builtin_amdgcn_s_getreg((3 << 11) | 20) & 0xFu; }
#define XB_SPIN(cond, bar) do { unsigned _sp = 0; while (cond) { __builtin_amdgcn_s_sleep(1); \
    if ((++_sp & 255u) == 0u) { if (xb_ld(&(bar)[XB_TMO])) break; if (_sp > XB_SPIN_CAP) { atomicAdd(&(bar)[XB_TMO], 1u); break; } } } } while (0)

struct XcdBarrier {
    unsigned* bar; unsigned x;
    volatile LAS unsigned* st;
};

__device__ __forceinline__ XcdBarrier xcd_barrier_post(unsigned* bar, volatile LAS unsigned* st) {
    XcdBarrier b; b.bar = bar; b.x = xb_xcc_id(); b.st = st;
    if (threadIdx.x == 0) (void)xb_add(&bar[XB_XCNT(b.x)], 1u);
    return b;
}
__device__ __forceinline__ void xcd_barrier_complete(unsigned* bar, unsigned x, unsigned& nloc, unsigned& nx) {
    const unsigned G = gridDim.x * gridDim.y * gridDim.z;
    unsigned sum, cnt, mine, sp = 0u;
    for (;;) {
        sum = 0u; cnt = 0u; mine = 0u;
#pragma unroll
        for (unsigned j = 0; j < 16; ++j) { const unsigned c = xb_ld(&bar[XB_XCNT(j)]); sum += c; cnt += (c > 0u) ? 1u : 0u; mine = (j == x) ? c : mine; }
        if (sum == G) break;
        __builtin_amdgcn_s_sleep(1);
        if ((++sp & 255u) == 0u) { if (xb_ld(&bar[XB_TMO])) break; if (sp > XB_SPIN_CAP) { atomicAdd(&bar[XB_TMO], 1u); break; } }
    }
    nloc = mine > 0u ? mine : 1u; nx = cnt > 0u ? cnt : 1u;
}

__device__ __forceinline__ void xcd_barrier(const XcdBarrier& b) {
    asm volatile("s_waitcnt vmcnt(0)" ::: "memory");
    __syncthreads();
    if (threadIdx.x == 0) {
        unsigned* bar = b.bar;
        __builtin_amdgcn_s_waitcnt(0);
        unsigned nloc = b.st[0], nx = b.st[1];
        if (nloc == 0u) { xcd_barrier_complete(bar, b.x, nloc, nx); b.st[0] = nloc; b.st[1] = nx; }
        const unsigned old = xb_add(&bar[XB_XSUB(b.x)], 1u);
        const unsigned gen = old / nloc;
        if (old + 1u == (gen + 1u) * nloc) {
            __builtin_amdgcn_fence(__ATOMIC_RELEASE, "agent");
            asm volatile("s_waitcnt vmcnt(0)" ::: "memory");
            const unsigned og = xb_add(&bar[XB_TOP], 1u);
            const unsigned tg = og / nx;
            if (og + 1u == (tg + 1u) * nx) xb_add(&bar[XB_TOPGEN], 1u);
            else XB_SPIN(xb_ld(&bar[XB_TOPGEN]) == tg, bar);
            __builtin_amdgcn_fence(__ATOMIC_ACQUIRE, "agent");
            xb_add(&bar[XB_XGEN(b.x)], 1u);
            asm volatile("s_waitcnt vmcnt(0)" ::: "memory");
        } else {
            XB_SPIN(xb_ld(&bar[XB_XGEN(b.x)]) == gen, bar);
            __builtin_amdgcn_fence(__ATOMIC_ACQUIRE, "agent");
            asm volatile("s_waitcnt vmcnt(0)" ::: "memory");
        }
    }
    __syncthreads();
}
#define NA_VSTR 520
#define NA_V_OFF 65536
#define NA_RPB_OFF (65536 + 64 * NA_VSTR * 2)
__device__ __forceinline__ void phase_na(const Params& p, LAS unsigned char* lds) {
    const int tid = fresh_tid(), lane = tid & 63, wave = tid >> 6, G = gridDim.x;
    const int vcu = (G % 8 == 0) ? ((int)blockIdx.x % 8) * (G / 8) + (int)blockIdx.x / 8 : (int)blockIdx.x;
    LAS unsigned char* Kl = lds;
    LAS bf16* Vl = (LAS bf16*)(lds + NA_V_OFF);
    LAS float* rpb_s = (LAS float*)(lds + NA_RPB_OFF);
    const int qi = lane & 15, g = lane >> 4, qg = wave & 3, dh = wave >> 2;
    const int c0 = qg * 16, c = c0 + qi;
    int cs0 = c0 - 8; cs0 = cs0 < 0 ? 0 : (cs0 > 32 ? 32 : cs0);
    int csq = c - 8; csq = csq < 0 ? 0 : (csq > 48 ? 48 : csq);
    for (int task = vcu; task < 256; task += G) {
        const int bh = task >> 2, r0 = (task & 3) * 8, h = bh & 7, b = bh >> 3;
        const size_t hb = (size_t)bh * 2048;
        const bf16* Kg = p.KNA() + hb * 64;
        const bf16* Vg = p.VNAT() + (size_t)bh * 64 * 2048;
        __syncthreads();
        for (int i = tid; i < 465; i += NT) rpb_s[i] = p.rpb[h * 465 + i];
        {
            int rs0 = r0 - 4; rs0 = rs0 < 0 ? 0 : (rs0 > 24 ? 24 : rs0);
#pragma unroll
            for (int q = 0; q < 8; ++q) {
                const int pc = tid + q * NT;
                const int krow = pc >> 9, col = (pc >> 3) & 63, ch = pc & 7, kr = rs0 + krow, sl = kr & 7;
                const u32x4 kv = *(const u32x4*)(Kg + ((size_t)kr * 64 + col) * 64 + ch * 8);
                *(LAS u32x4*)(Kl + (sl * 64 + col) * 128 + ((ch ^ (col & 7)) << 4)) = kv;
                const int d = (pc >> 3) & 63, vch = pc & 7;
                const u32x4 vv = *(const u32x4*)(Vg + (size_t)d * 2048 + kr * 64 + vch * 8);
                *(LAS u32x4*)(Vl + d * NA_VSTR + sl * 64 + vch * 8) = vv;
            }
        }
        __syncthreads();
        float bt[16][4];
        int bt_delta = 1000;
        bf16x8 qn[2];
#pragma unroll
        for (int ks = 0; ks < 2; ++ks) qn[ks] = *(const bf16x8*)(p.QNA() + (hb + r0 * 64 + c) * 64 + ks * 32 + 8 * g);
        for (int ri = 0; ri < 8; ++ri) {
            const int r = r0 + ri;
            int rs = r - 4; rs = rs < 0 ? 0 : (rs > 24 ? 24 : rs);
            int rsn = r + 1 - 4; rsn = rsn < 0 ? 0 : (rsn > 24 ? 24 : rsn);
            const bool add = (ri < 7) && (rsn != rs);
            u32x4 pk = {0u, 0u, 0u, 0u}, pv = {0u, 0u, 0u, 0u};
            const int ncol = tid >> 3, nch = tid & 7, nkr = rsn + 7;
            if (add) { pk = *(const u32x4*)(Kg + ((size_t)nkr * 64 + ncol) * 64 + nch * 8); pv = *(const u32x4*)(Vg + (size_t)ncol * 2048 + nkr * 64 + nch * 8); }
            bf16x8 qf[2]; qf[0] = qn[0]; qf[1] = qn[1];
            if (ri < 7) {
#pragma unroll
                for (int ks = 0; ks < 2; ++ks) qn[ks] = *(const bf16x8*)(p.QNA() + (hb + (r + 1) * 64 + c) * 64 + ks * 32 + 8 * g);
            }
            if (rs - r != bt_delta) {
                bt_delta = rs - r;
#pragma unroll
                for (int j = 0; j < 8; ++j)
#pragma unroll
                    for (int ct = 0; ct < 2; ++ct)
#pragma unroll
                        for (int rr = 0; rr < 4; ++rr) {
                            const int kc = cs0 + 8 * g + 4 * ct + rr;
                            const bool valid = (kc >= csq) && (kc < csq + 16);
                            int dc = kc - c + 15; dc = dc < 0 ? 0 : (dc > 30 ? 30 : dc);
                            bt[j * 2 + ct][rr] = valid ? rpb_s[(bt_delta + j + 7) * 31 + dc] : -1e30f;
                        }
            }
            float s[16][4];
#pragma unroll
            for (int j = 0; j < 8; ++j) {
                const int sl = (rs + j) & 7;
#pragma unroll
                for (int ct = 0; ct < 2; ++ct) {
                    const int col = cs0 + 8 * (qi >> 2) + 4 * ct + (qi & 3);
                    const LAS unsigned char* kp = Kl + (sl * 64 + col) * 128;
                    f32x4 a = {0.f, 0.f, 0.f, 0.f};
#pragma unroll
                    for (int ks = 0; ks < 2; ++ks) {
                        const bf16x8 kf = *(const LAS bf16x8*)(kp + (((4 * ks + g) ^ (col & 7)) << 4));
                        a = __builtin_amdgcn_mfma_f32_16x16x32_bf16(kf, qf[ks], a, 0, 0, 0);
                    }
#pragma unroll
                    for (int rr = 0; rr < 4; ++rr) s[j * 2 + ct][rr] = a[rr] + bt[j * 2 + ct][rr];
                }
            }
            float mx = -3e38f;
#pragma unroll
            for (int i = 0; i < 16; ++i)
#pragma unroll
                for (int rr = 0; rr < 4; ++rr) mx = fmaxf(mx, s[i][rr]);
            mx = fmaxf(mx, __shfl_xor(mx, 16)); mx = fmaxf(mx, __shfl_xor(mx, 32));
            float sum = 0.f;
#pragma unroll
            for (int i = 0; i < 16; ++i)
#pragma unroll
                for (int rr = 0; rr < 4; ++rr) { s[i][rr] = __expf(s[i][rr] - mx); sum += s[i][rr]; }
            sum += __shfl_xor(sum, 16); sum += __shfl_xor(sum, 32);
            const float inv = __builtin_amdgcn_rcpf(sum);
            f32x4 o[2];
            o[0] = (f32x4){0.f, 0.f, 0.f, 0.f}; o[1] = (f32x4){0.f, 0.f, 0.f, 0.f};
#pragma unroll
            for (int kk = 0; kk < 8; ++kk) {
                u32x4 pw; pw.x = pk2(s[2 * kk][0] * inv, s[2 * kk][1] * inv); pw.y = pk2(s[2 * kk][2] * inv, s[2 * kk][3] * inv);
                pw.z = pk2(s[2 * kk + 1][0] * inv, s[2 * kk + 1][1] * inv); pw.w = pk2(s[2 * kk + 1][2] * inv, s[2 * kk + 1][3] * inv);
                const bf16x8 pf = __builtin_bit_cast(bf16x8, pw);
                const int sl = (rs + kk) & 7;
#pragma unroll
                for (int dd = 0; dd < 2; ++dd) {
                    const bf16x8 vf = *(const LAS bf16x8*)(Vl + ((2 * dh + dd) * 16 + qi) * NA_VSTR + sl * 64 + cs0 + 8 * g);
                    o[dd] = __builtin_amdgcn_mfma_f32_16x16x32_bf16(vf, pf, o[dd], 0, 0, 0);
                }
            }
            {
                const size_t tg = (size_t)b * 2048 + r * 64 + c;
#pragma unroll
                for (int dd = 0; dd < 2; ++dd) { u32x2 ov; ov.x = pk2(o[dd][0], o[dd][1]); ov.y = pk2(o[dd][2], o[dd][3]);
                    *(u32x2*)(p.NAOUT() + tg * 512 + h * 64 + (2 * dh + dd) * 16 + 4 * g) = ov; }
            }
            __syncthreads();
            if (add) { const int sl = nkr & 7;
                *(LAS u32x4*)(Kl + (sl * 64 + ncol) * 128 + ((nch ^ (ncol & 7)) << 4)) = pk;
                *(LAS u32x4*)(Vl + ncol * NA_VSTR + sl * 64 + nch * 8) = pv; }
            __syncthreads();
        }
    }
}
#define LDSTR 72
#define MATB (64 * LDSTR * 2)
__device__ __forceinline__ f32x4 mfma16(bf16x8 a, bf16x8 b, f32x4 c) { return __builtin_amdgcn_mfma_f32_16x16x32_bf16(a, b, c, 0, 0, 0); }

template <bool SWZ_A = false, bool SWZ_B = false>
__device__ __forceinline__ void slab_mma(const LAS bf16* A, const LAS bf16* Bt, int w, int lane, f32x4 (&acc)[4]) {
    const int r16 = lane & 15, g = lane >> 4;
    const int ra = 16 * w + r16, sa = SWZ_A ? ((ra >> 3) & 7) : 0;
    const bf16x8 a0 = *(const LAS bf16x8*)(A + ra * LDSTR + 8 * (g ^ sa));
    const bf16x8 a1 = *(const LAS bf16x8*)(A + ra * LDSTR + 8 * ((4 + g) ^ sa));
#pragma unroll
    for (int nt = 0; nt < 4; ++nt) {
        const int rb = nt * 16 + r16, sb = SWZ_B ? ((rb >> 3) & 7) : 0;
        const bf16x8 b0 = *(const LAS bf16x8*)(Bt + rb * LDSTR + 8 * (g ^ sb));
        const bf16x8 b1 = *(const LAS bf16x8*)(Bt + rb * LDSTR + 8 * ((4 + g) ^ sb));
        acc[nt] = mfma16(a0, b0, acc[nt]); acc[nt] = mfma16(a1, b1, acc[nt]);
    }
}

struct DnBufs { char* ws; char* out;
    __device__ __forceinline__ bf16* MN() const { return (bf16*)out; }
    __device__ __forceinline__ bf16* QO() const { return WSP(bf16, 179); }
    __device__ __forceinline__ bf16* SB() const { return WSP(bf16, 97); } };

__device__ __forceinline__ void conv8(const float* conv_w, const bf16* src, size_t hb, int t, int c0, int wch, float (&y)[8]) {
#pragma unroll
    for (int d = 0; d < 8; ++d) y[d] = 0.f;
#pragma unroll
    for (int j = 0; j < 5; ++j) {
        const int tt = t + j - 2;
        if (tt >= 0 && tt < SEQ) {
            const bf16x8 x0 = *(const bf16x8*)(src + (hb + tt) * 64 + c0);
            const f32x4 w0 = *(const f32x4*)(conv_w + j * 1536 + wch + c0), w1 = *(const f32x4*)(conv_w + j * 1536 + wch + c0 + 4);
#pragma unroll
            for (int d = 0; d < 4; ++d) { y[d] = fmaf(bf2f((unsigned short)x0[d]), w0[d], y[d]); y[4 + d] = fmaf(bf2f((unsigned short)x0[4 + d]), w1[d], y[4 + d]); }
        }
    }
#pragma unroll
    for (int d = 0; d < 8; ++d) y[d] = siluf_(y[d]);
}
__device__ __forceinline__ u32x4 pack8(const float (&y)[8]) { u32x4 o; o.x = pk2(y[0], y[1]); o.y = pk2(y[2], y[3]); o.z = pk2(y[4], y[5]); o.w = pk2(y[6], y[7]); return o; }

#ifndef DN_STEP_DUP
#define DN_STEP_DUP 0
#endif
#define TEAM_BYTES 71680
#define XSTR2 40
__device__ __forceinline__ void phase_dnprep(const Params& p, const DnBufs& B, LAS unsigned char* lds) {
    const int tid = fresh_tid(), lane = tid & 63, wave = tid >> 6, team = wave >> 2, w = wave & 3, G = gridDim.x;
    const int r16 = lane & 15, g = lane >> 4;
    LAS unsigned char* base = lds + team * TEAM_BYTES;
    LAS bf16* Kr = (LAS bf16*)(base);
    LAS bf16* Qr = (LAS bf16*)(base + MATB);
    LAS bf16* KdT = (LAS bf16*)(base + 2 * MATB);
    LAS bf16* KbT = (LAS bf16*)(base + 3 * MATB);
    LAS bf16* VbT = (LAS bf16*)(base + 4 * MATB);
    LAS bf16* IN = (LAS bf16*)(base + 5 * MATB);
    LAS bf16* Lb = (LAS bf16*)(base + 6 * MATB);
    LAS bf16* TTa = Lb + 64 * LDSTR; LAS bf16* T22T = TTa + 32 * XSTR2; LAS bf16* XT = T22T + 16 * XSTR2;
    LAS bf16* Tm = Kr; LAS bf16* WT = Lb; LAS bf16* UT = KbT;
    LAS float* beta_s = (LAS float*)(lds + 143360 + team * 1024); LAS float* gc_s = beta_s + 64;
    const int dir0 = team;
    float pf_be = 0.f, pf_g = 0.f;
#define DN_GATE_PREFETCH(pi_) do { if (w == 0) { const int tc_ = (pi_) & 31, bh_ = (pi_) >> 5, cc_ = dir0 ? 31 - tc_ : tc_, s_ = cc_ * 64 + lane, t_ = dir0 ? 2047 - s_ : s_; \
        pf_be = p.GATES()[(size_t)dir0 * NTOK * 8 + (size_t)bh_ * 2048 + t_]; pf_g = p.GATES()[(size_t)(2 + dir0) * NTOK * 8 + (size_t)bh_ * 2048 + t_]; } } while (0)
#define DN_L2_PREFETCH(pi_) do { if (tid < 204) { const int tc_ = (pi_) & 31, bh_ = (pi_) >> 5, mtx_ = tid / 68, row_ = tid - mtx_ * 68; int t_ = tc_ * 64 - 2 + row_; t_ = t_ < 0 ? 0 : (t_ > SEQ - 1 ? SEQ - 1 : t_); \
        __builtin_amdgcn_global_load_lds((const unsigned*)(p.QKVDN() + (size_t)mtx_ * NTOK * 512 + ((size_t)bh_ * 2048 + t_) * 64), (LAS unsigned*)(lds + 145408 + wave * 256), 4, 0, 0); } } while (0)
    if ((int)blockIdx.x < 2048) DN_GATE_PREFETCH((int)blockIdx.x);
    for (int pi = blockIdx.x; pi < 2048; pi += G) {
        const int tc = pi & 31, bh = pi >> 5, h = bh & 7, dir = team, cc = dir ? 31 - tc : tc;
        const int it = (bh * 2 + dir) * 32 + cc;
        const size_t hb = (size_t)bh * 2048;
        __syncthreads();
        if (w == 0) {
            const float be = pf_be;
            float gv = pf_g;
#pragma unroll
            for (int o = 1; o < 64; o <<= 1) { const float n = __shfl_up(gv, o); if (lane >= o) gv += n; }
            beta_s[lane] = be; gc_s[lane] = gv;
        }
        __syncthreads();
        for (int rep1 = 0; rep1 < 1 + (DN_STEP_DUP & 1); ++rep1) {
            const int tau = tid >> 3, c0 = (tid & 7) * 8, t = tc * 64 + tau;
            float yk[8], yq[8], yv[8];
            conv8(p.conv_w, p.QKVDN() + (size_t)NTOK * 512, hb, t, c0, 512 + h * 64, yk);
            asm volatile("" ::: "memory");
            conv8(p.conv_w, p.QKVDN(), hb, t, c0, h * 64, yq);
            asm volatile("" ::: "memory");
            conv8(p.conv_w, p.QKVDN() + (size_t)2 * NTOK * 512, hb, t, c0, 1024 + h * 64, yv);
            asm volatile("" ::: "memory");
            if (pi + G < 2048) { DN_GATE_PREFETCH(pi + G); DN_L2_PREFETCH(pi + G); }
            float sk = 0.f, sq = 0.f;
#pragma unroll
            for (int d = 0; d < 8; ++d) { sk = fmaf(yk[d], yk[d], sk); sq = fmaf(yq[d], yq[d], sq); }
            sk += __shfl_xor(sk, 1); sq += __shfl_xor(sq, 1); sk += __shfl_xor(sk, 2); sq += __shfl_xor(sq, 2); sk += __shfl_xor(sk, 4); sq += __shfl_xor(sq, 4);
            const float rk = rsqrtf(sk + RMS_EPS), rq = rsqrtf(sq + RMS_EPS);
#pragma unroll
            for (int d = 0; d < 8; ++d) { yk[d] *= rk; yq[d] *= rq; }
            const u32x4 kp = pack8(yk), qp = pack8(yq);
#pragma unroll
            for (int dd = 0; dd < 2; ++dd) {
                LAS unsigned char* tb = lds + dd * TEAM_BYTES;
                const LAS float* bs = (const LAS float*)(lds + 143360 + dd * 1024); const LAS float* gs = bs + 64;
                const int i = dd ? 63 - tau : tau;
                const float be = bs[i], gci = gs[i], gl = gs[63];
                const float e_gc = __expf(gci), e_kd = __expf(gl - gci), bg = be * e_gc;
                *(LAS u32x4*)((LAS bf16*)tb + i * LDSTR + c0) = kp;
                *(LAS u32x4*)((LAS bf16*)(tb + MATB) + i * LDSTR + c0) = qp;
                LAS bf16* kd = (LAS bf16*)(tb + 2 * MATB); LAS bf16* kb = (LAS bf16*)(tb + 3 * MATB); LAS bf16* vb = (LAS bf16*)(tb + 4 * MATB);
#pragma unroll
                for (int d = 0; d < 8; ++d) { const int isw = i ^ ((c0 >> 3) << 3);
                    kd[(c0 + d) * LDSTR + isw] = (bf16)f2bf(yk[d] * e_kd); kb[(c0 + d) * LDSTR + isw] = (bf16)f2bf(yk[d] * bg); vb[(c0 + d) * LDSTR + isw] = (bf16)f2bf(yv[d] * be); }
            }
        }
        __syncthreads();
#pragma unroll 1
        for (int rep2 = 0; rep2 < 1 + ((DN_STEP_DUP >> 3) & 1); ++rep2) {
            f32x4 akk[4], aqk[4];
#pragma unroll
            for (int nt = 0; nt < 4; ++nt) { akk[nt] = (f32x4){0.f, 0.f, 0.f, 0.f}; aqk[nt] = (f32x4){0.f, 0.f, 0.f, 0.f}; }
            slab_mma(Kr, Kr, w, lane, akk);
            slab_mma(Qr, Kr, w, lane, aqk);
#pragma unroll
            for (int nt = 0; nt < 4; ++nt) {
                const int j = nt * 16 + r16; const float gcj = gc_s[j];
#pragma unroll
                for (int r = 0; r < 4; ++r) {
                    const int i = 16 * w + 4 * g + r;
                    const float dec = (j <= i) ? __expf(gc_s[i] - gcj) : 0.f;
                    Lb[i * LDSTR + j] = (bf16)f2bf((j < i) ? beta_s[i] * akk[nt][r] * dec : 0.f);
                    IN[i * LDSTR + j] = (bf16)f2bf(aqk[nt][r] * 0.125f * dec);
                }
            }
        }
        __syncthreads();
        for (int rep3 = 0; rep3 < 1 + ((DN_STEP_DUP >> 1) & 1); ++rep3) if (w == 0) {
            const u32x4 z4 = {0u, 0u, 0u, 0u};
#pragma unroll
            for (int q = 0; q < 9; ++q) { const int idx = lane + 64 * q; *(LAS u32x4*)(Tm + (idx / 9) * LDSTR + (idx % 9) * 8) = z4; }
            const int blk = lane >> 4, j = lane & 15;
            float x[16];
#pragma unroll
            for (int i = 0; i < 16; ++i) {
                float a = (i == j) ? 1.f : 0.f;
#pragma unroll
                for (int m = 0; m < i; ++m) a = fmaf(-bf2f(Lb[(16 * blk + i) * LDSTR + 16 * blk + m]), x[m], a);
                x[i] = a;
            }
#pragma unroll
            for (int i = 0; i < 16; ++i) Tm[(16 * blk + i) * LDSTR + 16 * blk + j] = (bf16)f2bf(x[i]);
            {
                u32x4 lo, hi; lo.x = pk2(x[0], x[1]); lo.y = pk2(x[2], x[3]); lo.z = pk2(x[4], x[5]); lo.w = pk2(x[6], x[7]);
                hi.x = pk2(x[8], x[9]); hi.y = pk2(x[10], x[11]); hi.z = pk2(x[12], x[13]); hi.w = pk2(x[14], x[15]);
                if (blk < 2) { LAS bf16* dst = TTa + (16 * blk + j) * XSTR2 + 16 * blk; *(LAS u32x4*)dst = lo; *(LAS u32x4*)(dst + 8) = hi;
                    if (blk == 1) { *(LAS u32x4*)(TTa + (16 + j) * XSTR2) = z4; *(LAS u32x4*)(TTa + (16 + j) * XSTR2 + 8) = z4; } }
                else if (blk == 2) { *(LAS u32x4*)(T22T + j * XSTR2) = lo; *(LAS u32x4*)(T22T + j * XSTR2 + 8) = hi; }
            }
            LDS_WAIT();
            const bf16x8 zf = {0, 0, 0, 0, 0, 0, 0, 0};
            const f32x4 z0 = {0.f, 0.f, 0.f, 0.f};
            const bool lo2 = g < 2;
            {
                const bf16x8 aA = lo2 ? *(const LAS bf16x8*)(Lb + (16 + r16) * LDSTR + 8 * g) : zf, bA = lo2 ? *(const LAS bf16x8*)(TTa + r16 * XSTR2 + 8 * g) : zf;
                const bf16x8 aB = lo2 ? *(const LAS bf16x8*)(Lb + (48 + r16) * LDSTR + 32 + 8 * g) : zf, bB = lo2 ? *(const LAS bf16x8*)(T22T + r16 * XSTR2 + 8 * g) : zf;
                const f32x4 xa = mfma16(aA, bA, z0), xb = mfma16(aB, bB, z0);
                u32x2 o; o.x = pk2(xa[0], xa[1]); o.y = pk2(xa[2], xa[3]); *(LAS u32x2*)(XT + r16 * XSTR2 + 4 * g) = o;
                o.x = pk2(xb[0], xb[1]); o.y = pk2(xb[2], xb[3]); *(LAS u32x2*)(XT + (16 + r16) * XSTR2 + 4 * g) = o;
            }
            LDS_WAIT();
            {
                const bf16x8 aA = lo2 ? *(const LAS bf16x8*)(Tm + (16 + r16) * LDSTR + 16 + 8 * g) : zf, bA = lo2 ? *(const LAS bf16x8*)(XT + r16 * XSTR2 + 8 * g) : zf;
                const bf16x8 aB = lo2 ? *(const LAS bf16x8*)(Tm + (48 + r16) * LDSTR + 48 + 8 * g) : zf, bB = lo2 ? *(const LAS bf16x8*)(XT + (16 + r16) * XSTR2 + 8 * g) : zf;
                const f32x4 ta = mfma16(aA, bA, z0), tb2 = mfma16(aB, bB, z0);
#pragma unroll
                for (int r = 0; r < 4; ++r) { Tm[(16 + 4 * g + r) * LDSTR + r16] = (bf16)f2bf(-ta[r]); Tm[(48 + 4 * g + r) * LDSTR + 32 + r16] = (bf16)f2bf(-tb2[r]); }
                u32x2 o; o.x = pk2(-ta[0], -ta[1]); o.y = pk2(-ta[2], -ta[3]); *(LAS u32x2*)(TTa + r16 * XSTR2 + 16 + 4 * g) = o;
            }
            LDS_WAIT();
            {
                f32x4 x2[2][2];
#pragma unroll
                for (int mt = 0; mt < 2; ++mt) {
                    const bf16x8 a = *(const LAS bf16x8*)(Lb + (32 + 16 * mt + r16) * LDSTR + 8 * g);
#pragma unroll
                    for (int nt = 0; nt < 2; ++nt) { const bf16x8 b2 = *(const LAS bf16x8*)(TTa + (16 * nt + r16) * XSTR2 + 8 * g); x2[mt][nt] = mfma16(a, b2, z0); }
                }
#pragma unroll
                for (int mt = 0; mt < 2; ++mt)
#pragma unroll
                    for (int nt = 0; nt < 2; ++nt) { u32x2 o; o.x = pk2(x2[mt][nt][0], x2[mt][nt][1]); o.y = pk2(x2[mt][nt][2], x2[mt][nt][3]); *(LAS u32x2*)(XT + (16 * nt + r16) * XSTR2 + 16 * mt + 4 * g) = o; }
            }
            LDS_WAIT();
            {
#pragma unroll
                for (int mt = 0; mt < 2; ++mt) {
                    const bf16x8 a = *(const LAS bf16x8*)(Tm + (32 + 16 * mt + r16) * LDSTR + 32 + 8 * g);
#pragma unroll
                    for (int nt = 0; nt < 2; ++nt) {
                        const bf16x8 b2 = *(const LAS bf16x8*)(XT + (16 * nt + r16) * XSTR2 + 8 * g);
                        const f32x4 tv = mfma16(a, b2, z0);
#pragma unroll
                        for (int r = 0; r < 4; ++r) Tm[(32 + 16 * mt + 4 * g + r) * LDSTR + 16 * nt + r16] = (bf16)f2bf(-tv[r]);
                    }
                }
            }
        }
        __syncthreads();
        {
            f32x4 a[4];
#pragma unroll
            for (int nt = 0; nt < 4; ++nt) a[nt] = (f32x4){0.f, 0.f, 0.f, 0.f};
            slab_mma<false, true>(Tm, KbT, w, lane, a);
#pragma unroll
            for (int nt = 0; nt < 4; ++nt) { u32x2 o; o.x = pk2(a[nt][0], a[nt][1]); o.y = pk2(a[nt][2], a[nt][3]); *(LAS u32x2*)(WT + (nt * 16 + r16) * LDSTR + 16 * w + 4 * g) = o; }
        }
        __syncthreads();
        {
            f32x4 a[4];
#pragma unroll
            for (int nt = 0; nt < 4; ++nt) a[nt] = (f32x4){0.f, 0.f, 0.f, 0.f};
            slab_mma<false, true>(Tm, VbT, w, lane, a);
#pragma unroll
            for (int nt = 0; nt < 4; ++nt) { u32x2 o; o.x = pk2(a[nt][0], a[nt][1]); o.y = pk2(a[nt][2], a[nt][3]); *(LAS u32x2*)(UT + (nt * 16 + r16) * LDSTR + 16 * w + 4 * g) = o; }
        }
        __syncthreads();
#pragma unroll 1
        for (int rep6 = 0; rep6 < 1 + ((DN_STEP_DUP >> 2) & 1); ++rep6) {
            const float egl = __expf(gc_s[63]);
            bf16* Mg = B.MN() + (size_t)it * 8192; bf16* NTg = Mg + 4096;
            bf16* Qg = B.QO() + ((size_t)((bh * 2 + dir) * 32 + tc)) * 8192; bf16* OTg = Qg + 4096;
            f32x4 a[4];
#pragma unroll
            for (int nt = 0; nt < 4; ++nt) a[nt] = (f32x4){0.f, 0.f, 0.f, 0.f};
            slab_mma<false, true>(WT, KdT, w, lane, a);
#pragma unroll
            for (int nt = 0; nt < 4; ++nt) { const int ra = nt * 16 + r16, cb = 16 * w + 4 * g; u32x2 o;
                o.x = pk2((ra == cb ? egl : 0.f) - a[nt][0], (ra == cb + 1 ? egl : 0.f) - a[nt][1]); o.y = pk2((ra == cb + 2 ? egl : 0.f) - a[nt][2], (ra == cb + 3 ? egl : 0.f) - a[nt][3]);
                *(u32x2*)(Mg + (((ra >> 4) * 2 + (cb >> 5)) * 64 + ((cb & 31) >> 3) * 16 + (ra & 15)) * 8 + (cb & 7)) = o; }
#pragma unroll
            for (int nt = 0; nt < 4; ++nt) a[nt] = (f32x4){0.f, 0.f, 0.f, 0.f};
            slab_mma<true, false>(KdT, UT, w, lane, a);
#pragma unroll
            for (int nt = 0; nt < 4; ++nt) { u32x2 o; o.x = pk2(a[nt][0], a[nt][1]); o.y = pk2(a[nt][2], a[nt][3]); *(u32x2*)(NTg + ((nt * 4 + w) * 64 + g * 16 + r16) * 4) = o; }
#pragma unroll
            for (int nt = 0; nt < 4; ++nt) a[nt] = (f32x4){0.f, 0.f, 0.f, 0.f};
            slab_mma(WT, IN, w, lane, a);
#pragma unroll
            for (int nt = 0; nt < 4; ++nt) { const int i = nt * 16 + r16, cb = 16 * w + 4 * g, ro = dir ? 63 - i : i;
                const float sc = 0.125f * __expf(gc_s[i]);
                const u32x2 qv = *(const LAS u32x2*)(Qr + i * LDSTR + cb);
                u32x2 o; o.x = pk2(bf2f(qv.x & 0xffffu) * sc - a[nt][0], bf2f(qv.x >> 16) * sc - a[nt][1]); o.y = pk2(bf2f(qv.y & 0xffffu) * sc - a[nt][2], bf2f(qv.y >> 16) * sc - a[nt][3]);
                *(u32x2*)(Qg + (((ro >> 4) * 2 + (cb >> 5)) * 64 + ((cb & 31) >> 3) * 16 + (ro & 15)) * 8 + (cb & 7)) = o; }
#pragma unroll
            for (int nt = 0; nt < 4; ++nt) a[nt] = (f32x4){0.f, 0.f, 0.f, 0.f};
            slab_mma(UT, IN, w, lane, a);
#pragma unroll
            for (int nt = 0; nt < 4; ++nt) { const int i = nt * 16 + r16, ro = dir ? 63 - i : i; u32x2 o; o.x = pk2(a[nt][0], a[nt][1]); o.y = pk2(a[nt][2], a[nt][3]);
                *(u32x2*)(OTg + (((ro >> 4) * 4 + w) * 64 + g * 16 + (ro & 15)) * 4) = o; }
        }
    }
#undef DN_GATE_PREFETCH
#undef DN_L2_PREFETCH
}

template <int VARIANT = 0>
__device__ __forceinline__ void phase_dnscan(const Params& p, const DnBufs& B, LAS unsigned char* lds) {
    const int tid = fresh_tid(), lane = tid & 63, wave = tid >> 6;
    const int r16 = lane & 15, g = lane >> 4;
    if (wave < 4) {
    const int vp = wave;
    LAS bf16* St = (LAS bf16*)(lds + wave * (16 * LDSTR * 2));
    for (int chain = blockIdx.x; chain < 128; chain += gridDim.x) {
    f32x4 sacc[4];
#pragma unroll
    for (int mt = 0; mt < 4; ++mt) sacc[mt] = (f32x4){0.f, 0.f, 0.f, 0.f};
    bf16x8 mf[4][4][2]; u32x2 nf[4][4];
    if (VARIANT == 2) {
#pragma unroll
        for (int a_ = 0; a_ < 4; ++a_)
#pragma unroll
            for (int b_ = 0; b_ < 4; ++b_) { mf[a_][b_][0] = (bf16x8){0,0,0,0,0,0,0,0}; mf[a_][b_][1] = mf[a_][b_][0]; nf[a_][b_] = (u32x2){0u, 0u}; }
    }
    const bf16* MN0 = B.MN() + (size_t)chain * 32 * 8192;
    bf16* SB0 = B.SB() + (size_t)chain * 32 * 4096;
#define SCAN_LOAD(slot, step) do { if (VARIANT == 2) break; const bf16* Mg_ = MN0 + (size_t)(step) * 8192; const bf16* NTg_ = Mg_ + 4096; \
        _Pragma("unroll") for (int mt = 0; mt < 4; ++mt) { mf[slot][mt][0] = *(const bf16x8*)(Mg_ + ((mt * 2) * 64 + lane) * 8); mf[slot][mt][1] = *(const bf16x8*)(Mg_ + ((mt * 2 + 1) * 64 + lane) * 8); \
            nf[slot][mt] = *(const u32x2*)(NTg_ + ((vp * 4 + mt) * 64 + lane) * 4); } } while (0)
#define SCAN_STEP(slot, step) do { bf16* Sg_ = SB0 + (size_t)(step) * 4096; \
        _Pragma("unroll") for (int mt = 0; mt < 4; ++mt) { u32x2 o; o.x = pk2(sacc[mt][0], sacc[mt][1]); o.y = pk2(sacc[mt][2], sacc[mt][3]); \
            if (VARIANT == 0) *(u32x2*)(Sg_ + ((vp * 2 + (mt >> 1)) * 64 + (2 * (mt & 1) + (g >> 1)) * 16 + r16) * 8 + 4 * (g & 1)) = o; *(LAS u32x2*)(St + r16 * LDSTR + mt * 16 + 4 * g) = o; } \
        LDS_WAIT(); \
        const bf16x8 s0 = *(const LAS bf16x8*)(St + r16 * LDSTR + 8 * g), s1 = *(const LAS bf16x8*)(St + r16 * LDSTR + 32 + 8 * g); \
        _Pragma("unroll") for (int mt = 0; mt < 4; ++mt) { const u32x2 nv = nf[slot][mt]; \
            f32x4 a = {bf2f(nv.x & 0xffffu), bf2f(nv.x >> 16), bf2f(nv.y & 0xffffu), bf2f(nv.y >> 16)}; \
            a = mfma16(mf[slot][mt][0], s0, a); a = mfma16(mf[slot][mt][1], s1, a); sacc[mt] = a; } \
        LDS_WAIT(); } while (0)
#define SCAN_PIN() asm volatile("" ::: "memory")
    SCAN_LOAD(0, 0); SCAN_LOAD(1, 1); SCAN_LOAD(2, 2); SCAN_PIN();
#pragma unroll
    for (int c0 = 0; c0 < 32; c0 += 4) {
        SCAN_LOAD(3, c0 + 3); SCAN_PIN();
        SCAN_STEP(0, c0); SCAN_PIN();
        if (c0 + 4 < 32) { SCAN_LOAD(0, c0 + 4); SCAN_PIN(); }
        SCAN_STEP(1, c0 + 1); SCAN_PIN();
        if (c0 + 5 < 32) { SCAN_LOAD(1, c0 + 5); SCAN_PIN(); }
        SCAN_STEP(2, c0 + 2); SCAN_PIN();
        if (c0 + 6 < 32) { SCAN_LOAD(2, c0 + 6); SCAN_PIN(); }
        SCAN_STEP(3, c0 + 3); SCAN_PIN();
    }
#undef SCAN_PIN
#undef SCAN_LOAD
#undef SCAN_STEP
    }
    }
}

__device__ __forceinline__ void phase_dnout(const Params& p, const DnBufs& B) {
    const int tid = fresh_tid(), lane = tid & 63, wave = tid >> 6, G = gridDim.x;
    const int r16 = lane & 15, g = lane >> 4;
    for (int task = blockIdx.x * 8 + wave; task < 8192; task += G * 8) {
        const int w = task & 3, tc = (task >> 2) & 31, bh = task >> 7, h = bh & 7, b = bh >> 3;
        f32x4 acc[4];
#pragma unroll
        for (int vt = 0; vt < 4; ++vt) acc[vt] = (f32x4){0.f, 0.f, 0.f, 0.f};
#pragma unroll
        for (int dir = 0; dir < 2; ++dir) {
            const int cc = dir ? 31 - tc : tc;
            const bf16* Qg = B.QO() + ((size_t)((bh * 2 + dir) * 32 + tc)) * 8192; const bf16* O0g = Qg + 4096;
            const bf16* Sg = B.SB() + ((size_t)((bh * 2 + dir) * 32 + cc)) * 4096;
            const bf16x8 q0 = *(const bf16x8*)(Qg + ((w * 2) * 64 + lane) * 8), q1 = *(const bf16x8*)(Qg + ((w * 2 + 1) * 64 + lane) * 8);
#pragma unroll
            for (int vt = 0; vt < 4; ++vt) {
                const u32x2 ov = *(const u32x2*)(O0g + ((w * 4 + vt) * 64 + lane) * 4);
                acc[vt][0] += bf2f(ov.x & 0xffffu); acc[vt][1] += bf2f(ov.x >> 16); acc[vt][2] += bf2f(ov.y & 0xffffu); acc[vt][3] += bf2f(ov.y >> 16);
                const bf16x8 s0 = *(const bf16x8*)(Sg + ((vt * 2) * 64 + lane) * 8), s1 = *(const bf16x8*)(Sg + ((vt * 2 + 1) * 64 + lane) * 8);
                acc[vt] = mfma16(s0, q0, acc[vt]); acc[vt] = mfma16(s1, q1, acc[vt]);
            }
        }
        float ss = 0.f;
#pragma unroll
        for (int vt = 0; vt < 4; ++vt)
#pragma unroll
            for (int r = 0; r < 4; ++r) ss = fmaf(acc[vt][r], acc[vt][r], ss);
        ss += __shfl_xor(ss, 16); ss += __shfl_xor(ss, 32);
        const float rn = rsqrtf(ss * (1.f / 64.f) + RMS_EPS);
        const int t = tc * 64 + 16 * w + r16;
#pragma unroll
        for (int vt = 0; vt < 4; ++vt) {
            const int v = vt * 16 + 4 * g;
            const u32x2 zv = *(const u32x2*)(p.Z() + ((size_t)bh * 2048 + t) * 64 + v);
            const f32x4 nw = *(const f32x4*)(p.norm_w + v);
            u32x2 o; o.x = pk2(acc[vt][0] * rn * nw[0] * bf2f(zv.x & 0xffffu), acc[vt][1] * rn * nw[1] * bf2f(zv.x >> 16));
            o.y = pk2(acc[vt][2] * rn * nw[2] * bf2f(zv.y & 0xffffu), acc[vt][3] * rn * nw[3] * bf2f(zv.y >> 16));
            *(u32x2*)(p.DNOUT() + ((size_t)b * 2048 + t) * 512 + h * 64 + v) = o;
        }
    }
}
struct MixBufs { char* ws; char* out;
    __device__ __forceinline__ bf16* GB() const { return WSP(bf16, 179); }
    __device__ __forceinline__ bf16* MERGED() const { return WSP(bf16, 211); }
    __device__ __forceinline__ float* V() const { return (float*)out; } };
template <int MODE>
struct EpiMerge {
    static constexpr bool PERM = true, AFTER_DRAIN = false;
    bf16* GB; bf16* MG;
    __device__ __forceinline__ void operator()(const pg8::f32x4 (&acc)[2][2][4][2], const pg8::Unit& u, int wr, int wc, int fr, int fq) const {
#pragma unroll
        for (int ai = 0; ai < 2; ++ai)
#pragma unroll
            for (int m = 0; m < 4; ++m) {
                const size_t row = (size_t)u.pm * 256 + ai * 128 + wr * 64 + m * 16 + fr;
#pragma unroll
                for (int bj = 0; bj < 2; ++bj) {
                    const int col = u.pn * 256 + bj * 128 + wc * 32 + 8 * fq;
                    const pg8::f32x4 v0 = acc[ai][bj][m][0], v1 = acc[ai][bj][m][1];
                    float e[8] = {v0[0], v0[1], v0[2], v0[3], v1[0], v1[1], v1[2], v1[3]};
                    if (MODE == 0) {
#pragma unroll
                        for (int j = 0; j < 8; ++j) e[j] = sigmoidf_(e[j]);
                    } else {
                        const u32x4 gw = *(const u32x4*)(GB + row * 1024 + col);
                        const unsigned gws[4] = {gw.x, gw.y, gw.z, gw.w};
#pragma unroll
                        for (int j = 0; j < 4; ++j) { e[2 * j] *= bf2f(gws[j] & 0xffffu); e[2 * j + 1] *= bf2f(gws[j] >> 16); }
                        if (MODE == 2) {
                            const u32x4 mw = *(const u32x4*)(MG + row * 1024 + col);
                            const unsigned mws[4] = {mw.x, mw.y, mw.z, mw.w};
#pragma unroll
                            for (int j = 0; j < 4; ++j) { e[2 * j] += bf2f(mws[j] & 0xffffu); e[2 * j + 1] += bf2f(mws[j] >> 16); }
                        }
                    }
                    u32x4 w; w.x = pk2(e[0], e[1]); w.y = pk2(e[2], e[3]); w.z = pk2(e[4], e[5]); w.w = pk2(e[6], e[7]);
                    *(u32x4*)((MODE == 0 ? GB : MG) + row * 1024 + col) = w;
                }
            }
    }
};
struct EpiOutProj {
    static constexpr bool PERM = false, AFTER_DRAIN = false;
    const float* x; float* V;
    __device__ __forceinline__ void operator()(const pg8::f32x4 (&acc)[2][2][4][2], const pg8::Unit& u, int wr, int wc, int fr, int fq) const {
#pragma unroll
        for (int ai = 0; ai < 2; ++ai)
#pragma unroll
            for (int m = 0; m < 4; ++m) {
                const size_t row = (size_t)u.pm * 256 + ai * 128 + wr * 64 + m * 16 + fr;
#pragma unroll
                for (int bj = 0; bj < 2; ++bj)
#pragma unroll
                    for (int n = 0; n < 2; ++n) {
                        const int col = u.pn * 256 + bj * 128 + wc * 32 + 16 * n + 4 * fq;
                        const f32x4 xv = *(const f32x4*)(x + row * 1024 + col);
                        const pg8::f32x4 a = acc[ai][bj][m][n];
                        f32x4 o = {ALPHA * xv[0] + a[0], ALPHA * xv[1] + a[1], ALPHA * xv[2] + a[2], ALPHA * xv[3] + a[3]};
                        *(f32x4*)(V + row * 1024 + col) = o;
                    }
            }
    }
};
__device__ __forceinline__ void phase_merge(const Params& p, const MixBufs& B, LAS unsigned char* lds) {
    pg8::StaticOrder S; S.init(NTOK, 1024, gridDim.x, (int)blockIdx.x);
    { pg8::Gemm g{p.XB(), p.WG(), NTOK, 1024, 1024}; EpiMerge<0> E{B.GB(), B.MERGED()}; pg8::gemm_phase<EpiMerge<0>, pg8::StaticOrder, true, true>(lds, g, S, E); }
    { pg8::Gemm g{p.NAOUT(), p.WPNA(), NTOK, 1024, 512}; EpiMerge<1> E{B.GB(), B.MERGED()}; pg8::gemm_phase<EpiMerge<1>, pg8::StaticOrder, true, true>(lds, g, S, E); }
    { pg8::Gemm g{p.XB(), p.WG() + (size_t)1024 * 1024, NTOK, 1024, 1024}; EpiMerge<0> E{B.GB(), B.MERGED()}; pg8::gemm_phase<EpiMerge<0>, pg8::StaticOrder, true, true>(lds, g, S, E); }
    { pg8::Gemm g{p.DNOUT(), p.WPDN(), NTOK, 1024, 512}; EpiMerge<2> E{B.GB(), B.MERGED()}; pg8::gemm_phase<EpiMerge<2>, pg8::StaticOrder, true, true>(lds, g, S, E); }
}
__device__ __forceinline__ void phase_outproj(const Params& p, const MixBufs& B, LAS unsigned char* lds) {
    pg8::StaticOrder S; S.init(NTOK, 1024, gridDim.x, (int)blockIdx.x);
    pg8::Gemm g{B.MERGED(), p.WOUT(), NTOK, 1024, 1024}; EpiOutProj E{p.x, B.V()};
    pg8::gemm_phase<EpiOutProj, pg8::StaticOrder, true, true>(lds, g, S, E);
}
struct MoeBufs { char* ws; char* out; int kdown;
#define TBP(T, kb) ((T*)(ws + ((size_t)243 << 20) + ((size_t)(kb) << 10)))
    __device__ __forceinline__ const float* V() const { return (const float*)out; }
    __device__ __forceinline__ bf16* X1B() const { return WSP(bf16, 17); }
    __device__ __forceinline__ bf16* XS() const { return WSP(bf16, 97); }
    __device__ __forceinline__ bf16* HID() const { return WSP(bf16, 211); }
    __device__ __forceinline__ bf16* YPART() const { return WSP(bf16, 97); }
    __device__ __forceinline__ int* CNT() const { return TBP(int, 0); }
    __device__ __forceinline__ int* ROUTE() const { return TBP(int, 64); }
    __device__ __forceinline__ float* ROUTEP() const { return TBP(float, 384); }
    __device__ __forceinline__ int* ROWINFO() const { return TBP(int, 576); }
    __device__ __forceinline__ float* ROWPW() const { return TBP(float, 768); }
    __device__ __forceinline__ float* STATS() const { return TBP(float, 960); }
    __device__ __forceinline__ bf16* RWH() const { return TBP(bf16, 1152); }
    __device__ __forceinline__ bf16* RWL() const { return TBP(bf16, 1280); }
};
#define XSTR 1032
#define TAB_OFF 131072
#define MOE_OVF_BASE 32768

__device__ __forceinline__ void phase0_router(const Params& p, const MoeBufs& B) {
    const size_t gt = (size_t)blockIdx.x * NT + fresh_tid(), GT = (size_t)gridDim.x * NT;
    for (size_t i = gt; i < 48 * 1024; i += GT) {
        const int n = (int)(i >> 10), k = (int)(i & 1023);
        const float w = n < 4 ? p.wrg[k * 4 + n] : (n < 36 ? p.wre[k * 32 + n - 4] : 0.f);
        const unsigned hi = f2bf(w); const float lo = w - bf2f(hi);
        B.RWH()[i] = (bf16)hi; B.RWL()[i] = (bf16)f2bf(lo);
    }
}

__device__ __forceinline__ float wave_sum64(float v) {
#pragma unroll
    for (int o = 1; o < 64; o <<= 1) v += __shfl_xor(v, o);
    return v;
}

__device__ __forceinline__ void phase_ln1(const Params& p, const MoeBufs& B, LAS unsigned char* lds) {
    const int tid = fresh_tid(), lane = tid & 63, wave = tid >> 6;
    const int r16 = lane & 15, g = lane >> 4;
    LAS bf16* XH = (LAS bf16*)lds;
    LAS bf16* XL = (LAS bf16*)(lds + 16 * XSTR * 2);
    LAS float* PART = (LAS float*)(lds + 2 * 16 * XSTR * 2);
    LAS float* LOG = PART + 8 * 16 * 48;
    LAS int* hist = (LAS int*)(LOG + 16 * 36);
    if (tid < 32) hist[tid] = 0;
    for (int i = blockIdx.x * NT + tid; i < 40960; i += gridDim.x * NT) B.ROWINFO()[i] = -1;
    bf16x8 rbh[4][3], rbl[4][3];
#pragma unroll
    for (int ks = 0; ks < 4; ++ks)
#pragma unroll
        for (int nt = 0; nt < 3; ++nt) { const int k0 = wave * 128 + ks * 32 + 8 * g;
            rbh[ks][nt] = *(const bf16x8*)(B.RWH() + (size_t)(nt * 16 + r16) * 1024 + k0); rbl[ks][nt] = *(const bf16x8*)(B.RWL() + (size_t)(nt * 16 + r16) * 1024 + k0); }
    for (int blk = blockIdx.x; blk < 256; blk += gridDim.x) {
        f32x4 vpre[2][4];
#pragma unroll
        for (int q = 0; q < 2; ++q)
#pragma unroll
            for (int j = 0; j < 4; ++j) vpre[q][j] = *(const f32x4*)(B.V() + ((size_t)blk * 64 + 2 * wave + q) * 1024 + 4 * lane + 256 * j);
        for (int itn = 0; itn < 4; ++itn) {
            __syncthreads();
#pragma unroll
            for (int q = 0; q < 2; ++q) {
                const int lt = 2 * wave + q; const size_t tg = (size_t)blk * 64 + itn * 16 + lt;
                f32x4 v[4]; float s = 0.f;
#pragma unroll
                for (int j = 0; j < 4; ++j) { v[j] = vpre[q][j]; s += (v[j][0] + v[j][1]) + (v[j][2] + v[j][3]); }
                if (itn < 3) {
#pragma unroll
                    for (int j = 0; j < 4; ++j) vpre[q][j] = *(const f32x4*)(B.V() + (tg + 16) * 1024 + 4 * lane + 256 * j);
                }
                const float mu = wave_sum64(s) * (1.f / 1024.f);
                float qq = 0.f;
#pragma unroll
                for (int j = 0; j < 4; ++j) { v[j] = v[j] - mu; qq += (v[j][0] * v[j][0] + v[j][1] * v[j][1]) + (v[j][2] * v[j][2] + v[j][3] * v[j][3]); }
                const float rstd = rsqrtf(wave_sum64(qq) * (1.f / 1024.f) + LN_EPS);
                if (lane == 0) { B.STATS()[tg * 2] = mu; B.STATS()[tg * 2 + 1] = rstd; }
#pragma unroll
                for (int j = 0; j < 4; ++j) {
                    const int c = 4 * lane + 256 * j;
                    const f32x4 gg = *(const f32x4*)(p.ln1_g + c), bb = *(const f32x4*)(p.ln1_b + c);
                    float y[4]; unsigned hi[4]; float lo[4];
#pragma unroll
                    for (int e = 0; e < 4; ++e) { y[e] = v[j][e] * rstd * gg[e] + bb[e]; hi[e] = f2bf(y[e]); lo[e] = y[e] - bf2f(hi[e]); }
                    u32x2 hw; hw.x = hi[0] | (hi[1] << 16); hw.y = hi[2] | (hi[3] << 16);
                    u32x2 lw; lw.x = pk2(lo[0], lo[1]); lw.y = pk2(lo[2], lo[3]);
                    *(u32x2*)(B.X1B() + tg * 1024 + c) = hw;
                    *(LAS u32x2*)(XH + lt * XSTR + c) = hw; *(LAS u32x2*)(XL + lt * XSTR + c) = lw;
                }
            }
            __syncthreads();
            {
                f32x4 acc[3];
#pragma unroll
                for (int nt = 0; nt < 3; ++nt) acc[nt] = (f32x4){0.f, 0.f, 0.f, 0.f};
#pragma unroll
                for (int ks = 0; ks < 4; ++ks) {
                    const int k0 = wave * 128 + ks * 32 + 8 * g;
                    const bf16x8 ah = *(const LAS bf16x8*)(XH + r16 * XSTR + k0), al = *(const LAS bf16x8*)(XL + r16 * XSTR + k0);
#pragma unroll
                    for (int nt = 0; nt < 3; ++nt) {
                        acc[nt] = mfma16(ah, rbh[ks][nt], acc[nt]); acc[nt] = mfma16(ah, rbl[ks][nt], acc[nt]); acc[nt] = mfma16(al, rbh[ks][nt], acc[nt]);
                    }
                }
#pragma unroll
                for (int nt = 0; nt < 3; ++nt)
#pragma unroll
                    for (int r = 0; r < 4; ++r) PART[(wave * 16 + 4 * g + r) * 48 + nt * 16 + r16] = acc[nt][r];
            }
            __syncthreads();
            for (int idx = tid; idx < 16 * 36; idx += NT) {
                const int tk = idx / 36, n = idx % 36;
                float a = n < 4 ? p.brg[n] : p.bre[n - 4];
#pragma unroll
                for (int w2 = 0; w2 < 8; ++w2) a += PART[(w2 * 16 + tk) * 48 + n];
                LOG[tk * 36 + n] = a;
            }
            __syncthreads();
            if (tid < 16) {
                const LAS float* lg = LOG + tid * 36; const size_t tg = (size_t)blk * 64 + itn * 16 + tid;
                int gi = 0; float gm = lg[0];
                for (int q = 1; q < 4; ++q) if (lg[q] > gm) { gm = lg[q]; gi = q; }
                float gs = 0.f;
                for (int q = 0; q < 4; ++q) gs += expf(lg[q] - gm);
                const float gp = 1.f / gs;
                const LAS float* el = lg + 4 + gi * 8;
                int i1 = 0; float l1 = el[0];
                for (int e = 1; e < 8; ++e) if (el[e] > l1) { l1 = el[e]; i1 = e; }
                int i2 = -1; float l2 = -3.0e38f;
                for (int e = 0; e < 8; ++e) if (e != i1 && el[e] > l2) { l2 = el[e]; i2 = e; }
                const float e2 = expf(l2 - l1);
                const int e0 = gi * 8 + i1, e1 = gi * 8 + i2;
                const int r0 = atomicAdd((int*)&hist[e0], 1), r1 = atomicAdd((int*)&hist[e1], 1);
                B.ROUTE()[tg * 4] = e0; B.ROUTE()[tg * 4 + 1] = e1; B.ROUTE()[tg * 4 + 2] = r0; B.ROUTE()[tg * 4 + 3] = r1;
                B.ROUTEP()[tg * 2] = gp / (1.f + e2); B.ROUTEP()[tg * 2 + 1] = gp * e2 / (1.f + e2);
            }
        }
        __syncthreads();
        if (tid < 32) { B.CNT()[blk * 32 + tid] = hist[tid]; hist[tid] = 0; }
    }
}

__device__ __forceinline__ void moe_tables(const MoeBufs& B, LAS unsigned char* lds, int nj, int blk) {
    const int tid = fresh_tid();
    LAS int* tab = (LAS int*)(lds + TAB_OFF);
    LAS int* scr = tab + 256;
    {
        const int e = tid & 31, q = tid >> 5; int tot = 0, pre = 0;
        for (int b2 = q * 16; b2 < q * 16 + 16; ++b2) { const int c = B.CNT()[b2 * 32 + e]; tot += c; if (b2 < blk) pre += c; }
        scr[q * 64 + e] = tot; scr[q * 64 + 32 + e] = pre;
    }
    __syncthreads();
    if (tid < 32) { int tot = 0, pre = 0; for (int q = 0; q < 16; ++q) { tot += scr[q * 64 + tid]; pre += scr[q * 64 + 32 + tid]; } tab[66 + tid] = tot; tab[99 + tid] = pre; }
    __syncthreads();
    if (tid == 0) { int cum = 0, off = 0, og = 0; for (int e = 0; e < 32; ++e) { tab[e] = cum; tab[33 + e] = off; tab[132 + e] = og; const int tot = tab[66 + e]; int nrt = (tot + 255) >> 8; nrt = nrt > 4 ? 4 : nrt;
            cum += nrt * nj; off += nrt; og += tot > 1024 ? (tot - 1024 + 15) >> 4 : 0; } tab[32] = cum; tab[164] = og; }
    __syncthreads();
}

__device__ __forceinline__ void phase_gather(const Params& p, const MoeBufs& B, LAS unsigned char* lds) {
    const int tid = fresh_tid(), lane = tid & 63, wave = tid >> 6;
    LAS int* tab = (LAS int*)(lds + TAB_OFF);
    for (int blk = blockIdx.x; blk < 256; blk += gridDim.x) {
    moe_tables(B, lds, 2, blk);
    for (int sl = wave; sl < 128; sl += 8) {
        const int lt = sl >> 1, k = sl & 1; const size_t tg = (size_t)blk * 64 + lt;
        const int e = B.ROUTE()[tg * 4 + k], lr = B.ROUTE()[tg * 4 + 2 + k];
        const int lrg = tab[99 + e] + lr;
        const size_t row = lrg < 1024 ? (size_t)tab[33 + e] * 256 + lrg : (size_t)MOE_OVF_BASE + tab[132 + e] * 16 + (lrg - 1024);
        const u32x4 a = *(const u32x4*)(B.X1B() + tg * 1024 + lane * 8), b2 = *(const u32x4*)(B.X1B() + tg * 1024 + 512 + lane * 8);
        *(u32x4*)(B.XS() + row * 1024 + lane * 8) = a; *(u32x4*)(B.XS() + row * 1024 + 512 + lane * 8) = b2;
        if (lane == 0) { B.ROWINFO()[row] = (int)tg * 2 + k; B.ROWPW()[row] = B.ROUTEP()[tg * 2 + k]; }
    }
    __syncthreads();
    }
}

struct MoeSched {
    const LAS int* tab; int G, c, nj;
    __device__ __forceinline__ bool next(int i, pg8::Unit& u) const {
        int L = i * G + c; const int U = tab[32]; if (L >= U) return false;
        { const int q = U >> 3, r = U & 7, xcd = L & 7, off = L >> 3; L = (xcd < r ? xcd * (q + 1) : r * (q + 1) + (xcd - r) * q) + off; }
        int e = 0;
#pragma unroll
        for (int k = 1; k < 32; ++k) e += (L >= tab[k]) ? 1 : 0;
        const int rem = L - tab[e], j = rem % nj, rt = rem / nj;
        u.pm = tab[33 + e] + rt; u.pn = e * nj + j; return true;
    }
    __device__ __forceinline__ void a_ready(const pg8::Unit&) const {}
    __device__ __forceinline__ void done(const pg8::Unit&) const {}
};
struct EpiGateUp {
    static constexpr bool PERM = true, AFTER_DRAIN = false;
    bf16* HID; const float* ROWPW;
    __device__ __forceinline__ void operator()(const pg8::f32x4 (&acc)[2][2][4][2], const pg8::Unit& u, int wr, int wc, int fr, int fq) const {
#pragma unroll
        for (int ai = 0; ai < 2; ++ai)
#pragma unroll
            for (int m = 0; m < 4; ++m) {
                const size_t row = (size_t)u.pm * 256 + ai * 128 + wr * 64 + m * 16 + fr;
                const float pw = ROWPW[row];
                const int f = (u.pn & 1) * 128 + wc * 32 + 8 * fq;
                const pg8::f32x4 g0 = acc[ai][0][m][0], g1 = acc[ai][0][m][1], u0 = acc[ai][1][m][0], u1 = acc[ai][1][m][1];
                float e[8];
#pragma unroll
                for (int j = 0; j < 4; ++j) { e[j] = siluf_(g0[j]) * u0[j] * pw; e[4 + j] = siluf_(g1[j]) * u1[j] * pw; }
                u32x4 w; w.x = pk2(e[0], e[1]); w.y = pk2(e[2], e[3]); w.z = pk2(e[4], e[5]); w.w = pk2(e[6], e[7]);
                *(u32x4*)(HID + row * 256 + f) = w;
            }
    }
};
struct EpiDown {
    static constexpr bool PERM = true, AFTER_DRAIN = false;
    bf16* YPART; const int* ROWINFO;
    __device__ __forceinline__ void operator()(const pg8::f32x4 (&acc)[2][2][4][2], const pg8::Unit& u, int wr, int wc, int fr, int fq) const {
        const int j = u.pn & 3;
#pragma unroll
        for (int ai = 0; ai < 2; ++ai)
#pragma unroll
            for (int m = 0; m < 4; ++m) {
                const int row = u.pm * 256 + ai * 128 + wr * 64 + m * 16 + fr;
                asm volatile("" ::: "memory");
                const int info = ROWINFO[row];
                if (info >= 0) {
                    const size_t tg = (size_t)(info >> 1); const int k = info & 1;
#pragma unroll
                    for (int bj = 0; bj < 2; ++bj) {
                        const int col = j * 256 + bj * 128 + wc * 32 + 8 * fq;
                        const pg8::f32x4 v0 = acc[ai][bj][m][0], v1 = acc[ai][bj][m][1];
                        u32x4 w; w.x = pk2(v0[0], v0[1]); w.y = pk2(v0[2], v0[3]); w.z = pk2(v1[0], v1[1]); w.w = pk2(v1[2], v1[3]);
                        *(u32x4*)(YPART + ((size_t)k * NTOK + tg) * 1024 + col) = w;
                    }
                }
            }
    }
};
__device__ __forceinline__ void moe1_overflow(const Params& p, const MoeBufs& B, LAS unsigned char* lds) {
    const int tid = fresh_tid(), lane = tid & 63, wave = tid >> 6, r16 = lane & 15, g = lane >> 4;
    const LAS int* tab = (const LAS int*)(lds + TAB_OFF);
    LAS float* part = (LAS float*)lds;
    const int ntask = tab[164] * 8;
    for (int tk = blockIdx.x; tk < ntask; tk += gridDim.x) {
        const int t = tk >> 3, fc = tk & 7;
        int e = 0;
#pragma unroll
        for (int k = 1; k < 32; ++k) e += (t >= tab[132 + k]) ? 1 : 0;
        const size_t R0 = (size_t)MOE_OVF_BASE + (size_t)t * 16;
        const bf16* A = B.XS() + (R0 + r16) * 1024 + wave * 128 + 8 * g;
        const bf16* Wg = p.WGU() + ((size_t)e * 512 + (fc >> 2) * 256 + 32 * (fc & 3) + r16) * 1024 + wave * 128 + 8 * g;
        f32x4 acc[4];
#pragma unroll
        for (int q = 0; q < 4; ++q) acc[q] = (f32x4){0.f, 0.f, 0.f, 0.f};
#pragma unroll
        for (int ks = 0; ks < 4; ++ks) {
            const bf16x8 a = *(const bf16x8*)(A + ks * 32);
#pragma unroll
            for (int q = 0; q < 4; ++q) acc[q] = mfma16(a, *(const bf16x8*)(Wg + (size_t)((q >> 1) * 128 + 16 * (q & 1)) * 1024 + ks * 32), acc[q]);
        }
        __syncthreads();
#pragma unroll
        for (int q = 0; q < 4; ++q) *(LAS f32x4*)(part + ((wave * 4 + q) * 64 + lane) * 4) = acc[q];
        __syncthreads();
        {
            const int fs = tid >> 8, l2 = (tid >> 2) & 63, r = tid & 3;
            float gs = 0.f, us = 0.f;
#pragma unroll
            for (int w2 = 0; w2 < 8; ++w2) { gs += part[((w2 * 4 + fs) * 64 + l2) * 4 + r]; us += part[((w2 * 4 + 2 + fs) * 64 + l2) * 4 + r]; }
            const size_t row = R0 + 4 * (l2 >> 4) + r;
            B.HID()[row * 256 + 32 * fc + 16 * fs + (l2 & 15)] = (bf16)f2bf(siluf_(gs) * us * B.ROWPW()[row]);
        }
    }
}
__device__ __forceinline__ void moe2_overflow(const Params& p, const MoeBufs& B, LAS unsigned char* lds) {
    const int tid = fresh_tid(), lane = tid & 63, wave = tid >> 6, r16 = lane & 15, g = lane >> 4;
    const LAS int* tab = (const LAS int*)(lds + TAB_OFF);
    LAS float* part = (LAS float*)lds;
    const int ntask = tab[164] * 8;
    for (int tk = blockIdx.x; tk < ntask; tk += gridDim.x) {
        const int t = tk >> 3, nc = tk & 7;
        int e = 0;
#pragma unroll
        for (int k = 1; k < 32; ++k) e += (t >= tab[132 + k]) ? 1 : 0;
        const size_t R0 = (size_t)MOE_OVF_BASE + (size_t)t * 16;
        const bf16x8 a = *(const bf16x8*)(B.HID() + (R0 + r16) * 256 + wave * 32 + 8 * g);
        const bf16* W = p.WD() + ((size_t)e * 1024 + 128 * nc + r16) * 256 + wave * 32 + 8 * g;
        __syncthreads();
#pragma unroll
        for (int nt = 0; nt < 8; ++nt) { const f32x4 v = mfma16(a, *(const bf16x8*)(W + (size_t)(16 * nt) * 256), (f32x4){0.f, 0.f, 0.f, 0.f});
            *(LAS f32x4*)(part + ((wave * 8 + nt) * 64 + lane) * 4) = v; }
        __syncthreads();
#pragma unroll
        for (int q = 0; q < 4; ++q) {
            const int idx = tid + q * NT, nt = idx >> 8, l2 = (idx >> 2) & 63, r = idx & 3;
            float s = 0.f;
#pragma unroll
            for (int w2 = 0; w2 < 8; ++w2) s += part[((w2 * 8 + nt) * 64 + l2) * 4 + r];
            const int info = B.ROWINFO()[R0 + 4 * (l2 >> 4) + r];
            if (info >= 0) B.YPART()[((size_t)(info & 1) * NTOK + (size_t)(info >> 1)) * 1024 + 128 * nc + 16 * nt + (l2 & 15)] = (bf16)f2bf(s);
        }
    }
}
__device__ __forceinline__ void phase_moe1(const Params& p, const MoeBufs& B, LAS unsigned char* lds) {
    moe_tables(B, lds, 2, 0);
    MoeSched S{(const LAS int*)(lds + TAB_OFF), (int)gridDim.x, (int)blockIdx.x, 2};
    pg8::Gemm g{B.XS(), p.WGU(), 0, 0, 1024}; EpiGateUp E{B.HID(), B.ROWPW()};
    pg8::gemm_phase<EpiGateUp, MoeSched, true, true>(lds, g, S, E);
    moe1_overflow(p, B, lds);
}
__device__ __forceinline__ void phase_moe2(const Params& p, const MoeBufs& B, LAS unsigned char* lds) {
    moe_tables(B, lds, 4, 0);
    MoeSched S{(const LAS int*)(lds + TAB_OFF), (int)gridDim.x, (int)blockIdx.x, 4};
    pg8::Gemm g{B.HID(), p.WD(), 0, 0, B.kdown}; EpiDown E{B.YPART(), B.ROWINFO()};
    pg8::gemm_phase<EpiDown, MoeSched, true, true>(lds, g, S, E);
    moe2_overflow(p, B, lds);
}
__device__ __forceinline__ void phase_ln2(const Params& p, const MoeBufs& B) {
    const int tid = fresh_tid(), lane = tid & 63, wave = tid >> 6;
    for (size_t tg = (size_t)blockIdx.x * 8 + wave; tg < NTOK; tg += (size_t)gridDim.x * 8) {
        const float mu1 = B.STATS()[tg * 2], rstd1 = B.STATS()[tg * 2 + 1];
        f32x4 v[4]; float s = 0.f;
#pragma unroll
        for (int j = 0; j < 4; ++j) {
            const int c = 4 * lane + 256 * j;
            const f32x4 x = *(const f32x4*)(B.V() + tg * 1024 + c);
            const f32x4 gg = *(const f32x4*)(p.ln1_g + c), bb = *(const f32x4*)(p.ln1_b + c);
            const u32x2 y0 = *(const u32x2*)(B.YPART() + tg * 1024 + c), y1 = *(const u32x2*)(B.YPART() + ((size_t)NTOK + tg) * 1024 + c);
            const float ya[4] = {bf2f(y0.x & 0xffffu) + bf2f(y1.x & 0xffffu), bf2f(y0.x >> 16) + bf2f(y1.x >> 16), bf2f(y0.y & 0xffffu) + bf2f(y1.y & 0xffffu), bf2f(y0.y >> 16) + bf2f(y1.y >> 16)};
#pragma unroll
            for (int e = 0; e < 4; ++e) { v[j][e] = ALPHA * ((x[e] - mu1) * rstd1 * gg[e] + bb[e]) + ya[e]; s += v[j][e]; }
        }
        const float mu = wave_sum64(s) * (1.f / 1024.f);
        float qq = 0.f;
#pragma unroll
        for (int j = 0; j < 4; ++j) { v[j] = v[j] - mu; qq += (v[j][0] * v[j][0] + v[j][1] * v[j][1]) + (v[j][2] * v[j][2] + v[j][3] * v[j][3]); }
        const float rstd = rsqrtf(wave_sum64(qq) * (1.f / 1024.f) + LN_EPS);
#pragma unroll
        for (int j = 0; j < 4; ++j) {
            const int c = 4 * lane + 256 * j;
            const f32x4 gg = *(const f32x4*)(p.ln2_g + c), bb = *(const f32x4*)(p.ln2_b + c);
            f32x4 o;
#pragma unroll
            for (int e = 0; e < 4; ++e) o[e] = v[j][e] * rstd * gg[e] + bb[e];
            *(f32x4*)(p.out + tg * 1024 + c) = o;
        }
    }
}
#ifndef SCAN_VARIANT
#define SCAN_VARIANT 0
#endif
#ifndef PH_DUP
#define PH_DUP 0
#endif
#ifndef PH_MASK
#define PH_MASK 8191
#endif
#define BAR_LDS_OFF (LDS_BYTES - 64)
struct MegaArgs { Params p; };
#define CAS __attribute__((address_space(4)))
#define GASC __attribute__((address_space(1)))
__device__ __forceinline__ Params load_params(const CAS char* kp) {
    Params p; const CAS unsigned long long* src = (const CAS unsigned long long*)kp;
    const float** pf = (const float**)&p;
#pragma unroll
    for (int i = 0; i < 22; ++i) pf[i] = (const float*)(const GASC float*)src[i];
    static_assert(offsetof(Params, out) == 22 * 8 && offsetof(Params, ws) == 23 * 8 && offsetof(Params, bar) == 24 * 8 && offsetof(Params, kdown) == 25 * 8, "Params layout");
    p.out = (float*)(GASC float*)src[22]; p.ws = (char*)(GASC char*)src[23]; p.bar = (unsigned*)(GASC unsigned*)src[24];
    p.kdown = (int)(src[25] & 0xffffffffu); p.pad0 = 0;
    return p;
}
#define FRESH_P(name) const CAS char* name##_kp = kptr; asm volatile("" : "+s"(name##_kp)); const Params name = load_params(name##_kp)
#define GRID_BAR() do { const CAS char* b_kp = kptr; asm volatile("" : "+s"(b_kp)); XcdBarrier bar; bar.bar = (unsigned*)(GASC unsigned*)(*(const CAS unsigned long long*)(b_kp + offsetof(Params, bar))); bar.x = xb_xcc_id(); \
        bar.st = (volatile LAS unsigned*)(lds + BAR_LDS_OFF); xcd_barrier(bar); } while (0)
__global__ void __launch_bounds__(NT, 2) mega_fwd(MegaArgs) {
    extern __shared__ __attribute__((aligned(16))) unsigned char lds_raw[];
    LAS unsigned char* lds = (LAS unsigned char*)lds_raw;
    const CAS char* kptr = (const CAS char*)__builtin_amdgcn_kernarg_segment_ptr();
    if (threadIdx.x < 16) ((LAS unsigned*)(lds + BAR_LDS_OFF))[threadIdx.x] = 0u;
    __syncthreads();
    { FRESH_P(p); (void)xcd_barrier_post(p.bar, (volatile LAS unsigned*)(lds + BAR_LDS_OFF)); }
#if PH_MASK & 1
    { FRESH_P(p); const MoeBufs Q{p.ws, (char*)p.out, p.kdown}; phase0(p, lds); phase0_router(p, Q); }
#endif
#if PH_DUP & 1
    GRID_BAR();
    { FRESH_P(p); const MoeBufs Q{p.ws, (char*)p.out, p.kdown}; phase0(p, lds); phase0_router(p, Q); }
#endif
    GRID_BAR();
#if PH_MASK & 2
    { FRESH_P(p); phase1(p, lds); }
#endif
#if PH_DUP & 2
    GRID_BAR();
    { FRESH_P(p); phase1(p, lds); }
#endif
    GRID_BAR();
#if PH_MASK & 4
    { FRESH_P(p); phase_na(p, lds); }
#endif
#if PH_DUP & 4
    GRID_BAR();
    { FRESH_P(p); phase_na(p, lds); }
    GRID_BAR();
#endif
#if PH_MASK & 8
    { FRESH_P(p); const DnBufs D{p.ws, (char*)p.out}; phase_dnprep(p, D, lds); }
#endif
#if PH_DUP & 8
    GRID_BAR();
    { FRESH_P(p); const DnBufs D{p.ws, (char*)p.out}; phase_dnprep(p, D, lds); }
    GRID_BAR();
#endif
    GRID_BAR();
#if PH_MASK & 16
    {
        FRESH_P(p); const DnBufs D{p.ws, (char*)p.out};
        const int nb = (int)gridDim.x;
        unsigned* counter = p.bar + XCD_BAR_WORDS;
        if ((int)blockIdx.x >= 128) phase_zgemm(p, lds, nb - 128, (int)blockIdx.x - 128);
        else if ((fresh_tid() >> 6) >= 4) phase0_moe(p, counter);
        if ((int)blockIdx.x < 128) phase_dnscan(p, D, lds);
        if ((int)blockIdx.x >= 128 || (fresh_tid() >> 6) < 4) phase0_moe(p, counter);
    }
#endif
#if PH_DUP & 16
    GRID_BAR();
    {
        FRESH_P(p); const DnBufs D{p.ws, (char*)p.out};
        const int nb = (int)gridDim.x;
        unsigned* counter = p.bar + XCD_BAR_WORDS;
#if !(PH_DUP & 8192)
        if ((int)blockIdx.x >= 128) phase_zgemm(p, lds, nb - 128, (int)blockIdx.x - 128);
#endif
        if ((int)blockIdx.x >= 128) {} else if ((fresh_tid() >> 6) >= 4) phase0_moe(p, counter);
#if !(PH_DUP & 16384)
        if ((int)blockIdx.x < 128) phase_dnscan<SCAN_VARIANT>(p, D, lds);
#endif
        if ((int)blockIdx.x >= 128 || (fresh_tid() >> 6) < 4) phase0_moe(p, counter);
    }
#endif
    GRID_BAR();
#if PH_MASK & 32
    { FRESH_P(p); const DnBufs D{p.ws, (char*)p.out}; phase_dnout(p, D); }
#endif
#if PH_DUP & 32
    GRID_BAR();
    { FRESH_P(p); const DnBufs D{p.ws, (char*)p.out}; phase_dnout(p, D); }
#endif
    GRID_BAR();
#if PH_MASK & 64
    { FRESH_P(p); const MixBufs X{p.ws, (char*)p.out}; phase_merge(p, X, lds); }
#endif
#if PH_DUP & 64
    GRID_BAR();
    { FRESH_P(p); const MixBufs X{p.ws, (char*)p.out}; phase_merge(p, X, lds); }
#endif
    GRID_BAR();
#if PH_MASK & 128
    { FRESH_P(p); const MixBufs X{p.ws, (char*)p.out}; phase_outproj(p, X, lds); }
#endif
#if PH_DUP & 128
    GRID_BAR();
    { FRESH_P(p); const MixBufs X{p.ws, (char*)p.out}; phase_outproj(p, X, lds); }
#endif
    GRID_BAR();
#if PH_MASK & 256
    { FRESH_P(p); const MoeBufs Q{p.ws, (char*)p.out, p.kdown}; phase_ln1(p, Q, lds); }
#endif
#if PH_DUP & 256
    GRID_BAR();
    { FRESH_P(p); const MoeBufs Q{p.ws, (char*)p.out, p.kdown}; phase_ln1(p, Q, lds); }
#endif
    GRID_BAR();
#if PH_MASK & 512
    { FRESH_P(p); const MoeBufs Q{p.ws, (char*)p.out, p.kdown}; phase_gather(p, Q, lds); }
#endif
#if PH_DUP & 512
    GRID_BAR();
    { FRESH_P(p); const MoeBufs Q{p.ws, (char*)p.out, p.kdown}; phase_gather(p, Q, lds); }
#endif
    GRID_BAR();
#if PH_MASK & 1024
    { FRESH_P(p); const MoeBufs Q{p.ws, (char*)p.out, p.kdown}; phase_moe1(p, Q, lds); }
#endif
#if PH_DUP & 1024
    GRID_BAR();
    { FRESH_P(p); const MoeBufs Q{p.ws, (char*)p.out, p.kdown}; phase_moe1(p, Q, lds); }
#endif
    GRID_BAR();
#if PH_MASK & 2048
    { FRESH_P(p); const MoeBufs Q{p.ws, (char*)p.out, p.kdown}; phase_moe2(p, Q, lds); }
#endif
#if PH_DUP & 2048
    GRID_BAR();
    { FRESH_P(p); const MoeBufs Q{p.ws, (char*)p.out, p.kdown}; phase_moe2(p, Q, lds); }
#endif
    GRID_BAR();
#if PH_MASK & 4096
    { FRESH_P(p); const MoeBufs Q{p.ws, (char*)p.out, p.kdown}; phase_ln2(p, Q); }
#endif
}

#define MB(x) ((size_t)(x) << 20)
extern "C" void kernel_launch(void* const* d_in, const int* in_sizes, int n_in, void* d_out, int out_size, void* d_ws, size_t ws_size, hipStream_t stream) {
    MegaArgs a{};
    Params& p = a.p;
    p.x = (const float*)d_in[0]; p.w_in = (const float*)d_in[1]; p.rpb = (const float*)d_in[2]; p.conv_w = (const float*)d_in[3];
    p.a_log_f = (const float*)d_in[4]; p.a_log_b = (const float*)d_in[5]; p.dtb_f = (const float*)d_in[6]; p.dtb_b = (const float*)d_in[7];
    p.norm_w = (const float*)d_in[8]; p.w_proj_na = (const float*)d_in[9]; p.w_proj_dn = (const float*)d_in[10]; p.w_out = (const float*)d_in[11];
    p.ln1_g = (const float*)d_in[12]; p.ln1_b = (const float*)d_in[13]; p.wrg = (const float*)d_in[14]; p.brg = (const float*)d_in[15];
    p.wre = (const float*)d_in[16]; p.bre = (const float*)d_in[17]; p.wgu = (const float*)d_in[18]; p.wd = (const float*)d_in[19];
    p.ln2_g = (const float*)d_in[20]; p.ln2_b = (const float*)d_in[21];
    p.out = (float*)d_out;
    p.ws = (char*)d_ws; p.bar = (unsigned*)d_ws; p.kdown = 256;

    static int grid = 0;
    if (grid == 0) {
        int dev = 0, cus = 0, per_cu = 0;
        hipGetDevice(&dev);
        hipDeviceGetAttribute(&cus, hipDeviceAttributeMultiprocessorCount, dev);
        hipFuncSetAttribute((const void*)mega_fwd, hipFuncAttributeMaxDynamicSharedMemorySize, LDS_BYTES);
        hipOccupancyMaxActiveBlocksPerMultiprocessor(&per_cu, (const void*)mega_fwd, NT, LDS_BYTES);
        if (per_cu < 1) { fprintf(stderr, "kernel_launch: occupancy query reports %d workgroups per CU\n", per_cu); per_cu = 1; }
        if (per_cu > 1) per_cu = 1;
        grid = cus * per_cu;
        if (grid > 256) grid = 256;
        (void)hipGetLastError();
    }
    hipMemsetAsync(p.bar, 0, (XCD_BAR_WORDS + 64) * sizeof(unsigned), stream);
    hipLaunchKernelGGL(mega_fwd, dim3(grid), dim3(NT), LDS_BYTES, stream, a);
}
```

```cpp
#include <hip/hip_runtime.h>
#include <math.h>
#include <stdint.h>
#include <stddef.h>
#include <stdio.h>
namespace pg8 {
#define PG8_LAS __attribute__((address_space(3)))
typedef unsigned short bf16_t;
typedef short bf16x8 __attribute__((ext_vector_type(8)));
typedef float f32x4 __attribute__((ext_vector_type(4)));
typedef unsigned u32x4 __attribute__((ext_vector_type(4)));
constexpr int BM = 256, BK = 64, HALF = 128, HTB = HALF * BK * 2  , STAGE_BYTES = 8 * HTB, NXCD = 8, WGM = 8;

__host__ __device__ __forceinline__ int lds_byte(int r, int c) { const int st = (r >> 4) * 2 + (c >> 5), rr = r & 15, cc = c & 31, ob = rr * 64 + cc * 2; return st * 1024 + (ob ^ (((ob >> 9) & 1) << 5)); }
__host__ __device__ __forceinline__ void stage_rc(int b, int& R, int& C) { const int st = b / 1024, sb = b % 1024, swz = sb ^ (((sb >> 9) & 1) << 5); R = (st >> 1) * 16 + swz / 64; C = (st & 1) * 32 + (swz % 64) / 2; }
__host__ __device__ __forceinline__ int perm32(int rho) { const int n = rho >> 4, i = rho & 15; return 8 * (i >> 2) + 4 * n + (i & 3); }

struct Unit { int pm, pn; };
struct Gemm { const bf16_t* A; const bf16_t* Bt; int M, N, K; };

struct StaticOrder {
    int nM, nN, nwg, G, c;
    __host__ __device__ __forceinline__ void init(int M, int N, int G_, int c_) { nM = M / BM; nN = N / BM; nwg = nM * nN; G = G_; c = c_; }
    __host__ __device__ __forceinline__ bool next(int i, Unit& u) const {
        const long L = (long)i * G + c; if (L >= nwg) return false;
        int wgid = (int)L; { const int q = nwg / NXCD, r = nwg % NXCD, xcd = wgid % NXCD, off = wgid / NXCD; wgid = (xcd < r ? xcd * (q + 1) : r * (q + 1) + (xcd - r) * q) + off; }
        const int nig = WGM * nN, gid = wgid / nig, fm = gid * WGM, gsz = (nM - fm) < WGM ? (nM - fm) : WGM;
        u.pm = fm + ((wgid % nig) % gsz); u.pn = (wgid % nig) / gsz; return true;
    }
    __device__ __forceinline__ void a_ready(const Unit&) const {}
    __device__ __forceinline__ void done(const Unit&) const {}
};
__device__ __forceinline__ unsigned cvt_pk_bf16(float lo, float hi) { unsigned r; asm volatile("v_cvt_pk_bf16_f32 %0, %1, %2" : "=v"(r) : "v"(lo), "v"(hi)); return r; }

template <class Epi, class Sched, bool ALIGN_EPI = false, bool SP2 = false>
__device__ __forceinline__ void gemm_phase(PG8_LAS unsigned char* lds, const Gemm g, const Sched& S, const Epi& E) {
    int tid_ = threadIdx.x; asm volatile("" : "+v"(tid_));
    const int tid = tid_, wid = __builtin_amdgcn_readfirstlane(tid >> 6), lane = tid & 63, wr = wid >> 2, wc = wid & 3, fr = lane & 15, fq = lane >> 4;
    const int K = g.K, nt = K / BK;
    unsigned voffA[2], voffB[2];
#pragma unroll
    for (int i = 0; i < 2; ++i) { int R, C; stage_rc(tid * 16 + i * 8192, R, C); const int Rb = Epi::PERM ? ((R & ~31) + perm32(R & 31)) : R;
        voffA[i] = (unsigned)(R * K + C) * 2u; voffB[i] = (unsigned)(Rb * K + C) * 2u; }
    const size_t kstep = (size_t)(BK * 2);
    const size_t hstep = (size_t)HALF * K * 2;
    const size_t tstep = 2 * hstep;
    const unsigned ldsw = (unsigned)wid * 1024u;
    const int aoff = lds_byte(wr * 64 + fr, fq * 8), boff = lds_byte(wc * 32 + fr, fq * 8);
#define PG8_SA(b, h) (((b) * 2 + (h)) * HTB)
#define PG8_SB(b, h) ((4 + (b) * 2 + (h)) * HTB)
#define PG8_STAGE(bufoff, gbase, voff) do { _Pragma("unroll") for (int _i = 0; _i < 2; ++_i) \
        __builtin_amdgcn_global_load_lds((const unsigned*)((const char*)(gbase) + (voff)[_i]), (PG8_LAS unsigned*)(lds + (bufoff) + ldsw + _i * 8192), 16, 0, 0); } while (0)
#define PG8_LDA(dst, b, h) do { _Pragma("unroll") for (int m = 0; m < 4; ++m) _Pragma("unroll") for (int k = 0; k < 2; ++k) dst[m][k] = *(const PG8_LAS bf16x8*)(lds + PG8_SA(b, h) + aoff + m * 2048 + k * 1024); } while (0)
#define PG8_LDB(dst, b, h) do { _Pragma("unroll") for (int n = 0; n < 2; ++n) _Pragma("unroll") for (int k = 0; k < 2; ++k) dst[n][k] = *(const PG8_LAS bf16x8*)(lds + PG8_SB(b, h) + boff + n * 2048 + k * 1024); } while (0)
#define PG8_MMA(ai, bj, At, Bt) do { __builtin_amdgcn_s_setprio(1); _Pragma("unroll") for (int m = 0; m < 4; ++m) _Pragma("unroll") for (int n = 0; n < 2; ++n) _Pragma("unroll") for (int k = 0; k < 2; ++k) \
        acc[ai][bj][m][n] = __builtin_amdgcn_mfma_f32_16x16x32_bf16(Bt[n][k], At[m][k], acc[ai][bj][m][n], 0, 0, 0); __builtin_amdgcn_s_setprio(0); } while (0)
#define PG8_WAIT_V(n) asm volatile("s_waitcnt vmcnt(" #n ")" ::: "memory")
#define PG8_WAIT_L(n) asm volatile("s_waitcnt lgkmcnt(" #n ")" ::: "memory")
#define PG8_BAR __builtin_amdgcn_s_barrier()
#define PG8_SCHED __builtin_amdgcn_sched_barrier(0)
    Unit cur, nxt; int ui = 0;
    if (!S.next(0, cur)) return;
    f32x4 acc[2][2][4][2];
#pragma unroll
    for (int a = 0; a < 2; ++a)
#pragma unroll
        for (int b = 0; b < 2; ++b)
#pragma unroll
            for (int m = 0; m < 4; ++m)
#pragma unroll
                for (int n = 0; n < 2; ++n) acc[a][b][m][n] = (f32x4){0.f, 0.f, 0.f, 0.f};
    bf16x8 At[4][2], B0[2][2], B1[2][2];
    const char* cA = (const char*)g.A + (size_t)cur.pm * tstep; const char* cB = (const char*)g.Bt + (size_t)cur.pn * tstep;
    S.a_ready(cur);
    if constexpr (SP2) {
        PG8_STAGE(PG8_SB(0, 0), cB, voffB); PG8_STAGE(PG8_SB(0, 1), cB + hstep, voffB); PG8_STAGE(PG8_SA(0, 0), cA, voffA); PG8_STAGE(PG8_SA(0, 1), cA + hstep, voffA);
        if (wr == 1) PG8_BAR;
        PG8_WAIT_V(2); PG8_BAR;
        PG8_STAGE(PG8_SB(1, 0), cB + kstep, voffB); PG8_STAGE(PG8_SA(1, 0), cA + kstep, voffA); PG8_STAGE(PG8_SB(1, 1), cB + hstep + kstep, voffB);
        PG8_WAIT_V(6); PG8_BAR;
    } else {
        PG8_STAGE(PG8_SB(0, 0), cB, voffB); PG8_STAGE(PG8_SA(0, 0), cA, voffA); PG8_STAGE(PG8_SB(0, 1), cB + hstep, voffB); PG8_STAGE(PG8_SA(0, 1), cA + hstep, voffA);
        if (wr == 1) PG8_BAR;
        PG8_WAIT_V(4); PG8_BAR;
        PG8_STAGE(PG8_SB(1, 0), cB + kstep, voffB); PG8_STAGE(PG8_SA(1, 0), cA + kstep, voffA); PG8_STAGE(PG8_SB(1, 1), cB + hstep + kstep, voffB);
        PG8_WAIT_V(6); PG8_BAR;
    }
    for (;;) {
        const bool has_next = S.next(ui + 1, nxt);
        const char* nA = has_next ? (const char*)g.A + (size_t)nxt.pm * tstep : cA; const char* nB = has_next ? (const char*)g.Bt + (size_t)nxt.pn * tstep : cB;
        for (int t = 0; t < nt; t += 2) {
            const bool last = (t == nt - 2);
            const char* a1 = cA + (size_t)(t + 1) * kstep;
            const char* a2 = last ? nA : cA + (size_t)(t + 2) * kstep; const char* b2 = last ? nB : cB + (size_t)(t + 2) * kstep;
            const char* a3 = a2 + kstep; const char* b3 = b2 + kstep;
            if (last && has_next) S.a_ready(nxt);
            if constexpr (SP2) {
            PG8_LDB(B0, 0, 0); PG8_LDB(B1, 0, 1); PG8_SCHED; PG8_LDA(At, 0, 0); PG8_STAGE(PG8_SA(1, 1), a1 + hstep, voffA);
            PG8_WAIT_V(8); PG8_WAIT_L(0); PG8_BAR; PG8_MMA(0, 0, At, B0); PG8_MMA(0, 1, At, B1); PG8_BAR; PG8_SCHED;
            PG8_LDA(At, 0, 1); PG8_STAGE(PG8_SB(0, 0), b2, voffB); PG8_STAGE(PG8_SB(0, 1), b2 + hstep, voffB); PG8_STAGE(PG8_SA(0, 0), a2, voffA);
            PG8_WAIT_V(8); PG8_WAIT_L(0); PG8_BAR; PG8_MMA(1, 0, At, B0); PG8_MMA(1, 1, At, B1); PG8_BAR; PG8_SCHED;
            PG8_LDB(B0, 1, 0); PG8_LDB(B1, 1, 1); PG8_SCHED; PG8_LDA(At, 1, 0); PG8_STAGE(PG8_SA(0, 1), a2 + hstep, voffA);
            PG8_WAIT_V(8); PG8_WAIT_L(0); PG8_BAR; PG8_MMA(0, 0, At, B0); PG8_MMA(0, 1, At, B1); PG8_BAR; PG8_SCHED;
            PG8_LDA(At, 1, 1); PG8_STAGE(PG8_SB(1, 0), b3, voffB); PG8_STAGE(PG8_SB(1, 1), b3 + hstep, voffB); PG8_STAGE(PG8_SA(1, 0), a3, voffA);
            PG8_WAIT_V(8); PG8_WAIT_L(0); PG8_BAR; PG8_MMA(1, 0, At, B0); PG8_MMA(1, 1, At, B1); PG8_BAR; PG8_SCHED;
            } else {
            PG8_LDB(B0, 0, 0); PG8_SCHED; PG8_LDA(At, 0, 0); PG8_STAGE(PG8_SA(1, 1), a1 + hstep, voffA);
            PG8_WAIT_L(8); PG8_BAR; PG8_WAIT_L(0); PG8_MMA(0, 0, At, B0); PG8_BAR; PG8_SCHED;
            PG8_LDB(B1, 0, 1); PG8_STAGE(PG8_SB(0, 0), b2, voffB);
            PG8_BAR; PG8_WAIT_L(0); PG8_MMA(0, 1, At, B1); PG8_BAR;
            PG8_LDA(At, 0, 1); PG8_STAGE(PG8_SA(0, 0), a2, voffA);
            PG8_BAR; PG8_WAIT_L(0); PG8_MMA(1, 0, At, B0); PG8_BAR; PG8_SCHED;
            PG8_STAGE(PG8_SB(0, 1), b2 + hstep, voffB);
            PG8_WAIT_V(6); PG8_BAR; PG8_MMA(1, 1, At, B1); PG8_BAR;
            PG8_LDB(B0, 1, 0); PG8_SCHED; PG8_LDA(At, 1, 0); PG8_STAGE(PG8_SA(0, 1), a2 + hstep, voffA);
            PG8_WAIT_L(8); PG8_BAR; PG8_WAIT_L(0); PG8_MMA(0, 0, At, B0); PG8_BAR; PG8_SCHED;
            PG8_LDB(B1, 1, 1); PG8_STAGE(PG8_SB(1, 0), b3, voffB);
            PG8_BAR; PG8_WAIT_L(0); PG8_MMA(0, 1, At, B1); PG8_BAR;
            PG8_LDA(At, 1, 1); PG8_STAGE(PG8_SA(1, 0), a3, voffA);
            PG8_BAR; PG8_WAIT_L(0); PG8_MMA(1, 0, At, B0); PG8_BAR; PG8_SCHED;
            PG8_STAGE(PG8_SB(1, 1), b3 + hstep, voffB);
            PG8_WAIT_V(6); PG8_BAR; PG8_MMA(1, 1, At, B1); PG8_BAR;
            }
        }
        if constexpr (ALIGN_EPI) { if (wr == 0) PG8_BAR; }
        if constexpr (!Epi::AFTER_DRAIN) { E(acc, cur, wr, wc, fr, fq); S.done(cur); }
        if (!has_next) break;
#pragma unroll
        for (int a = 0; a < 2; ++a)
#pragma unroll
            for (int b = 0; b < 2; ++b)
#pragma unroll
                for (int m = 0; m < 4; ++m)
#pragma unroll
                    for (int n = 0; n < 2; ++n) acc[a][b][m][n] = (f32x4){0.f, 0.f, 0.f, 0.f};
        cur = nxt; cA = nA; cB = nB; ++ui;
        if constexpr (ALIGN_EPI) { if (wr == 1) PG8_BAR; }
    }
    PG8_WAIT_V(0);
    if constexpr (!ALIGN_EPI) { if (wr == 0) PG8_BAR; }
    PG8_BAR;
    if constexpr (Epi::AFTER_DRAIN) { E.fused(acc, cur, wr, wc, fr, fq, lds, wid, lane); S.done(cur); }
#undef PG8_SA
#undef PG8_SB
#undef PG8_STAGE
#undef PG8_LDA
#undef PG8_LDB
#undef PG8_MMA
#undef PG8_WAIT_V
#undef PG8_WAIT_L
#undef PG8_BAR
#undef PG8_SCHED
}
}
typedef unsigned short bf16;
#define LAS __attribute__((address_space(3)))
typedef float f32x4 __attribute__((ext_vector_type(4)));
typedef short bf16x8 __attribute__((ext_vector_type(8)));
typedef unsigned u32x4 __attribute__((ext_vector_type(4)));
typedef unsigned u32x2 __attribute__((ext_vector_type(2)));

#define D_MODEL 1024
#define BATCH 8
#define SEQ 2048
#define D_IN 5664
#define NTOK (BATCH * SEQ)
#define ALPHA 1.189207115002721f
#define LN_EPS 1e-5f
#define RMS_EPS 1e-6f
#define NWIN 3072
#define NT 512
#define LDS_BYTES 147456

#define LDS_WAIT() asm volatile("s_waitcnt lgkmcnt(0)" ::: "memory")
#define VM_WAIT() asm volatile("s_waitcnt vmcnt(0)" ::: "memory")

__device__ __forceinline__ int fresh_tid() { int t = threadIdx.x; asm volatile("" : "+v"(t)); return t; }
typedef float f32x2_t __attribute__((ext_vector_type(2)));
typedef __bf16 bf16x2_t __attribute__((ext_vector_type(2)));
__device__ __forceinline__ unsigned pk2(float lo, float hi) { const f32x2_t v = {lo, hi}; const bf16x2_t b = __builtin_convertvector(v, bf16x2_t); return __builtin_bit_cast(unsigned, b); }
__device__ __forceinline__ unsigned f2bf(float f) { return pk2(f, 0.f) & 0xffffu; }
__device__ __forceinline__ float bf2f(unsigned h) { return __builtin_bit_cast(float, (h & 0xffffu) << 16); }
__device__ __forceinline__ float sigmoidf_(float x) { return __builtin_amdgcn_rcpf(1.f + __expf(-x)); }
__device__ __forceinline__ float siluf_(float x) { return x * __builtin_amdgcn_rcpf(1.f + __expf(-x)); }
__device__ __forceinline__ float softplusf_(float x) { return x > 20.f ? x : log1pf(expf(x)); }

struct Params {
    const float *x, *w_in, *rpb, *conv_w, *a_log_f, *a_log_b, *dtb_f, *dtb_b, *norm_w, *w_proj_na, *w_proj_dn, *w_out, *ln1_g, *ln1_b;
    const float *wrg, *brg, *wre, *bre, *wgu, *wd, *ln2_g, *ln2_b;
    float* out;
    char* ws;
    unsigned* bar;
    int kdown, pad0;
#define WSP(T, mb) ((T*)(ws + ((size_t)(mb) << 20)))
    __device__ __forceinline__ bf16* WIN() const { return WSP(bf16, 1); }
    __device__ __forceinline__ bf16* WG() const { return WSP(bf16, 9); }
    __device__ __forceinline__ bf16* WPNA() const { return WSP(bf16, 13); }
    __device__ __forceinline__ bf16* WPDN() const { return WSP(bf16, 14); }
    __device__ __forceinline__ bf16* WOUT() const { return WSP(bf16, 15); }
    __device__ __forceinline__ bf16* XB() const { return WSP(bf16, 17); }
    __device__ __forceinline__ bf16* WGU() const { return WSP(bf16, 49); }
    __device__ __forceinline__ bf16* WD() const { return WSP(bf16, 81); }
    __device__ __forceinline__ bf16* QNA() const { return WSP(bf16, 49); }
    __device__ __forceinline__ bf16* KNA() const { return WSP(bf16, 65); }
    __device__ __forceinline__ bf16* VNAT() const { return WSP(bf16, 81); }
    __device__ __forceinline__ bf16* QKVDN() const { return WSP(bf16, 97); }
    __device__ __forceinline__ bf16* Z() const { return WSP(bf16, 145); }
    __device__ __forceinline__ float* GATES() const { return WSP(float, 161); }
    __device__ __forceinline__ bf16* NAOUT() const { return WSP(bf16, 163); }
    __device__ __forceinline__ bf16* DNOUT() const { return WSP(bf16, 129); }
};

__device__ __forceinline__ void transpose_item(const float* W, size_t ldW, bf16* WT, int Kdst, int k0, int n0, int rowdst0, LAS float*  , int lane) {
    const int m = lane & 15, g = lane >> 4;
    bf16x8 idb[2];
#pragma unroll
    for (int half = 0; half < 2; ++half)
#pragma unroll
        for (int j = 0; j < 8; ++j) idb[half][j] = (8 * g + j == m + 16 * half) ? (short)0x3F80 : (short)0;
#pragma unroll
    for (int kg = 0; kg < 2; ++kg) {
        f32x4 d[2][2];
#pragma unroll
        for (int q = 0; q < 2; ++q) {
            const float* src = W + (size_t)(k0 + 32 * kg + 8 * (m >> 2) + 4 * q + (m & 3)) * ldW + n0 + 8 * g;
            const f32x4 a0 = *(const f32x4*)src, a1 = *(const f32x4*)(src + 4);
            u32x4 aw; aw.x = pk2(a0[0], a0[1]); aw.y = pk2(a0[2], a0[3]); aw.z = pk2(a1[0], a1[1]); aw.w = pk2(a1[2], a1[3]);
            const bf16x8 af = __builtin_bit_cast(bf16x8, aw);
#pragma unroll
            for (int half = 0; half < 2; ++half) d[q][half] = __builtin_amdgcn_mfma_f32_16x16x32_bf16(af, idb[half], (f32x4){0.f, 0.f, 0.f, 0.f}, 0, 0, 0);
        }
#pragma unroll
        for (int half = 0; half < 2; ++half) {
            u32x4 o; o.x = pk2(d[0][half][0], d[0][half][1]); o.y = pk2(d[0][half][2], d[0][half][3]); o.z = pk2(d[1][half][0], d[1][half][1]); o.w = pk2(d[1][half][2], d[1][half][3]);
            *(u32x4*)(WT + (size_t)(rowdst0 + 16 * half + m) * Kdst + k0 + 32 * kg + 8 * g) = o;
        }
    }
}

#define IT_WIN (16 * 113)
#define IT_WG (16 * 64)
#define IT_WPNA (8 * 32)
#define IT_WPDN (8 * 32)
#define IT_WOUT (16 * 32)
#define IT_SMALL (IT_WIN + IT_WG + IT_WPNA + IT_WPDN + IT_WOUT)
#define IT_WGU (32 * 16 * 16)
#define IT_WD (32 * 4 * 32)

__device__ __forceinline__ void p0_small_item(const Params& p, int r, LAS float* scr, int lane) {
    if (r < IT_WIN) { const int kb = r / 113, nb = r % 113; transpose_item(p.w_in, D_IN, p.WIN(), 1024, kb * 64, nb * 32, nb * 32, scr, lane); return; } r -= IT_WIN;
    if (r < IT_WG) { const int kb = r / 64, nb = r % 64; transpose_item(p.w_in + 3616, D_IN, p.WG(), 1024, kb * 64, nb * 32, nb * 32, scr, lane); return; } r -= IT_WG;
    if (r < IT_WPNA) { const int kb = r / 32, nb = r % 32; transpose_item(p.w_proj_na, 1024, p.WPNA(), 512, kb * 64, nb * 32, nb * 32, scr, lane); return; } r -= IT_WPNA;
    if (r < IT_WPDN) { const int kb = r / 32, nb = r % 32; transpose_item(p.w_proj_dn, 1024, p.WPDN(), 512, kb * 64, nb * 32, nb * 32, scr, lane); return; } r -= IT_WPDN;
    { const int kb = r / 32, nb = r % 32; transpose_item(p.w_out, 1024, p.WOUT(), 1024, kb * 64, nb * 32, nb * 32, scr, lane); }
}
__device__ __forceinline__ void p0_moe_item(const Params& p, int r, LAS float* scr, int lane) {
    if (r < IT_WGU) { const int e = r / 256, q = r % 256, kb = q / 16, nb = q % 16;
        const int n0 = nb * 32, up = n0 >= 256, f0 = n0 - (up ? 256 : 0);
        transpose_item(p.wgu + (size_t)e * 1024 * 512, 512, p.WGU(), 1024, kb * 64, n0, e * 512 + (f0 / 128) * 256 + (up ? 128 : 0) + (f0 % 128), scr, lane); return; }
    r -= IT_WGU;
    { const int e = r / 128, q = r % 128, kb = q / 32, nb = q % 32;
        transpose_item(p.wd + (size_t)e * 256 * 1024, 1024, p.WD(), 256, kb * 64, nb * 32, e * 1024 + nb * 32, scr, lane); }
}

__device__ __forceinline__ void phase0_moe(const Params& p, unsigned* counter) {
    const int lane = fresh_tid() & 63;
    for (;;) {
        unsigned base = 0;
        if (lane == 0) base = __hip_atomic_fetch_add(counter, 4u, __ATOMIC_RELAXED, __HIP_MEMORY_SCOPE_AGENT);
        base = (unsigned)__builtin_amdgcn_readfirstlane((int)base);
        if (base >= (unsigned)(IT_WGU + IT_WD)) break;
#pragma unroll 1
        for (int k = 0; k < 4; ++k) p0_moe_item(p, (int)base + k, nullptr, lane);
    }
}
__device__ __forceinline__ void phase0(const Params& p, LAS unsigned char* lds) {
    const int tid = fresh_tid(), lane = tid & 63, wave = tid >> 6, G = gridDim.x;
    LAS float* scr = (LAS float*)(lds + wave * 16384);
    const int gw = blockIdx.x * 8 + wave, NGW = G * 8;
    for (int it = gw; it < IT_SMALL; it += NGW) p0_small_item(p, it, scr, lane);
    const size_t gt = (size_t)blockIdx.x * NT + tid, GT = (size_t)G * NT;
    for (size_t i = gt; i < (size_t)NTOK * 1024 / 8; i += GT) {
        const f32x4 a = *(const f32x4*)(p.x + i * 8), b = *(const f32x4*)(p.x + i * 8 + 4);
        u32x4 o; o.x = pk2(a.x, a.y); o.y = pk2(a.z, a.w); o.z = pk2(b.x, b.y); o.w = pk2(b.z, b.w);
        *(u32x4*)(p.XB() + i * 8) = o;
    }
}

struct EpiInProj {
    static constexpr bool PERM = true, AFTER_DRAIN = false;
    LAS unsigned char* lds_epi;
    struct Mini { char* ws;
        __device__ __forceinline__ bf16* QNA() const { return WSP(bf16, 49); }
        __device__ __forceinline__ bf16* KNA() const { return WSP(bf16, 65); }
        __device__ __forceinline__ bf16* VNAT() const { return WSP(bf16, 81); }
        __device__ __forceinline__ bf16* QKVDN() const { return WSP(bf16, 97); }
    } p;
    __device__ __forceinline__ void operator()(const pg8::f32x4 (&acc)[2][2][4][2], const pg8::Unit& u, int wr, int wc, int fr, int fq) const {
        const int pn = u.pn;
#pragma unroll
        for (int ai = 0; ai < 2; ++ai)
#pragma unroll
            for (int m = 0; m < 4; ++m) {
                const int row = u.pm * 256 + ai * 128 + wr * 64 + m * 16 + fr;
                const int b = row >> 11, t = row & 2047;
#pragma unroll
                for (int bj = 0; bj < 2; ++bj) {
                    const pg8::f32x4 v0 = acc[ai][bj][m][0], v1 = acc[ai][bj][m][1];
                    const int head = (pn & 1) * 4 + bj * 2 + (wc >> 1), d0 = (wc & 1) * 32 + 8 * fq;
                    const size_t hm = ((size_t)(b * 8 + head) * 2048 + t) * 64 + d0;
                    if (pn < 4 || pn >= 6) {
                        bf16* dst; float sc = 1.f;
                        if (pn < 2) { dst = p.QNA(); sc = 0.125f; }
                        else if (pn < 4) dst = p.KNA();
                        else dst = p.QKVDN() + (size_t)((pn - 6) >> 1) * ((size_t)NTOK * 512);
                        float e[8] = {v0[0], v0[1], v0[2], v0[3], v1[0], v1[1], v1[2], v1[3]};
#pragma unroll
                        for (int j = 0; j < 8; ++j) e[j] *= sc;
                        u32x4 w; w.x = pk2(e[0], e[1]); w.y = pk2(e[2], e[3]); w.z = pk2(e[4], e[5]); w.w = pk2(e[6], e[7]);
                        *(u32x4*)(dst + hm) = w;
                    } else {
                        LAS bf16* scr = (LAS bf16*)(lds_epi + (wr * 4 + wc) * 1280);
                        const float e[8] = {v0[0], v0[1], v0[2], v0[3], v1[0], v1[1], v1[2], v1[3]};
#pragma unroll
                        for (int j = 0; j < 8; ++j) scr[(8 * fq + j) * 20 + fr] = (bf16)f2bf(e[j]);
                        LDS_WAIT();
                        const int lane = fq * 16 + fr, dd = lane >> 1, hf = lane & 1;
                        const u32x2 lo = *(const LAS u32x2*)(scr + dd * 20 + 8 * hf), hi = *(const LAS u32x2*)(scr + dd * 20 + 8 * hf + 4);
                        const int t0 = (u.pm * 256 + ai * 128 + wr * 64 + m * 16) & 2047;
                        u32x4 w; w.x = lo.x; w.y = lo.y; w.z = hi.x; w.w = hi.y;
                        *(u32x4*)(p.VNAT() + ((size_t)(b * 8 + head) * 64 + (wc & 1) * 32 + dd) * 2048 + t0 + 8 * hf) = w;
                        LDS_WAIT();
                    }
                }
            }
    }
};
struct EpiZ {
    static constexpr bool PERM = true, AFTER_DRAIN = false;
    bf16* Z;
    __device__ __forceinline__ void operator()(const pg8::f32x4 (&acc)[2][2][4][2], const pg8::Unit& u, int wr, int wc, int fr, int fq) const {
#pragma unroll
        for (int ai = 0; ai < 2; ++ai)
#pragma unroll
            for (int m = 0; m < 4; ++m) {
                const int row = u.pm * 256 + ai * 128 + wr * 64 + m * 16 + fr;
                const int b = row >> 11, t = row & 2047;
#pragma unroll
                for (int bj = 0; bj < 2; ++bj) {
                    const pg8::f32x4 v0 = acc[ai][bj][m][0], v1 = acc[ai][bj][m][1];
                    const int head = (u.pn & 1) * 4 + bj * 2 + (wc >> 1), d0 = (wc & 1) * 32 + 8 * fq;
                    float e[8] = {v0[0], v0[1], v0[2], v0[3], v1[0], v1[1], v1[2], v1[3]};
#pragma unroll
                    for (int j = 0; j < 8; ++j) e[j] = siluf_(e[j]);
                    u32x4 w; w.x = pk2(e[0], e[1]); w.y = pk2(e[2], e[3]); w.z = pk2(e[4], e[5]); w.w = pk2(e[6], e[7]);
                    *(u32x4*)(Z + ((size_t)(b * 8 + head) * 2048 + t) * 64 + d0) = w;
                }
            }
    }
};
__device__ __forceinline__ void gates_minigemm(const Params& p) {
    const int tid = fresh_tid(), lane = tid & 63, wave = tid >> 6, r16 = lane & 15, g = lane >> 4;
    for (int blk = blockIdx.x; blk < 256; blk += gridDim.x) {
        const int mt = wave & 3, nt = wave >> 2;
        const bf16* A = p.XB() + ((size_t)blk * 64 + mt * 16 + r16) * 1024 + 8 * g;
        const bf16* Bt = p.WIN() + ((size_t)3584 + nt * 16 + r16) * 1024 + 8 * g;
        f32x4 acc0 = {0.f, 0.f, 0.f, 0.f}, acc1 = {0.f, 0.f, 0.f, 0.f};
#pragma unroll 8
        for (int ks = 0; ks < 32; ks += 2) {
            acc0 = __builtin_amdgcn_mfma_f32_16x16x32_bf16(*(const bf16x8*)(A + ks * 32), *(const bf16x8*)(Bt + ks * 32), acc0, 0, 0, 0);
            acc1 = __builtin_amdgcn_mfma_f32_16x16x32_bf16(*(const bf16x8*)(A + ks * 32 + 32), *(const bf16x8*)(Bt + ks * 32 + 32), acc1, 0, 0, 0);
        }
        const int col = nt * 16 + r16, type = col >> 3, hd = col & 7;
        const size_t tg0 = (size_t)blk * 64 + mt * 16 + 4 * g; const int b = (int)(tg0 >> 11), t = (int)(tg0 & 2047);
        f32x4 o;
#pragma unroll
        for (int r = 0; r < 4; ++r) {
            const float e = acc0[r] + acc1[r];
            o[r] = type < 2 ? sigmoidf_(e) : (type == 2 ? -expf(p.a_log_f[hd]) * softplusf_(e + p.dtb_f[hd]) : -expf(p.a_log_b[hd]) * softplusf_(e + p.dtb_b[hd]));
        }
        *(f32x4*)(p.GATES() + (size_t)type * NTOK * 8 + ((size_t)b * 8 + hd) * 2048 + t) = o;
    }
}

__device__ __forceinline__ void phase1(const Params& p, LAS unsigned char* lds) {
    pg8::Gemm g{p.XB(), p.WIN(), NTOK, NWIN, 1024};
    pg8::StaticOrder S; S.init(NTOK, NWIN, gridDim.x, (int)blockIdx.x);
    EpiInProj E{lds + 131072, {p.ws}};
    pg8::gemm_phase<EpiInProj, pg8::StaticOrder, true, true>(lds, g, S, E);
    gates_minigemm(p);
}
__device__ __forceinline__ void phase_zgemm(const Params& p, LAS unsigned char* lds, int nb, int c) {
    pg8::Gemm g{p.XB(), p.WIN() + (size_t)3072 * 1024, NTOK, 512, 1024};
    pg8::StaticOrder S; S.init(NTOK, 512, nb, c);
    EpiZ E{p.Z()};
    pg8::gemm_phase<EpiZ, pg8::StaticOrder, true, true>(lds, g, S, E);
}

#define XB_TMO      128
#define XB_XCNT(j)  (256  + 64 * (j))
#define XB_XSUB(j)  (1280 + 64 * (j))
#define XB_XGEN(j)  (2304 + 64 * (j))
#define XB_TOP      3328
#define XB_TOPGEN   3392
#define XCD_BAR_WORDS 3456
#define XB_SPIN_CAP (1u << 18)


__device__ __forceinline__ unsigned xb_ld(unsigned* p)              { return __hip_atomic_load(p, __ATOMIC_RELAXED, __HIP_MEMORY_SCOPE_AGENT); }
__device__ __forceinline__ unsigned xb_add(unsigned* p, unsigned v) { return __hip_atomic_fetch_add(p, v, __ATOMIC_RELAXED, __HIP_MEMORY_SCOPE_AGENT); }
__device__ __forceinline__ unsigned xb_xcc_id() { return (unsigned)__builtin_amdgcn_s_getreg((3 << 11) | 20) & 0xFu; }
#define XB_SPIN(cond, bar) do { unsigned _sp = 0; while (cond) { __builtin_amdgcn_s_sleep(1); \
    if ((++_sp & 255u) == 0u) { if (xb_ld(&(bar)[XB_TMO])) break; if (_sp > XB_SPIN_CAP) { atomicAdd(&(bar)[XB_TMO], 1u); break; } } } } while (0)

struct XcdBarrier {
    unsigned* bar; unsigned x;
    volatile LAS unsigned* st;
};

__device__ __forceinline__ XcdBarrier xcd_barrier_post(unsigned* bar, volatile LAS unsigned* st) {
    XcdBarrier b; b.bar = bar; b.x = xb_xcc_id(); b.st = st;
    if (threadIdx.x == 0) (void)xb_add(&bar[XB_XCNT(b.x)], 1u);
    return b;
}
__device__ __forceinline__ void xcd_barrier_complete(unsigned* bar, unsigned x, unsigned& nloc, unsigned& nx) {
    const unsigned G = gridDim.x * gridDim.y * gridDim.z;
    unsigned sum, cnt, mine, sp = 0u;
    for (;;) {
        sum = 0u; cnt = 0u; mine = 0u;
#pragma unroll
        for (unsigned j = 0; j < 16; ++j) { const unsigned c = xb_ld(&bar[XB_XCNT(j)]); sum += c; cnt += (c > 0u) ? 1u : 0u; mine = (j == x) ? c : mine; }
        if (sum == G) break;
        __builtin_amdgcn_s_sleep(1);
        if ((++sp & 255u) == 0u) { if (xb_ld(&bar[XB_TMO])) break; if (sp > XB_SPIN_CAP) { atomicAdd(&bar[XB_TMO], 1u); break; } }
    }
    nloc = mine > 0u ? mine : 1u; nx = cnt > 0u ? cnt : 1u;
}

__device__ __forceinline__ void xcd_barrier(const XcdBarrier& b) {
    asm volatile("s_waitcnt vmcnt(0)" ::: "memory");
    __syncthreads();
    if (threadIdx.x == 0) {
        unsigned* bar = b.bar;
        __builtin_amdgcn_s_waitcnt(0);
        unsigned nloc = b.st[0], nx = b.st[1];
        if (nloc == 0u) { xcd_barrier_complete(bar, b.x, nloc, nx); b.st[0] = nloc; b.st[1] = nx; }
        const unsigned old = xb_add(&bar[XB_XSUB(b.x)], 1u);
        const unsigned gen = old / nloc;
        if (old + 1u == (gen + 1u) * nloc) {
            __builtin_amdgcn_fence(__ATOMIC_RELEASE, "agent");
            asm volatile("s_waitcnt vmcnt(0)" ::: "memory");
            const unsigned og = xb_add(&bar[XB_TOP], 1u);
            const unsigned tg = og / nx;
            if (og + 1u == (tg + 1u) * nx) xb_add(&bar[XB_TOPGEN], 1u);
            else XB_SPIN(xb_ld(&bar[XB_TOPGEN]) == tg, bar);
            __builtin_amdgcn_fence(__ATOMIC_ACQUIRE, "agent");
            xb_add(&bar[XB_XGEN(b.x)], 1u);
            asm volatile("s_waitcnt vmcnt(0)" ::: "memory");
        } else {
            XB_SPIN(xb_ld(&bar[XB_XGEN(b.x)]) == gen, bar);
            __builtin_amdgcn_fence(__ATOMIC_ACQUIRE, "agent");
            asm volatile("s_waitcnt vmcnt(0)" ::: "memory");
        }
    }
    __syncthreads();
}
#define NA_VSTR 520
#define NA_V_OFF 65536
#define NA_RPB_OFF (65536 + 64 * NA_VSTR * 2)
__device__ __forceinline__ void phase_na(const Params& p, LAS unsigned char* lds) {
    const int tid = fresh_tid(), lane = tid & 63, wave = tid >> 6, G = gridDim.x;
    const int vcu = (G % 8 == 0) ? ((int)blockIdx.x % 8) * (G / 8) + (int)blockIdx.x / 8 : (int)blockIdx.x;
    LAS unsigned char* Kl = lds;
    LAS bf16* Vl = (LAS bf16*)(lds + NA_V_OFF);
    LAS float* rpb_s = (LAS float*)(lds + NA_RPB_OFF);
    const int qi = lane & 15, g = lane >> 4, qg = wave & 3, dh = wave >> 2;
    const int c0 = qg * 16, c = c0 + qi;
    int cs0 = c0 - 8; cs0 = cs0 < 0 ? 0 : (cs0 > 32 ? 32 : cs0);
    int csq = c - 8; csq = csq < 0 ? 0 : (csq > 48 ? 48 : csq);
    for (int task = vcu; task < 256; task += G) {
        const int bh = task >> 2, r0 = (task & 3) * 8, h = bh & 7, b = bh >> 3;
        const size_t hb = (size_t)bh * 2048;
        const bf16* Kg = p.KNA() + hb * 64;
        const bf16* Vg = p.VNAT() + (size_t)bh * 64 * 2048;
        __syncthreads();
        for (int i = tid; i < 465; i += NT) rpb_s[i] = p.rpb[h * 465 + i];
        {
            int rs0 = r0 - 4; rs0 = rs0 < 0 ? 0 : (rs0 > 24 ? 24 : rs0);
#pragma unroll
            for (int q = 0; q < 8; ++q) {
                const int pc = tid + q * NT;
                const int krow = pc >> 9, col = (pc >> 3) & 63, ch = pc & 7, kr = rs0 + krow, sl = kr & 7;
                const u32x4 kv = *(const u32x4*)(Kg + ((size_t)kr * 64 + col) * 64 + ch * 8);
                *(LAS u32x4*)(Kl + (sl * 64 + col) * 128 + ((ch ^ (col & 7)) << 4)) = kv;
                const int d = (pc >> 3) & 63, vch = pc & 7;
                const u32x4 vv = *(const u32x4*)(Vg + (size_t)d * 2048 + kr * 64 + vch * 8);
                *(LAS u32x4*)(Vl + d * NA_VSTR + sl * 64 + vch * 8) = vv;
            }
        }
        __syncthreads();
        float bt[16][4];
        int bt_delta = 1000;
        bf16x8 qn[2];
#pragma unroll
        for (int ks = 0; ks < 2; ++ks) qn[ks] = *(const bf16x8*)(p.QNA() + (hb + r0 * 64 + c) * 64 + ks * 32 + 8 * g);
        for (int ri = 0; ri < 8; ++ri) {
            const int r = r0 + ri;
            int rs = r - 4; rs = rs < 0 ? 0 : (rs > 24 ? 24 : rs);
            int rsn = r + 1 - 4; rsn = rsn < 0 ? 0 : (rsn > 24 ? 24 : rsn);
            const bool add = (ri < 7) && (rsn != rs);
            u32x4 pk = {0u, 0u, 0u, 0u}, pv = {0u, 0u, 0u, 0u};
            const int ncol = tid >> 3, nch = tid & 7, nkr = rsn + 7;
            if (add) { pk = *(const u32x4*)(Kg + ((size_t)nkr * 64 + ncol) * 64 + nch * 8); pv = *(const u32x4*)(Vg + (size_t)ncol * 2048 + nkr * 64 + nch * 8); }
            bf16x8 qf[2]; qf[0] = qn[0]; qf[1] = qn[1];
            if (ri < 7) {
#pragma unroll
                for (int ks = 0; ks < 2; ++ks) qn[ks] = *(const bf16x8*)(p.QNA() + (hb + (r + 1) * 64 + c) * 64 + ks * 32 + 8 * g);
            }
            if (rs - r != bt_delta) {
                bt_delta = rs - r;
#pragma unroll
                for (int j = 0; j < 8; ++j)
#pragma unroll
                    for (int ct = 0; ct < 2; ++ct)
#pragma unroll
                        for (int rr = 0; rr < 4; ++rr) {
                            const int kc = cs0 + 8 * g + 4 * ct + rr;
                            const bool valid = (kc >= csq) && (kc < csq + 16);
                            int dc = kc - c + 15; dc = dc < 0 ? 0 : (dc > 30 ? 30 : dc);
                            bt[j * 2 + ct][rr] = valid ? rpb_s[(bt_delta + j + 7) * 31 + dc] : -1e30f;
                        }
            }
            float s[16][4];
#pragma unroll
            for (int j = 0; j < 8; ++j) {
                const int sl = (rs + j) & 7;
#pragma unroll
                for (int ct = 0; ct < 2; ++ct) {
                    const int col = cs0 + 8 * (qi >> 2) + 4 * ct + (qi & 3);
                    const LAS unsigned char* kp = Kl + (sl * 64 + col) * 128;
                    f32x4 a = {0.f, 0.f, 0.f, 0.f};
#pragma unroll
                    for (int ks = 0; ks < 2; ++ks) {
                        const bf16x8 kf = *(const LAS bf16x8*)(kp + (((4 * ks + g) ^ (col & 7)) << 4));
                        a = __builtin_amdgcn_mfma_f32_16x16x32_bf16(kf, qf[ks], a, 0, 0, 0);
                    }
#pragma unroll
                    for (int rr = 0; rr < 4; ++rr) s[j * 2 + ct][rr] = a[rr] + bt[j * 2 + ct][rr];
                }
            }
            float mx = -3e38f;
#pragma unroll
            for (int i = 0; i < 16; ++i)
#pragma unroll
                for (int rr = 0; rr < 4; ++rr) mx = fmaxf(mx, s[i][rr]);
            mx = fmaxf(mx, __shfl_xor(mx, 16)); mx = fmaxf(mx, __shfl_xor(mx, 32));
            float sum = 0.f;
#pragma unroll
            for (int i = 0; i < 16; ++i)
#pragma unroll
                for (int rr = 0; rr < 4; ++rr) { s[i][rr] = __expf(s[i][rr] - mx); sum += s[i][rr]; }
            sum += __shfl_xor(sum, 16); sum += __shfl_xor(sum, 32);
            const float inv = __builtin_amdgcn_rcpf(sum);
            f32x4 o[2];
            o[0] = (f32x4){0.f, 0.f, 0.f, 0.f}; o[1] = (f32x4){0.f, 0.f, 0.f, 0.f};
#pragma unroll
            for (int kk = 0; kk < 8; ++kk) {
                u32x4 pw; pw.x = pk2(s[2 * kk][0] * inv, s[2 * kk][1] * inv); pw.y = pk2(s[2 * kk][2] * inv, s[2 * kk][3] * inv);
                pw.z = pk2(s[2 * kk + 1][0] * inv, s[2 * kk + 1][1] * inv); pw.w = pk2(s[2 * kk + 1][2] * inv, s[2 * kk + 1][3] * inv);
                const bf16x8 pf = __builtin_bit_cast(bf16x8, pw);
                const int sl = (rs + kk) & 7;
#pragma unroll
                for (int dd = 0; dd < 2; ++dd) {
                    const bf16x8 vf = *(const LAS bf16x8*)(Vl + ((2 * dh + dd) * 16 + qi) * NA_VSTR + sl * 64 + cs0 + 8 * g);
                    o[dd] = __builtin_amdgcn_mfma_f32_16x16x32_bf16(vf, pf, o[dd], 0, 0, 0);
                }
            }
            {
                const size_t tg = (size_t)b * 2048 + r * 64 + c;
#pragma unroll
                for (int dd = 0; dd < 2; ++dd) { u32x2 ov; ov.x = pk2(o[dd][0], o[dd][1]); ov.y = pk2(o[dd][2], o[dd][3]);
                    *(u32x2*)(p.NAOUT() + tg * 512 + h * 64 + (2 * dh + dd) * 16 + 4 * g) = ov; }
            }
            __syncthreads();
            if (add) { const int sl = nkr & 7;
                *(LAS u32x4*)(Kl + (sl * 64 + ncol) * 128 + ((nch ^ (ncol & 7)) << 4)) = pk;
                *(LAS u32x4*)(Vl + ncol * NA_VSTR + sl * 64 + nch * 8) = pv; }
            __syncthreads();
        }
    }
}
#define LDSTR 72
#define MATB (64 * LDSTR * 2)
__device__ __forceinline__ f32x4 mfma16(bf16x8 a, bf16x8 b, f32x4 c) { return __builtin_amdgcn_mfma_f32_16x16x32_bf16(a, b, c, 0, 0, 0); }

template <bool SWZ_A = false, bool SWZ_B = false>
__device__ __forceinline__ void slab_mma(const LAS bf16* A, const LAS bf16* Bt, int w, int lane, f32x4 (&acc)[4]) {
    const int r16 = lane & 15, g = lane >> 4;
    const int ra = 16 * w + r16, sa = SWZ_A ? ((ra >> 3) & 7) : 0;
    const bf16x8 a0 = *(const LAS bf16x8*)(A + ra * LDSTR + 8 * (g ^ sa));
    const bf16x8 a1 = *(const LAS bf16x8*)(A + ra * LDSTR + 8 * ((4 + g) ^ sa));
#pragma unroll
    for (int nt = 0; nt < 4; ++nt) {
        const int rb = nt * 16 + r16, sb = SWZ_B ? ((rb >> 3) & 7) : 0;
        const bf16x8 b0 = *(const LAS bf16x8*)(Bt + rb * LDSTR + 8 * (g ^ sb));
        const bf16x8 b1 = *(const LAS bf16x8*)(Bt + rb * LDSTR + 8 * ((4 + g) ^ sb));
        acc[nt] = mfma16(a0, b0, acc[nt]); acc[nt] = mfma16(a1, b1, acc[nt]);
    }
}

struct DnBufs { char* ws; char* out;
    __device__ __forceinline__ bf16* MN() const { return (bf16*)out; }
    __device__ __forceinline__ bf16* QO() const { return WSP(bf16, 179); }
    __device__ __forceinline__ bf16* SB() const { return WSP(bf16, 97); } };

__device__ __forceinline__ void conv8(const float* conv_w, const bf16* src, size_t hb, int t, int c0, int wch, float (&y)[8]) {
#pragma unroll
    for (int d = 0; d < 8; ++d) y[d] = 0.f;
#pragma unroll
    for (int j = 0; j < 5; ++j) {
        const int tt = t + j - 2;
        if (tt >= 0 && tt < SEQ) {
            const bf16x8 x0 = *(const bf16x8*)(src + (hb + tt) * 64 + c0);
            const f32x4 w0 = *(const f32x4*)(conv_w + j * 1536 + wch + c0), w1 = *(const f32x4*)(conv_w + j * 1536 + wch + c0 + 4);
#pragma unroll
            for (int d = 0; d < 4; ++d) { y[d] = fmaf(bf2f((unsigned short)x0[d]), w0[d], y[d]); y[4 + d] = fmaf(bf2f((unsigned short)x0[4 + d]), w1[d], y[4 + d]); }
        }
    }
#pragma unroll
    for (int d = 0; d < 8; ++d) y[d] = siluf_(y[d]);
}
__device__ __forceinline__ u32x4 pack8(const float (&y)[8]) { u32x4 o; o.x = pk2(y[0], y[1]); o.y = pk2(y[2], y[3]); o.z = pk2(y[4], y[5]); o.w = pk2(y[6], y[7]); return o; }

#ifndef DN_STEP_DUP
#define DN_STEP_DUP 0
#endif
#define TEAM_BYTES 71680
#define XSTR2 40
__device__ __forceinline__ void phase_dnprep(const Params& p, const DnBufs& B, LAS unsigned char* lds) {
    const int tid = fresh_tid(), lane = tid & 63, wave = tid >> 6, team = wave >> 2, w = wave & 3, G = gridDim.x;
    const int r16 = lane & 15, g = lane >> 4;
    LAS unsigned char* base = lds + team * TEAM_BYTES;
    LAS bf16* Kr = (LAS bf16*)(base);
    LAS bf16* Qr = (LAS bf16*)(base + MATB);
    LAS bf16* KdT = (LAS bf16*)(base + 2 * MATB);
    LAS bf16* KbT = (LAS bf16*)(base + 3 * MATB);
    LAS bf16* VbT = (LAS bf16*)(base + 4 * MATB);
    LAS bf16* IN = (LAS bf16*)(base + 5 * MATB);
    LAS bf16* Lb = (LAS bf16*)(base + 6 * MATB);
    LAS bf16* TTa = Lb + 64 * LDSTR; LAS bf16* T22T = TTa + 32 * XSTR2; LAS bf16* XT = T22T + 16 * XSTR2;
    LAS bf16* Tm = Kr; LAS bf16* WT = Lb; LAS bf16* UT = KbT;
    LAS float* beta_s = (LAS float*)(lds + 143360 + team * 1024); LAS float* gc_s = beta_s + 64;
    const int dir0 = team;
    float pf_be = 0.f, pf_g = 0.f;
#define DN_GATE_PREFETCH(pi_) do { if (w == 0) { const int tc_ = (pi_) & 31, bh_ = (pi_) >> 5, cc_ = dir0 ? 31 - tc_ : tc_, s_ = cc_ * 64 + lane, t_ = dir0 ? 2047 - s_ : s_; \
        pf_be = p.GATES()[(size_t)dir0 * NTOK * 8 + (size_t)bh_ * 2048 + t_]; pf_g = p.GATES()[(size_t)(2 + dir0) * NTOK * 8 + (size_t)bh_ * 2048 + t_]; } } while (0)
#define DN_L2_PREFETCH(pi_) do { if (tid < 204) { const int tc_ = (pi_) & 31, bh_ = (pi_) >> 5, mtx_ = tid / 68, row_ = tid - mtx_ * 68; int t_ = tc_ * 64 - 2 + row_; t_ = t_ < 0 ? 0 : (t_ > SEQ - 1 ? SEQ - 1 : t_); \
        __builtin_amdgcn_global_load_lds((const unsigned*)(p.QKVDN() + (size_t)mtx_ * NTOK * 512 + ((size_t)bh_ * 2048 + t_) * 64), (LAS unsigned*)(lds + 145408 + wave * 256), 4, 0, 0); } } while (0)
    if ((int)blockIdx.x < 2048) DN_GATE_PREFETCH((int)blockIdx.x);
    for (int pi = blockIdx.x; pi < 2048; pi += G) {
        const int tc = pi & 31, bh = pi >> 5, h = bh & 7, dir = team, cc = dir ? 31 - tc : tc;
        const int it = (bh * 2 + dir) * 32 + cc;
        const size_t hb = (size_t)bh * 2048;
        __syncthreads();
        if (w == 0) {
            const float be = pf_be;
            float gv = pf_g;
#pragma unroll
            for (int o = 1; o < 64; o <<= 1) { const float n = __shfl_up(gv, o); if (lane >= o) gv += n; }
            beta_s[lane] = be; gc_s[lane] = gv;
        }
        __syncthreads();
        for (int rep1 = 0; rep1 < 1 + (DN_STEP_DUP & 1); ++rep1) {
            const int tau = tid >> 3, c0 = (tid & 7) * 8, t = tc * 64 + tau;
            float yk[8], yq[8], yv[8];
            conv8(p.conv_w, p.QKVDN() + (size_t)NTOK * 512, hb, t, c0, 512 + h * 64, yk);
            asm volatile("" ::: "memory");
            conv8(p.conv_w, p.QKVDN(), hb, t, c0, h * 64, yq);
            asm volatile("" ::: "memory");
            conv8(p.conv_w, p.QKVDN() + (size_t)2 * NTOK * 512, hb, t, c0, 1024 + h * 64, yv);
            asm volatile("" ::: "memory");
            if (pi + G < 2048) { DN_GATE_PREFETCH(pi + G); DN_L2_PREFETCH(pi + G); }
            float sk = 0.f, sq = 0.f;
#pragma unroll
            for (int d = 0; d < 8; ++d) { sk = fmaf(yk[d], yk[d], sk); sq = fmaf(yq[d], yq[d], sq); }
            sk += __shfl_xor(sk, 1); sq += __shfl_xor(sq, 1); sk += __shfl_xor(sk, 2); sq += __shfl_xor(sq, 2); sk += __shfl_xor(sk, 4); sq += __shfl_xor(sq, 4);
            const float rk = rsqrtf(sk + RMS_EPS), rq = rsqrtf(sq + RMS_EPS);
#pragma unroll
            for (int d = 0; d < 8; ++d) { yk[d] *= rk; yq[d] *= rq; }
            const u32x4 kp = pack8(yk), qp = pack8(yq);
#pragma unroll
            for (int dd = 0; dd < 2; ++dd) {
                LAS unsigned char* tb = lds + dd * TEAM_BYTES;
                const LAS float* bs = (const LAS float*)(lds + 143360 + dd * 1024); const LAS float* gs = bs + 64;
                const int i = dd ? 63 - tau : tau;
                const float be = bs[i], gci = gs[i], gl = gs[63];
                const float e_gc = __expf(gci), e_kd = __expf(gl - gci), bg = be * e_gc;
                *(LAS u32x4*)((LAS bf16*)tb + i * LDSTR + c0) = kp;
                *(LAS u32x4*)((LAS bf16*)(tb + MATB) + i * LDSTR + c0) = qp;
                LAS bf16* kd = (LAS bf16*)(tb + 2 * MATB); LAS bf16* kb = (LAS bf16*)(tb + 3 * MATB); LAS bf16* vb = (LAS bf16*)(tb + 4 * MATB);
#pragma unroll
                for (int d = 0; d < 8; ++d) { const int isw = i ^ ((c0 >> 3) << 3);
                    kd[(c0 + d) * LDSTR + isw] = (bf16)f2bf(yk[d] * e_kd); kb[(c0 + d) * LDSTR + isw] = (bf16)f2bf(yk[d] * bg); vb[(c0 + d) * LDSTR + isw] = (bf16)f2bf(yv[d] * be); }
            }
        }
        __syncthreads();
#pragma unroll 1
        for (int rep2 = 0; rep2 < 1 + ((DN_STEP_DUP >> 3) & 1); ++rep2) {
            f32x4 akk[4], aqk[4];
#pragma unroll
            for (int nt = 0; nt < 4; ++nt) { akk[nt] = (f32x4){0.f, 0.f, 0.f, 0.f}; aqk[nt] = (f32x4){0.f, 0.f, 0.f, 0.f}; }
            slab_mma(Kr, Kr, w, lane, akk);
            slab_mma(Qr, Kr, w, lane, aqk);
#pragma unroll
            for (int nt = 0; nt < 4; ++nt) {
                const int j = nt * 16 + r16; const float gcj = gc_s[j];
#pragma unroll
                for (int r = 0; r < 4; ++r) {
                    const int i = 16 * w + 4 * g + r;
                    const float dec = (j <= i) ? __expf(gc_s[i] - gcj) : 0.f;
                    Lb[i * LDSTR + j] = (bf16)f2bf((j < i) ? beta_s[i] * akk[nt][r] * dec : 0.f);
                    IN[i * LDSTR + j] = (bf16)f2bf(aqk[nt][r] * 0.125f * dec);
                }
            }
        }
        __syncthreads();
        for (int rep3 = 0; rep3 < 1 + ((DN_STEP_DUP >> 1) & 1); ++rep3) if (w == 0) {
            const u32x4 z4 = {0u, 0u, 0u, 0u};
#pragma unroll
            for (int q = 0; q < 9; ++q) { const int idx = lane + 64 * q; *(LAS u32x4*)(Tm + (idx / 9) * LDSTR + (idx % 9) * 8) = z4; }
            const int blk = lane >> 4, j = lane & 15;
            float x[16];
#pragma unroll
            for (int i = 0; i < 16; ++i) {
                float a = (i == j) ? 1.f : 0.f;
#pragma unroll
                for (int m = 0; m < i; ++m) a = fmaf(-bf2f(Lb[(16 * blk + i) * LDSTR + 16 * blk + m]), x[m], a);
                x[i] = a;
            }
#pragma unroll
            for (int i = 0; i < 16; ++i) Tm[(16 * blk + i) * LDSTR + 16 * blk + j] = (bf16)f2bf(x[i]);
            {
                u32x4 lo, hi; lo.x = pk2(x[0], x[1]); lo.y = pk2(x[2], x[3]); lo.z = pk2(x[4], x[5]); lo.w = pk2(x[6], x[7]);
                hi.x = pk2(x[8], x[9]); hi.y = pk2(x[10], x[11]); hi.z = pk2(x[12], x[13]); hi.w = pk2(x[14], x[15]);
                if (blk < 2) { LAS bf16* dst = TTa + (16 * blk + j) * XSTR2 + 16 * blk; *(LAS u32x4*)dst = lo; *(LAS u32x4*)(dst + 8) = hi;
                    if (blk == 1) { *(LAS u32x4*)(TTa + (16 + j) * XSTR2) = z4; *(LAS u32x4*)(TTa + (16 + j) * XSTR2 + 8) = z4; } }
                else if (blk == 2) { *(LAS u32x4*)(T22T + j * XSTR2) = lo; *(LAS u32x4*)(T22T + j * XSTR2 + 8) = hi; }
            }
            LDS_WAIT();
            const bf16x8 zf = {0, 0, 0, 0, 0, 0, 0, 0};
            const f32x4 z0 = {0.f, 0.f, 0.f, 0.f};
            const bool lo2 = g < 2;
            {
                const bf16x8 aA = lo2 ? *(const LAS bf16x8*)(Lb + (16 + r16) * LDSTR + 8 * g) : zf, bA = lo2 ? *(const LAS bf16x8*)(TTa + r16 * XSTR2 + 8 * g) : zf;
                const bf16x8 aB = lo2 ? *(const LAS bf16x8*)(Lb + (48 + r16) * LDSTR + 32 + 8 * g) : zf, bB = lo2 ? *(const LAS bf16x8*)(T22T + r16 * XSTR2 + 8 * g) : zf;
                const f32x4 xa = mfma16(aA, bA, z0), xb = mfma16(aB, bB, z0);
                u32x2 o; o.x = pk2(xa[0], xa[1]); o.y = pk2(xa[2], xa[3]); *(LAS u32x2*)(XT + r16 * XSTR2 + 4 * g) = o;
                o.x = pk2(xb[0], xb[1]); o.y = pk2(xb[2], xb[3]); *(LAS u32x2*)(XT + (16 + r16) * XSTR2 + 4 * g) = o;
            }
            LDS_WAIT();
            {
                const bf16x8 aA = lo2 ? *(const LAS bf16x8*)(Tm + (16 + r16) * LDSTR + 16 + 8 * g) : zf, bA = lo2 ? *(const LAS bf16x8*)(XT + r16 * XSTR2 + 8 * g) : zf;
                const bf16x8 aB = lo2 ? *(const LAS bf16x8*)(Tm + (48 + r16) * LDSTR + 48 + 8 * g) : zf, bB = lo2 ? *(const LAS bf16x8*)(XT + (16 + r16) * XSTR2 + 8 * g) : zf;
                const f32x4 ta = mfma16(aA, bA, z0), tb2 = mfma16(aB, bB, z0);
#pragma unroll
                for (int r = 0; r < 4; ++r) { Tm[(16 + 4 * g + r) * LDSTR + r16] = (bf16)f2bf(-ta[r]); Tm[(48 + 4 * g + r) * LDSTR + 32 + r16] = (bf16)f2bf(-tb2[r]); }
                u32x2 o; o.x = pk2(-ta[0], -ta[1]); o.y = pk2(-ta[2], -ta[3]); *(LAS u32x2*)(TTa + r16 * XSTR2 + 16 + 4 * g) = o;
            }
            LDS_WAIT();
            {
                f32x4 x2[2][2];
#pragma unroll
                for (int mt = 0; mt < 2; ++mt) {
                    const bf16x8 a = *(const LAS bf16x8*)(Lb + (32 + 16 * mt + r16) * LDSTR + 8 * g);
#pragma unroll
                    for (int nt = 0; nt < 2; ++nt) { const bf16x8 b2 = *(const LAS bf16x8*)(TTa + (16 * nt + r16) * XSTR2 + 8 * g); x2[mt][nt] = mfma16(a, b2, z0); }
                }
#pragma unroll
                for (int mt = 0; mt < 2; ++mt)
#pragma unroll
                    for (int nt = 0; nt < 2; ++nt) { u32x2 o; o.x = pk2(x2[mt][nt][0], x2[mt][nt][1]); o.y = pk2(x2[mt][nt][2], x2[mt][nt][3]); *(LAS u32x2*)(XT + (16 * nt + r16) * XSTR2 + 16 * mt + 4 * g) = o; }
            }
            LDS_WAIT();
            {
#pragma unroll
                for (int mt = 0; mt < 2; ++mt) {
                    const bf16x8 a = *(const LAS bf16x8*)(Tm + (32 + 16 * mt + r16) * LDSTR + 32 + 8 * g);
#pragma unroll
                    for (int nt = 0; nt < 2; ++nt) {
                        const bf16x8 b2 = *(const LAS bf16x8*)(XT + (16 * nt + r16) * XSTR2 + 8 * g);
                        const f32x4 tv = mfma16(a, b2, z0);
#pragma unroll
                        for (int r = 0; r < 4; ++r) Tm[(32 + 16 * mt + 4 * g + r) * LDSTR + 16 * nt + r16] = (bf16)f2bf(-tv[r]);
                    }
                }
            }
        }
        __syncthreads();
        {
            f32x4 a[4];
#pragma unroll
            for (int nt = 0; nt < 4; ++nt) a[nt] = (f32x4){0.f, 0.f, 0.f, 0.f};
            slab_mma<false, true>(Tm, KbT, w, lane, a);
#pragma unroll
            for (int nt = 0; nt < 4; ++nt) { u32x2 o; o.x = pk2(a[nt][0], a[nt][1]); o.y = pk2(a[nt][2], a[nt][3]); *(LAS u32x2*)(WT + (nt * 16 + r16) * LDSTR + 16 * w + 4 * g) = o; }
        }
        __syncthreads();
        {
            f32x4 a[4];
#pragma unroll
            for (int nt = 0; nt < 4; ++nt) a[nt] = (f32x4){0.f, 0.f, 0.f, 0.f};
            slab_mma<false, true>(Tm, VbT, w, lane, a);
#pragma unroll
            for (int nt = 0; nt < 4; ++nt) { u32x2 o; o.x = pk2(a[nt][0], a[nt][1]); o.y = pk2(a[nt][2], a[nt][3]); *(LAS u32x2*)(UT + (nt * 16 + r16) * LDSTR + 16 * w + 4 * g) = o; }
        }
        __syncthreads();
#pragma unroll 1
        for (int rep6 = 0; rep6 < 1 + ((DN_STEP_DUP >> 2) & 1); ++rep6) {
            const float egl = __expf(gc_s[63]);
            bf16* Mg = B.MN() + (size_t)it * 8192; bf16* NTg = Mg + 4096;
            bf16* Qg = B.QO() + ((size_t)((bh * 2 + dir) * 32 + tc)) * 8192; bf16* OTg = Qg + 4096;
            f32x4 a[4];
#pragma unroll
            for (int nt = 0; nt < 4; ++nt) a[nt] = (f32x4){0.f, 0.f, 0.f, 0.f};
            slab_mma<false, true>(WT, KdT, w, lane, a);
#pragma unroll
            for (int nt = 0; nt < 4; ++nt) { const int ra = nt * 16 + r16, cb = 16 * w + 4 * g; u32x2 o;
                o.x = pk2((ra == cb ? egl : 0.f) - a[nt][0], (ra == cb + 1 ? egl : 0.f) - a[nt][1]); o.y = pk2((ra == cb + 2 ? egl : 0.f) - a[nt][2], (ra == cb + 3 ? egl : 0.f) - a[nt][3]);
                *(u32x2*)(Mg + (((ra >> 4) * 2 + (cb >> 5)) * 64 + ((cb & 31) >> 3) * 16 + (ra & 15)) * 8 + (cb & 7)) = o; }
#pragma unroll
            for (int nt = 0; nt < 4; ++nt) a[nt] = (f32x4){0.f, 0.f, 0.f, 0.f};
            slab_mma<true, false>(KdT, UT, w, lane, a);
#pragma unroll
            for (int nt = 0; nt < 4; ++nt) { u32x2 o; o.x = pk2(a[nt][0], a[nt][1]); o.y = pk2(a[nt][2], a[nt][3]); *(u32x2*)(NTg + ((nt * 4 + w) * 64 + g * 16 + r16) * 4) = o; }
#pragma unroll
            for (int nt = 0; nt < 4; ++nt) a[nt] = (f32x4){0.f, 0.f, 0.f, 0.f};
            slab_mma(WT, IN, w, lane, a);
#pragma unroll
            for (int nt = 0; nt < 4; ++nt) { const int i = nt * 16 + r16, cb = 16 * w + 4 * g, ro = dir ? 63 - i : i;
                const float sc = 0.125f * __expf(gc_s[i]);
                const u32x2 qv = *(const LAS u32x2*)(Qr + i * LDSTR + cb);
                u32x2 o; o.x = pk2(bf2f(qv.x & 0xffffu) * sc - a[nt][0], bf2f(qv.x >> 16) * sc - a[nt][1]); o.y = pk2(bf2f(qv.y & 0xffffu) * sc - a[nt][2], bf2f(qv.y >> 16) * sc - a[nt][3]);
                *(u32x2*)(Qg + (((ro >> 4) * 2 + (cb >> 5)) * 64 + ((cb & 31) >> 3) * 16 + (ro & 15)) * 8 + (cb & 7)) = o; }
#pragma unroll
            for (int nt = 0; nt < 4; ++nt) a[nt] = (f32x4){0.f, 0.f, 0.f, 0.f};
            slab_mma(UT, IN, w, lane, a);
#pragma unroll
            for (int nt = 0; nt < 4; ++nt) { const int i = nt * 16 + r16, ro = dir ? 63 - i : i; u32x2 o; o.x = pk2(a[nt][0], a[nt][1]); o.y = pk2(a[nt][2], a[nt][3]);
                *(u32x2*)(OTg + (((ro >> 4) * 4 + w) * 64 + g * 16 + (ro & 15)) * 4) = o; }
        }
    }
#undef DN_GATE_PREFETCH
#undef DN_L2_PREFETCH
}

template <int VARIANT = 0>
__device__ __forceinline__ void phase_dnscan(const Params& p, const DnBufs& B, LAS unsigned char* lds) {
    const int tid = fresh_tid(), lane = tid & 63, wave = tid >> 6;
    const int r16 = lane & 15, g = lane >> 4;
    if (wave < 4) {
    const int vp = wave;
    LAS bf16* St = (LAS bf16*)(lds + wave * (16 * LDSTR * 2));
    for (int chain = blockIdx.x; chain < 128; chain += gridDim.x) {
    f32x4 sacc[4];
#pragma unroll
    for (int mt = 0; mt < 4; ++mt) sacc[mt] = (f32x4){0.f, 0.f, 0.f, 0.f};
    bf16x8 mf[4][4][2]; u32x2 nf[4][4];
    if (VARIANT == 2) {
#pragma unroll
        for (int a_ = 0; a_ < 4; ++a_)
#pragma unroll
            for (int b_ = 0; b_ < 4; ++b_) { mf[a_][b_][0] = (bf16x8){0,0,0,0,0,0,0,0}; mf[a_][b_][1] = mf[a_][b_][0]; nf[a_][b_] = (u32x2){0u, 0u}; }
    }
    const bf16* MN0 = B.MN() + (size_t)chain * 32 * 8192;
    bf16* SB0 = B.SB() + (size_t)chain * 32 * 4096;
#define SCAN_LOAD(slot, step) do { if (VARIANT == 2) break; const bf16* Mg_ = MN0 + (size_t)(step) * 8192; const bf16* NTg_ = Mg_ + 4096; \
        _Pragma("unroll") for (int mt = 0; mt < 4; ++mt) { mf[slot][mt][0] = *(const bf16x8*)(Mg_ + ((mt * 2) * 64 + lane) * 8); mf[slot][mt][1] = *(const bf16x8*)(Mg_ + ((mt * 2 + 1) * 64 + lane) * 8); \
            nf[slot][mt] = *(const u32x2*)(NTg_ + ((vp * 4 + mt) * 64 + lane) * 4); } } while (0)
#define SCAN_STEP(slot, step) do { bf16* Sg_ = SB0 + (size_t)(step) * 4096; \
        _Pragma("unroll") for (int mt = 0; mt < 4; ++mt) { u32x2 o; o.x = pk2(sacc[mt][0], sacc[mt][1]); o.y = pk2(sacc[mt][2], sacc[mt][3]); \
            if (VARIANT == 0) *(u32x2*)(Sg_ + ((vp * 2 + (mt >> 1)) * 64 + (2 * (mt & 1) + (g >> 1)) * 16 + r16) * 8 + 4 * (g & 1)) = o; *(LAS u32x2*)(St + r16 * LDSTR + mt * 16 + 4 * g) = o; } \
        LDS_WAIT(); \
        const bf16x8 s0 = *(const LAS bf16x8*)(St + r16 * LDSTR + 8 * g), s1 = *(const LAS bf16x8*)(St + r16 * LDSTR + 32 + 8 * g); \
        _Pragma("unroll") for (int mt = 0; mt < 4; ++mt) { const u32x2 nv = nf[slot][mt]; \
            f32x4 a = {bf2f(nv.x & 0xffffu), bf2f(nv.x >> 16), bf2f(nv.y & 0xffffu), bf2f(nv.y >> 16)}; \
            a = mfma16(mf[slot][mt][0], s0, a); a = mfma16(mf[slot][mt][1], s1, a); sacc[mt] = a; } \
        LDS_WAIT(); } while (0)
#define SCAN_PIN() asm volatile("" ::: "memory")
    SCAN_LOAD(0, 0); SCAN_LOAD(1, 1); SCAN_LOAD(2, 2); SCAN_PIN();
#pragma unroll
    for (int c0 = 0; c0 < 32; c0 += 4) {
        SCAN_LOAD(3, c0 + 3); SCAN_PIN();
        SCAN_STEP(0, c0); SCAN_PIN();
        if (c0 + 4 < 32) { SCAN_LOAD(0, c0 + 4); SCAN_PIN(); }
        SCAN_STEP(1, c0 + 1); SCAN_PIN();
        if (c0 + 5 < 32) { SCAN_LOAD(1, c0 + 5); SCAN_PIN(); }
        SCAN_STEP(2, c0 + 2); SCAN_PIN();
        if (c0 + 6 < 32) { SCAN_LOAD(2, c0 + 6); SCAN_PIN(); }
        SCAN_STEP(3, c0 + 3); SCAN_PIN();
    }
#undef SCAN_PIN
#undef SCAN_LOAD
#undef SCAN_STEP
    }
    }
}

__device__ __forceinline__ void phase_dnout(const Params& p, const DnBufs& B) {
    const int tid = fresh_tid(), lane = tid & 63, wave = tid >> 6, G = gridDim.x;
    const int r16 = lane & 15, g = lane >> 4;
    for (int task = blockIdx.x * 8 + wave; task < 8192; task += G * 8) {
        const int w = task & 3, tc = (task >> 2) & 31, bh = task >> 7, h = bh & 7, b = bh >> 3;
        f32x4 acc[4];
#pragma unroll
        for (int vt = 0; vt < 4; ++vt) acc[vt] = (f32x4){0.f, 0.f, 0.f, 0.f};
#pragma unroll
        for (int dir = 0; dir < 2; ++dir) {
            const int cc = dir ? 31 - tc : tc;
            const bf16* Qg = B.QO() + ((size_t)((bh * 2 + dir) * 32 + tc)) * 8192; const bf16* O0g = Qg + 4096;
            const bf16* Sg = B.SB() + ((size_t)((bh * 2 + dir) * 32 + cc)) * 4096;
            const bf16x8 q0 = *(const bf16x8*)(Qg + ((w * 2) * 64 + lane) * 8), q1 = *(const bf16x8*)(Qg + ((w * 2 + 1) * 64 + lane) * 8);
#pragma unroll
            for (int vt = 0; vt < 4; ++vt) {
                const u32x2 ov = *(const u32x2*)(O0g + ((w * 4 + vt) * 64 + lane) * 4);
                acc[vt][0] += bf2f(ov.x & 0xffffu); acc[vt][1] += bf2f(ov.x >> 16); acc[vt][2] += bf2f(ov.y & 0xffffu); acc[vt][3] += bf2f(ov.y >> 16);
                const bf16x8 s0 = *(const bf16x8*)(Sg + ((vt * 2) * 64 + lane) * 8), s1 = *(const bf16x8*)(Sg + ((vt * 2 + 1) * 64 + lane) * 8);
                acc[vt] = mfma16(s0, q0, acc[vt]); acc[vt] = mfma16(s1, q1, acc[vt]);
            }
        }
        float ss = 0.f;
#pragma unroll
        for (int vt = 0; vt < 4; ++vt)
#pragma unroll
            for (int r = 0; r < 4; ++r) ss = fmaf(acc[vt][r], acc[vt][r], ss);
        ss += __shfl_xor(ss, 16); ss += __shfl_xor(ss, 32);
        const float rn = rsqrtf(ss * (1.f / 64.f) + RMS_EPS);
        const int t = tc * 64 + 16 * w + r16;
#pragma unroll
        for (int vt = 0; vt < 4; ++vt) {
            const int v = vt * 16 + 4 * g;
            const u32x2 zv = *(const u32x2*)(p.Z() + ((size_t)bh * 2048 + t) * 64 + v);
            const f32x4 nw = *(const f32x4*)(p.norm_w + v);
            u32x2 o; o.x = pk2(acc[vt][0] * rn * nw[0] * bf2f(zv.x & 0xffffu), acc[vt][1] * rn * nw[1] * bf2f(zv.x >> 16));
            o.y = pk2(acc[vt][2] * rn * nw[2] * bf2f(zv.y & 0xffffu), acc[vt][3] * rn * nw[3] * bf2f(zv.y >> 16));
            *(u32x2*)(p.DNOUT() + ((size_t)b * 2048 + t) * 512 + h * 64 + v) = o;
        }
    }
}
#define WSP_TAB_ROWINFO(ws_) ((int*)((ws_) + ((size_t)243 << 20) + ((size_t)576 << 10)))
struct MixBufs { char* ws; char* out;
    __device__ __forceinline__ bf16* GB() const { return WSP(bf16, 179); }
    __device__ __forceinline__ bf16* MERGED() const { return WSP(bf16, 211); }
    __device__ __forceinline__ bf16* V() const { return WSP(bf16, 179); } };
template <int MODE>
struct EpiMerge {
    static constexpr bool PERM = true, AFTER_DRAIN = false;
    bf16* GB; bf16* MG;
    __device__ __forceinline__ void operator()(const pg8::f32x4 (&acc)[2][2][4][2], const pg8::Unit& u, int wr, int wc, int fr, int fq) const {
#pragma unroll
        for (int ai = 0; ai < 2; ++ai)
#pragma unroll
            for (int m = 0; m < 4; ++m) {
                const size_t row = (size_t)u.pm * 256 + ai * 128 + wr * 64 + m * 16 + fr;
#pragma unroll
                for (int bj = 0; bj < 2; ++bj) {
                    const int col = u.pn * 256 + bj * 128 + wc * 32 + 8 * fq;
                    const pg8::f32x4 v0 = acc[ai][bj][m][0], v1 = acc[ai][bj][m][1];
                    float e[8] = {v0[0], v0[1], v0[2], v0[3], v1[0], v1[1], v1[2], v1[3]};
                    if (MODE == 0) {
#pragma unroll
                        for (int j = 0; j < 8; ++j) e[j] = sigmoidf_(e[j]);
                    } else {
                        const u32x4 gw = *(const u32x4*)(GB + row * 1024 + col);
                        const unsigned gws[4] = {gw.x, gw.y, gw.z, gw.w};
#pragma unroll
                        for (int j = 0; j < 4; ++j) { e[2 * j] *= bf2f(gws[j] & 0xffffu); e[2 * j + 1] *= bf2f(gws[j] >> 16); }
                        if (MODE == 2) {
                            const u32x4 mw = *(const u32x4*)(MG + row * 1024 + col);
                            const unsigned mws[4] = {mw.x, mw.y, mw.z, mw.w};
#pragma unroll
                            for (int j = 0; j < 4; ++j) { e[2 * j] += bf2f(mws[j] & 0xffffu); e[2 * j + 1] += bf2f(mws[j] >> 16); }
                        }
                    }
                    u32x4 w; w.x = pk2(e[0], e[1]); w.y = pk2(e[2], e[3]); w.z = pk2(e[4], e[5]); w.w = pk2(e[6], e[7]);
                    *(u32x4*)((MODE == 0 ? GB : MG) + row * 1024 + col) = w;
                }
            }
    }
};
struct EpiOutProj {
    static constexpr bool PERM = true, AFTER_DRAIN = false;
    const bf16* xb; bf16* V;
    __device__ __forceinline__ void operator()(const pg8::f32x4 (&acc)[2][2][4][2], const pg8::Unit& u, int wr, int wc, int fr, int fq) const {
#pragma unroll
        for (int ai = 0; ai < 2; ++ai)
#pragma unroll
            for (int m = 0; m < 4; ++m) {
                const size_t row = (size_t)u.pm * 256 + ai * 128 + wr * 64 + m * 16 + fr;
#pragma unroll
                for (int bj = 0; bj < 2; ++bj) {
                    const int col = u.pn * 256 + bj * 128 + wc * 32 + 8 * fq;
                    const u32x4 xv = *(const u32x4*)(xb + row * 1024 + col);
                    const pg8::f32x4 a0 = acc[ai][bj][m][0], a1 = acc[ai][bj][m][1];
                    u32x4 w; w.x = pk2(ALPHA * bf2f(xv.x & 0xffffu) + a0[0], ALPHA * bf2f(xv.x >> 16) + a0[1]); w.y = pk2(ALPHA * bf2f(xv.y & 0xffffu) + a0[2], ALPHA * bf2f(xv.y >> 16) + a0[3]);
                    w.z = pk2(ALPHA * bf2f(xv.z & 0xffffu) + a1[0], ALPHA * bf2f(xv.z >> 16) + a1[1]); w.w = pk2(ALPHA * bf2f(xv.w & 0xffffu) + a1[2], ALPHA * bf2f(xv.w >> 16) + a1[3]);
                    *(u32x4*)(V + row * 1024 + col) = w;
                }
            }
    }
};
__device__ __forceinline__ void phase_merge(const Params& p, const MixBufs& B, LAS unsigned char* lds) {
    pg8::StaticOrder S; S.init(NTOK, 1024, gridDim.x, (int)blockIdx.x);
    { pg8::Gemm g{p.XB(), p.WG(), NTOK, 1024, 1024}; EpiMerge<0> E{B.GB(), B.MERGED()}; pg8::gemm_phase<EpiMerge<0>, pg8::StaticOrder, true, true>(lds, g, S, E); }
    { pg8::Gemm g{p.NAOUT(), p.WPNA(), NTOK, 1024, 512}; EpiMerge<1> E{B.GB(), B.MERGED()}; pg8::gemm_phase<EpiMerge<1>, pg8::StaticOrder, true, true>(lds, g, S, E); }
    { pg8::Gemm g{p.XB(), p.WG() + (size_t)1024 * 1024, NTOK, 1024, 1024}; EpiMerge<0> E{B.GB(), B.MERGED()}; pg8::gemm_phase<EpiMerge<0>, pg8::StaticOrder, true, true>(lds, g, S, E); }
    { pg8::Gemm g{p.DNOUT(), p.WPDN(), NTOK, 1024, 512}; EpiMerge<2> E{B.GB(), B.MERGED()}; pg8::gemm_phase<EpiMerge<2>, pg8::StaticOrder, true, true>(lds, g, S, E); }
}
__device__ __forceinline__ void phase_outproj(const Params& p, const MixBufs& B, LAS unsigned char* lds) {
    { int* ri = WSP_TAB_ROWINFO(p.ws); for (int i = blockIdx.x * NT + fresh_tid(); i < 40960; i += gridDim.x * NT) ri[i] = -1; }
    pg8::StaticOrder S; S.init(NTOK, 1024, gridDim.x, (int)blockIdx.x);
    pg8::Gemm g{B.MERGED(), p.WOUT(), NTOK, 1024, 1024}; EpiOutProj E{p.XB(), B.V()};
    pg8::gemm_phase<EpiOutProj, pg8::StaticOrder, true, true>(lds, g, S, E);
}
struct MoeBufs { char* ws; char* out; int kdown; unsigned* ctr;
#define TBP(T, kb) ((T*)(ws + ((size_t)243 << 20) + ((size_t)(kb) << 10)))
    __device__ __forceinline__ const bf16* V() const { return WSP(bf16, 179); }
    __device__ __forceinline__ bf16* X1B() const { return WSP(bf16, 17); }
    __device__ __forceinline__ bf16* XS() const { return WSP(bf16, 97); }
    __device__ __forceinline__ bf16* HID() const { return WSP(bf16, 211); }
    __device__ __forceinline__ bf16* YPART() const { return WSP(bf16, 97); }
    __device__ __forceinline__ int* SPILL() const { return TBP(int, 0); }
    __device__ __forceinline__ int* ROUTE() const { return TBP(int, 64); }
    __device__ __forceinline__ float* ROUTEP() const { return TBP(float, 384); }
    __device__ __forceinline__ int* ROWINFO() const { return TBP(int, 576); }
    __device__ __forceinline__ float* ROWPW() const { return TBP(float, 768); }
    __device__ __forceinline__ float* STATS() const { return TBP(float, 960); }
    __device__ __forceinline__ bf16* RWH() const { return TBP(bf16, 1152); }
    __device__ __forceinline__ bf16* RWL() const { return TBP(bf16, 1280); }
};
#define XSTR 1032
#define TAB_OFF 131072
#define MOE_OVF_BASE 32768
#ifndef MOE_CAP
#define MOE_CAP 1280
#endif
__device__ __forceinline__ int moe_row(int e, int slot) { return slot < 1024 ? e * 1024 + slot : MOE_OVF_BASE + e * 256 + (slot - 1024); }

__device__ __forceinline__ void phase0_router(const Params& p, const MoeBufs& B) {
    const size_t gt = (size_t)blockIdx.x * NT + fresh_tid(), GT = (size_t)gridDim.x * NT;
    for (size_t i = gt; i < 48 * 1024; i += GT) {
        const int n = (int)(i >> 10), k = (int)(i & 1023);
        const float w = n < 4 ? p.wrg[k * 4 + n] : (n < 36 ? p.wre[k * 32 + n - 4] : 0.f);
        const unsigned hi = f2bf(w); const float lo = w - bf2f(hi);
        B.RWH()[i] = (bf16)hi; B.RWL()[i] = (bf16)f2bf(lo);
    }
}

__device__ __forceinline__ float wave_sum64(float v) {
#pragma unroll
    for (int o = 1; o < 64; o <<= 1) v += __shfl_xor(v, o);
    return v;
}

__device__ __forceinline__ void phase_ln1(const Params& p, const MoeBufs& B, LAS unsigned char* lds) {
    const int tid = fresh_tid(), lane = tid & 63, wave = tid >> 6;
    const int r16 = lane & 15, g = lane >> 4;
    LAS bf16* XH = (LAS bf16*)lds;
    LAS bf16* XL = (LAS bf16*)(lds + 16 * XSTR * 2);
    LAS float* PART = (LAS float*)(lds + 2 * 16 * XSTR * 2);
    LAS float* LOG = PART + 8 * 16 * 48;
    LAS int* rowdst = (LAS int*)(LOG + 16 * 36);
    LAS int* ihist = rowdst + 32;
    LAS int* rinfo = ihist + 32;
    LAS float* rpw = (LAS float*)(rinfo + 64);
    if (tid < 32) ihist[tid] = 0;
    bf16x8 rbh[4][3], rbl[4][3];
#pragma unroll
    for (int ks = 0; ks < 4; ++ks)
#pragma unroll
        for (int nt = 0; nt < 3; ++nt) { const int k0 = wave * 128 + ks * 32 + 8 * g;
            rbh[ks][nt] = *(const bf16x8*)(B.RWH() + (size_t)(nt * 16 + r16) * 1024 + k0); rbl[ks][nt] = *(const bf16x8*)(B.RWL() + (size_t)(nt * 16 + r16) * 1024 + k0); }
    for (int blk = blockIdx.x; blk < 256; blk += gridDim.x) {
        u32x4 vpre[2][2];
#pragma unroll
        for (int q = 0; q < 2; ++q)
#pragma unroll
            for (int j = 0; j < 2; ++j) vpre[q][j] = *(const u32x4*)(B.V() + ((size_t)blk * 64 + 2 * wave + q) * 1024 + 8 * lane + 512 * j);
        for (int itn = 0; itn < 4; ++itn) {
            __syncthreads();
#pragma unroll
            for (int q = 0; q < 2; ++q) {
                const int lt = 2 * wave + q; const size_t tg = (size_t)blk * 64 + itn * 16 + lt;
                float v[2][8]; float s = 0.f;
#pragma unroll
                for (int j = 0; j < 2; ++j) { const unsigned wv[4] = {vpre[q][j].x, vpre[q][j].y, vpre[q][j].z, vpre[q][j].w};
#pragma unroll
                    for (int e = 0; e < 4; ++e) { v[j][2 * e] = bf2f(wv[e] & 0xffffu); v[j][2 * e + 1] = bf2f(wv[e] >> 16); s += v[j][2 * e] + v[j][2 * e + 1]; } }
                if (itn < 3) {
#pragma unroll
                    for (int j = 0; j < 2; ++j) vpre[q][j] = *(const u32x4*)(B.V() + (tg + 16) * 1024 + 8 * lane + 512 * j);
                }
                const float mu = wave_sum64(s) * (1.f / 1024.f);
                float qq = 0.f;
#pragma unroll
                for (int j = 0; j < 2; ++j)
#pragma unroll
                    for (int e = 0; e < 8; ++e) { v[j][e] -= mu; qq = fmaf(v[j][e], v[j][e], qq); }
                const float rstd = rsqrtf(wave_sum64(qq) * (1.f / 1024.f) + LN_EPS);
                if (lane == 0) { B.STATS()[tg * 2] = mu; B.STATS()[tg * 2 + 1] = rstd; }
#pragma unroll
                for (int j = 0; j < 2; ++j) {
                    const int c = 8 * lane + 512 * j;
                    const f32x4 g0 = *(const f32x4*)(p.ln1_g + c), g1 = *(const f32x4*)(p.ln1_g + c + 4), b0 = *(const f32x4*)(p.ln1_b + c), b1 = *(const f32x4*)(p.ln1_b + c + 4);
                    float y[8], lo[8];
#pragma unroll
                    for (int e = 0; e < 4; ++e) { y[e] = v[j][e] * rstd * g0[e] + b0[e]; y[4 + e] = v[j][4 + e] * rstd * g1[e] + b1[e]; }
                    u32x4 hw; hw.x = pk2(y[0], y[1]); hw.y = pk2(y[2], y[3]); hw.z = pk2(y[4], y[5]); hw.w = pk2(y[6], y[7]);
                    const unsigned hws[4] = {hw.x, hw.y, hw.z, hw.w};
#pragma unroll
                    for (int e = 0; e < 4; ++e) { lo[2 * e] = y[2 * e] - bf2f(hws[e] & 0xffffu); lo[2 * e + 1] = y[2 * e + 1] - bf2f(hws[e] >> 16); }
                    u32x4 lw; lw.x = pk2(lo[0], lo[1]); lw.y = pk2(lo[2], lo[3]); lw.z = pk2(lo[4], lo[5]); lw.w = pk2(lo[6], lo[7]);
                    *(LAS u32x4*)(XH + lt * XSTR + c) = hw; *(LAS u32x4*)(XL + lt * XSTR + c) = lw;
                }
            }
            __syncthreads();
            {
                f32x4 acc[3];
#pragma unroll
                for (int nt = 0; nt < 3; ++nt) acc[nt] = (f32x4){0.f, 0.f, 0.f, 0.f};
#pragma unroll
                for (int ks = 0; ks < 4; ++ks) {
                    const int k0 = wave * 128 + ks * 32 + 8 * g;
                    const bf16x8 ah = *(const LAS bf16x8*)(XH + r16 * XSTR + k0), al = *(const LAS bf16x8*)(XL + r16 * XSTR + k0);
#pragma unroll
                    for (int nt = 0; nt < 3; ++nt) {
                        acc[nt] = mfma16(ah, rbh[ks][nt], acc[nt]); acc[nt] = mfma16(ah, rbl[ks][nt], acc[nt]); acc[nt] = mfma16(al, rbh[ks][nt], acc[nt]);
                    }
                }
#pragma unroll
                for (int nt = 0; nt < 3; ++nt)
#pragma unroll
                    for (int r = 0; r < 4; ++r) PART[(wave * 16 + 4 * g + r) * 48 + nt * 16 + r16] = acc[nt][r];
            }
            __syncthreads();
            for (int idx = tid; idx < 16 * 36; idx += NT) {
                const int tk = idx / 36, n = idx % 36;
                float a = n < 4 ? p.brg[n] : p.bre[n - 4];
#pragma unroll
                for (int w2 = 0; w2 < 8; ++w2) a += PART[(w2 * 16 + tk) * 48 + n];
                LOG[tk * 36 + n] = a;
            }
            __syncthreads();
            if (tid < 16) {
                const LAS float* lg = LOG + tid * 36; const size_t tg = (size_t)blk * 64 + itn * 16 + tid;
                int gi = 0; float gm = lg[0];
                for (int q = 1; q < 4; ++q) if (lg[q] > gm) { gm = lg[q]; gi = q; }
                float gs = 0.f;
                for (int q = 0; q < 4; ++q) gs += expf(lg[q] - gm);
                const float gp = 1.f / gs;
                const LAS float* el = lg + 4 + gi * 8;
                int i1 = 0; float l1 = el[0];
                for (int e = 1; e < 8; ++e) if (el[e] > l1) { l1 = el[e]; i1 = e; }
                int i2 = -1; float l2 = -3.0e38f;
                for (int e = 0; e < 8; ++e) if (e != i1 && el[e] > l2) { l2 = el[e]; i2 = e; }
                const float e2 = expf(l2 - l1);
                const int e0 = gi * 8 + i1, e1 = gi * 8 + i2;
                const float pw0 = gp / (1.f + e2), pw1 = gp * e2 / (1.f + e2);
                rinfo[tid * 4] = e0; rinfo[tid * 4 + 1] = atomicAdd((int*)&ihist[e0], 1); rinfo[tid * 4 + 2] = e1; rinfo[tid * 4 + 3] = atomicAdd((int*)&ihist[e1], 1);
                rpw[tid * 2] = pw0; rpw[tid * 2 + 1] = pw1;
            }
            __syncthreads();
            if (tid < 32) { const int c = ihist[tid]; ihist[tid] = c ? (int)__hip_atomic_fetch_add(B.ctr + tid, (unsigned)c, __ATOMIC_RELAXED, __HIP_MEMORY_SCOPE_AGENT) : 0; }
            __syncthreads();
            if (tid < 32) {
                const int e = rinfo[tid * 2], slot = ihist[e] + rinfo[tid * 2 + 1]; const size_t tg = (size_t)blk * 64 + itn * 16 + (tid >> 1); const float pw = rpw[tid];
                int row = -1;
                if (slot < MOE_CAP) { row = moe_row(e, slot); B.ROWINFO()[row] = (int)tg * 2 + (tid & 1); B.ROWPW()[row] = pw; }
                else { const int si = (int)__hip_atomic_fetch_add(B.ctr + 32, 1u, __ATOMIC_RELAXED, __HIP_MEMORY_SCOPE_AGENT); B.SPILL()[si] = (int)tg * 2 + (tid & 1); B.ROUTE()[tg * 4 + (tid & 1)] = e; B.ROUTEP()[tg * 2 + (tid & 1)] = pw; }
                rowdst[tid] = row;
            }
            __syncthreads();
            if (tid < 32) ihist[tid] = 0;
            {
                const int q = tid >> 4, pc = tid & 15, row = rowdst[q];
                if (row >= 0) {
                    const LAS bf16* src = XH + (q >> 1) * XSTR + pc * 64; bf16* dst = B.XS() + (size_t)row * 1024 + pc * 64;
#pragma unroll
                    for (int i = 0; i < 8; ++i) *(u32x4*)(dst + i * 8) = *(const LAS u32x4*)(src + i * 8);
                }
            }
        }
    }
}

__device__ __forceinline__ void moe_tables(const MoeBufs& B, LAS unsigned char* lds, int nj) {
    const int tid = fresh_tid();
    LAS int* tab = (LAS int*)(lds + TAB_OFF);
    __syncthreads();
    if (tid < 32) { int c = (int)__hip_atomic_load(B.ctr + tid, __ATOMIC_RELAXED, __HIP_MEMORY_SCOPE_AGENT); tab[66 + tid] = c > MOE_CAP ? MOE_CAP : c; }
    __syncthreads();
    if (tid == 0) { int cum = 0, og = 0; for (int e = 0; e < 32; ++e) { tab[e] = cum; tab[33 + e] = 4 * e; tab[132 + e] = og; const int tot = tab[66 + e]; const int mainr = tot > 1024 ? 1024 : tot;
            cum += ((mainr + 255) >> 8) * nj; og += tot > 1024 ? (tot - 1024 + 15) >> 4 : 0; } tab[32] = cum; tab[164] = og; }
    __syncthreads();
}
struct MoeSched {
    const LAS int* tab; int G, c, nj;
    __device__ __forceinline__ bool next(int i, pg8::Unit& u) const {
        int L = i * G + c; const int U = tab[32]; if (L >= U) return false;
        { const int q = U >> 3, r = U & 7, xcd = L & 7, off = L >> 3; L = (xcd < r ? xcd * (q + 1) : r * (q + 1) + (xcd - r) * q) + off; }
        int e = 0;
#pragma unroll
        for (int k = 1; k < 32; ++k) e += (L >= tab[k]) ? 1 : 0;
        const int rem = L - tab[e], j = rem % nj, rt = rem / nj;
        u.pm = tab[33 + e] + rt; u.pn = e * nj + j; return true;
    }
    __device__ __forceinline__ void a_ready(const pg8::Unit&) const {}
    __device__ __forceinline__ void done(const pg8::Unit&) const {}
};
struct EpiGateUp {
    static constexpr bool PERM = true, AFTER_DRAIN = false;
    bf16* HID; const float* ROWPW;
    __device__ __forceinline__ void operator()(const pg8::f32x4 (&acc)[2][2][4][2], const pg8::Unit& u, int wr, int wc, int fr, int fq) const {
#pragma unroll
        for (int ai = 0; ai < 2; ++ai)
#pragma unroll
            for (int m = 0; m < 4; ++m) {
                const size_t row = (size_t)u.pm * 256 + ai * 128 + wr * 64 + m * 16 + fr;
                const float pw = ROWPW[row];
                const int f = (u.pn & 1) * 128 + wc * 32 + 8 * fq;
                const pg8::f32x4 g0 = acc[ai][0][m][0], g1 = acc[ai][0][m][1], u0 = acc[ai][1][m][0], u1 = acc[ai][1][m][1];
                float e[8];
#pragma unroll
                for (int j = 0; j < 4; ++j) { e[j] = siluf_(g0[j]) * u0[j] * pw; e[4 + j] = siluf_(g1[j]) * u1[j] * pw; }
                u32x4 w; w.x = pk2(e[0], e[1]); w.y = pk2(e[2], e[3]); w.z = pk2(e[4], e[5]); w.w = pk2(e[6], e[7]);
                *(u32x4*)(HID + row * 256 + f) = w;
            }
    }
};
struct EpiDown {
    static constexpr bool PERM = true, AFTER_DRAIN = false;
    bf16* YPART; const int* ROWINFO;
    __device__ __forceinline__ void operator()(const pg8::f32x4 (&acc)[2][2][4][2], const pg8::Unit& u, int wr, int wc, int fr, int fq) const {
        const int j = u.pn & 3;
#pragma unroll
        for (int ai = 0; ai < 2; ++ai)
#pragma unroll
            for (int m = 0; m < 4; ++m) {
                const int row = u.pm * 256 + ai * 128 + wr * 64 + m * 16 + fr;
                asm volatile("" ::: "memory");
                const int info = ROWINFO[row];
                if (info >= 0) {
                    const size_t tg = (size_t)(info >> 1); const int k = info & 1;
#pragma unroll
                    for (int bj = 0; bj < 2; ++bj) {
                        const int col = j * 256 + bj * 128 + wc * 32 + 8 * fq;
                        const pg8::f32x4 v0 = acc[ai][bj][m][0], v1 = acc[ai][bj][m][1];
                        u32x4 w; w.x = pk2(v0[0], v0[1]); w.y = pk2(v0[2], v0[3]); w.z = pk2(v1[0], v1[1]); w.w = pk2(v1[2], v1[3]);
                        *(u32x4*)(YPART + ((size_t)k * NTOK + tg) * 1024 + col) = w;
                    }
                }
            }
    }
};
__device__ __forceinline__ void moe1_overflow(const Params& p, const MoeBufs& B, LAS unsigned char* lds) {
    const int tid = fresh_tid(), lane = tid & 63, wave = tid >> 6, r16 = lane & 15, g = lane >> 4;
    const LAS int* tab = (const LAS int*)(lds + TAB_OFF);
    LAS float* part = (LAS float*)lds;
    const int ntask = tab[164] * 8;
    for (int tk = blockIdx.x; tk < ntask; tk += gridDim.x) {
        const int t = tk >> 3, fc = tk & 7;
        int e = 0;
#pragma unroll
        for (int k = 1; k < 32; ++k) e += (t >= tab[132 + k]) ? 1 : 0;
        const size_t R0 = (size_t)MOE_OVF_BASE + (size_t)e * 256 + (size_t)(t - tab[132 + e]) * 16;
        const bf16* A = B.XS() + (R0 + r16) * 1024 + wave * 128 + 8 * g;
        const bf16* Wg = p.WGU() + ((size_t)e * 512 + (fc >> 2) * 256 + 32 * (fc & 3) + r16) * 1024 + wave * 128 + 8 * g;
        f32x4 acc[4];
#pragma unroll
        for (int q = 0; q < 4; ++q) acc[q] = (f32x4){0.f, 0.f, 0.f, 0.f};
#pragma unroll
        for (int ks = 0; ks < 4; ++ks) {
            const bf16x8 a = *(const bf16x8*)(A + ks * 32);
#pragma unroll
            for (int q = 0; q < 4; ++q) acc[q] = mfma16(a, *(const bf16x8*)(Wg + (size_t)((q >> 1) * 128 + 16 * (q & 1)) * 1024 + ks * 32), acc[q]);
        }
        __syncthreads();
#pragma unroll
        for (int q = 0; q < 4; ++q) *(LAS f32x4*)(part + ((wave * 4 + q) * 64 + lane) * 4) = acc[q];
        __syncthreads();
        {
            const int fs = tid >> 8, l2 = (tid >> 2) & 63, r = tid & 3;
            float gs = 0.f, us = 0.f;
#pragma unroll
            for (int w2 = 0; w2 < 8; ++w2) { gs += part[((w2 * 4 + fs) * 64 + l2) * 4 + r]; us += part[((w2 * 4 + 2 + fs) * 64 + l2) * 4 + r]; }
            const size_t row = R0 + 4 * (l2 >> 4) + r;
            B.HID()[row * 256 + 32 * fc + 16 * fs + (l2 & 15)] = (bf16)f2bf(siluf_(gs) * us * B.ROWPW()[row]);
        }
    }
}
__device__ __forceinline__ void moe2_overflow(const Params& p, const MoeBufs& B, LAS unsigned char* lds) {
    const int tid = fresh_tid(), lane = tid & 63, wave = tid >> 6, r16 = lane & 15, g = lane >> 4;
    const LAS int* tab = (const LAS int*)(lds + TAB_OFF);
    LAS float* part = (LAS float*)lds;
    const int ntask = tab[164] * 8;
    for (int tk = blockIdx.x; tk < ntask; tk += gridDim.x) {
        const int t = tk >> 3, nc = tk & 7;
        int e = 0;
#pragma unroll
        for (int k = 1; k < 32; ++k) e += (t >= tab[132 + k]) ? 1 : 0;
        const size_t R0 = (size_t)MOE_OVF_BASE + (size_t)e * 256 + (size_t)(t - tab[132 + e]) * 16;
        const bf16x8 a = *(const bf16x8*)(B.HID() + (R0 + r16) * 256 + wave * 32 + 8 * g);
        const bf16* W = p.WD() + ((size_t)e * 1024 + 128 * nc + r16) * 256 + wave * 32 + 8 * g;
        __syncthreads();
#pragma unroll
        for (int nt = 0; nt < 8; ++nt) { const f32x4 v = mfma16(a, *(const bf16x8*)(W + (size_t)(16 * nt) * 256), (f32x4){0.f, 0.f, 0.f, 0.f});
            *(LAS f32x4*)(part + ((wave * 8 + nt) * 64 + lane) * 4) = v; }
        __syncthreads();
#pragma unroll
        for (int q = 0; q < 4; ++q) {
            const int idx = tid + q * NT, nt = idx >> 8, l2 = (idx >> 2) & 63, r = idx & 3;
            float s = 0.f;
#pragma unroll
            for (int w2 = 0; w2 < 8; ++w2) s += part[((w2 * 8 + nt) * 64 + l2) * 4 + r];
            const int info = B.ROWINFO()[R0 + 4 * (l2 >> 4) + r];
            if (info >= 0) B.YPART()[((size_t)(info & 1) * NTOK + (size_t)(info >> 1)) * 1024 + 128 * nc + 16 * nt + (l2 & 15)] = (bf16)f2bf(s);
        }
    }
}
__device__ __forceinline__ void moe_spill(const Params& p, const MoeBufs& B) {
    const int tid = fresh_tid(), lane = tid & 63, wave = tid >> 6;
    const int nsp = (int)__hip_atomic_load(B.ctr + 32, __ATOMIC_RELAXED, __HIP_MEMORY_SCOPE_AGENT);
    for (int si = blockIdx.x * 8 + wave; si < nsp; si += gridDim.x * 8) {
        const int info = B.SPILL()[si]; const size_t tg = (size_t)(info >> 1); const int k = info & 1;
        const int e = B.ROUTE()[tg * 4 + k]; const float pw = B.ROUTEP()[tg * 2 + k];
        const float mu = B.STATS()[tg * 2], rstd = B.STATS()[tg * 2 + 1];
        float x1[16];
#pragma unroll
        for (int j = 0; j < 2; ++j) { const int c = 8 * lane + 512 * j; const u32x4 xv = *(const u32x4*)(B.V() + tg * 1024 + c); const unsigned xs[4] = {xv.x, xv.y, xv.z, xv.w};
#pragma unroll
            for (int i = 0; i < 8; ++i) { const float v = (i & 1) ? bf2f(xs[i >> 1] >> 16) : bf2f(xs[i >> 1] & 0xffffu); x1[8 * j + i] = bf2f(f2bf((v - mu) * rstd * p.ln1_g[c + i] + p.ln1_b[c + i])); } }
        float hid[4];
#pragma unroll 1
        for (int f0 = 0; f0 < 256; f0 += 4) {
            float hv[4];
#pragma unroll
            for (int q = 0; q < 4; ++q) { const int f = f0 + q; const bf16* wg = p.WGU() + ((size_t)e * 512 + (f >> 7) * 256 + (f & 127)) * 1024; const bf16* wu = wg + (size_t)128 * 1024;
                float sg = 0.f, su = 0.f;
#pragma unroll
                for (int j = 0; j < 2; ++j) { const u32x4 a = *(const u32x4*)(wg + 8 * lane + 512 * j), b2 = *(const u32x4*)(wu + 8 * lane + 512 * j); const unsigned as[4] = {a.x, a.y, a.z, a.w}, bs[4] = {b2.x, b2.y, b2.z, b2.w};
#pragma unroll
                    for (int i = 0; i < 8; ++i) { const float xa = x1[8 * j + i]; sg = fmaf(xa, (i & 1) ? bf2f(as[i >> 1] >> 16) : bf2f(as[i >> 1] & 0xffffu), sg); su = fmaf(xa, (i & 1) ? bf2f(bs[i >> 1] >> 16) : bf2f(bs[i >> 1] & 0xffffu), su); } }
                sg = wave_sum64(sg); su = wave_sum64(su);
                hv[q] = bf2f(f2bf(siluf_(sg) * su * pw)); }
            if ((f0 >> 2) == lane) { hid[0] = hv[0]; hid[1] = hv[1]; hid[2] = hv[2]; hid[3] = hv[3]; }
        }
#pragma unroll 1
        for (int n = 0; n < 1024; ++n) {
            const u32x2 wv = *(const u32x2*)(p.WD() + ((size_t)e * 1024 + n) * 256 + 4 * lane);
            float s = hid[0] * bf2f(wv.x & 0xffffu) + hid[1] * bf2f(wv.x >> 16) + hid[2] * bf2f(wv.y & 0xffffu) + hid[3] * bf2f(wv.y >> 16);
            s = wave_sum64(s);
            if (lane == 0) B.YPART()[((size_t)k * NTOK + tg) * 1024 + n] = (bf16)f2bf(s);
        }
    }
}
__device__ __forceinline__ void phase_moe1(const Params& p, const MoeBufs& B, LAS unsigned char* lds) {
    moe_tables(B, lds, 2);
    MoeSched S{(const LAS int*)(lds + TAB_OFF), (int)gridDim.x, (int)blockIdx.x, 2};
    pg8::Gemm g{B.XS(), p.WGU(), 0, 0, 1024}; EpiGateUp E{B.HID(), B.ROWPW()};
    pg8::gemm_phase<EpiGateUp, MoeSched, true, true>(lds, g, S, E);
    moe1_overflow(p, B, lds);
}
__device__ __forceinline__ void phase_moe2(const Params& p, const MoeBufs& B, LAS unsigned char* lds) {
    moe_tables(B, lds, 4);
    MoeSched S{(const LAS int*)(lds + TAB_OFF), (int)gridDim.x, (int)blockIdx.x, 4};
    pg8::Gemm g{B.HID(), p.WD(), 0, 0, B.kdown}; EpiDown E{B.YPART(), B.ROWINFO()};
    pg8::gemm_phase<EpiDown, MoeSched, true, true>(lds, g, S, E);
    moe2_overflow(p, B, lds);
    moe_spill(p, B);
}
__device__ __forceinline__ void phase_ln2(const Params& p, const MoeBufs& B) {
    const int tid = fresh_tid(), lane = tid & 63, wave = tid >> 6;
    for (size_t tg = (size_t)blockIdx.x * 8 + wave; tg < NTOK; tg += (size_t)gridDim.x * 8) {
        const float mu1 = B.STATS()[tg * 2], rstd1 = B.STATS()[tg * 2 + 1];
        float v[2][8]; float s = 0.f;
#pragma unroll
        for (int j = 0; j < 2; ++j) {
            const int c = 8 * lane + 512 * j;
            const u32x4 xv = *(const u32x4*)(B.V() + tg * 1024 + c);
            const u32x4 y0 = *(const u32x4*)(B.YPART() + tg * 1024 + c), y1 = *(const u32x4*)(B.YPART() + ((size_t)NTOK + tg) * 1024 + c);
            const f32x4 g0 = *(const f32x4*)(p.ln1_g + c), g1 = *(const f32x4*)(p.ln1_g + c + 4), b0 = *(const f32x4*)(p.ln1_b + c), b1 = *(const f32x4*)(p.ln1_b + c + 4);
            const unsigned xs[4] = {xv.x, xv.y, xv.z, xv.w}, y0s[4] = {y0.x, y0.y, y0.z, y0.w}, y1s[4] = {y1.x, y1.y, y1.z, y1.w};
#pragma unroll
            for (int e = 0; e < 4; ++e) {
                const float ga = e < 2 ? g0[2 * e] : g1[2 * e - 4], gb = e < 2 ? g0[2 * e + 1] : g1[2 * e - 3], ba = e < 2 ? b0[2 * e] : b1[2 * e - 4], bb = e < 2 ? b0[2 * e + 1] : b1[2 * e - 3];
                v[j][2 * e] = ALPHA * ((bf2f(xs[e] & 0xffffu) - mu1) * rstd1 * ga + ba) + bf2f(y0s[e] & 0xffffu) + bf2f(y1s[e] & 0xffffu);
                v[j][2 * e + 1] = ALPHA * ((bf2f(xs[e] >> 16) - mu1) * rstd1 * gb + bb) + bf2f(y0s[e] >> 16) + bf2f(y1s[e] >> 16);
                s += v[j][2 * e] + v[j][2 * e + 1];
            }
        }
        const float mu = wave_sum64(s) * (1.f / 1024.f);
        float qq = 0.f;
#pragma unroll
        for (int j = 0; j < 2; ++j)
#pragma unroll
            for (int e = 0; e < 8; ++e) { v[j][e] -= mu; qq = fmaf(v[j][e], v[j][e], qq); }
        const float rstd = rsqrtf(wave_sum64(qq) * (1.f / 1024.f) + LN_EPS);
#pragma unroll
        for (int j = 0; j < 2; ++j) {
            const int c = 8 * lane + 512 * j;
            const f32x4 g0 = *(const f32x4*)(p.ln2_g + c), g1 = *(const f32x4*)(p.ln2_g + c + 4), b0 = *(const f32x4*)(p.ln2_b + c), b1 = *(const f32x4*)(p.ln2_b + c + 4);
            f32x4 o0, o1;
#pragma unroll
            for (int e = 0; e < 4; ++e) { o0[e] = v[j][e] * rstd * g0[e] + b0[e]; o1[e] = v[j][4 + e] * rstd * g1[e] + b1[e]; }
            *(f32x4*)(p.out + tg * 1024 + c) = o0; *(f32x4*)(p.out + tg * 1024 + c + 4) = o1;
        }
    }
}
#ifndef SCAN_VARIANT
#define SCAN_VARIANT 0
#endif
#ifndef BAR_DUP
#define BAR_DUP 0
#endif
#ifndef FWD_REP
#define FWD_REP 1
#endif
#ifndef PH_DUP
#define PH_DUP 0
#endif
#ifndef PH_MASK
#define PH_MASK 8191
#endif
#define BAR_LDS_OFF (LDS_BYTES - 64)
struct MegaArgs { Params p; };
#define CAS __attribute__((address_space(4)))
#define GASC __attribute__((address_space(1)))
__device__ __forceinline__ Params load_params(const CAS char* kp) {
    Params p; const CAS unsigned long long* src = (const CAS unsigned long long*)kp;
    const float** pf = (const float**)&p;
#pragma unroll
    for (int i = 0; i < 22; ++i) pf[i] = (const float*)(const GASC float*)src[i];
    static_assert(offsetof(Params, out) == 22 * 8 && offsetof(Params, ws) == 23 * 8 && offsetof(Params, bar) == 24 * 8 && offsetof(Params, kdown) == 25 * 8, "Params layout");
    p.out = (float*)(GASC float*)src[22]; p.ws = (char*)(GASC char*)src[23]; p.bar = (unsigned*)(GASC unsigned*)src[24];
    p.kdown = (int)(src[25] & 0xffffffffu); p.pad0 = 0;
    return p;
}
#define FRESH_P(name) const CAS char* name##_kp = kptr; asm volatile("" : "+s"(name##_kp)); const Params name = load_params(name##_kp)
#define GRID_BAR() do { const CAS char* b_kp = kptr; asm volatile("" : "+s"(b_kp)); XcdBarrier bar; bar.bar = (unsigned*)(GASC unsigned*)(*(const CAS unsigned long long*)(b_kp + offsetof(Params, bar))); bar.x = xb_xcc_id(); \
        bar.st = (volatile LAS unsigned*)(lds + BAR_LDS_OFF); xcd_barrier(bar); if (BAR_DUP) xcd_barrier(bar); } while (0)
__global__ void __launch_bounds__(NT, 2) mega_fwd(MegaArgs) {
    extern __shared__ __attribute__((aligned(16))) unsigned char lds_raw[];
    LAS unsigned char* lds = (LAS unsigned char*)lds_raw;
    const CAS char* kptr = (const CAS char*)__builtin_amdgcn_kernarg_segment_ptr();
    if (threadIdx.x < 16) ((LAS unsigned*)(lds + BAR_LDS_OFF))[threadIdx.x] = 0u;
    __syncthreads();
    { FRESH_P(p); (void)xcd_barrier_post(p.bar, (volatile LAS unsigned*)(lds + BAR_LDS_OFF)); }
#if PH_MASK & 1
    { FRESH_P(p); const MoeBufs Q{p.ws, (char*)p.out, p.kdown, p.bar + XCD_BAR_WORDS + 16}; phase0(p, lds); phase0_router(p, Q); }
#endif
#if PH_DUP & 1
    GRID_BAR();
    { FRESH_P(p); const MoeBufs Q{p.ws, (char*)p.out, p.kdown, p.bar + XCD_BAR_WORDS + 16}; phase0(p, lds); phase0_router(p, Q); }
#endif
    GRID_BAR();
#if PH_MASK & 2
    { FRESH_P(p); phase1(p, lds); }
#endif
#if PH_DUP & 2
    GRID_BAR();
    { FRESH_P(p); phase1(p, lds); }
#endif
    GRID_BAR();
#if PH_MASK & 4
    { FRESH_P(p); phase_na(p, lds); }
#endif
#if PH_DUP & 4
    GRID_BAR();
    { FRESH_P(p); phase_na(p, lds); }
    GRID_BAR();
#endif
#if PH_MASK & 8
    { FRESH_P(p); const DnBufs D{p.ws, (char*)p.out}; phase_dnprep(p, D, lds); }
#endif
#if PH_DUP & 8
    GRID_BAR();
    { FRESH_P(p); const DnBufs D{p.ws, (char*)p.out}; phase_dnprep(p, D, lds); }
    GRID_BAR();
#endif
    GRID_BAR();
#if PH_MASK & 16
    {
        FRESH_P(p); const DnBufs D{p.ws, (char*)p.out};
        const int nb = (int)gridDim.x;
        unsigned* counter = p.bar + XCD_BAR_WORDS;
        if ((int)blockIdx.x >= 128) phase_zgemm(p, lds, nb - 128, (int)blockIdx.x - 128);
        else if ((fresh_tid() >> 6) >= 4) phase0_moe(p, counter);
        if ((int)blockIdx.x < 128) phase_dnscan(p, D, lds);
        if ((int)blockIdx.x >= 128 || (fresh_tid() >> 6) < 4) phase0_moe(p, counter);
    }
#endif
#if PH_DUP & 16
    GRID_BAR();
    {
        FRESH_P(p); const DnBufs D{p.ws, (char*)p.out};
        const int nb = (int)gridDim.x;
        unsigned* counter = p.bar + XCD_BAR_WORDS;
#if !(PH_DUP & 8192)
        if ((int)blockIdx.x >= 128) phase_zgemm(p, lds, nb - 128, (int)blockIdx.x - 128);
#endif
        if ((int)blockIdx.x >= 128) {} else if ((fresh_tid() >> 6) >= 4) phase0_moe(p, counter);
#if !(PH_DUP & 16384)
        if ((int)blockIdx.x < 128) phase_dnscan<SCAN_VARIANT>(p, D, lds);
#endif
        if ((int)blockIdx.x >= 128 || (fresh_tid() >> 6) < 4) phase0_moe(p, counter);
    }
#endif
    GRID_BAR();
#if PH_MASK & 32
    { FRESH_P(p); const DnBufs D{p.ws, (char*)p.out}; phase_dnout(p, D); }
#endif
#if PH_DUP & 32
    GRID_BAR();
    { FRESH_P(p); const DnBufs D{p.ws, (char*)p.out}; phase_dnout(p, D); }
#endif
    GRID_BAR();
#if PH_MASK & 64
    { FRESH_P(p); const MixBufs X{p.ws, (char*)p.out}; phase_merge(p, X, lds); }
#endif
#if PH_DUP & 64
    GRID_BAR();
    { FRESH_P(p); const MixBufs X{p.ws, (char*)p.out}; phase_merge(p, X, lds); }
#endif
    GRID_BAR();
#if PH_MASK & 128
    { FRESH_P(p); const MixBufs X{p.ws, (char*)p.out}; phase_outproj(p, X, lds); }
#endif
#if PH_DUP & 128
    GRID_BAR();
    { FRESH_P(p); const MixBufs X{p.ws, (char*)p.out}; phase_outproj(p, X, lds); }
#endif
    GRID_BAR();
#if PH_MASK & 256
    { FRESH_P(p); const MoeBufs Q{p.ws, (char*)p.out, p.kdown, p.bar + XCD_BAR_WORDS + 16}; phase_ln1(p, Q, lds); }
#endif
#if PH_DUP & 256
    GRID_BAR();
    { FRESH_P(p); const MoeBufs Q{p.ws, (char*)p.out, p.kdown, p.bar + XCD_BAR_WORDS + 16}; phase_ln1(p, Q, lds); }
#endif
    GRID_BAR();
#if PH_MASK & 1024
    { FRESH_P(p); const MoeBufs Q{p.ws, (char*)p.out, p.kdown, p.bar + XCD_BAR_WORDS + 16}; phase_moe1(p, Q, lds); }
#endif
#if PH_DUP & 1024
    GRID_BAR();
    { FRESH_P(p); const MoeBufs Q{p.ws, (char*)p.out, p.kdown, p.bar + XCD_BAR_WORDS + 16}; phase_moe1(p, Q, lds); }
#endif
    GRID_BAR();
#if PH_MASK & 2048
    { FRESH_P(p); const MoeBufs Q{p.ws, (char*)p.out, p.kdown, p.bar + XCD_BAR_WORDS + 16}; phase_moe2(p, Q, lds); }
#endif
#if PH_DUP & 2048
    GRID_BAR();
    { FRESH_P(p); const MoeBufs Q{p.ws, (char*)p.out, p.kdown, p.bar + XCD_BAR_WORDS + 16}; phase_moe2(p, Q, lds); }
#endif
    GRID_BAR();
#if PH_MASK & 4096
    { FRESH_P(p); const MoeBufs Q{p.ws, (char*)p.out, p.kdown, p.bar + XCD_BAR_WORDS + 16}; phase_ln2(p, Q); }
#endif
#if FWD_REP > 1
    GRID_BAR();
    { FRESH_P(p); if (blockIdx.x == 0 && threadIdx.x < 64) __hip_atomic_store(p.bar + XCD_BAR_WORDS + threadIdx.x, 0u, __ATOMIC_RELAXED, __HIP_MEMORY_SCOPE_AGENT); }
    GRID_BAR();
#if PH_MASK & 1
    { FRESH_P(p); const MoeBufs Q{p.ws, (char*)p.out, p.kdown, p.bar + XCD_BAR_WORDS + 16}; phase0(p, lds); phase0_router(p, Q); }
#endif
#if PH_DUP & 1
    GRID_BAR();
    { FRESH_P(p); const MoeBufs Q{p.ws, (char*)p.out, p.kdown, p.bar + XCD_BAR_WORDS + 16}; phase0(p, lds); phase0_router(p, Q); }
#endif
    GRID_BAR();
#if PH_MASK & 2
    { FRESH_P(p); phase1(p, lds); }
#endif
#if PH_DUP & 2
    GRID_BAR();
    { FRESH_P(p); phase1(p, lds); }
#endif
    GRID_BAR();
#if PH_MASK & 4
    { FRESH_P(p); phase_na(p, lds); }
#endif
#if PH_DUP & 4
    GRID_BAR();
    { FRESH_P(p); phase_na(p, lds); }
    GRID_BAR();
#endif
#if PH_MASK & 8
    { FRESH_P(p); const DnBufs D{p.ws, (char*)p.out}; phase_dnprep(p, D, lds); }
#endif
#if PH_DUP & 8
    GRID_BAR();
    { FRESH_P(p); const DnBufs D{p.ws, (char*)p.out}; phase_dnprep(p, D, lds); }
    GRID_BAR();
#endif
    GRID_BAR();
#if PH_MASK & 16
    {
        FRESH_P(p); const DnBufs D{p.ws, (char*)p.out};
        const int nb = (int)gridDim.x;
        unsigned* counter = p.bar + XCD_BAR_WORDS;
        if ((int)blockIdx.x >= 128) phase_zgemm(p, lds, nb - 128, (int)blockIdx.x - 128);
        else if ((fresh_tid() >> 6) >= 4) phase0_moe(p, counter);
        if ((int)blockIdx.x < 128) phase_dnscan(p, D, lds);
        if ((int)blockIdx.x >= 128 || (fresh_tid() >> 6) < 4) phase0_moe(p, counter);
    }
#endif
#if PH_DUP & 16
    GRID_BAR();
    {
        FRESH_P(p); const DnBufs D{p.ws, (char*)p.out};
        const int nb = (int)gridDim.x;
        unsigned* counter = p.bar + XCD_BAR_WORDS;
#if !(PH_DUP & 8192)
        if ((int)blockIdx.x >= 128) phase_zgemm(p, lds, nb - 128, (int)blockIdx.x - 128);
#endif
        if ((int)blockIdx.x >= 128) {} else if ((fresh_tid() >> 6) >= 4) phase0_moe(p, counter);
#if !(PH_DUP & 16384)
        if ((int)blockIdx.x < 128) phase_dnscan<SCAN_VARIANT>(p, D, lds);
#endif
        if ((int)blockIdx.x >= 128 || (fresh_tid() >> 6) < 4) phase0_moe(p, counter);
    }
#endif
    GRID_BAR();
#if PH_MASK & 32
    { FRESH_P(p); const DnBufs D{p.ws, (char*)p.out}; phase_dnout(p, D); }
#endif
#if PH_DUP & 32
    GRID_BAR();
    { FRESH_P(p); const DnBufs D{p.ws, (char*)p.out}; phase_dnout(p, D); }
#endif
    GRID_BAR();
#if PH_MASK & 64
    { FRESH_P(p); const MixBufs X{p.ws, (char*)p.out}; phase_merge(p, X, lds); }
#endif
#if PH_DUP & 64
    GRID_BAR();
    { FRESH_P(p); const MixBufs X{p.ws, (char*)p.out}; phase_merge(p, X, lds); }
#endif
    GRID_BAR();
#if PH_MASK & 128
    { FRESH_P(p); const MixBufs X{p.ws, (char*)p.out}; phase_outproj(p, X, lds); }
#endif
#if PH_DUP & 128
    GRID_BAR();
    { FRESH_P(p); const MixBufs X{p.ws, (char*)p.out}; phase_outproj(p, X, lds); }
#endif
    GRID_BAR();
#if PH_MASK & 256
    { FRESH_P(p); const MoeBufs Q{p.ws, (char*)p.out, p.kdown, p.bar + XCD_BAR_WORDS + 16}; phase_ln1(p, Q, lds); }
#endif
#if PH_DUP & 256
    GRID_BAR();
    { FRESH_P(p); const MoeBufs Q{p.ws, (char*)p.out, p.kdown, p.bar + XCD_BAR_WORDS + 16}; phase_ln1(p, Q, lds); }
#endif
    GRID_BAR();
#if PH_MASK & 1024
    { FRESH_P(p); const MoeBufs Q{p.ws, (char*)p.out, p.kdown, p.bar + XCD_BAR_WORDS + 16}; phase_moe1(p, Q, lds); }
#endif
#if PH_DUP & 1024
    GRID_BAR();
    { FRESH_P(p); const MoeBufs Q{p.ws, (char*)p.out, p.kdown, p.bar + XCD_BAR_WORDS + 16}; phase_moe1(p, Q, lds); }
#endif
    GRID_BAR();
#if PH_MASK & 2048
    { FRESH_P(p); const MoeBufs Q{p.ws, (char*)p.out, p.kdown, p.bar + XCD_BAR_WORDS + 16}; phase_moe2(p, Q, lds); }
#endif
#if PH_DUP & 2048
    GRID_BAR();
    { FRESH_P(p); const MoeBufs Q{p.ws, (char*)p.out, p.kdown, p.bar + XCD_BAR_WORDS + 16}; phase_moe2(p, Q, lds); }
#endif
    GRID_BAR();
#if PH_MASK & 4096
    { FRESH_P(p); const MoeBufs Q{p.ws, (char*)p.out, p.kdown, p.bar + XCD_BAR_WORDS + 16}; phase_ln2(p, Q); }
#endif
#endif
}

#define MB(x) ((size_t)(x) << 20)
extern "C" void kernel_launch(void* const* d_in, const int* in_sizes, int n_in, void* d_out, int out_size, void* d_ws, size_t ws_size, hipStream_t stream) {
    MegaArgs a{};
    Params& p = a.p;
    p.x = (const float*)d_in[0]; p.w_in = (const float*)d_in[1]; p.rpb = (const float*)d_in[2]; p.conv_w = (const float*)d_in[3];
    p.a_log_f = (const float*)d_in[4]; p.a_log_b = (const float*)d_in[5]; p.dtb_f = (const float*)d_in[6]; p.dtb_b = (const float*)d_in[7];
    p.norm_w = (const float*)d_in[8]; p.w_proj_na = (const float*)d_in[9]; p.w_proj_dn = (const float*)d_in[10]; p.w_out = (const float*)d_in[11];
    p.ln1_g = (const float*)d_in[12]; p.ln1_b = (const float*)d_in[13]; p.wrg = (const float*)d_in[14]; p.brg = (const float*)d_in[15];
    p.wre = (const float*)d_in[16]; p.bre = (const float*)d_in[17]; p.wgu = (const float*)d_in[18]; p.wd = (const float*)d_in[19];
    p.ln2_g = (const float*)d_in[20]; p.ln2_b = (const float*)d_in[21];
    p.out = (float*)d_out;
    p.ws = (char*)d_ws; p.bar = (unsigned*)d_ws; p.kdown = 256;

    static int grid = 0;
    if (grid == 0) {
        int dev = 0, cus = 0, per_cu = 0;
        hipGetDevice(&dev);
        hipDeviceGetAttribute(&cus, hipDeviceAttributeMultiprocessorCount, dev);
        hipFuncSetAttribute((const void*)mega_fwd, hipFuncAttributeMaxDynamicSharedMemorySize, LDS_BYTES);
        hipOccupancyMaxActiveBlocksPerMultiprocessor(&per_cu, (const void*)mega_fwd, NT, LDS_BYTES);
        if (per_cu < 1) { fprintf(stderr, "kernel_launch: occupancy query reports %d workgroups per CU\n", per_cu); per_cu = 1; }
        if (per_cu > 1) per_cu = 1;
        grid = cus * per_cu;
        if (grid > 256) grid = 256;
        (void)hipGetLastError();
    }
    hipMemsetAsync(p.bar, 0, (XCD_BAR_WORDS + 64) * sizeof(unsigned), stream);
    hipLaunchKernelGGL(mega_fwd, dim3(grid), dim3(NT), LDS_BYTES, stream, a);
}
```

```cpp
#include <hip/hip_runtime.h>
#include <math.h>
#include <stdint.h>
#include <stddef.h>
#include <stdio.h>
namespace pg8 {
#define PG8_LAS __attribute__((address_space(3)))
typedef unsigned short bf16_t;
typedef short bf16x8 __attribute__((ext_vector_type(8)));
typedef float f32x4 __attribute__((ext_vector_type(4)));
typedef unsigned u32x4 __attribute__((ext_vector_type(4)));
constexpr int BM = 256, BK = 64, HALF = 128, HTB = HALF * BK * 2  , STAGE_BYTES = 8 * HTB, NXCD = 8, WGM = 8;

__host__ __device__ __forceinline__ int lds_byte(int r, int c) { const int st = (r >> 4) * 2 + (c >> 5), rr = r & 15, cc = c & 31, ob = rr * 64 + cc * 2; return st * 1024 + (ob ^ (((ob >> 9) & 1) << 5)); }
__host__ __device__ __forceinline__ void stage_rc(int b, int& R, int& C) { const int st = b / 1024, sb = b % 1024, swz = sb ^ (((sb >> 9) & 1) << 5); R = (st >> 1) * 16 + swz / 64; C = (st & 1) * 32 + (swz % 64) / 2; }
__host__ __device__ __forceinline__ int perm32(int rho) { const int n = rho >> 4, i = rho & 15; return 8 * (i >> 2) + 4 * n + (i & 3); }

struct Unit { int pm, pn; };
struct Gemm { const bf16_t* A; const bf16_t* Bt; int M, N, K; };

struct StaticOrder {
    int nM, nN, nwg, G, c;
    __host__ __device__ __forceinline__ void init(int M, int N, int G_, int c_) { nM = M / BM; nN = N / BM; nwg = nM * nN; G = G_; c = c_; }
    __host__ __device__ __forceinline__ bool next(int i, Unit& u) const {
        const long L = (long)i * G + c; if (L >= nwg) return false;
        int wgid = (int)L; { const int q = nwg / NXCD, r = nwg % NXCD, xcd = wgid % NXCD, off = wgid / NXCD; wgid = (xcd < r ? xcd * (q + 1) : r * (q + 1) + (xcd - r) * q) + off; }
        const int nig = WGM * nN, gid = wgid / nig, fm = gid * WGM, gsz = (nM - fm) < WGM ? (nM - fm) : WGM;
        u.pm = fm + ((wgid % nig) % gsz); u.pn = (wgid % nig) / gsz; return true;
    }
    __device__ __forceinline__ void a_ready(const Unit&) const {}
    __device__ __forceinline__ void done(const Unit&) const {}
};
__device__ __forceinline__ unsigned cvt_pk_bf16(float lo, float hi) { unsigned r; asm volatile("v_cvt_pk_bf16_f32 %0, %1, %2" : "=v"(r) : "v"(lo), "v"(hi)); return r; }

template <class Epi, class Sched, bool ALIGN_EPI = false, bool SP2 = false>
__device__ __forceinline__ void gemm_phase(PG8_LAS unsigned char* lds, const Gemm g, const Sched& S, const Epi& E) {
    int tid_ = threadIdx.x; asm volatile("" : "+v"(tid_));
    const int tid = tid_, wid = __builtin_amdgcn_readfirstlane(tid >> 6), lane = tid & 63, wr = wid >> 2, wc = wid & 3, fr = lane & 15, fq = lane >> 4;
    const int K = g.K, nt = K / BK;
    unsigned voffA[2], voffB[2];
#pragma unroll
    for (int i = 0; i < 2; ++i) { int R, C; stage_rc(tid * 16 + i * 8192, R, C); const int Rb = Epi::PERM ? ((R & ~31) + perm32(R & 31)) : R;
        voffA[i] = (unsigned)(R * K + C) * 2u; voffB[i] = (unsigned)(Rb * K + C) * 2u; }
    const size_t kstep = (size_t)(BK * 2);
    const size_t hstep = (size_t)HALF * K * 2;
    const size_t tstep = 2 * hstep;
    const unsigned ldsw = (unsigned)wid * 1024u;
    const int aoff = lds_byte(wr * 64 + fr, fq * 8), boff = lds_byte(wc * 32 + fr, fq * 8);
#define PG8_SA(b, h) (((b) * 2 + (h)) * HTB)
#define PG8_SB(b, h) ((4 + (b) * 2 + (h)) * HTB)
#define PG8_STAGE(bufoff, gbase, voff) do { _Pragma("unroll") for (int _i = 0; _i < 2; ++_i) \
        __builtin_amdgcn_global_load_lds((const unsigned*)((const char*)(gbase) + (voff)[_i]), (PG8_LAS unsigned*)(lds + (bufoff) + ldsw + _i * 8192), 16, 0, 0); } while (0)
#define PG8_LDA(dst, b, h) do { _Pragma("unroll") for (int m = 0; m < 4; ++m) _Pragma("unroll") for (int k = 0; k < 2; ++k) dst[m][k] = *(const PG8_LAS bf16x8*)(lds + PG8_SA(b, h) + aoff + m * 2048 + k * 1024); } while (0)
#define PG8_LDB(dst, b, h) do { _Pragma("unroll") for (int n = 0; n < 2; ++n) _Pragma("unroll") for (int k = 0; k < 2; ++k) dst[n][k] = *(const PG8_LAS bf16x8*)(lds + PG8_SB(b, h) + boff + n * 2048 + k * 1024); } while (0)
#define PG8_MMA(ai, bj, At, Bt) do { __builtin_amdgcn_s_setprio(1); _Pragma("unroll") for (int m = 0; m < 4; ++m) _Pragma("unroll") for (int n = 0; n < 2; ++n) _Pragma("unroll") for (int k = 0; k < 2; ++k) \
        acc[ai][bj][m][n] = __builtin_amdgcn_mfma_f32_16x16x32_bf16(Bt[n][k], At[m][k], acc[ai][bj][m][n], 0, 0, 0); __builtin_amdgcn_s_setprio(0); } while (0)
#define PG8_WAIT_V(n) asm volatile("s_waitcnt vmcnt(" #n ")" ::: "memory")
#define PG8_WAIT_L(n) asm volatile("s_waitcnt lgkmcnt(" #n ")" ::: "memory")
#define PG8_BAR __builtin_amdgcn_s_barrier()
#define PG8_SCHED __builtin_amdgcn_sched_barrier(0)
    Unit cur, nxt; int ui = 0;
    if (!S.next(0, cur)) return;
    f32x4 acc[2][2][4][2];
#pragma unroll
    for (int a = 0; a < 2; ++a)
#pragma unroll
        for (int b = 0; b < 2; ++b)
#pragma unroll
            for (int m = 0; m < 4; ++m)
#pragma unroll
                for (int n = 0; n < 2; ++n) acc[a][b][m][n] = (f32x4){0.f, 0.f, 0.f, 0.f};
    bf16x8 At[4][2], B0[2][2], B1[2][2];
    const char* cA = (const char*)g.A + (size_t)cur.pm * tstep; const char* cB = (const char*)g.Bt + (size_t)cur.pn * tstep;
    S.a_ready(cur);
    if constexpr (SP2) {
        PG8_STAGE(PG8_SB(0, 0), cB, voffB); PG8_STAGE(PG8_SB(0, 1), cB + hstep, voffB); PG8_STAGE(PG8_SA(0, 0), cA, voffA); PG8_STAGE(PG8_SA(0, 1), cA + hstep, voffA);
        if (wr == 1) PG8_BAR;
        PG8_WAIT_V(2); PG8_BAR;
        PG8_STAGE(PG8_SB(1, 0), cB + kstep, voffB); PG8_STAGE(PG8_SA(1, 0), cA + kstep, voffA); PG8_STAGE(PG8_SB(1, 1), cB + hstep + kstep, voffB);
        PG8_WAIT_V(6); PG8_BAR;
    } else {
        PG8_STAGE(PG8_SB(0, 0), cB, voffB); PG8_STAGE(PG8_SA(0, 0), cA, voffA); PG8_STAGE(PG8_SB(0, 1), cB + hstep, voffB); PG8_STAGE(PG8_SA(0, 1), cA + hstep, voffA);
        if (wr == 1) PG8_BAR;
        PG8_WAIT_V(4); PG8_BAR;
        PG8_STAGE(PG8_SB(1, 0), cB + kstep, voffB); PG8_STAGE(PG8_SA(1, 0), cA + kstep, voffA); PG8_STAGE(PG8_SB(1, 1), cB + hstep + kstep, voffB);
        PG8_WAIT_V(6); PG8_BAR;
    }
    for (;;) {
        const bool has_next = S.next(ui + 1, nxt);
        const char* nA = has_next ? (const char*)g.A + (size_t)nxt.pm * tstep : cA; const char* nB = has_next ? (const char*)g.Bt + (size_t)nxt.pn * tstep : cB;
        for (int t = 0; t < nt; t += 2) {
            const bool last = (t == nt - 2);
            const char* a1 = cA + (size_t)(t + 1) * kstep;
            const char* a2 = last ? nA : cA + (size_t)(t + 2) * kstep; const char* b2 = last ? nB : cB + (size_t)(t + 2) * kstep;
            const char* a3 = a2 + kstep; const char* b3 = b2 + kstep;
            if (last && has_next) S.a_ready(nxt);
            if constexpr (SP2) {
            PG8_LDB(B0, 0, 0); PG8_LDB(B1, 0, 1); PG8_SCHED; PG8_LDA(At, 0, 0); PG8_STAGE(PG8_SA(1, 1), a1 + hstep, voffA);
            PG8_WAIT_V(8); PG8_WAIT_L(0); PG8_BAR; PG8_MMA(0, 0, At, B0); PG8_MMA(0, 1, At, B1); PG8_BAR; PG8_SCHED;
            PG8_LDA(At, 0, 1); PG8_STAGE(PG8_SB(0, 0), b2, voffB); PG8_STAGE(PG8_SB(0, 1), b2 + hstep, voffB); PG8_STAGE(PG8_SA(0, 0), a2, voffA);
            PG8_WAIT_V(8); PG8_WAIT_L(0); PG8_BAR; PG8_MMA(1, 0, At, B0); PG8_MMA(1, 1, At, B1); PG8_BAR; PG8_SCHED;
            PG8_LDB(B0, 1, 0); PG8_LDB(B1, 1, 1); PG8_SCHED; PG8_LDA(At, 1, 0); PG8_STAGE(PG8_SA(0, 1), a2 + hstep, voffA);
            PG8_WAIT_V(8); PG8_WAIT_L(0); PG8_BAR; PG8_MMA(0, 0, At, B0); PG8_MMA(0, 1, At, B1); PG8_BAR; PG8_SCHED;
            PG8_LDA(At, 1, 1); PG8_STAGE(PG8_SB(1, 0), b3, voffB); PG8_STAGE(PG8_SB(1, 1), b3 + hstep, voffB); PG8_STAGE(PG8_SA(1, 0), a3, voffA);
            PG8_WAIT_V(8); PG8_WAIT_L(0); PG8_BAR; PG8_MMA(1, 0, At, B0); PG8_MMA(1, 1, At, B1); PG8_BAR; PG8_SCHED;
            } else {
            PG8_LDB(B0, 0, 0); PG8_SCHED; PG8_LDA(At, 0, 0); PG8_STAGE(PG8_SA(1, 1), a1 + hstep, voffA);
            PG8_WAIT_L(8); PG8_BAR; PG8_WAIT_L(0); PG8_MMA(0, 0, At, B0); PG8_BAR; PG8_SCHED;
            PG8_LDB(B1, 0, 1); PG8_STAGE(PG8_SB(0, 0), b2, voffB);
            PG8_BAR; PG8_WAIT_L(0); PG8_MMA(0, 1, At, B1); PG8_BAR;
            PG8_LDA(At, 0, 1); PG8_STAGE(PG8_SA(0, 0), a2, voffA);
            PG8_BAR; PG8_WAIT_L(0); PG8_MMA(1, 0, At, B0); PG8_BAR; PG8_SCHED;
            PG8_STAGE(PG8_SB(0, 1), b2 + hstep, voffB);
            PG8_WAIT_V(6); PG8_BAR; PG8_MMA(1, 1, At, B1); PG8_BAR;
            PG8_LDB(B0, 1, 0); PG8_SCHED; PG8_LDA(At, 1, 0); PG8_STAGE(PG8_SA(0, 1), a2 + hstep, voffA);
            PG8_WAIT_L(8); PG8_BAR; PG8_WAIT_L(0); PG8_MMA(0, 0, At, B0); PG8_BAR; PG8_SCHED;
            PG8_LDB(B1, 1, 1); PG8_STAGE(PG8_SB(1, 0), b3, voffB);
            PG8_BAR; PG8_WAIT_L(0); PG8_MMA(0, 1, At, B1); PG8_BAR;
            PG8_LDA(At, 1, 1); PG8_STAGE(PG8_SA(1, 0), a3, voffA);
            PG8_BAR; PG8_WAIT_L(0); PG8_MMA(1, 0, At, B0); PG8_BAR; PG8_SCHED;
            PG8_STAGE(PG8_SB(1, 1), b3 + hstep, voffB);
            PG8_WAIT_V(6); PG8_BAR; PG8_MMA(1, 1, At, B1); PG8_BAR;
            }
        }
        if constexpr (ALIGN_EPI) { if (wr == 0) PG8_BAR; }
        if constexpr (!Epi::AFTER_DRAIN) { E(acc, cur, wr, wc, fr, fq); S.done(cur); }
        if (!has_next) break;
#pragma unroll
        for (int a = 0; a < 2; ++a)
#pragma unroll
            for (int b = 0; b < 2; ++b)
#pragma unroll
                for (int m = 0; m < 4; ++m)
#pragma unroll
                    for (int n = 0; n < 2; ++n) acc[a][b][m][n] = (f32x4){0.f, 0.f, 0.f, 0.f};
        cur = nxt; cA = nA; cB = nB; ++ui;
        if constexpr (ALIGN_EPI) { if (wr == 1) PG8_BAR; }
    }
    PG8_WAIT_V(0);
    if constexpr (!ALIGN_EPI) { if (wr == 0) PG8_BAR; }
    PG8_BAR;
    if constexpr (Epi::AFTER_DRAIN) { E.fused(acc, cur, wr, wc, fr, fq, lds, wid, lane); S.done(cur); }
#undef PG8_SA
#undef PG8_SB
#undef PG8_STAGE
#undef PG8_LDA
#undef PG8_LDB
#undef PG8_MMA
#undef PG8_WAIT_V
#undef PG8_WAIT_L
#undef PG8_BAR
#undef PG8_SCHED
}
}
typedef unsigned short bf16;
#define LAS __attribute__((address_space(3)))
typedef float f32x4 __attribute__((ext_vector_type(4)));
typedef short bf16x8 __attribute__((ext_vector_type(8)));
typedef unsigned u32x4 __attribute__((ext_vector_type(4)));
typedef unsigned u32x2 __attribute__((ext_vector_type(2)));

#define D_MODEL 1024
#define BATCH 8
#define SEQ 2048
#define D_IN 5664
#define NTOK (BATCH * SEQ)
#define ALPHA 1.189207115002721f
#define LN_EPS 1e-5f
#define RMS_EPS 1e-6f
#define NWIN 3072
#define NT 512
#define LDS_BYTES 147456

#define LDS_WAIT() asm volatile("s_waitcnt lgkmcnt(0)" ::: "memory")
#define VM_WAIT() asm volatile("s_waitcnt vmcnt(0)" ::: "memory")

__device__ __forceinline__ int fresh_tid() { int t = threadIdx.x; asm volatile("" : "+v"(t)); return t; }
typedef float f32x2_t __attribute__((ext_vector_type(2)));
typedef __bf16 bf16x2_t __attribute__((ext_vector_type(2)));
__device__ __forceinline__ unsigned pk2(float lo, float hi) { const f32x2_t v = {lo, hi}; const bf16x2_t b = __builtin_convertvector(v, bf16x2_t); return __builtin_bit_cast(unsigned, b); }
__device__ __forceinline__ unsigned f2bf(float f) { return pk2(f, 0.f) & 0xffffu; }
#ifndef WT_STORES
#define WT_STORES 0
#endif
__device__ __forceinline__ void st16(void* ptr, u32x4 v) {
#if WT_STORES
    asm volatile("global_store_dwordx4 %0, %1, off sc1\n\ts_nop 1" :: "v"(ptr), "v"(v) : "memory");
#else
    *(u32x4*)ptr = v;
#endif
}
__device__ __forceinline__ float bf2f(unsigned h) { return __builtin_bit_cast(float, (h & 0xffffu) << 16); }
__device__ __forceinline__ float sigmoidf_(float x) { return __builtin_amdgcn_rcpf(1.f + __expf(-x)); }
__device__ __forceinline__ float siluf_(float x) { return x * __builtin_amdgcn_rcpf(1.f + __expf(-x)); }
__device__ __forceinline__ float softplusf_(float x) { return x > 20.f ? x : log1pf(expf(x)); }

struct Params {
    const float *x, *w_in, *rpb, *conv_w, *a_log_f, *a_log_b, *dtb_f, *dtb_b, *norm_w, *w_proj_na, *w_proj_dn, *w_out, *ln1_g, *ln1_b;
    const float *wrg, *brg, *wre, *bre, *wgu, *wd, *ln2_g, *ln2_b;
    float* out;
    char* ws;
    unsigned* bar;
    int kdown, pad0;
#define WSP(T, mb) ((T*)(ws + ((size_t)(mb) << 20)))
    __device__ __forceinline__ bf16* WIN() const { return WSP(bf16, 1); }
    __device__ __forceinline__ bf16* WG() const { return WSP(bf16, 9); }
    __device__ __forceinline__ bf16* WPNA() const { return WSP(bf16, 13); }
    __device__ __forceinline__ bf16* WPDN() const { return WSP(bf16, 14); }
    __device__ __forceinline__ bf16* WOUT() const { return WSP(bf16, 15); }
    __device__ __forceinline__ bf16* XB() const { return WSP(bf16, 17); }
    __device__ __forceinline__ bf16* WGU() const { return WSP(bf16, 49); }
    __device__ __forceinline__ bf16* WD() const { return WSP(bf16, 81); }
    __device__ __forceinline__ bf16* QNA() const { return WSP(bf16, 49); }
    __device__ __forceinline__ bf16* KNA() const { return WSP(bf16, 65); }
    __device__ __forceinline__ bf16* VNAT() const { return WSP(bf16, 81); }
    __device__ __forceinline__ bf16* QKVDN() const { return WSP(bf16, 97); }
    __device__ __forceinline__ bf16* Z() const { return WSP(bf16, 145); }
    __device__ __forceinline__ float* GATES() const { return WSP(float, 161); }
    __device__ __forceinline__ bf16* NAOUT() const { return WSP(bf16, 163); }
    __device__ __forceinline__ bf16* DNOUT() const { return WSP(bf16, 129); }
};

__device__ __forceinline__ void transpose_item(const float* W, size_t ldW, bf16* WT, int Kdst, int k0, int n0, int rowdst0, LAS float*  , int lane) {
    const int m = lane & 15, g = lane >> 4;
    bf16x8 idb[2];
#pragma unroll
    for (int half = 0; half < 2; ++half)
#pragma unroll
        for (int j = 0; j < 8; ++j) idb[half][j] = (8 * g + j == m + 16 * half) ? (short)0x3F80 : (short)0;
#pragma unroll
    for (int kg = 0; kg < 2; ++kg) {
        f32x4 d[2][2];
#pragma unroll
        for (int q = 0; q < 2; ++q) {
            const float* src = W + (size_t)(k0 + 32 * kg + 8 * (m >> 2) + 4 * q + (m & 3)) * ldW + n0 + 8 * g;
            const f32x4 a0 = *(const f32x4*)src, a1 = *(const f32x4*)(src + 4);
            u32x4 aw; aw.x = pk2(a0[0], a0[1]); aw.y = pk2(a0[2], a0[3]); aw.z = pk2(a1[0], a1[1]); aw.w = pk2(a1[2], a1[3]);
            const bf16x8 af = __builtin_bit_cast(bf16x8, aw);
#pragma unroll
            for (int half = 0; half < 2; ++half) d[q][half] = __builtin_amdgcn_mfma_f32_16x16x32_bf16(af, idb[half], (f32x4){0.f, 0.f, 0.f, 0.f}, 0, 0, 0);
        }
#pragma unroll
        for (int half = 0; half < 2; ++half) {
            u32x4 o; o.x = pk2(d[0][half][0], d[0][half][1]); o.y = pk2(d[0][half][2], d[0][half][3]); o.z = pk2(d[1][half][0], d[1][half][1]); o.w = pk2(d[1][half][2], d[1][half][3]);
            *(u32x4*)(WT + (size_t)(rowdst0 + 16 * half + m) * Kdst + k0 + 32 * kg + 8 * g) = o;
        }
    }
}

#define IT_WIN (16 * 113)
#define IT_WG (16 * 64)
#define IT_WPNA (8 * 32)
#define IT_WPDN (8 * 32)
#define IT_WOUT (16 * 32)
#define IT_SMALL (IT_WIN + IT_WG + IT_WPNA + IT_WPDN + IT_WOUT)
#define IT_WGU (32 * 16 * 16)
#define IT_WD (32 * 4 * 32)

__device__ __forceinline__ void p0_small_item(const Params& p, int r, LAS float* scr, int lane) {
    if (r < IT_WIN) { const int kb = r / 113, nb = r % 113; transpose_item(p.w_in, D_IN, p.WIN(), 1024, kb * 64, nb * 32, nb * 32, scr, lane); return; } r -= IT_WIN;
    if (r < IT_WG) { const int kb = r / 64, nb = r % 64; transpose_item(p.w_in + 3616, D_IN, p.WG(), 1024, kb * 64, nb * 32, nb * 32, scr, lane); return; } r -= IT_WG;
    if (r < IT_WPNA) { const int kb = r / 32, nb = r % 32; transpose_item(p.w_proj_na, 1024, p.WPNA(), 512, kb * 64, nb * 32, nb * 32, scr, lane); return; } r -= IT_WPNA;
    if (r < IT_WPDN) { const int kb = r / 32, nb = r % 32; transpose_item(p.w_proj_dn, 1024, p.WPDN(), 512, kb * 64, nb * 32, nb * 32, scr, lane); return; } r -= IT_WPDN;
    { const int kb = r / 32, nb = r % 32; transpose_item(p.w_out, 1024, p.WOUT(), 1024, kb * 64, nb * 32, nb * 32, scr, lane); }
}
__device__ __forceinline__ void p0_moe_item(const Params& p, int r, LAS float* scr, int lane) {
    if (r < IT_WGU) { const int e = r / 256, q = r % 256, kb = q / 16, nb = q % 16;
        const int n0 = nb * 32, up = n0 >= 256, f0 = n0 - (up ? 256 : 0);
        transpose_item(p.wgu + (size_t)e * 1024 * 512, 512, p.WGU(), 1024, kb * 64, n0, e * 512 + (f0 / 128) * 256 + (up ? 128 : 0) + (f0 % 128), scr, lane); return; }
    r -= IT_WGU;
    { const int e = r / 128, q = r % 128, kb = q / 32, nb = q % 32;
        transpose_item(p.wd + (size_t)e * 256 * 1024, 1024, p.WD(), 256, kb * 64, nb * 32, e * 1024 + nb * 32, scr, lane); }
}

__device__ __forceinline__ void phase0_moe(const Params& p, unsigned* counter) {
    const int lane = fresh_tid() & 63;
    for (;;) {
        unsigned base = 0;
        if (lane == 0) base = __hip_atomic_fetch_add(counter, 4u, __ATOMIC_RELAXED, __HIP_MEMORY_SCOPE_AGENT);
        base = (unsigned)__builtin_amdgcn_readfirstlane((int)base);
        if (base >= (unsigned)(IT_WGU + IT_WD)) break;
#pragma unroll 2
        for (int k = 0; k < 4; ++k) p0_moe_item(p, (int)base + k, nullptr, lane);
    }
}
__device__ __forceinline__ void phase0(const Params& p, LAS unsigned char* lds) {
    const int tid = fresh_tid(), lane = tid & 63, wave = tid >> 6, G = gridDim.x;
    LAS float* scr = (LAS float*)(lds + wave * 16384);
    const int gw = blockIdx.x * 8 + wave, NGW = G * 8;
    for (int it = gw; it < IT_SMALL; it += NGW) p0_small_item(p, it, scr, lane);
    const size_t gt = (size_t)blockIdx.x * NT + tid, GT = (size_t)G * NT;
    for (size_t i = gt; i < (size_t)NTOK * 1024 / 8; i += GT) {
        const f32x4 a = *(const f32x4*)(p.x + i * 8), b = *(const f32x4*)(p.x + i * 8 + 4);
        u32x4 o; o.x = pk2(a.x, a.y); o.y = pk2(a.z, a.w); o.z = pk2(b.x, b.y); o.w = pk2(b.z, b.w);
        *(u32x4*)(p.XB() + i * 8) = o;
    }
}

struct EpiInProj {
    static constexpr bool PERM = true, AFTER_DRAIN = false;
    LAS unsigned char* lds_epi;
    struct Mini { char* ws;
        __device__ __forceinline__ bf16* QNA() const { return WSP(bf16, 49); }
        __device__ __forceinline__ bf16* KNA() const { return WSP(bf16, 65); }
        __device__ __forceinline__ bf16* VNAT() const { return WSP(bf16, 81); }
        __device__ __forceinline__ bf16* QKVDN() const { return WSP(bf16, 97); }
    } p;
    __device__ __forceinline__ void operator()(const pg8::f32x4 (&acc)[2][2][4][2], const pg8::Unit& u, int wr, int wc, int fr, int fq) const {
        const int pn = u.pn;
#pragma unroll
        for (int ai = 0; ai < 2; ++ai)
#pragma unroll
            for (int m = 0; m < 4; ++m) {
                const int row = u.pm * 256 + ai * 128 + wr * 64 + m * 16 + fr;
                const int b = row >> 11, t = row & 2047;
#pragma unroll
                for (int bj = 0; bj < 2; ++bj) {
                    const pg8::f32x4 v0 = acc[ai][bj][m][0], v1 = acc[ai][bj][m][1];
                    const int head = (pn & 1) * 4 + bj * 2 + (wc >> 1), d0 = (wc & 1) * 32 + 8 * fq;
                    const size_t hm = ((size_t)(b * 8 + head) * 2048 + t) * 64 + d0;
                    if (pn < 4 || pn >= 6) {
                        bf16* dst; float sc = 1.f;
                        if (pn < 2) { dst = p.QNA(); sc = 0.125f; }
                        else if (pn < 4) dst = p.KNA();
                        else dst = p.QKVDN() + (size_t)((pn - 6) >> 1) * ((size_t)NTOK * 512);
                        float e[8] = {v0[0], v0[1], v0[2], v0[3], v1[0], v1[1], v1[2], v1[3]};
#pragma unroll
                        for (int j = 0; j < 8; ++j) e[j] *= sc;
                        u32x4 w; w.x = pk2(e[0], e[1]); w.y = pk2(e[2], e[3]); w.z = pk2(e[4], e[5]); w.w = pk2(e[6], e[7]);
                        st16(dst + hm, w);
                    } else {
                        LAS bf16* scr = (LAS bf16*)(lds_epi + (wr * 4 + wc) * 1280);
                        const float e[8] = {v0[0], v0[1], v0[2], v0[3], v1[0], v1[1], v1[2], v1[3]};
#pragma unroll
                        for (int j = 0; j < 8; ++j) scr[(8 * fq + j) * 20 + fr] = (bf16)f2bf(e[j]);
                        LDS_WAIT();
                        const int lane = fq * 16 + fr, dd = lane >> 1, hf = lane & 1;
                        const u32x2 lo = *(const LAS u32x2*)(scr + dd * 20 + 8 * hf), hi = *(const LAS u32x2*)(scr + dd * 20 + 8 * hf + 4);
                        const int t0 = (u.pm * 256 + ai * 128 + wr * 64 + m * 16) & 2047;
                        u32x4 w; w.x = lo.x; w.y = lo.y; w.z = hi.x; w.w = hi.y;
                        *(u32x4*)(p.VNAT() + ((size_t)(b * 8 + head) * 64 + (wc & 1) * 32 + dd) * 2048 + t0 + 8 * hf) = w;
                        LDS_WAIT();
                    }
                }
            }
    }
};
struct EpiZ {
    static constexpr bool PERM = true, AFTER_DRAIN = false;
    bf16* Z;
    __device__ __forceinline__ void operator()(const pg8::f32x4 (&acc)[2][2][4][2], const pg8::Unit& u, int wr, int wc, int fr, int fq) const {
#pragma unroll
        for (int ai = 0; ai < 2; ++ai)
#pragma unroll
            for (int m = 0; m < 4; ++m) {
                const int row = u.pm * 256 + ai * 128 + wr * 64 + m * 16 + fr;
                const int b = row >> 11, t = row & 2047;
#pragma unroll
                for (int bj = 0; bj < 2; ++bj) {
                    const pg8::f32x4 v0 = acc[ai][bj][m][0], v1 = acc[ai][bj][m][1];
                    const int head = (u.pn & 1) * 4 + bj * 2 + (wc >> 1), d0 = (wc & 1) * 32 + 8 * fq;
                    float e[8] = {v0[0], v0[1], v0[2], v0[3], v1[0], v1[1], v1[2], v1[3]};
#pragma unroll
                    for (int j = 0; j < 8; ++j) e[j] = siluf_(e[j]);
                    u32x4 w; w.x = pk2(e[0], e[1]); w.y = pk2(e[2], e[3]); w.z = pk2(e[4], e[5]); w.w = pk2(e[6], e[7]);
                    *(u32x4*)(Z + ((size_t)(b * 8 + head) * 2048 + t) * 64 + d0) = w;
                }
            }
    }
};
__device__ __forceinline__ void gates_minigemm(const Params& p) {
    const int tid = fresh_tid(), lane = tid & 63, wave = tid >> 6, r16 = lane & 15, g = lane >> 4;
    for (int blk = blockIdx.x; blk < 256; blk += gridDim.x) {
        const int mt = wave & 3, nt = wave >> 2;
        const bf16* A = p.XB() + ((size_t)blk * 64 + mt * 16 + r16) * 1024 + 8 * g;
        const bf16* Bt = p.WIN() + ((size_t)3584 + nt * 16 + r16) * 1024 + 8 * g;
        f32x4 acc0 = {0.f, 0.f, 0.f, 0.f}, acc1 = {0.f, 0.f, 0.f, 0.f};
#pragma unroll 8
        for (int ks = 0; ks < 32; ks += 2) {
            acc0 = __builtin_amdgcn_mfma_f32_16x16x32_bf16(*(const bf16x8*)(A + ks * 32), *(const bf16x8*)(Bt + ks * 32), acc0, 0, 0, 0);
            acc1 = __builtin_amdgcn_mfma_f32_16x16x32_bf16(*(const bf16x8*)(A + ks * 32 + 32), *(const bf16x8*)(Bt + ks * 32 + 32), acc1, 0, 0, 0);
        }
        const int col = nt * 16 + r16, type = col >> 3, hd = col & 7;
        const size_t tg0 = (size_t)blk * 64 + mt * 16 + 4 * g; const int b = (int)(tg0 >> 11), t = (int)(tg0 & 2047);
        f32x4 o;
#pragma unroll
        for (int r = 0; r < 4; ++r) {
            const float e = acc0[r] + acc1[r];
            o[r] = type < 2 ? sigmoidf_(e) : (type == 2 ? -expf(p.a_log_f[hd]) * softplusf_(e + p.dtb_f[hd]) : -expf(p.a_log_b[hd]) * softplusf_(e + p.dtb_b[hd]));
        }
        *(f32x4*)(p.GATES() + (size_t)type * NTOK * 8 + ((size_t)b * 8 + hd) * 2048 + t) = o;
    }
}

__device__ __forceinline__ void phase1(const Params& p, LAS unsigned char* lds) {
    pg8::Gemm g{p.XB(), p.WIN(), NTOK, NWIN, 1024};
    pg8::StaticOrder S; S.init(NTOK, NWIN, gridDim.x, (int)blockIdx.x);
    EpiInProj E{lds + 131072, {p.ws}};
    pg8::gemm_phase<EpiInProj, pg8::StaticOrder, true, true>(lds, g, S, E);
    gates_minigemm(p);
}
__device__ __forceinline__ void phase_zgemm(const Params& p, LAS unsigned char* lds, int nb, int c) {
    pg8::Gemm g{p.XB(), p.WIN() + (size_t)3072 * 1024, NTOK, 512, 1024};
    pg8::StaticOrder S; S.init(NTOK, 512, nb, c);
    EpiZ E{p.Z()};
    pg8::gemm_phase<EpiZ, pg8::StaticOrder, true, true>(lds, g, S, E);
}

#define XB_TMO      128
#define XB_XCNT(j)  (256  + 64 * (j))
#define XB_XSUB(j)  (1280 + 64 * (j))
#define XB_XGEN(j)  (2304 + 64 * (j))
#define XB_TOP      3328
#define XB_TOPGEN   3392
#define XCD_BAR_WORDS 3456
#define XB_SPIN_CAP (1u << 18)


__device__ __forceinline__ unsigned xb_ld(unsigned* p)              { return __hip_atomic_load(p, __ATOMIC_RELAXED, __HIP_MEMORY_SCOPE_AGENT); }
__device__ __forceinline__ unsigned xb_add(unsigned* p, unsigned v) { return __hip_atomic_fetch_add(p, v, __ATOMIC_RELAXED, __HIP_MEMORY_SCOPE_AGENT); }
__device__ __forceinline__ unsigned xb_xcc_id() { return (unsigned)__builtin_amdgcn_s_getreg((3 << 11) | 20) & 0xFu; }
#define XB_SPIN(cond, bar) do { unsigned _sp = 0; while (cond) { __builtin_amdgcn_s_sleep(1); \
    if ((++_sp & 255u) == 0u) { if (xb_ld(&(bar)[XB_TMO])) break; if (_sp > XB_SPIN_CAP) { atomicAdd(&(bar)[XB_TMO], 1u); break; } } } } while (0)

struct XcdBarrier {
    unsigned* bar; unsigned x;
    volatile LAS unsigned* st;
};

__device__ __forceinline__ XcdBarrier xcd_barrier_post(unsigned* bar, volatile LAS unsigned* st) {
    XcdBarrier b; b.bar = bar; b.x = xb_xcc_id(); b.st = st;
    if (threadIdx.x == 0) (void)xb_add(&bar[XB_XCNT(b.x)], 1u);
    return b;
}
__device__ __forceinline__ void xcd_barrier_complete(unsigned* bar, unsigned x, unsigned& nloc, unsigned& nx) {
    const unsigned G = gridDim.x * gridDim.y * gridDim.z;
    unsigned sum, cnt, mine, sp = 0u;
    for (;;) {
        sum = 0u; cnt = 0u; mine = 0u;
#pragma unroll
        for (unsigned j = 0; j < 16; ++j) { const unsigned c = xb_ld(&bar[XB_XCNT(j)]); sum += c; cnt += (c > 0u) ? 1u : 0u; mine = (j == x) ? c : mine; }
        if (sum == G) break;
        __builtin_amdgcn_s_sleep(1);
        if ((++sp & 255u) == 0u) { if (xb_ld(&bar[XB_TMO])) break; if (sp > XB_SPIN_CAP) { atomicAdd(&bar[XB_TMO], 1u); break; } }
    }
    nloc = mine > 0u ? mine : 1u; nx = cnt > 0u ? cnt : 1u;
}

__device__ __forceinline__ void xcd_barrier(const XcdBarrier& b) {
    asm volatile("s_waitcnt vmcnt(0)" ::: "memory");
    __syncthreads();
    if (threadIdx.x == 0) {
        unsigned* bar = b.bar;
        __builtin_amdgcn_s_waitcnt(0);
        unsigned nloc = b.st[0], nx = b.st[1];
        if (nloc == 0u) { xcd_barrier_complete(bar, b.x, nloc, nx); b.st[0] = nloc; b.st[1] = nx; }
        const unsigned old = xb_add(&bar[XB_XSUB(b.x)], 1u);
        const unsigned gen = old / nloc;
        if (old + 1u == (gen + 1u) * nloc) {
            __builtin_amdgcn_fence(__ATOMIC_RELEASE, "agent");
            asm volatile("s_waitcnt vmcnt(0)" ::: "memory");
            const unsigned og = xb_add(&bar[XB_TOP], 1u);
            const unsigned tg = og / nx;
            if (og + 1u == (tg + 1u) * nx) xb_add(&bar[XB_TOPGEN], 1u);
            else XB_SPIN(xb_ld(&bar[XB_TOPGEN]) == tg, bar);
            __builtin_amdgcn_fence(__ATOMIC_ACQUIRE, "agent");
            xb_add(&bar[XB_XGEN(b.x)], 1u);
            asm volatile("s_waitcnt vmcnt(0)" ::: "memory");
        } else {
            XB_SPIN(xb_ld(&bar[XB_XGEN(b.x)]) == gen, bar);
            __builtin_amdgcn_fence(__ATOMIC_ACQUIRE, "agent");
            asm volatile("s_waitcnt vmcnt(0)" ::: "memory");
        }
    }
    __syncthreads();
}
#define NA_VSTR 520
#define NA_V_OFF 65536
#define NA_RPB_OFF (65536 + 64 * NA_VSTR * 2)
__device__ __forceinline__ void phase_na(const Params& p, LAS unsigned char* lds) {
    const int tid = fresh_tid(), lane = tid & 63, wave = tid >> 6, G = gridDim.x;
    const int vcu = (G % 8 == 0) ? ((int)blockIdx.x % 8) * (G / 8) + (int)blockIdx.x / 8 : (int)blockIdx.x;
    LAS unsigned char* Kl = lds;
    LAS bf16* Vl = (LAS bf16*)(lds + NA_V_OFF);
    LAS float* rpb_s = (LAS float*)(lds + NA_RPB_OFF);
    const int qi = lane & 15, g = lane >> 4, qg = wave & 3, dh = wave >> 2;
    const int c0 = qg * 16, c = c0 + qi;
    int cs0 = c0 - 8; cs0 = cs0 < 0 ? 0 : (cs0 > 32 ? 32 : cs0);
    int csq = c - 8; csq = csq < 0 ? 0 : (csq > 48 ? 48 : csq);
    for (int task = vcu; task < 256; task += G) {
        const int bh = task >> 2, r0 = (task & 3) * 8, h = bh & 7, b = bh >> 3;
        const size_t hb = (size_t)bh * 2048;
        const bf16* Kg = p.KNA() + hb * 64;
        const bf16* Vg = p.VNAT() + (size_t)bh * 64 * 2048;
        __syncthreads();
        for (int i = tid; i < 465; i += NT) rpb_s[i] = p.rpb[h * 465 + i];
        {
            int rs0 = r0 - 4; rs0 = rs0 < 0 ? 0 : (rs0 > 24 ? 24 : rs0);
#pragma unroll
            for (int q = 0; q < 8; ++q) {
                const int pc = tid + q * NT;
                const int krow = pc >> 9, col = (pc >> 3) & 63, ch = pc & 7, kr = rs0 + krow, sl = kr & 7;
                const u32x4 kv = *(const u32x4*)(Kg + ((size_t)kr * 64 + col) * 64 + ch * 8);
                *(LAS u32x4*)(Kl + (sl * 64 + col) * 128 + ((ch ^ (col & 7)) << 4)) = kv;
                const int d = (pc >> 3) & 63, vch = pc & 7;
                const u32x4 vv = *(const u32x4*)(Vg + (size_t)d * 2048 + kr * 64 + vch * 8);
                *(LAS u32x4*)(Vl + d * NA_VSTR + sl * 64 + vch * 8) = vv;
            }
        }
        __syncthreads();
        float bt[16][4];
        int bt_delta = 1000;
        bf16x8 qn[2];
#pragma unroll
        for (int ks = 0; ks < 2; ++ks) qn[ks] = *(const bf16x8*)(p.QNA() + (hb + r0 * 64 + c) * 64 + ks * 32 + 8 * g);
        for (int ri = 0; ri < 8; ++ri) {
            const int r = r0 + ri;
            int rs = r - 4; rs = rs < 0 ? 0 : (rs > 24 ? 24 : rs);
            int rsn = r + 1 - 4; rsn = rsn < 0 ? 0 : (rsn > 24 ? 24 : rsn);
            const bool add = (ri < 7) && (rsn != rs);
            u32x4 pk = {0u, 0u, 0u, 0u}, pv = {0u, 0u, 0u, 0u};
            const int ncol = tid >> 3, nch = tid & 7, nkr = rsn + 7;
            if (add) { pk = *(const u32x4*)(Kg + ((size_t)nkr * 64 + ncol) * 64 + nch * 8); pv = *(const u32x4*)(Vg + (size_t)ncol * 2048 + nkr * 64 + nch * 8); }
            bf16x8 qf[2]; qf[0] = qn[0]; qf[1] = qn[1];
            if (ri < 7) {
#pragma unroll
                for (int ks = 0; ks < 2; ++ks) qn[ks] = *(const bf16x8*)(p.QNA() + (hb + (r + 1) * 64 + c) * 64 + ks * 32 + 8 * g);
            }
            if (rs - r != bt_delta) {
                bt_delta = rs - r;
#pragma unroll
                for (int j = 0; j < 8; ++j)
#pragma unroll
                    for (int ct = 0; ct < 2; ++ct)
#pragma unroll
                        for (int rr = 0; rr < 4; ++rr) {
                            const int kc = cs0 + 8 * g + 4 * ct + rr;
                            const bool valid = (kc >= csq) && (kc < csq + 16);
                            int dc = kc - c + 15; dc = dc < 0 ? 0 : (dc > 30 ? 30 : dc);
                            bt[j * 2 + ct][rr] = valid ? rpb_s[(bt_delta + j + 7) * 31 + dc] : -1e30f;
                        }
            }
            float s[16][4];
#pragma unroll
            for (int j = 0; j < 8; ++j) {
                const int sl = (rs + j) & 7;
#pragma unroll
                for (int ct = 0; ct < 2; ++ct) {
                    const int col = cs0 + 8 * (qi >> 2) + 4 * ct + (qi & 3);
                    const LAS unsigned char* kp = Kl + (sl * 64 + col) * 128;
                    f32x4 a = {0.f, 0.f, 0.f, 0.f};
#pragma unroll
                    for (int ks = 0; ks < 2; ++ks) {
                        const bf16x8 kf = *(const LAS bf16x8*)(kp + (((4 * ks + g) ^ (col & 7)) << 4));
                        a = __builtin_amdgcn_mfma_f32_16x16x32_bf16(kf, qf[ks], a, 0, 0, 0);
                    }
#pragma unroll
                    for (int rr = 0; rr < 4; ++rr) s[j * 2 + ct][rr] = a[rr] + bt[j * 2 + ct][rr];
                }
            }
            float mx = -3e38f;
#pragma unroll
            for (int i = 0; i < 16; ++i)
#pragma unroll
                for (int rr = 0; rr < 4; ++rr) mx = fmaxf(mx, s[i][rr]);
            mx = fmaxf(mx, __shfl_xor(mx, 16)); mx = fmaxf(mx, __shfl_xor(mx, 32));
            float sum = 0.f;
#pragma unroll
            for (int i = 0; i < 16; ++i)
#pragma unroll
                for (int rr = 0; rr < 4; ++rr) { s[i][rr] = __expf(s[i][rr] - mx); sum += s[i][rr]; }
            sum += __shfl_xor(sum, 16); sum += __shfl_xor(sum, 32);
            const float inv = __builtin_amdgcn_rcpf(sum);
            f32x4 o[2];
            o[0] = (f32x4){0.f, 0.f, 0.f, 0.f}; o[1] = (f32x4){0.f, 0.f, 0.f, 0.f};
#pragma unroll
            for (int kk = 0; kk < 8; ++kk) {
                u32x4 pw; pw.x = pk2(s[2 * kk][0] * inv, s[2 * kk][1] * inv); pw.y = pk2(s[2 * kk][2] * inv, s[2 * kk][3] * inv);
                pw.z = pk2(s[2 * kk + 1][0] * inv, s[2 * kk + 1][1] * inv); pw.w = pk2(s[2 * kk + 1][2] * inv, s[2 * kk + 1][3] * inv);
                const bf16x8 pf = __builtin_bit_cast(bf16x8, pw);
                const int sl = (rs + kk) & 7;
#pragma unroll
                for (int dd = 0; dd < 2; ++dd) {
                    const bf16x8 vf = *(const LAS bf16x8*)(Vl + ((2 * dh + dd) * 16 + qi) * NA_VSTR + sl * 64 + cs0 + 8 * g);
                    o[dd] = __builtin_amdgcn_mfma_f32_16x16x32_bf16(vf, pf, o[dd], 0, 0, 0);
                }
            }
            {
                const size_t tg = (size_t)b * 2048 + r * 64 + c;
#pragma unroll
                for (int dd = 0; dd < 2; ++dd) { u32x2 ov; ov.x = pk2(o[dd][0], o[dd][1]); ov.y = pk2(o[dd][2], o[dd][3]);
                    *(u32x2*)(p.NAOUT() + tg * 512 + h * 64 + (2 * dh + dd) * 16 + 4 * g) = ov; }
            }
            __syncthreads();
            if (add) { const int sl = nkr & 7;
                *(LAS u32x4*)(Kl + (sl * 64 + ncol) * 128 + ((nch ^ (ncol & 7)) << 4)) = pk;
                *(LAS u32x4*)(Vl + ncol * NA_VSTR + sl * 64 + nch * 8) = pv; }
            __syncthreads();
        }
    }
}
#define LDSTR 72
#define MATB (64 * LDSTR * 2)
__device__ __forceinline__ f32x4 mfma16(bf16x8 a, bf16x8 b, f32x4 c) { return __builtin_amdgcn_mfma_f32_16x16x32_bf16(a, b, c, 0, 0, 0); }

template <bool SWZ_A = false, bool SWZ_B = false>
__device__ __forceinline__ void slab_mma(const LAS bf16* A, const LAS bf16* Bt, int w, int lane, f32x4 (&acc)[4]) {
    const int r16 = lane & 15, g = lane >> 4;
    const int ra = 16 * w + r16, sa = SWZ_A ? ((ra >> 3) & 7) : 0;
    const bf16x8 a0 = *(const LAS bf16x8*)(A + ra * LDSTR + 8 * (g ^ sa));
    const bf16x8 a1 = *(const LAS bf16x8*)(A + ra * LDSTR + 8 * ((4 + g) ^ sa));
#pragma unroll
    for (int nt = 0; nt < 4; ++nt) {
        const int rb = nt * 16 + r16, sb = SWZ_B ? ((rb >> 3) & 7) : 0;
        const bf16x8 b0 = *(const LAS bf16x8*)(Bt + rb * LDSTR + 8 * (g ^ sb));
        const bf16x8 b1 = *(const LAS bf16x8*)(Bt + rb * LDSTR + 8 * ((4 + g) ^ sb));
        acc[nt] = mfma16(a0, b0, acc[nt]); acc[nt] = mfma16(a1, b1, acc[nt]);
    }
}

struct DnBufs { char* ws; char* out;
    __device__ __forceinline__ bf16* MN() const { return (bf16*)out; }
    __device__ __forceinline__ bf16* QO() const { return WSP(bf16, 179); }
    __device__ __forceinline__ bf16* SB() const { return WSP(bf16, 97); } };

__device__ __forceinline__ void conv8(const float* conv_w, const bf16* src, size_t hb, int t, int c0, int wch, float (&y)[8]) {
#pragma unroll
    for (int d = 0; d < 8; ++d) y[d] = 0.f;
#pragma unroll
    for (int j = 0; j < 5; ++j) {
        const int tt = t + j - 2;
        if (tt >= 0 && tt < SEQ) {
            const bf16x8 x0 = *(const bf16x8*)(src + (hb + tt) * 64 + c0);
            const f32x4 w0 = *(const f32x4*)(conv_w + j * 1536 + wch + c0), w1 = *(const f32x4*)(conv_w + j * 1536 + wch + c0 + 4);
#pragma unroll
            for (int d = 0; d < 4; ++d) { y[d] = fmaf(bf2f((unsigned short)x0[d]), w0[d], y[d]); y[4 + d] = fmaf(bf2f((unsigned short)x0[4 + d]), w1[d], y[4 + d]); }
        }
    }
#pragma unroll
    for (int d = 0; d < 8; ++d) y[d] = siluf_(y[d]);
}
__device__ __forceinline__ u32x4 pack8(const float (&y)[8]) { u32x4 o; o.x = pk2(y[0], y[1]); o.y = pk2(y[2], y[3]); o.z = pk2(y[4], y[5]); o.w = pk2(y[6], y[7]); return o; }

#ifndef DN_STEP_DUP
#define DN_STEP_DUP 0
#endif
#define TEAM_BYTES 71680
#define XSTR2 40
__device__ __forceinline__ void phase_dnprep(const Params& p, const DnBufs& B, LAS unsigned char* lds) {
    const int tid = fresh_tid(), lane = tid & 63, wave = tid >> 6, team = wave >> 2, w = wave & 3, G = gridDim.x;
    const int r16 = lane & 15, g = lane >> 4;
    LAS unsigned char* base = lds + team * TEAM_BYTES;
    LAS bf16* Kr = (LAS bf16*)(base);
    LAS bf16* Qr = (LAS bf16*)(base + MATB);
    LAS bf16* KdT = (LAS bf16*)(base + 2 * MATB);
    LAS bf16* KbT = (LAS bf16*)(base + 3 * MATB);
    LAS bf16* VbT = (LAS bf16*)(base + 4 * MATB);
    LAS bf16* IN = (LAS bf16*)(base + 5 * MATB);
    LAS bf16* Lb = (LAS bf16*)(base + 6 * MATB);
    LAS bf16* TTa = Lb + 64 * LDSTR; LAS bf16* T22T = TTa + 32 * XSTR2; LAS bf16* XT = T22T + 16 * XSTR2;
    LAS bf16* Tm = Kr; LAS bf16* WT = Lb; LAS bf16* UT = KbT;
    LAS float* beta_s = (LAS float*)(lds + 143360 + team * 1024); LAS float* gc_s = beta_s + 64;
    const int dir0 = team;
    float pf_be = 0.f, pf_g = 0.f;
#define DN_GATE_PREFETCH(pi_) do { if (w == 0) { const int tc_ = (pi_) & 31, bh_ = (pi_) >> 5, cc_ = dir0 ? 31 - tc_ : tc_, s_ = cc_ * 64 + lane, t_ = dir0 ? 2047 - s_ : s_; \
        pf_be = p.GATES()[(size_t)dir0 * NTOK * 8 + (size_t)bh_ * 2048 + t_]; pf_g = p.GATES()[(size_t)(2 + dir0) * NTOK * 8 + (size_t)bh_ * 2048 + t_]; } } while (0)
#define DN_L2_PREFETCH(pi_) do { if (tid < 204) { const int tc_ = (pi_) & 31, bh_ = (pi_) >> 5, mtx_ = tid / 68, row_ = tid - mtx_ * 68; int t_ = tc_ * 64 - 2 + row_; t_ = t_ < 0 ? 0 : (t_ > SEQ - 1 ? SEQ - 1 : t_); \
        __builtin_amdgcn_global_load_lds((const unsigned*)(p.QKVDN() + (size_t)mtx_ * NTOK * 512 + ((size_t)bh_ * 2048 + t_) * 64), (LAS unsigned*)(lds + 145408 + wave * 256), 4, 0, 0); } } while (0)
    if ((int)blockIdx.x < 2048) DN_GATE_PREFETCH((int)blockIdx.x);
    for (int pi = blockIdx.x; pi < 2048; pi += G) {
        const int tc = pi & 31, bh = pi >> 5, h = bh & 7, dir = team, cc = dir ? 31 - tc : tc;
        const int it = (bh * 2 + dir) * 32 + cc;
        const size_t hb = (size_t)bh * 2048;
        __syncthreads();
        if (w == 0) {
            const float be = pf_be;
            float gv = pf_g;
#pragma unroll
            for (int o = 1; o < 64; o <<= 1) { const float n = __shfl_up(gv, o); if (lane >= o) gv += n; }
            beta_s[lane] = be; gc_s[lane] = gv;
        }
        __syncthreads();
        for (int rep1 = 0; rep1 < 1 + (DN_STEP_DUP & 1); ++rep1) {
            const int tau = tid >> 3, c0 = (tid & 7) * 8, t = tc * 64 + tau;
            float yk[8], yq[8], yv[8];
            conv8(p.conv_w, p.QKVDN() + (size_t)NTOK * 512, hb, t, c0, 512 + h * 64, yk);
            asm volatile("" ::: "memory");
            conv8(p.conv_w, p.QKVDN(), hb, t, c0, h * 64, yq);
            asm volatile("" ::: "memory");
            conv8(p.conv_w, p.QKVDN() + (size_t)2 * NTOK * 512, hb, t, c0, 1024 + h * 64, yv);
            asm volatile("" ::: "memory");
            if (pi + G < 2048) { DN_GATE_PREFETCH(pi + G); DN_L2_PREFETCH(pi + G); }
            float sk = 0.f, sq = 0.f;
#pragma unroll
            for (int d = 0; d < 8; ++d) { sk = fmaf(yk[d], yk[d], sk); sq = fmaf(yq[d], yq[d], sq); }
            sk += __shfl_xor(sk, 1); sq += __shfl_xor(sq, 1); sk += __shfl_xor(sk, 2); sq += __shfl_xor(sq, 2); sk += __shfl_xor(sk, 4); sq += __shfl_xor(sq, 4);
            const float rk = rsqrtf(sk + RMS_EPS), rq = rsqrtf(sq + RMS_EPS);
#pragma unroll
            for (int d = 0; d < 8; ++d) { yk[d] *= rk; yq[d] *= rq; }
            const u32x4 kp = pack8(yk), qp = pack8(yq);
#pragma unroll
            for (int dd = 0; dd < 2; ++dd) {
                LAS unsigned char* tb = lds + dd * TEAM_BYTES;
                const LAS float* bs = (const LAS float*)(lds + 143360 + dd * 1024); const LAS float* gs = bs + 64;
                const int i = dd ? 63 - tau : tau;
                const float be = bs[i], gci = gs[i], gl = gs[63];
                const float e_gc = __expf(gci), e_kd = __expf(gl - gci), bg = be * e_gc;
                *(LAS u32x4*)((LAS bf16*)tb + i * LDSTR + c0) = kp;
                *(LAS u32x4*)((LAS bf16*)(tb + MATB) + i * LDSTR + c0) = qp;
                LAS bf16* kd = (LAS bf16*)(tb + 2 * MATB); LAS bf16* kb = (LAS bf16*)(tb + 3 * MATB); LAS bf16* vb = (LAS bf16*)(tb + 4 * MATB);
#pragma unroll
                for (int d = 0; d < 8; ++d) { const int isw = i ^ ((c0 >> 3) << 3);
                    kd[(c0 + d) * LDSTR + isw] = (bf16)f2bf(yk[d] * e_kd); kb[(c0 + d) * LDSTR + isw] = (bf16)f2bf(yk[d] * bg); vb[(c0 + d) * LDSTR + isw] = (bf16)f2bf(yv[d] * be); }
            }
        }
        __syncthreads();
#pragma unroll 1
        for (int rep2 = 0; rep2 < 1 + ((DN_STEP_DUP >> 3) & 1); ++rep2) {
            f32x4 akk[4], aqk[4];
#pragma unroll
            for (int nt = 0; nt < 4; ++nt) { akk[nt] = (f32x4){0.f, 0.f, 0.f, 0.f}; aqk[nt] = (f32x4){0.f, 0.f, 0.f, 0.f}; }
            slab_mma(Kr, Kr, w, lane, akk);
            slab_mma(Qr, Kr, w, lane, aqk);
#pragma unroll
            for (int nt = 0; nt < 4; ++nt) {
                const int j = nt * 16 + r16; const float gcj = gc_s[j];
#pragma unroll
                for (int r = 0; r < 4; ++r) {
                    const int i = 16 * w + 4 * g + r;
                    const float dec = (j <= i) ? __expf(gc_s[i] - gcj) : 0.f;
                    Lb[i * LDSTR + j] = (bf16)f2bf((j < i) ? beta_s[i] * akk[nt][r] * dec : 0.f);
                    IN[i * LDSTR + j] = (bf16)f2bf(aqk[nt][r] * 0.125f * dec);
                }
            }
        }
        __syncthreads();
        for (int rep3 = 0; rep3 < 1 + ((DN_STEP_DUP >> 1) & 1); ++rep3) if (w == 0) {
            const u32x4 z4 = {0u, 0u, 0u, 0u};
#pragma unroll
            for (int q = 0; q < 9; ++q) { const int idx = lane + 64 * q; *(LAS u32x4*)(Tm + (idx / 9) * LDSTR + (idx % 9) * 8) = z4; }
            const int blk = lane >> 4, j = lane & 15;
            float x[16];
#pragma unroll
            for (int i = 0; i < 16; ++i) {
                float a = (i == j) ? 1.f : 0.f;
#pragma unroll
                for (int m = 0; m < i; ++m) a = fmaf(-bf2f(Lb[(16 * blk + i) * LDSTR + 16 * blk + m]), x[m], a);
                x[i] = a;
            }
#pragma unroll
            for (int i = 0; i < 16; ++i) Tm[(16 * blk + i) * LDSTR + 16 * blk + j] = (bf16)f2bf(x[i]);
            {
                u32x4 lo, hi; lo.x = pk2(x[0], x[1]); lo.y = pk2(x[2], x[3]); lo.z = pk2(x[4], x[5]); lo.w = pk2(x[6], x[7]);
                hi.x = pk2(x[8], x[9]); hi.y = pk2(x[10], x[11]); hi.z = pk2(x[12], x[13]); hi.w = pk2(x[14], x[15]);
                if (blk < 2) { LAS bf16* dst = TTa + (16 * blk + j) * XSTR2 + 16 * blk; *(LAS u32x4*)dst = lo; *(LAS u32x4*)(dst + 8) = hi;
                    if (blk == 1) { *(LAS u32x4*)(TTa + (16 + j) * XSTR2) = z4; *(LAS u32x4*)(TTa + (16 + j) * XSTR2 + 8) = z4; } }
                else if (blk == 2) { *(LAS u32x4*)(T22T + j * XSTR2) = lo; *(LAS u32x4*)(T22T + j * XSTR2 + 8) = hi; }
            }
            LDS_WAIT();
            const bf16x8 zf = {0, 0, 0, 0, 0, 0, 0, 0};
            const f32x4 z0 = {0.f, 0.f, 0.f, 0.f};
            const bool lo2 = g < 2;
            {
                const bf16x8 aA = lo2 ? *(const LAS bf16x8*)(Lb + (16 + r16) * LDSTR + 8 * g) : zf, bA = lo2 ? *(const LAS bf16x8*)(TTa + r16 * XSTR2 + 8 * g) : zf;
                const bf16x8 aB = lo2 ? *(const LAS bf16x8*)(Lb + (48 + r16) * LDSTR + 32 + 8 * g) : zf, bB = lo2 ? *(const LAS bf16x8*)(T22T + r16 * XSTR2 + 8 * g) : zf;
                const f32x4 xa = mfma16(aA, bA, z0), xb = mfma16(aB, bB, z0);
                u32x2 o; o.x = pk2(xa[0], xa[1]); o.y = pk2(xa[2], xa[3]); *(LAS u32x2*)(XT + r16 * XSTR2 + 4 * g) = o;
                o.x = pk2(xb[0], xb[1]); o.y = pk2(xb[2], xb[3]); *(LAS u32x2*)(XT + (16 + r16) * XSTR2 + 4 * g) = o;
            }
            LDS_WAIT();
            {
                const bf16x8 aA = lo2 ? *(const LAS bf16x8*)(Tm + (16 + r16) * LDSTR + 16 + 8 * g) : zf, bA = lo2 ? *(const LAS bf16x8*)(XT + r16 * XSTR2 + 8 * g) : zf;
                const bf16x8 aB = lo2 ? *(const LAS bf16x8*)(Tm + (48 + r16) * LDSTR + 48 + 8 * g) : zf, bB = lo2 ? *(const LAS bf16x8*)(XT + (16 + r16) * XSTR2 + 8 * g) : zf;
                const f32x4 ta = mfma16(aA, bA, z0), tb2 = mfma16(aB, bB, z0);
#pragma unroll
                for (int r = 0; r < 4; ++r) { Tm[(16 + 4 * g + r) * LDSTR + r16] = (bf16)f2bf(-ta[r]); Tm[(48 + 4 * g + r) * LDSTR + 32 + r16] = (bf16)f2bf(-tb2[r]); }
                u32x2 o; o.x = pk2(-ta[0], -ta[1]); o.y = pk2(-ta[2], -ta[3]); *(LAS u32x2*)(TTa + r16 * XSTR2 + 16 + 4 * g) = o;
            }
            LDS_WAIT();
            {
                f32x4 x2[2][2];
#pragma unroll
                for (int mt = 0; mt < 2; ++mt) {
                    const bf16x8 a = *(const LAS bf16x8*)(Lb + (32 + 16 * mt + r16) * LDSTR + 8 * g);
#pragma unroll
                    for (int nt = 0; nt < 2; ++nt) { const bf16x8 b2 = *(const LAS bf16x8*)(TTa + (16 * nt + r16) * XSTR2 + 8 * g); x2[mt][nt] = mfma16(a, b2, z0); }
                }
#pragma unroll
                for (int mt = 0; mt < 2; ++mt)
#pragma unroll
                    for (int nt = 0; nt < 2; ++nt) { u32x2 o; o.x = pk2(x2[mt][nt][0], x2[mt][nt][1]); o.y = pk2(x2[mt][nt][2], x2[mt][nt][3]); *(LAS u32x2*)(XT + (16 * nt + r16) * XSTR2 + 16 * mt + 4 * g) = o; }
            }
            LDS_WAIT();
            {
#pragma unroll
                for (int mt = 0; mt < 2; ++mt) {
                    const bf16x8 a = *(const LAS bf16x8*)(Tm + (32 + 16 * mt + r16) * LDSTR + 32 + 8 * g);
#pragma unroll
                    for (int nt = 0; nt < 2; ++nt) {
                        const bf16x8 b2 = *(const LAS bf16x8*)(XT + (16 * nt + r16) * XSTR2 + 8 * g);
                        const f32x4 tv = mfma16(a, b2, z0);
#pragma unroll
                        for (int r = 0; r < 4; ++r) Tm[(32 + 16 * mt + 4 * g + r) * LDSTR + 16 * nt + r16] = (bf16)f2bf(-tv[r]);
                    }
                }
            }
        }
        __syncthreads();
        {
            f32x4 a[4];
#pragma unroll
            for (int nt = 0; nt < 4; ++nt) a[nt] = (f32x4){0.f, 0.f, 0.f, 0.f};
            slab_mma<false, true>(Tm, KbT, w, lane, a);
#pragma unroll
            for (int nt = 0; nt < 4; ++nt) { u32x2 o; o.x = pk2(a[nt][0], a[nt][1]); o.y = pk2(a[nt][2], a[nt][3]); *(LAS u32x2*)(WT + (nt * 16 + r16) * LDSTR + 16 * w + 4 * g) = o; }
        }
        __syncthreads();
        {
            f32x4 a[4];
#pragma unroll
            for (int nt = 0; nt < 4; ++nt) a[nt] = (f32x4){0.f, 0.f, 0.f, 0.f};
            slab_mma<false, true>(Tm, VbT, w, lane, a);
#pragma unroll
            for (int nt = 0; nt < 4; ++nt) { u32x2 o; o.x = pk2(a[nt][0], a[nt][1]); o.y = pk2(a[nt][2], a[nt][3]); *(LAS u32x2*)(UT + (nt * 16 + r16) * LDSTR + 16 * w + 4 * g) = o; }
        }
        __syncthreads();
#pragma unroll 1
        for (int rep6 = 0; rep6 < 1 + ((DN_STEP_DUP >> 2) & 1); ++rep6) {
            const float egl = __expf(gc_s[63]);
            bf16* Mg = B.MN() + (size_t)it * 8192; bf16* NTg = Mg + 4096;
            bf16* Qg = B.QO() + ((size_t)((bh * 2 + dir) * 32 + tc)) * 8192; bf16* OTg = Qg + 4096;
            f32x4 a[4];
#pragma unroll
            for (int nt = 0; nt < 4; ++nt) a[nt] = (f32x4){0.f, 0.f, 0.f, 0.f};
            slab_mma<false, true>(WT, KdT, w, lane, a);
#pragma unroll
            for (int nt = 0; nt < 4; ++nt) { const int ra = nt * 16 + r16, cb = 16 * w + 4 * g; u32x2 o;
                o.x = pk2((ra == cb ? egl : 0.f) - a[nt][0], (ra == cb + 1 ? egl : 0.f) - a[nt][1]); o.y = pk2((ra == cb + 2 ? egl : 0.f) - a[nt][2], (ra == cb + 3 ? egl : 0.f) - a[nt][3]);
                *(u32x2*)(Mg + (((ra >> 4) * 2 + (cb >> 5)) * 64 + ((cb & 31) >> 3) * 16 + (ra & 15)) * 8 + (cb & 7)) = o; }
#pragma unroll
            for (int nt = 0; nt < 4; ++nt) a[nt] = (f32x4){0.f, 0.f, 0.f, 0.f};
            slab_mma<true, false>(KdT, UT, w, lane, a);
#pragma unroll
            for (int nt = 0; nt < 4; ++nt) { u32x2 o; o.x = pk2(a[nt][0], a[nt][1]); o.y = pk2(a[nt][2], a[nt][3]); *(u32x2*)(NTg + ((nt * 4 + w) * 64 + g * 16 + r16) * 4) = o; }
#pragma unroll
            for (int nt = 0; nt < 4; ++nt) a[nt] = (f32x4){0.f, 0.f, 0.f, 0.f};
            slab_mma(WT, IN, w, lane, a);
#pragma unroll
            for (int nt = 0; nt < 4; ++nt) { const int i = nt * 16 + r16, cb = 16 * w + 4 * g, ro = dir ? 63 - i : i;
                const float sc = 0.125f * __expf(gc_s[i]);
                const u32x2 qv = *(const LAS u32x2*)(Qr + i * LDSTR + cb);
                u32x2 o; o.x = pk2(bf2f(qv.x & 0xffffu) * sc - a[nt][0], bf2f(qv.x >> 16) * sc - a[nt][1]); o.y = pk2(bf2f(qv.y & 0xffffu) * sc - a[nt][2], bf2f(qv.y >> 16) * sc - a[nt][3]);
                *(u32x2*)(Qg + (((ro >> 4) * 2 + (cb >> 5)) * 64 + ((cb & 31) >> 3) * 16 + (ro & 15)) * 8 + (cb & 7)) = o; }
#pragma unroll
            for (int nt = 0; nt < 4; ++nt) a[nt] = (f32x4){0.f, 0.f, 0.f, 0.f};
            slab_mma(UT, IN, w, lane, a);
#pragma unroll
            for (int nt = 0; nt < 4; ++nt) { const int i = nt * 16 + r16, ro = dir ? 63 - i : i; u32x2 o; o.x = pk2(a[nt][0], a[nt][1]); o.y = pk2(a[nt][2], a[nt][3]);
                *(u32x2*)(OTg + (((ro >> 4) * 4 + w) * 64 + g * 16 + (ro & 15)) * 4) = o; }
        }
    }
#undef DN_GATE_PREFETCH
#undef DN_L2_PREFETCH
}

template <int VARIANT = 0>
__device__ __forceinline__ void phase_dnscan(const Params& p, const DnBufs& B, LAS unsigned char* lds) {
    const int tid = fresh_tid(), lane = tid & 63, wave = tid >> 6;
    const int r16 = lane & 15, g = lane >> 4;
    if (wave < 4) {
    const int vp = wave;
    LAS bf16* St = (LAS bf16*)(lds + wave * (16 * LDSTR * 2));
    for (int chain = blockIdx.x; chain < 128; chain += gridDim.x) {
    f32x4 sacc[4];
#pragma unroll
    for (int mt = 0; mt < 4; ++mt) sacc[mt] = (f32x4){0.f, 0.f, 0.f, 0.f};
    bf16x8 mf[4][4][2]; u32x2 nf[4][4];
    if (VARIANT == 2) {
#pragma unroll
        for (int a_ = 0; a_ < 4; ++a_)
#pragma unroll
            for (int b_ = 0; b_ < 4; ++b_) { mf[a_][b_][0] = (bf16x8){0,0,0,0,0,0,0,0}; mf[a_][b_][1] = mf[a_][b_][0]; nf[a_][b_] = (u32x2){0u, 0u}; }
    }
    const bf16* MN0 = B.MN() + (size_t)chain * 32 * 8192;
    bf16* SB0 = B.SB() + (size_t)chain * 32 * 4096;
#define SCAN_LOAD(slot, step) do { if (VARIANT == 2) break; const bf16* Mg_ = MN0 + (size_t)(step) * 8192; const bf16* NTg_ = Mg_ + 4096; \
        _Pragma("unroll") for (int mt = 0; mt < 4; ++mt) { mf[slot][mt][0] = *(const bf16x8*)(Mg_ + ((mt * 2) * 64 + lane) * 8); mf[slot][mt][1] = *(const bf16x8*)(Mg_ + ((mt * 2 + 1) * 64 + lane) * 8); \
            nf[slot][mt] = *(const u32x2*)(NTg_ + ((vp * 4 + mt) * 64 + lane) * 4); } } while (0)
#define SCAN_STEP(slot, step) do { bf16* Sg_ = SB0 + (size_t)(step) * 4096; \
        _Pragma("unroll") for (int mt = 0; mt < 4; ++mt) { u32x2 o; o.x = pk2(sacc[mt][0], sacc[mt][1]); o.y = pk2(sacc[mt][2], sacc[mt][3]); \
            if (VARIANT == 0) *(u32x2*)(Sg_ + ((vp * 2 + (mt >> 1)) * 64 + (2 * (mt & 1) + (g >> 1)) * 16 + r16) * 8 + 4 * (g & 1)) = o; *(LAS u32x2*)(St + r16 * LDSTR + mt * 16 + 4 * g) = o; } \
        LDS_WAIT(); \
        const bf16x8 s0 = *(const LAS bf16x8*)(St + r16 * LDSTR + 8 * g), s1 = *(const LAS bf16x8*)(St + r16 * LDSTR + 32 + 8 * g); \
        _Pragma("unroll") for (int mt = 0; mt < 4; ++mt) { const u32x2 nv = nf[slot][mt]; \
            f32x4 a = {bf2f(nv.x & 0xffffu), bf2f(nv.x >> 16), bf2f(nv.y & 0xffffu), bf2f(nv.y >> 16)}; \
            a = mfma16(mf[slot][mt][0], s0, a); a = mfma16(mf[slot][mt][1], s1, a); sacc[mt] = a; } \
        LDS_WAIT(); } while (0)
#define SCAN_PIN() asm volatile("" ::: "memory")
    SCAN_LOAD(0, 0); SCAN_LOAD(1, 1); SCAN_LOAD(2, 2); SCAN_PIN();
#pragma unroll
    for (int c0 = 0; c0 < 32; c0 += 4) {
        SCAN_LOAD(3, c0 + 3); SCAN_PIN();
        SCAN_STEP(0, c0); SCAN_PIN();
        if (c0 + 4 < 32) { SCAN_LOAD(0, c0 + 4); SCAN_PIN(); }
        SCAN_STEP(1, c0 + 1); SCAN_PIN();
        if (c0 + 5 < 32) { SCAN_LOAD(1, c0 + 5); SCAN_PIN(); }
        SCAN_STEP(2, c0 + 2); SCAN_PIN();
        if (c0 + 6 < 32) { SCAN_LOAD(2, c0 + 6); SCAN_PIN(); }
        SCAN_STEP(3, c0 + 3); SCAN_PIN();
    }
#undef SCAN_PIN
#undef SCAN_LOAD
#undef SCAN_STEP
    }
    }
}

__device__ __forceinline__ void phase_dnout(const Params& p, const DnBufs& B) {
    const int tid = fresh_tid(), lane = tid & 63, wave = tid >> 6, G = gridDim.x;
    const int r16 = lane & 15, g = lane >> 4;
    for (int task = blockIdx.x * 8 + wave; task < 8192; task += G * 8) {
        const int w = task & 3, tc = (task >> 2) & 31, bh = task >> 7, h = bh & 7, b = bh >> 3;
        f32x4 acc[4];
#pragma unroll
        for (int vt = 0; vt < 4; ++vt) acc[vt] = (f32x4){0.f, 0.f, 0.f, 0.f};
#pragma unroll
        for (int dir = 0; dir < 2; ++dir) {
            const int cc = dir ? 31 - tc : tc;
            const bf16* Qg = B.QO() + ((size_t)((bh * 2 + dir) * 32 + tc)) * 8192; const bf16* O0g = Qg + 4096;
            const bf16* Sg = B.SB() + ((size_t)((bh * 2 + dir) * 32 + cc)) * 4096;
            const bf16x8 q0 = *(const bf16x8*)(Qg + ((w * 2) * 64 + lane) * 8), q1 = *(const bf16x8*)(Qg + ((w * 2 + 1) * 64 + lane) * 8);
#pragma unroll
            for (int vt = 0; vt < 4; ++vt) {
                const u32x2 ov = *(const u32x2*)(O0g + ((w * 4 + vt) * 64 + lane) * 4);
                acc[vt][0] += bf2f(ov.x & 0xffffu); acc[vt][1] += bf2f(ov.x >> 16); acc[vt][2] += bf2f(ov.y & 0xffffu); acc[vt][3] += bf2f(ov.y >> 16);
                const bf16x8 s0 = *(const bf16x8*)(Sg + ((vt * 2) * 64 + lane) * 8), s1 = *(const bf16x8*)(Sg + ((vt * 2 + 1) * 64 + lane) * 8);
                acc[vt] = mfma16(s0, q0, acc[vt]); acc[vt] = mfma16(s1, q1, acc[vt]);
            }
        }
        float ss = 0.f;
#pragma unroll
        for (int vt = 0; vt < 4; ++vt)
#pragma unroll
            for (int r = 0; r < 4; ++r) ss = fmaf(acc[vt][r], acc[vt][r], ss);
        ss += __shfl_xor(ss, 16); ss += __shfl_xor(ss, 32);
        const float rn = rsqrtf(ss * (1.f / 64.f) + RMS_EPS);
        const int t = tc * 64 + 16 * w + r16;
#pragma unroll
        for (int vt = 0; vt < 4; ++vt) {
            const int v = vt * 16 + 4 * g;
            const u32x2 zv = *(const u32x2*)(p.Z() + ((size_t)bh * 2048 + t) * 64 + v);
            const f32x4 nw = *(const f32x4*)(p.norm_w + v);
            u32x2 o; o.x = pk2(acc[vt][0] * rn * nw[0] * bf2f(zv.x & 0xffffu), acc[vt][1] * rn * nw[1] * bf2f(zv.x >> 16));
            o.y = pk2(acc[vt][2] * rn * nw[2] * bf2f(zv.y & 0xffffu), acc[vt][3] * rn * nw[3] * bf2f(zv.y >> 16));
            *(u32x2*)(p.DNOUT() + ((size_t)b * 2048 + t) * 512 + h * 64 + v) = o;
        }
    }
}
#define WSP_TAB_ROWINFO(ws_) ((int*)((ws_) + ((size_t)243 << 20) + ((size_t)576 << 10)))
struct MixBufs { char* ws; char* out;
    __device__ __forceinline__ bf16* GB() const { return WSP(bf16, 179); }
    __device__ __forceinline__ bf16* GB2() const { return WSP(bf16, 97); }
    __device__ __forceinline__ bf16* MERGED() const { return WSP(bf16, 211); }
    __device__ __forceinline__ bf16* V() const { return WSP(bf16, 179); } };
#define MERGE_DPM (-136)
struct PairSched {
    pg8::StaticOrder S; int dpm;
    __device__ __forceinline__ bool next(int i, pg8::Unit& u) const { if (!S.next(i >> 1, u)) return false; if (i & 1) { u.pm += dpm; u.pn += 4; } return true; }
    __device__ __forceinline__ void a_ready(const pg8::Unit&) const {}
    __device__ __forceinline__ void done(const pg8::Unit&) const {}
};
template <int MODE>
struct EpiMerge {
    static constexpr bool PERM = true, AFTER_DRAIN = false;
    bf16* GB; bf16* GB2; bf16* MG;
    __device__ __forceinline__ void operator()(const pg8::f32x4 (&acc)[2][2][4][2], const pg8::Unit& u, int wr, int wc, int fr, int fq) const {
        const bool second = u.pn >= 4;
        const int pm = (MODE == 1 && second) ? u.pm - MERGE_DPM : u.pm, pn = u.pn & 3;
        bf16* G = second ? GB2 : GB;
#pragma unroll
        for (int ai = 0; ai < 2; ++ai)
#pragma unroll
            for (int m = 0; m < 4; ++m) {
                const size_t row = (size_t)pm * 256 + ai * 128 + wr * 64 + m * 16 + fr;
#pragma unroll
                for (int bj = 0; bj < 2; ++bj) {
                    const int col = pn * 256 + bj * 128 + wc * 32 + 8 * fq;
                    const pg8::f32x4 v0 = acc[ai][bj][m][0], v1 = acc[ai][bj][m][1];
                    float e[8] = {v0[0], v0[1], v0[2], v0[3], v1[0], v1[1], v1[2], v1[3]};
                    if (MODE == 0) {
#pragma unroll
                        for (int j = 0; j < 8; ++j) e[j] = sigmoidf_(e[j]);
                    } else {
                        const u32x4 gw = *(const u32x4*)(G + row * 1024 + col);
                        const unsigned gws[4] = {gw.x, gw.y, gw.z, gw.w};
#pragma unroll
                        for (int j = 0; j < 4; ++j) { e[2 * j] *= bf2f(gws[j] & 0xffffu); e[2 * j + 1] *= bf2f(gws[j] >> 16); }
                        if (second) {
                            const u32x4 mw = *(const u32x4*)(MG + row * 1024 + col);
                            const unsigned mws[4] = {mw.x, mw.y, mw.z, mw.w};
#pragma unroll
                            for (int j = 0; j < 4; ++j) { e[2 * j] += bf2f(mws[j] & 0xffffu); e[2 * j + 1] += bf2f(mws[j] >> 16); }
                        }
                    }
                    u32x4 w; w.x = pk2(e[0], e[1]); w.y = pk2(e[2], e[3]); w.z = pk2(e[4], e[5]); w.w = pk2(e[6], e[7]);
                    *(u32x4*)((MODE == 0 ? G : MG) + row * 1024 + col) = w;
                }
            }
    }
};
struct EpiOutProj {
    static constexpr bool PERM = true, AFTER_DRAIN = false;
    const bf16* xb; bf16* V;
    __device__ __forceinline__ void operator()(const pg8::f32x4 (&acc)[2][2][4][2], const pg8::Unit& u, int wr, int wc, int fr, int fq) const {
#pragma unroll
        for (int ai = 0; ai < 2; ++ai)
#pragma unroll
            for (int m = 0; m < 4; ++m) {
                const size_t row = (size_t)u.pm * 256 + ai * 128 + wr * 64 + m * 16 + fr;
#pragma unroll
                for (int bj = 0; bj < 2; ++bj) {
                    const int col = u.pn * 256 + bj * 128 + wc * 32 + 8 * fq;
                    const u32x4 xv = *(const u32x4*)(xb + row * 1024 + col);
                    const pg8::f32x4 a0 = acc[ai][bj][m][0], a1 = acc[ai][bj][m][1];
                    u32x4 w; w.x = pk2(ALPHA * bf2f(xv.x & 0xffffu) + a0[0], ALPHA * bf2f(xv.x >> 16) + a0[1]); w.y = pk2(ALPHA * bf2f(xv.y & 0xffffu) + a0[2], ALPHA * bf2f(xv.y >> 16) + a0[3]);
                    w.z = pk2(ALPHA * bf2f(xv.z & 0xffffu) + a1[0], ALPHA * bf2f(xv.z >> 16) + a1[1]); w.w = pk2(ALPHA * bf2f(xv.w & 0xffffu) + a1[2], ALPHA * bf2f(xv.w >> 16) + a1[3]);
                    *(u32x4*)(V + row * 1024 + col) = w;
                }
            }
    }
};
__device__ __forceinline__ void phase_merge(const Params& p, const MixBufs& B, LAS unsigned char* lds) {
    pg8::StaticOrder S; S.init(NTOK, 1024, gridDim.x, (int)blockIdx.x);
    { pg8::Gemm g{p.XB(), p.WG(), NTOK, 2048, 1024}; PairSched PS{S, 0}; EpiMerge<0> E{B.GB(), B.GB2(), B.MERGED()}; pg8::gemm_phase<EpiMerge<0>, PairSched, true, true>(lds, g, PS, E); }
    { pg8::Gemm g{p.NAOUT(), p.WPNA(), NTOK, 2048, 512}; PairSched PS{S, MERGE_DPM}; EpiMerge<1> E{B.GB(), B.GB2(), B.MERGED()}; pg8::gemm_phase<EpiMerge<1>, PairSched, true, true>(lds, g, PS, E); }
}
__device__ __forceinline__ void phase_outproj(const Params& p, const MixBufs& B, LAS unsigned char* lds) {
    { int* ri = WSP_TAB_ROWINFO(p.ws); for (int i = blockIdx.x * NT + fresh_tid(); i < 40960; i += gridDim.x * NT) ri[i] = -1; }
    pg8::StaticOrder S; S.init(NTOK, 1024, gridDim.x, (int)blockIdx.x);
    pg8::Gemm g{B.MERGED(), p.WOUT(), NTOK, 1024, 1024}; EpiOutProj E{p.XB(), B.V()};
    pg8::gemm_phase<EpiOutProj, pg8::StaticOrder, true, true>(lds, g, S, E);
}
struct MoeBufs { char* ws; char* out; int kdown; unsigned* ctr;
#define TBP(T, kb) ((T*)(ws + ((size_t)243 << 20) + ((size_t)(kb) << 10)))
    __device__ __forceinline__ const bf16* V() const { return WSP(bf16, 179); }
    __device__ __forceinline__ bf16* X1B() const { return WSP(bf16, 17); }
    __device__ __forceinline__ bf16* XS() const { return WSP(bf16, 97); }
    __device__ __forceinline__ bf16* HID() const { return WSP(bf16, 211); }
    __device__ __forceinline__ bf16* YPART() const { return WSP(bf16, 97); }
    __device__ __forceinline__ int* SPILL() const { return TBP(int, 0); }
    __device__ __forceinline__ int* ROUTE() const { return TBP(int, 64); }
    __device__ __forceinline__ float* ROUTEP() const { return TBP(float, 384); }
    __device__ __forceinline__ int* ROWINFO() const { return TBP(int, 576); }
    __device__ __forceinline__ float* ROWPW() const { return TBP(float, 768); }
    __device__ __forceinline__ float* STATS() const { return TBP(float, 960); }
    __device__ __forceinline__ bf16* RWH() const { return TBP(bf16, 1152); }
    __device__ __forceinline__ bf16* RWL() const { return TBP(bf16, 1280); }
};
#define XSTR 1032
#define TAB_OFF 131072
#define MOE_OVF_BASE 32768
#ifndef MOE_CAP
#define MOE_CAP 1280
#endif
__device__ __forceinline__ int moe_row(int e, int slot) { return slot < 1024 ? e * 1024 + slot : MOE_OVF_BASE + e * 256 + (slot - 1024); }

__device__ __forceinline__ void phase0_router(const Params& p, const MoeBufs& B) {
    const size_t gt = (size_t)blockIdx.x * NT + fresh_tid(), GT = (size_t)gridDim.x * NT;
    for (size_t i = gt; i < 48 * 1024; i += GT) {
        const int n = (int)(i >> 10), k = (int)(i & 1023);
        const float w = n < 4 ? p.wrg[k * 4 + n] : (n < 36 ? p.wre[k * 32 + n - 4] : 0.f);
        const unsigned hi = f2bf(w); const float lo = w - bf2f(hi);
        B.RWH()[i] = (bf16)hi; B.RWL()[i] = (bf16)f2bf(lo);
    }
}

__device__ __forceinline__ float wave_sum64(float v) {
#pragma unroll
    for (int o = 1; o < 64; o <<= 1) v += __shfl_xor(v, o);
    return v;
}

__device__ __forceinline__ void phase_ln1(const Params& p, const MoeBufs& B, LAS unsigned char* lds) {
    const int tid = fresh_tid(), lane = tid & 63, wave = tid >> 6;
    const int r16 = lane & 15, g = lane >> 4;
    LAS bf16* XH = (LAS bf16*)lds;
    LAS bf16* XL = (LAS bf16*)(lds + 16 * XSTR * 2);
    LAS float* PART = (LAS float*)(lds + 2 * 16 * XSTR * 2);
    LAS float* LOG = PART + 8 * 16 * 48;
    LAS int* rowdst = (LAS int*)(LOG + 16 * 36);
    LAS int* ihist = rowdst + 32;
    LAS int* rinfo = ihist + 32;
    LAS float* rpw = (LAS float*)(rinfo + 64);
    if (tid < 32) ihist[tid] = 0;
    bf16x8 rbh[4][3], rbl[4][3];
#pragma unroll
    for (int ks = 0; ks < 4; ++ks)
#pragma unroll
        for (int nt = 0; nt < 3; ++nt) { const int k0 = wave * 128 + ks * 32 + 8 * g;
            rbh[ks][nt] = *(const bf16x8*)(B.RWH() + (size_t)(nt * 16 + r16) * 1024 + k0); rbl[ks][nt] = *(const bf16x8*)(B.RWL() + (size_t)(nt * 16 + r16) * 1024 + k0); }
    for (int blk = blockIdx.x; blk < 256; blk += gridDim.x) {
        u32x4 vpre[2][2];
#pragma unroll
        for (int q = 0; q < 2; ++q)
#pragma unroll
            for (int j = 0; j < 2; ++j) vpre[q][j] = *(const u32x4*)(B.V() + ((size_t)blk * 64 + 2 * wave + q) * 1024 + 8 * lane + 512 * j);
        for (int itn = 0; itn < 4; ++itn) {
            __syncthreads();
#pragma unroll
            for (int q = 0; q < 2; ++q) {
                const int lt = 2 * wave + q; const size_t tg = (size_t)blk * 64 + itn * 16 + lt;
                float v[2][8]; float s = 0.f;
#pragma unroll
                for (int j = 0; j < 2; ++j) { const unsigned wv[4] = {vpre[q][j].x, vpre[q][j].y, vpre[q][j].z, vpre[q][j].w};
#pragma unroll
                    for (int e = 0; e < 4; ++e) { v[j][2 * e] = bf2f(wv[e] & 0xffffu); v[j][2 * e + 1] = bf2f(wv[e] >> 16); s += v[j][2 * e] + v[j][2 * e + 1]; } }
                if (itn < 3) {
#pragma unroll
                    for (int j = 0; j < 2; ++j) vpre[q][j] = *(const u32x4*)(B.V() + (tg + 16) * 1024 + 8 * lane + 512 * j);
                }
                const float mu = wave_sum64(s) * (1.f / 1024.f);
                float qq = 0.f;
#pragma unroll
                for (int j = 0; j < 2; ++j)
#pragma unroll
                    for (int e = 0; e < 8; ++e) { v[j][e] -= mu; qq = fmaf(v[j][e], v[j][e], qq); }
                const float rstd = rsqrtf(wave_sum64(qq) * (1.f / 1024.f) + LN_EPS);
                if (lane == 0) { B.STATS()[tg * 2] = mu; B.STATS()[tg * 2 + 1] = rstd; }
#pragma unroll
                for (int j = 0; j < 2; ++j) {
                    const int c = 8 * lane + 512 * j;
                    const f32x4 g0 = *(const f32x4*)(p.ln1_g + c), g1 = *(const f32x4*)(p.ln1_g + c + 4), b0 = *(const f32x4*)(p.ln1_b + c), b1 = *(const f32x4*)(p.ln1_b + c + 4);
                    float y[8], lo[8];
#pragma unroll
                    for (int e = 0; e < 4; ++e) { y[e] = v[j][e] * rstd * g0[e] + b0[e]; y[4 + e] = v[j][4 + e] * rstd * g1[e] + b1[e]; }
                    u32x4 hw; hw.x = pk2(y[0], y[1]); hw.y = pk2(y[2], y[3]); hw.z = pk2(y[4], y[5]); hw.w = pk2(y[6], y[7]);
                    const unsigned hws[4] = {hw.x, hw.y, hw.z, hw.w};
#pragma unroll
                    for (int e = 0; e < 4; ++e) { lo[2 * e] = y[2 * e] - bf2f(hws[e] & 0xffffu); lo[2 * e + 1] = y[2 * e + 1] - bf2f(hws[e] >> 16); }
                    u32x4 lw; lw.x = pk2(lo[0], lo[1]); lw.y = pk2(lo[2], lo[3]); lw.z = pk2(lo[4], lo[5]); lw.w = pk2(lo[6], lo[7]);
                    *(LAS u32x4*)(XH + lt * XSTR + c) = hw; *(LAS u32x4*)(XL + lt * XSTR + c) = lw;
                }
            }
            __syncthreads();
            {
                f32x4 acc[3];
#pragma unroll
                for (int nt = 0; nt < 3; ++nt) acc[nt] = (f32x4){0.f, 0.f, 0.f, 0.f};
#pragma unroll
                for (int ks = 0; ks < 4; ++ks) {
                    const int k0 = wave * 128 + ks * 32 + 8 * g;
                    const bf16x8 ah = *(const LAS bf16x8*)(XH + r16 * XSTR + k0), al = *(const LAS bf16x8*)(XL + r16 * XSTR + k0);
#pragma unroll
                    for (int nt = 0; nt < 3; ++nt) {
                        acc[nt] = mfma16(ah, rbh[ks][nt], acc[nt]); acc[nt] = mfma16(ah, rbl[ks][nt], acc[nt]); acc[nt] = mfma16(al, rbh[ks][nt], acc[nt]);
                    }
                }
#pragma unroll
                for (int nt = 0; nt < 3; ++nt)
#pragma unroll
                    for (int r = 0; r < 4; ++r) PART[(wave * 16 + 4 * g + r) * 48 + nt * 16 + r16] = acc[nt][r];
            }
            __syncthreads();
            for (int idx = tid; idx < 16 * 36; idx += NT) {
                const int tk = idx / 36, n = idx % 36;
                float a = n < 4 ? p.brg[n] : p.bre[n - 4];
#pragma unroll
                for (int w2 = 0; w2 < 8; ++w2) a += PART[(w2 * 16 + tk) * 48 + n];
                LOG[tk * 36 + n] = a;
            }
            __syncthreads();
            if (tid < 16) {
                const LAS float* lg = LOG + tid * 36; const size_t tg = (size_t)blk * 64 + itn * 16 + tid;
                int gi = 0; float gm = lg[0];
                for (int q = 1; q < 4; ++q) if (lg[q] > gm) { gm = lg[q]; gi = q; }
                float gs = 0.f;
                for (int q = 0; q < 4; ++q) gs += expf(lg[q] - gm);
                const float gp = 1.f / gs;
                const LAS float* el = lg + 4 + gi * 8;
                int i1 = 0; float l1 = el[0];
                for (int e = 1; e < 8; ++e) if (el[e] > l1) { l1 = el[e]; i1 = e; }
                int i2 = -1; float l2 = -3.0e38f;
                for (int e = 0; e < 8; ++e) if (e != i1 && el[e] > l2) { l2 = el[e]; i2 = e; }
                const float e2 = expf(l2 - l1);
                const int e0 = gi * 8 + i1, e1 = gi * 8 + i2;
                const float pw0 = gp / (1.f + e2), pw1 = gp * e2 / (1.f + e2);
                rinfo[tid * 4] = e0; rinfo[tid * 4 + 1] = atomicAdd((int*)&ihist[e0], 1); rinfo[tid * 4 + 2] = e1; rinfo[tid * 4 + 3] = atomicAdd((int*)&ihist[e1], 1);
                rpw[tid * 2] = pw0; rpw[tid * 2 + 1] = pw1;
            }
            if (tid < 64) {
                LDS_WAIT(); __builtin_amdgcn_wave_barrier();
                if (tid < 32) { const int c = ihist[tid]; const int base = c ? (int)__hip_atomic_fetch_add(B.ctr + tid, (unsigned)c, __ATOMIC_RELAXED, __HIP_MEMORY_SCOPE_AGENT) : 0; ihist[tid] = base; }
                LDS_WAIT(); __builtin_amdgcn_wave_barrier();
                if (tid < 32) {
                    const int e = rinfo[tid * 2], slot = ihist[e] + rinfo[tid * 2 + 1]; const size_t tg = (size_t)blk * 64 + itn * 16 + (tid >> 1); const float pw = rpw[tid];
                    int row = -1;
                    if (slot < MOE_CAP) { row = moe_row(e, slot); B.ROWINFO()[row] = (int)tg * 2 + (tid & 1); B.ROWPW()[row] = pw; }
                    else { const int si = (int)__hip_atomic_fetch_add(B.ctr + 32, 1u, __ATOMIC_RELAXED, __HIP_MEMORY_SCOPE_AGENT); B.SPILL()[si] = (int)tg * 2 + (tid & 1); B.ROUTE()[tg * 4 + (tid & 1)] = e; B.ROUTEP()[tg * 2 + (tid & 1)] = pw; }
                    rowdst[tid] = row;
                }
                LDS_WAIT(); __builtin_amdgcn_wave_barrier();
                if (tid < 32) ihist[tid] = 0;
            }
            __syncthreads();
            {
                const int q = tid >> 4, pc = tid & 15, row = rowdst[q];
                if (row >= 0) {
                    const LAS bf16* src = XH + (q >> 1) * XSTR + pc * 64; bf16* dst = B.XS() + (size_t)row * 1024 + pc * 64;
#pragma unroll
                    for (int i = 0; i < 8; ++i) *(u32x4*)(dst + i * 8) = *(const LAS u32x4*)(src + i * 8);
                }
            }
        }
    }
}

__device__ __forceinline__ void moe_tables(const MoeBufs& B, LAS unsigned char* lds, int nj) {
    const int tid = fresh_tid();
    LAS int* tab = (LAS int*)(lds + TAB_OFF);
    __syncthreads();
    if (tid < 32) { int c = (int)__hip_atomic_load(B.ctr + tid, __ATOMIC_RELAXED, __HIP_MEMORY_SCOPE_AGENT); tab[66 + tid] = c > MOE_CAP ? MOE_CAP : c; }
    __syncthreads();
    if (tid == 0) { int cum = 0, og = 0; for (int e = 0; e < 32; ++e) { tab[e] = cum; tab[33 + e] = 4 * e; tab[132 + e] = og; const int tot = tab[66 + e]; const int mainr = tot > 1024 ? 1024 : tot;
            cum += ((mainr + 255) >> 8) * nj; og += tot > 1024 ? (tot - 1024 + 15) >> 4 : 0; } tab[32] = cum; tab[164] = og; }
    __syncthreads();
}
struct MoeSched {
    const LAS int* tab; int G, c, nj;
    __device__ __forceinline__ bool next(int i, pg8::Unit& u) const {
        int L = i * G + c; const int U = tab[32]; if (L >= U) return false;
        { const int q = U >> 3, r = U & 7, xcd = L & 7, off = L >> 3; L = (xcd < r ? xcd * (q + 1) : r * (q + 1) + (xcd - r) * q) + off; }
        int e = 0;
#pragma unroll
        for (int k = 1; k < 32; ++k) e += (L >= tab[k]) ? 1 : 0;
        const int rem = L - tab[e], j = rem % nj, rt = rem / nj;
        u.pm = tab[33 + e] + rt; u.pn = e * nj + j; return true;
    }
    __device__ __forceinline__ void a_ready(const pg8::Unit&) const {}
    __device__ __forceinline__ void done(const pg8::Unit&) const {}
};
struct EpiGateUp {
    static constexpr bool PERM = true, AFTER_DRAIN = false;
    bf16* HID; const float* ROWPW;
    __device__ __forceinline__ void operator()(const pg8::f32x4 (&acc)[2][2][4][2], const pg8::Unit& u, int wr, int wc, int fr, int fq) const {
#pragma unroll
        for (int ai = 0; ai < 2; ++ai)
#pragma unroll
            for (int m = 0; m < 4; ++m) {
                const size_t row = (size_t)u.pm * 256 + ai * 128 + wr * 64 + m * 16 + fr;
                const float pw = ROWPW[row];
                const int f = (u.pn & 1) * 128 + wc * 32 + 8 * fq;
                const pg8::f32x4 g0 = acc[ai][0][m][0], g1 = acc[ai][0][m][1], u0 = acc[ai][1][m][0], u1 = acc[ai][1][m][1];
                float e[8];
#pragma unroll
                for (int j = 0; j < 4; ++j) { e[j] = siluf_(g0[j]) * u0[j] * pw; e[4 + j] = siluf_(g1[j]) * u1[j] * pw; }
                u32x4 w; w.x = pk2(e[0], e[1]); w.y = pk2(e[2], e[3]); w.z = pk2(e[4], e[5]); w.w = pk2(e[6], e[7]);
                *(u32x4*)(HID + row * 256 + f) = w;
            }
    }
};
struct EpiDown {
    static constexpr bool PERM = true, AFTER_DRAIN = false;
    bf16* YPART; const int* ROWINFO;
    __device__ __forceinline__ void operator()(const pg8::f32x4 (&acc)[2][2][4][2], const pg8::Unit& u, int wr, int wc, int fr, int fq) const {
        const int j = u.pn & 3;
#pragma unroll
        for (int ai = 0; ai < 2; ++ai)
#pragma unroll
            for (int m = 0; m < 4; ++m) {
                const int row = u.pm * 256 + ai * 128 + wr * 64 + m * 16 + fr;
                asm volatile("" ::: "memory");
                const int info = ROWINFO[row];
                if (info >= 0) {
                    const size_t tg = (size_t)(info >> 1); const int k = info & 1;
#pragma unroll
                    for (int bj = 0; bj < 2; ++bj) {
                        const int col = j * 256 + bj * 128 + wc * 32 + 8 * fq;
                        const pg8::f32x4 v0 = acc[ai][bj][m][0], v1 = acc[ai][bj][m][1];
                        u32x4 w; w.x = pk2(v0[0], v0[1]); w.y = pk2(v0[2], v0[3]); w.z = pk2(v1[0], v1[1]); w.w = pk2(v1[2], v1[3]);
                        *(u32x4*)(YPART + ((size_t)k * NTOK + tg) * 1024 + col) = w;
                    }
                }
            }
    }
};
__device__ __forceinline__ void moe1_overflow(const Params& p, const MoeBufs& B, LAS unsigned char* lds) {
    const int tid = fresh_tid(), lane = tid & 63, wave = tid >> 6, r16 = lane & 15, g = lane >> 4;
    const LAS int* tab = (const LAS int*)(lds + TAB_OFF);
    LAS float* part = (LAS float*)lds;
    const int ntask = tab[164] * 8;
    for (int tk = blockIdx.x; tk < ntask; tk += gridDim.x) {
        const int t = tk >> 3, fc = tk & 7;
        int e = 0;
#pragma unroll
        for (int k = 1; k < 32; ++k) e += (t >= tab[132 + k]) ? 1 : 0;
        const size_t R0 = (size_t)MOE_OVF_BASE + (size_t)e * 256 + (size_t)(t - tab[132 + e]) * 16;
        const bf16* A = B.XS() + (R0 + r16) * 1024 + wave * 128 + 8 * g;
        const bf16* Wg = p.WGU() + ((size_t)e * 512 + (fc >> 2) * 256 + 32 * (fc & 3) + r16) * 1024 + wave * 128 + 8 * g;
        f32x4 acc[4];
#pragma unroll
        for (int q = 0; q < 4; ++q) acc[q] = (f32x4){0.f, 0.f, 0.f, 0.f};
#pragma unroll
        for (int ks = 0; ks < 4; ++ks) {
            const bf16x8 a = *(const bf16x8*)(A + ks * 32);
#pragma unroll
            for (int q = 0; q < 4; ++q) acc[q] = mfma16(a, *(const bf16x8*)(Wg + (size_t)((q >> 1) * 128 + 16 * (q & 1)) * 1024 + ks * 32), acc[q]);
        }
        __syncthreads();
#pragma unroll
        for (int q = 0; q < 4; ++q) *(LAS f32x4*)(part + ((wave * 4 + q) * 64 + lane) * 4) = acc[q];
        __syncthreads();
        {
            const int fs = tid >> 8, l2 = (tid >> 2) & 63, r = tid & 3;
            float gs = 0.f, us = 0.f;
#pragma unroll
            for (int w2 = 0; w2 < 8; ++w2) { gs += part[((w2 * 4 + fs) * 64 + l2) * 4 + r]; us += part[((w2 * 4 + 2 + fs) * 64 + l2) * 4 + r]; }
            const size_t row = R0 + 4 * (l2 >> 4) + r;
            B.HID()[row * 256 + 32 * fc + 16 * fs + (l2 & 15)] = (bf16)f2bf(siluf_(gs) * us * B.ROWPW()[row]);
        }
    }
}
__device__ __forceinline__ void moe2_overflow(const Params& p, const MoeBufs& B, LAS unsigned char* lds) {
    const int tid = fresh_tid(), lane = tid & 63, wave = tid >> 6, r16 = lane & 15, g = lane >> 4;
    const LAS int* tab = (const LAS int*)(lds + TAB_OFF);
    LAS float* part = (LAS float*)lds;
    const int ntask = tab[164] * 8;
    for (int tk = blockIdx.x; tk < ntask; tk += gridDim.x) {
        const int t = tk >> 3, nc = tk & 7;
        int e = 0;
#pragma unroll
        for (int k = 1; k < 32; ++k) e += (t >= tab[132 + k]) ? 1 : 0;
        const size_t R0 = (size_t)MOE_OVF_BASE + (size_t)e * 256 + (size_t)(t - tab[132 + e]) * 16;
        const bf16x8 a = *(const bf16x8*)(B.HID() + (R0 + r16) * 256 + wave * 32 + 8 * g);
        const bf16* W = p.WD() + ((size_t)e * 1024 + 128 * nc + r16) * 256 + wave * 32 + 8 * g;
        __syncthreads();
#pragma unroll
        for (int nt = 0; nt < 8; ++nt) { const f32x4 v = mfma16(a, *(const bf16x8*)(W + (size_t)(16 * nt) * 256), (f32x4){0.f, 0.f, 0.f, 0.f});
            *(LAS f32x4*)(part + ((wave * 8 + nt) * 64 + lane) * 4) = v; }
        __syncthreads();
#pragma unroll
        for (int q = 0; q < 4; ++q) {
            const int idx = tid + q * NT, nt = idx >> 8, l2 = (idx >> 2) & 63, r = idx & 3;
            float s = 0.f;
#pragma unroll
            for (int w2 = 0; w2 < 8; ++w2) s += part[((w2 * 8 + nt) * 64 + l2) * 4 + r];
            const int info = B.ROWINFO()[R0 + 4 * (l2 >> 4) + r];
            if (info >= 0) B.YPART()[((size_t)(info & 1) * NTOK + (size_t)(info >> 1)) * 1024 + 128 * nc + 16 * nt + (l2 & 15)] = (bf16)f2bf(s);
        }
    }
}
__device__ __forceinline__ void moe_spill(const Params& p, const MoeBufs& B) {
    const int tid = fresh_tid(), lane = tid & 63, wave = tid >> 6;
    const int nsp = (int)__hip_atomic_load(B.ctr + 32, __ATOMIC_RELAXED, __HIP_MEMORY_SCOPE_AGENT);
    for (int si = blockIdx.x * 8 + wave; si < nsp; si += gridDim.x * 8) {
        const int info = B.SPILL()[si]; const size_t tg = (size_t)(info >> 1); const int k = info & 1;
        const int e = B.ROUTE()[tg * 4 + k]; const float pw = B.ROUTEP()[tg * 2 + k];
        const float mu = B.STATS()[tg * 2], rstd = B.STATS()[tg * 2 + 1];
        float x1[16];
#pragma unroll
        for (int j = 0; j < 2; ++j) { const int c = 8 * lane + 512 * j; const u32x4 xv = *(const u32x4*)(B.V() + tg * 1024 + c); const unsigned xs[4] = {xv.x, xv.y, xv.z, xv.w};
#pragma unroll
            for (int i = 0; i < 8; ++i) { const float v = (i & 1) ? bf2f(xs[i >> 1] >> 16) : bf2f(xs[i >> 1] & 0xffffu); x1[8 * j + i] = bf2f(f2bf((v - mu) * rstd * p.ln1_g[c + i] + p.ln1_b[c + i])); } }
        float hid[4];
#pragma unroll 1
        for (int f0 = 0; f0 < 256; f0 += 4) {
            float hv[4];
#pragma unroll
            for (int q = 0; q < 4; ++q) { const int f = f0 + q; const bf16* wg = p.WGU() + ((size_t)e * 512 + (f >> 7) * 256 + (f & 127)) * 1024; const bf16* wu = wg + (size_t)128 * 1024;
                float sg = 0.f, su = 0.f;
#pragma unroll
                for (int j = 0; j < 2; ++j) { const u32x4 a = *(const u32x4*)(wg + 8 * lane + 512 * j), b2 = *(const u32x4*)(wu + 8 * lane + 512 * j); const unsigned as[4] = {a.x, a.y, a.z, a.w}, bs[4] = {b2.x, b2.y, b2.z, b2.w};
#pragma unroll
                    for (int i = 0; i < 8; ++i) { const float xa = x1[8 * j + i]; sg = fmaf(xa, (i & 1) ? bf2f(as[i >> 1] >> 16) : bf2f(as[i >> 1] & 0xffffu), sg); su = fmaf(xa, (i & 1) ? bf2f(bs[i >> 1] >> 16) : bf2f(bs[i >> 1] & 0xffffu), su); } }
                sg = wave_sum64(sg); su = wave_sum64(su);
                hv[q] = bf2f(f2bf(siluf_(sg) * su * pw)); }
            if ((f0 >> 2) == lane) { hid[0] = hv[0]; hid[1] = hv[1]; hid[2] = hv[2]; hid[3] = hv[3]; }
        }
#pragma unroll 1
        for (int n = 0; n < 1024; ++n) {
            const u32x2 wv = *(const u32x2*)(p.WD() + ((size_t)e * 1024 + n) * 256 + 4 * lane);
            float s = hid[0] * bf2f(wv.x & 0xffffu) + hid[1] * bf2f(wv.x >> 16) + hid[2] * bf2f(wv.y & 0xffffu) + hid[3] * bf2f(wv.y >> 16);
            s = wave_sum64(s);
            if (lane == 0) B.YPART()[((size_t)k * NTOK + tg) * 1024 + n] = (bf16)f2bf(s);
        }
    }
}
__device__ __forceinline__ void phase_moe1(const Params& p, const MoeBufs& B, LAS unsigned char* lds) {
    moe_tables(B, lds, 2);
    MoeSched S{(const LAS int*)(lds + TAB_OFF), (int)gridDim.x, (int)blockIdx.x, 2};
    pg8::Gemm g{B.XS(), p.WGU(), 0, 0, 1024}; EpiGateUp E{B.HID(), B.ROWPW()};
    pg8::gemm_phase<EpiGateUp, MoeSched, true, true>(lds, g, S, E);
    moe1_overflow(p, B, lds);
}
__device__ __forceinline__ void phase_moe2(const Params& p, const MoeBufs& B, LAS unsigned char* lds) {
    moe_tables(B, lds, 4);
    MoeSched S{(const LAS int*)(lds + TAB_OFF), (int)gridDim.x, (int)blockIdx.x, 4};
    pg8::Gemm g{B.HID(), p.WD(), 0, 0, B.kdown}; EpiDown E{B.YPART(), B.ROWINFO()};
    pg8::gemm_phase<EpiDown, MoeSched, true, true>(lds, g, S, E);
    moe2_overflow(p, B, lds);
    moe_spill(p, B);
}
__device__ __forceinline__ void phase_ln2(const Params& p, const MoeBufs& B) {
    const int tid = fresh_tid(), lane = tid & 63, wave = tid >> 6;
    for (size_t tg = (size_t)blockIdx.x * 8 + wave; tg < NTOK; tg += (size_t)gridDim.x * 8) {
        const float mu1 = B.STATS()[tg * 2], rstd1 = B.STATS()[tg * 2 + 1];
        float v[2][8]; float s = 0.f;
#pragma unroll
        for (int j = 0; j < 2; ++j) {
            const int c = 8 * lane + 512 * j;
            const u32x4 xv = *(const u32x4*)(B.V() + tg * 1024 + c);
            const u32x4 y0 = *(const u32x4*)(B.YPART() + tg * 1024 + c), y1 = *(const u32x4*)(B.YPART() + ((size_t)NTOK + tg) * 1024 + c);
            const f32x4 g0 = *(const f32x4*)(p.ln1_g + c), g1 = *(const f32x4*)(p.ln1_g + c + 4), b0 = *(const f32x4*)(p.ln1_b + c), b1 = *(const f32x4*)(p.ln1_b + c + 4);
            const unsigned xs[4] = {xv.x, xv.y, xv.z, xv.w}, y0s[4] = {y0.x, y0.y, y0.z, y0.w}, y1s[4] = {y1.x, y1.y, y1.z, y1.w};
#pragma unroll
            for (int e = 0; e < 4; ++e) {
                const float ga = e < 2 ? g0[2 * e] : g1[2 * e - 4], gb = e < 2 ? g0[2 * e + 1] : g1[2 * e - 3], ba = e < 2 ? b0[2 * e] : b1[2 * e - 4], bb = e < 2 ? b0[2 * e + 1] : b1[2 * e - 3];
                v[j][2 * e] = ALPHA * ((bf2f(xs[e] & 0xffffu) - mu1) * rstd1 * ga + ba) + bf2f(y0s[e] & 0xffffu) + bf2f(y1s[e] & 0xffffu);
                v[j][2 * e + 1] = ALPHA * ((bf2f(xs[e] >> 16) - mu1) * rstd1 * gb + bb) + bf2f(y0s[e] >> 16) + bf2f(y1s[e] >> 16);
                s += v[j][2 * e] + v[j][2 * e + 1];
            }
        }
        const float mu = wave_sum64(s) * (1.f / 1024.f);
        float qq = 0.f;
#pragma unroll
        for (int j = 0; j < 2; ++j)
#pragma unroll
            for (int e = 0; e < 8; ++e) { v[j][e] -= mu; qq = fmaf(v[j][e], v[j][e], qq); }
        const float rstd = rsqrtf(wave_sum64(qq) * (1.f / 1024.f) + LN_EPS);
#pragma unroll
        for (int j = 0; j < 2; ++j) {
            const int c = 8 * lane + 512 * j;
            const f32x4 g0 = *(const f32x4*)(p.ln2_g + c), g1 = *(const f32x4*)(p.ln2_g + c + 4), b0 = *(const f32x4*)(p.ln2_b + c), b1 = *(const f32x4*)(p.ln2_b + c + 4);
            f32x4 o0, o1;
#pragma unroll
            for (int e = 0; e < 4; ++e) { o0[e] = v[j][e] * rstd * g0[e] + b0[e]; o1[e] = v[j][4 + e] * rstd * g1[e] + b1[e]; }
            *(f32x4*)(p.out + tg * 1024 + c) = o0; *(f32x4*)(p.out + tg * 1024 + c + 4) = o1;
        }
    }
}
#ifndef SCAN_VARIANT
#define SCAN_VARIANT 0
#endif
#ifndef BAR_DUP
#define BAR_DUP 0
#endif
#ifndef FWD_REP
#define FWD_REP 1
#endif
#ifndef PH_DUP
#define PH_DUP 0
#endif
#ifndef PH_MASK
#define PH_MASK 8191
#endif
#define BAR_LDS_OFF (LDS_BYTES - 64)
struct MegaArgs { Params p; };
#define CAS __attribute__((address_space(4)))
#define GASC __attribute__((address_space(1)))
__device__ __forceinline__ Params load_params(const CAS char* kp) {
    Params p; const CAS unsigned long long* src = (const CAS unsigned long long*)kp;
    const float** pf = (const float**)&p;
#pragma unroll
    for (int i = 0; i < 22; ++i) pf[i] = (const float*)(const GASC float*)src[i];
    static_assert(offsetof(Params, out) == 22 * 8 && offsetof(Params, ws) == 23 * 8 && offsetof(Params, bar) == 24 * 8 && offsetof(Params, kdown) == 25 * 8, "Params layout");
    p.out = (float*)(GASC float*)src[22]; p.ws = (char*)(GASC char*)src[23]; p.bar = (unsigned*)(GASC unsigned*)src[24];
    p.kdown = (int)(src[25] & 0xffffffffu); p.pad0 = 0;
    return p;
}
#define FRESH_P(name) const CAS char* name##_kp = kptr; asm volatile("" : "+s"(name##_kp)); const Params name = load_params(name##_kp)
#define GRID_BAR() do { const CAS char* b_kp = kptr; asm volatile("" : "+s"(b_kp)); XcdBarrier bar; bar.bar = (unsigned*)(GASC unsigned*)(*(const CAS unsigned long long*)(b_kp + offsetof(Params, bar))); bar.x = xb_xcc_id(); \
        bar.st = (volatile LAS unsigned*)(lds + BAR_LDS_OFF); xcd_barrier(bar); if (BAR_DUP) xcd_barrier(bar); } while (0)
__global__ void __launch_bounds__(NT, 2) mega_fwd(MegaArgs) {
    extern __shared__ __attribute__((aligned(16))) unsigned char lds_raw[];
    LAS unsigned char* lds = (LAS unsigned char*)lds_raw;
    const CAS char* kptr = (const CAS char*)__builtin_amdgcn_kernarg_segment_ptr();
    if (threadIdx.x < 16) ((LAS unsigned*)(lds + BAR_LDS_OFF))[threadIdx.x] = 0u;
    __syncthreads();
    { FRESH_P(p); (void)xcd_barrier_post(p.bar, (volatile LAS unsigned*)(lds + BAR_LDS_OFF)); }
#if PH_MASK & 1
    { FRESH_P(p); const MoeBufs Q{p.ws, (char*)p.out, p.kdown, p.bar + XCD_BAR_WORDS + 16}; phase0(p, lds); phase0_router(p, Q); }
#endif
#if PH_DUP & 1
    GRID_BAR();
    { FRESH_P(p); const MoeBufs Q{p.ws, (char*)p.out, p.kdown, p.bar + XCD_BAR_WORDS + 16}; phase0(p, lds); phase0_router(p, Q); }
#endif
    GRID_BAR();
#if PH_MASK & 2
    { FRESH_P(p); phase1(p, lds); }
#endif
#if PH_DUP & 2
    GRID_BAR();
    { FRESH_P(p); phase1(p, lds); }
#endif
    GRID_BAR();
#if PH_MASK & 4
    { FRESH_P(p); phase_na(p, lds); }
#endif
#if PH_DUP & 4
    GRID_BAR();
    { FRESH_P(p); phase_na(p, lds); }
    GRID_BAR();
#endif
#if PH_MASK & 8
    { FRESH_P(p); const DnBufs D{p.ws, (char*)p.out}; phase_dnprep(p, D, lds); }
#endif
#if PH_DUP & 8
    GRID_BAR();
    { FRESH_P(p); const DnBufs D{p.ws, (char*)p.out}; phase_dnprep(p, D, lds); }
    GRID_BAR();
#endif
    GRID_BAR();
#if PH_MASK & 16
    {
        FRESH_P(p); const DnBufs D{p.ws, (char*)p.out};
        const int nb = (int)gridDim.x;
        unsigned* counter = p.bar + XCD_BAR_WORDS;
        if ((int)blockIdx.x >= 128) phase_zgemm(p, lds, nb - 128, (int)blockIdx.x - 128);
        else if ((fresh_tid() >> 6) >= 4) phase0_moe(p, counter);
        if ((int)blockIdx.x < 128) phase_dnscan(p, D, lds);
        if ((int)blockIdx.x >= 128 || (fresh_tid() >> 6) < 4) phase0_moe(p, counter);
    }
#endif
#if PH_DUP & 16
    GRID_BAR();
    {
        FRESH_P(p); const DnBufs D{p.ws, (char*)p.out};
        const int nb = (int)gridDim.x;
        unsigned* counter = p.bar + XCD_BAR_WORDS;
#if !(PH_DUP & 8192)
        if ((int)blockIdx.x >= 128) phase_zgemm(p, lds, nb - 128, (int)blockIdx.x - 128);
#endif
        if ((int)blockIdx.x >= 128) {} else if ((fresh_tid() >> 6) >= 4) phase0_moe(p, counter);
#if !(PH_DUP & 16384)
        if ((int)blockIdx.x < 128) phase_dnscan<SCAN_VARIANT>(p, D, lds);
#endif
        if ((int)blockIdx.x >= 128 || (fresh_tid() >> 6) < 4) phase0_moe(p, counter);
    }
#endif
    GRID_BAR();
#if PH_MASK & 32
    { FRESH_P(p); const DnBufs D{p.ws, (char*)p.out}; phase_dnout(p, D); }
#endif
#if PH_DUP & 32
    GRID_BAR();
    { FRESH_P(p); const DnBufs D{p.ws, (char*)p.out}; phase_dnout(p, D); }
#endif
    GRID_BAR();
#if PH_MASK & 64
    { FRESH_P(p); const MixBufs X{p.ws, (char*)p.out}; phase_merge(p, X, lds); }
#endif
#if PH_DUP & 64
    GRID_BAR();
    { FRESH_P(p); const MixBufs X{p.ws, (char*)p.out}; phase_merge(p, X, lds); }
#endif
    GRID_BAR();
#if PH_MASK & 128
    { FRESH_P(p); const MixBufs X{p.ws, (char*)p.out}; phase_outproj(p, X, lds); }
#endif
#if PH_DUP & 128
    GRID_BAR();
    { FRESH_P(p); const MixBufs X{p.ws, (char*)p.out}; phase_outproj(p, X, lds); }
#endif
    GRID_BAR();
#if PH_MASK & 256
    { FRESH_P(p); const MoeBufs Q{p.ws, (char*)p.out, p.kdown, p.bar + XCD_BAR_WORDS + 16}; phase_ln1(p, Q, lds); }
#endif
#if PH_DUP & 256
    GRID_BAR();
    { FRESH_P(p); const MoeBufs Q{p.ws, (char*)p.out, p.kdown, p.bar + XCD_BAR_WORDS + 16}; phase_ln1(p, Q, lds); }
#endif
    GRID_BAR();
#if PH_MASK & 1024
    { FRESH_P(p); const MoeBufs Q{p.ws, (char*)p.out, p.kdown, p.bar + XCD_BAR_WORDS + 16}; phase_moe1(p, Q, lds); }
#endif
#if PH_DUP & 1024
    GRID_BAR();
    { FRESH_P(p); const MoeBufs Q{p.ws, (char*)p.out, p.kdown, p.bar + XCD_BAR_WORDS + 16}; phase_moe1(p, Q, lds); }
#endif
    GRID_BAR();
#if PH_MASK & 2048
    { FRESH_P(p); const MoeBufs Q{p.ws, (char*)p.out, p.kdown, p.bar + XCD_BAR_WORDS + 16}; phase_moe2(p, Q, lds); }
#endif
#if PH_DUP & 2048
    GRID_BAR();
    { FRESH_P(p); const MoeBufs Q{p.ws, (char*)p.out, p.kdown, p.bar + XCD_BAR_WORDS + 16}; phase_moe2(p, Q, lds); }
#endif
    GRID_BAR();
#if PH_MASK & 4096
    { FRESH_P(p); const MoeBufs Q{p.ws, (char*)p.out, p.kdown, p.bar + XCD_BAR_WORDS + 16}; phase_ln2(p, Q); }
#endif
#if FWD_REP > 1
    GRID_BAR();
    { FRESH_P(p); if (blockIdx.x == 0 && threadIdx.x < 64) __hip_atomic_store(p.bar + XCD_BAR_WORDS + threadIdx.x, 0u, __ATOMIC_RELAXED, __HIP_MEMORY_SCOPE_AGENT); }
    GRID_BAR();
#if PH_MASK & 1
    { FRESH_P(p); const MoeBufs Q{p.ws, (char*)p.out, p.kdown, p.bar + XCD_BAR_WORDS + 16}; phase0(p, lds); phase0_router(p, Q); }
#endif
#if PH_DUP & 1
    GRID_BAR();
    { FRESH_P(p); const MoeBufs Q{p.ws, (char*)p.out, p.kdown, p.bar + XCD_BAR_WORDS + 16}; phase0(p, lds); phase0_router(p, Q); }
#endif
    GRID_BAR();
#if PH_MASK & 2
    { FRESH_P(p); phase1(p, lds); }
#endif
#if PH_DUP & 2
    GRID_BAR();
    { FRESH_P(p); phase1(p, lds); }
#endif
    GRID_BAR();
#if PH_MASK & 4
    { FRESH_P(p); phase_na(p, lds); }
#endif
#if PH_DUP & 4
    GRID_BAR();
    { FRESH_P(p); phase_na(p, lds); }
    GRID_BAR();
#endif
#if PH_MASK & 8
    { FRESH_P(p); const DnBufs D{p.ws, (char*)p.out}; phase_dnprep(p, D, lds); }
#endif
#if PH_DUP & 8
    GRID_BAR();
    { FRESH_P(p); const DnBufs D{p.ws, (char*)p.out}; phase_dnprep(p, D, lds); }
    GRID_BAR();
#endif
    GRID_BAR();
#if PH_MASK & 16
    {
        FRESH_P(p); const DnBufs D{p.ws, (char*)p.out};
        const int nb = (int)gridDim.x;
        unsigned* counter = p.bar + XCD_BAR_WORDS;
        if ((int)blockIdx.x >= 128) phase_zgemm(p, lds, nb - 128, (int)blockIdx.x - 128);
        else if ((fresh_tid() >> 6) >= 4) phase0_moe(p, counter);
        if ((int)blockIdx.x < 128) phase_dnscan(p, D, lds);
        if ((int)blockIdx.x >= 128 || (fresh_tid() >> 6) < 4) phase0_moe(p, counter);
    }
#endif
#if PH_DUP & 16
    GRID_BAR();
    {
        FRESH_P(p); const DnBufs D{p.ws, (char*)p.out};
        const int nb = (int)gridDim.x;
        unsigned* counter = p.bar + XCD_BAR_WORDS;
#if !(PH_DUP & 8192)
        if ((int)blockIdx.x >= 128) phase_zgemm(p, lds, nb - 128, (int)blockIdx.x - 128);
#endif
        if ((int)blockIdx.x >= 128) {} else if ((fresh_tid() >> 6) >= 4) phase0_moe(p, counter);
#if !(PH_DUP & 16384)
        if ((int)blockIdx.x < 128) phase_dnscan<SCAN_VARIANT>(p, D, lds);
#endif
        if ((int)blockIdx.x >= 128 || (fresh_tid() >> 6) < 4) phase0_moe(p, counter);
    }
#endif
    GRID_BAR();
#if PH_MASK & 32
    { FRESH_P(p); const DnBufs D{p.ws, (char*)p.out}; phase_dnout(p, D); }
#endif
#if PH_DUP & 32
    GRID_BAR();
    { FRESH_P(p); const DnBufs D{p.ws, (char*)p.out}; phase_dnout(p, D); }
#endif
    GRID_BAR();
#if PH_MASK & 64
    { FRESH_P(p); const MixBufs X{p.ws, (char*)p.out}; phase_merge(p, X, lds); }
#endif
#if PH_DUP & 64
    GRID_BAR();
    { FRESH_P(p); const MixBufs X{p.ws, (char*)p.out}; phase_merge(p, X, lds); }
#endif
    GRID_BAR();
#if PH_MASK & 128
    { FRESH_P(p); const MixBufs X{p.ws, (char*)p.out}; phase_outproj(p, X, lds); }
#endif
#if PH_DUP & 128
    GRID_BAR();
    { FRESH_P(p); const MixBufs X{p.ws, (char*)p.out}; phase_outproj(p, X, lds); }
#endif
    GRID_BAR();
#if PH_MASK & 256
    { FRESH_P(p); const MoeBufs Q{p.ws, (char*)p.out, p.kdown, p.bar + XCD_BAR_WORDS + 16}; phase_ln1(p, Q, lds); }
#endif
#if PH_DUP & 256
    GRID_BAR();
    { FRESH_P(p); const MoeBufs Q{p.ws, (char*)p.out, p.kdown, p.bar + XCD_BAR_WORDS + 16}; phase_ln1(p, Q, lds); }
#endif
    GRID_BAR();
#if PH_MASK & 1024
    { FRESH_P(p); const MoeBufs Q{p.ws, (char*)p.out, p.kdown, p.bar + XCD_BAR_WORDS + 16}; phase_moe1(p, Q, lds); }
#endif
#if PH_DUP & 1024
    GRID_BAR();
    { FRESH_P(p); const MoeBufs Q{p.ws, (char*)p.out, p.kdown, p.bar + XCD_BAR_WORDS + 16}; phase_moe1(p, Q, lds); }
#endif
    GRID_BAR();
#if PH_MASK & 2048
    { FRESH_P(p); const MoeBufs Q{p.ws, (char*)p.out, p.kdown, p.bar + XCD_BAR_WORDS + 16}; phase_moe2(p, Q, lds); }
#endif
#if PH_DUP & 2048
    GRID_BAR();
    { FRESH_P(p); const MoeBufs Q{p.ws, (char*)p.out, p.kdown, p.bar + XCD_BAR_WORDS + 16}; phase_moe2(p, Q, lds); }
#endif
    GRID_BAR();
#if PH_MASK & 4096
    { FRESH_P(p); const MoeBufs Q{p.ws, (char*)p.out, p.kdown, p.bar + XCD_BAR_WORDS + 16}; phase_ln2(p, Q); }
#endif
#endif
}

#define MB(x) ((size_t)(x) << 20)
extern "C" void kernel_launch(void* const* d_in, const int* in_sizes, int n_in, void* d_out, int out_size, void* d_ws, size_t ws_size, hipStream_t stream) {
    MegaArgs a{};
    Params& p = a.p;
    p.x = (const float*)d_in[0]; p.w_in = (const float*)d_in[1]; p.rpb = (const float*)d_in[2]; p.conv_w = (const float*)d_in[3];
    p.a_log_f = (const float*)d_in[4]; p.a_log_b = (const float*)d_in[5]; p.dtb_f = (const float*)d_in[6]; p.dtb_b = (const float*)d_in[7];
    p.norm_w = (const float*)d_in[8]; p.w_proj_na = (const float*)d_in[9]; p.w_proj_dn = (const float*)d_in[10]; p.w_out = (const float*)d_in[11];
    p.ln1_g = (const float*)d_in[12]; p.ln1_b = (const float*)d_in[13]; p.wrg = (const float*)d_in[14]; p.brg = (const float*)d_in[15];
    p.wre = (const float*)d_in[16]; p.bre = (const float*)d_in[17]; p.wgu = (const float*)d_in[18]; p.wd = (const float*)d_in[19];
    p.ln2_g = (const float*)d_in[20]; p.ln2_b = (const float*)d_in[21];
    p.out = (float*)d_out;
    p.ws = (char*)d_ws; p.bar = (unsigned*)d_ws; p.kdown = 256;

    static int grid = 0;
    if (grid == 0) {
        int dev = 0, cus = 0, per_cu = 0;
        hipGetDevice(&dev);
        hipDeviceGetAttribute(&cus, hipDeviceAttributeMultiprocessorCount, dev);
        hipFuncSetAttribute((const void*)mega_fwd, hipFuncAttributeMaxDynamicSharedMemorySize, LDS_BYTES);
        hipOccupancyMaxActiveBlocksPerMultiprocessor(&per_cu, (const void*)mega_fwd, NT, LDS_BYTES);
        if (per_cu < 1) { fprintf(stderr, "kernel_launch: occupancy query reports %d workgroups per CU\n", per_cu); per_cu = 1; }
        if (per_cu > 1) per_cu = 1;
        grid = cus * per_cu;
        if (grid > 256) grid = 256;
        (void)hipGetLastError();
    }
    hipMemsetAsync(p.bar, 0, (XCD_BAR_WORDS + 64) * sizeof(unsigned), stream);
    hipLaunchKernelGGL(mega_fwd, dim3(grid), dim3(NT), LDS_BYTES, stream, a);
}
```

```cpp
#include <hip/hip_runtime.h>
#include <math.h>
#include <stdint.h>
#include <stddef.h>
#include <stdio.h>
namespace pg8 {
#define PG8_LAS __attribute__((address_space(3)))
typedef unsigned short bf16_t;
typedef short bf16x8 __attribute__((ext_vector_type(8)));
typedef float f32x4 __attribute__((ext_vector_type(4)));
typedef unsigned u32x4 __attribute__((ext_vector_type(4)));
constexpr int BM = 256, BK = 64, HALF = 128, HTB = HALF * BK * 2  , STAGE_BYTES = 8 * HTB, NXCD = 8, WGM = 8;

__host__ __device__ __forceinline__ int lds_byte(int r, int c) { const int st = (r >> 4) * 2 + (c >> 5), rr = r & 15, cc = c & 31, ob = rr * 64 + cc * 2; return st * 1024 + (ob ^ (((ob >> 9) & 1) << 5)); }
__host__ __device__ __forceinline__ void stage_rc(int b, int& R, int& C) { const int st = b / 1024, sb = b % 1024, swz = sb ^ (((sb >> 9) & 1) << 5); R = (st >> 1) * 16 + swz / 64; C = (st & 1) * 32 + (swz % 64) / 2; }
__host__ __device__ __forceinline__ int perm32(int rho) { const int n = rho >> 4, i = rho & 15; return 8 * (i >> 2) + 4 * n + (i & 3); }

struct Unit { int pm, pn; };
struct Gemm { const bf16_t* A; const bf16_t* Bt; int M, N, K; };

struct StaticOrder {
    int nM, nN, nwg, G, c;
    __host__ __device__ __forceinline__ void init(int M, int N, int G_, int c_) { nM = M / BM; nN = N / BM; nwg = nM * nN; G = G_; c = c_; }
    __host__ __device__ __forceinline__ bool next(int i, Unit& u) const {
        const long L = (long)i * G + c; if (L >= nwg) return false;
        int wgid = (int)L; { const int q = nwg / NXCD, r = nwg % NXCD, xcd = wgid % NXCD, off = wgid / NXCD; wgid = (xcd < r ? xcd * (q + 1) : r * (q + 1) + (xcd - r) * q) + off; }
        const int nig = WGM * nN, gid = wgid / nig, fm = gid * WGM, gsz = (nM - fm) < WGM ? (nM - fm) : WGM;
        u.pm = fm + ((wgid % nig) % gsz); u.pn = (wgid % nig) / gsz; return true;
    }
    __device__ __forceinline__ void a_ready(const Unit&) const {}
    __device__ __forceinline__ void done(const Unit&) const {}
};
__device__ __forceinline__ unsigned cvt_pk_bf16(float lo, float hi) { unsigned r; asm volatile("v_cvt_pk_bf16_f32 %0, %1, %2" : "=v"(r) : "v"(lo), "v"(hi)); return r; }

template <class Epi, class Sched, bool ALIGN_EPI = false, bool SP2 = false>
__device__ __forceinline__ void gemm_phase(PG8_LAS unsigned char* lds, const Gemm g, const Sched& S, const Epi& E) {
    int tid_ = threadIdx.x; asm volatile("" : "+v"(tid_));
    const int tid = tid_, wid = __builtin_amdgcn_readfirstlane(tid >> 6), lane = tid & 63, wr = wid >> 2, wc = wid & 3, fr = lane & 15, fq = lane >> 4;
    const int K = g.K, nt = K / BK;
    unsigned voffA[2], voffB[2];
#pragma unroll
    for (int i = 0; i < 2; ++i) { int R, C; stage_rc(tid * 16 + i * 8192, R, C); const int Rb = Epi::PERM ? ((R & ~31) + perm32(R & 31)) : R;
        voffA[i] = (unsigned)(R * K + C) * 2u; voffB[i] = (unsigned)(Rb * K + C) * 2u; }
    const size_t kstep = (size_t)(BK * 2);
    const size_t hstep = (size_t)HALF * K * 2;
    const size_t tstep = 2 * hstep;
    const unsigned ldsw = (unsigned)wid * 1024u;
    const int aoff = lds_byte(wr * 64 + fr, fq * 8), boff = lds_byte(wc * 32 + fr, fq * 8);
#define PG8_SA(b, h) (((b) * 2 + (h)) * HTB)
#define PG8_SB(b, h) ((4 + (b) * 2 + (h)) * HTB)
#define PG8_STAGE(bufoff, gbase, voff) do { _Pragma("unroll") for (int _i = 0; _i < 2; ++_i) \
        __builtin_amdgcn_global_load_lds((const unsigned*)((const char*)(gbase) + (voff)[_i]), (PG8_LAS unsigned*)(lds + (bufoff) + ldsw + _i * 8192), 16, 0, 0); } while (0)
#define PG8_LDA(dst, b, h) do { _Pragma("unroll") for (int m = 0; m < 4; ++m) _Pragma("unroll") for (int k = 0; k < 2; ++k) dst[m][k] = *(const PG8_LAS bf16x8*)(lds + PG8_SA(b, h) + aoff + m * 2048 + k * 1024); } while (0)
#define PG8_LDB(dst, b, h) do { _Pragma("unroll") for (int n = 0; n < 2; ++n) _Pragma("unroll") for (int k = 0; k < 2; ++k) dst[n][k] = *(const PG8_LAS bf16x8*)(lds + PG8_SB(b, h) + boff + n * 2048 + k * 1024); } while (0)
#define PG8_MMA(ai, bj, At, Bt) do { __builtin_amdgcn_s_setprio(1); _Pragma("unroll") for (int m = 0; m < 4; ++m) _Pragma("unroll") for (int n = 0; n < 2; ++n) _Pragma("unroll") for (int k = 0; k < 2; ++k) \
        acc[ai][bj][m][n] = __builtin_amdgcn_mfma_f32_16x16x32_bf16(Bt[n][k], At[m][k], acc[ai][bj][m][n], 0, 0, 0); __builtin_amdgcn_s_setprio(0); } while (0)
#define PG8_WAIT_V(n) asm volatile("s_waitcnt vmcnt(" #n ")" ::: "memory")
#define PG8_WAIT_L(n) asm volatile("s_waitcnt lgkmcnt(" #n ")" ::: "memory")
#define PG8_BAR __builtin_amdgcn_s_barrier()
#define PG8_SCHED __builtin_amdgcn_sched_barrier(0)
    Unit cur, nxt; int ui = 0;
    if (!S.next(0, cur)) return;
    f32x4 acc[2][2][4][2];
#pragma unroll
    for (int a = 0; a < 2; ++a)
#pragma unroll
        for (int b = 0; b < 2; ++b)
#pragma unroll
            for (int m = 0; m < 4; ++m)
#pragma unroll
                for (int n = 0; n < 2; ++n) acc[a][b][m][n] = (f32x4){0.f, 0.f, 0.f, 0.f};
    bf16x8 At[4][2], B0[2][2], B1[2][2];
    const char* cA = (const char*)g.A + (size_t)cur.pm * tstep; const char* cB = (const char*)g.Bt + (size_t)cur.pn * tstep;
    S.a_ready(cur);
    if constexpr (SP2) {
        PG8_STAGE(PG8_SB(0, 0), cB, voffB); PG8_STAGE(PG8_SB(0, 1), cB + hstep, voffB); PG8_STAGE(PG8_SA(0, 0), cA, voffA); PG8_STAGE(PG8_SA(0, 1), cA + hstep, voffA);
        if (wr == 1) PG8_BAR;
        PG8_WAIT_V(2); PG8_BAR;
        PG8_STAGE(PG8_SB(1, 0), cB + kstep, voffB); PG8_STAGE(PG8_SA(1, 0), cA + kstep, voffA); PG8_STAGE(PG8_SB(1, 1), cB + hstep + kstep, voffB);
        PG8_WAIT_V(6); PG8_BAR;
    } else {
        PG8_STAGE(PG8_SB(0, 0), cB, voffB); PG8_STAGE(PG8_SA(0, 0), cA, voffA); PG8_STAGE(PG8_SB(0, 1), cB + hstep, voffB); PG8_STAGE(PG8_SA(0, 1), cA + hstep, voffA);
        if (wr == 1) PG8_BAR;
        PG8_WAIT_V(4); PG8_BAR;
        PG8_STAGE(PG8_SB(1, 0), cB + kstep, voffB); PG8_STAGE(PG8_SA(1, 0), cA + kstep, voffA); PG8_STAGE(PG8_SB(1, 1), cB + hstep + kstep, voffB);
        PG8_WAIT_V(6); PG8_BAR;
    }
    for (;;) {
        const bool has_next = S.next(ui + 1, nxt);
        const char* nA = has_next ? (const char*)g.A + (size_t)nxt.pm * tstep : cA; const char* nB = has_next ? (const char*)g.Bt + (size_t)nxt.pn * tstep : cB;
        for (int t = 0; t < nt; t += 2) {
            const bool last = (t == nt - 2);
            const char* a1 = cA + (size_t)(t + 1) * kstep;
            const char* a2 = last ? nA : cA + (size_t)(t + 2) * kstep; const char* b2 = last ? nB : cB + (size_t)(t + 2) * kstep;
            const char* a3 = a2 + kstep; const char* b3 = b2 + kstep;
            if (last && has_next) S.a_ready(nxt);
            if constexpr (SP2) {
            PG8_LDB(B0, 0, 0); PG8_LDB(B1, 0, 1); PG8_SCHED; PG8_LDA(At, 0, 0); PG8_STAGE(PG8_SA(1, 1), a1 + hstep, voffA);
            PG8_WAIT_V(8); PG8_WAIT_L(0); PG8_BAR; PG8_MMA(0, 0, At, B0); PG8_MMA(0, 1, At, B1); PG8_BAR; PG8_SCHED;
            PG8_LDA(At, 0, 1); PG8_STAGE(PG8_SB(0, 0), b2, voffB); PG8_STAGE(PG8_SB(0, 1), b2 + hstep, voffB); PG8_STAGE(PG8_SA(0, 0), a2, voffA);
            PG8_WAIT_V(8); PG8_WAIT_L(0); PG8_BAR; PG8_MMA(1, 0, At, B0); PG8_MMA(1, 1, At, B1); PG8_BAR; PG8_SCHED;
            PG8_LDB(B0, 1, 0); PG8_LDB(B1, 1, 1); PG8_SCHED; PG8_LDA(At, 1, 0); PG8_STAGE(PG8_SA(0, 1), a2 + hstep, voffA);
            PG8_WAIT_V(8); PG8_WAIT_L(0); PG8_BAR; PG8_MMA(0, 0, At, B0); PG8_MMA(0, 1, At, B1); PG8_BAR; PG8_SCHED;
            PG8_LDA(At, 1, 1); PG8_STAGE(PG8_SB(1, 0), b3, voffB); PG8_STAGE(PG8_SB(1, 1), b3 + hstep, voffB); PG8_STAGE(PG8_SA(1, 0), a3, voffA);
            PG8_WAIT_V(8); PG8_WAIT_L(0); PG8_BAR; PG8_MMA(1, 0, At, B0); PG8_MMA(1, 1, At, B1); PG8_BAR; PG8_SCHED;
            } else {
            PG8_LDB(B0, 0, 0); PG8_SCHED; PG8_LDA(At, 0, 0); PG8_STAGE(PG8_SA(1, 1), a1 + hstep, voffA);
            PG8_WAIT_L(8); PG8_BAR; PG8_WAIT_L(0); PG8_MMA(0, 0, At, B0); PG8_BAR; PG8_SCHED;
            PG8_LDB(B1, 0, 1); PG8_STAGE(PG8_SB(0, 0), b2, voffB);
            PG8_BAR; PG8_WAIT_L(0); PG8_MMA(0, 1, At, B1); PG8_BAR;
            PG8_LDA(At, 0, 1); PG8_STAGE(PG8_SA(0, 0), a2, voffA);
            PG8_BAR; PG8_WAIT_L(0); PG8_MMA(1, 0, At, B0); PG8_BAR; PG8_SCHED;
            PG8_STAGE(PG8_SB(0, 1), b2 + hstep, voffB);
            PG8_WAIT_V(6); PG8_BAR; PG8_MMA(1, 1, At, B1); PG8_BAR;
            PG8_LDB(B0, 1, 0); PG8_SCHED; PG8_LDA(At, 1, 0); PG8_STAGE(PG8_SA(0, 1), a2 + hstep, voffA);
            PG8_WAIT_L(8); PG8_BAR; PG8_WAIT_L(0); PG8_MMA(0, 0, At, B0); PG8_BAR; PG8_SCHED;
            PG8_LDB(B1, 1, 1); PG8_STAGE(PG8_SB(1, 0), b3, voffB);
            PG8_BAR; PG8_WAIT_L(0); PG8_MMA(0, 1, At, B1); PG8_BAR;
            PG8_LDA(At, 1, 1); PG8_STAGE(PG8_SA(1, 0), a3, voffA);
            PG8_BAR; PG8_WAIT_L(0); PG8_MMA(1, 0, At, B0); PG8_BAR; PG8_SCHED;
            PG8_STAGE(PG8_SB(1, 1), b3 + hstep, voffB);
            PG8_WAIT_V(6); PG8_BAR; PG8_MMA(1, 1, At, B1); PG8_BAR;
            }
        }
        if constexpr (ALIGN_EPI) { if (wr == 0) PG8_BAR; }
        if constexpr (!Epi::AFTER_DRAIN) { E(acc, cur, wr, wc, fr, fq); S.done(cur); }
        if (!has_next) break;
#pragma unroll
        for (int a = 0; a < 2; ++a)
#pragma unroll
            for (int b = 0; b < 2; ++b)
#pragma unroll
                for (int m = 0; m < 4; ++m)
#pragma unroll
                    for (int n = 0; n < 2; ++n) acc[a][b][m][n] = (f32x4){0.f, 0.f, 0.f, 0.f};
        cur = nxt; cA = nA; cB = nB; ++ui;
        if constexpr (ALIGN_EPI) { if (wr == 1) PG8_BAR; }
    }
    PG8_WAIT_V(0);
    if constexpr (!ALIGN_EPI) { if (wr == 0) PG8_BAR; }
    PG8_BAR;
    if constexpr (Epi::AFTER_DRAIN) { E.fused(acc, cur, wr, wc, fr, fq, lds, wid, lane); S.done(cur); }
#undef PG8_SA
#undef PG8_SB
#undef PG8_STAGE
#undef PG8_LDA
#undef PG8_LDB
#undef PG8_MMA
#undef PG8_WAIT_V
#undef PG8_WAIT_L
#undef PG8_BAR
#undef PG8_SCHED
}
}
typedef unsigned short bf16;
#define LAS __attribute__((address_space(3)))
typedef float f32x4 __attribute__((ext_vector_type(4)));
typedef short bf16x8 __attribute__((ext_vector_type(8)));
typedef unsigned u32x4 __attribute__((ext_vector_type(4)));
typedef unsigned u32x2 __attribute__((ext_vector_type(2)));

#define D_MODEL 1024
#define BATCH 8
#define SEQ 2048
#define D_IN 5664
#define NTOK (BATCH * SEQ)
#define ALPHA 1.189207115002721f
#define LN_EPS 1e-5f
#define RMS_EPS 1e-6f
#define NWIN 3072
#define NT 512
#define LDS_BYTES 163840

#ifndef PROBE_BLK
#define PROBE_BLK 0
#endif
#ifndef PROBE_RGN
#define PROBE_RGN (-1)
#endif
#define RGN_WORD(lds_) ((volatile LAS unsigned*)((lds_) + LDS_BYTES - 64 + 40))
#define RGN_B(id, lds_) do { if (PROBE_RGN == (id) && blockIdx.x == PROBE_BLK && threadIdx.x == 0) RGN_WORD(lds_)[1] = (unsigned)__builtin_amdgcn_s_memrealtime(); } while (0)
#define RGN_E(id, lds_) do { if (PROBE_RGN == (id) && blockIdx.x == PROBE_BLK && threadIdx.x == 0) RGN_WORD(lds_)[0] += (unsigned)__builtin_amdgcn_s_memrealtime() - RGN_WORD(lds_)[1]; } while (0)
#define LDS_WAIT() asm volatile("s_waitcnt lgkmcnt(0)" ::: "memory")
#define VM_WAIT() asm volatile("s_waitcnt vmcnt(0)" ::: "memory")

__device__ __forceinline__ int fresh_tid() { int t = threadIdx.x; asm volatile("" : "+v"(t)); return t; }
typedef float f32x2_t __attribute__((ext_vector_type(2)));
typedef __bf16 bf16x2_t __attribute__((ext_vector_type(2)));
__device__ __forceinline__ unsigned pk2(float lo, float hi) { const f32x2_t v = {lo, hi}; const bf16x2_t b = __builtin_convertvector(v, bf16x2_t); return __builtin_bit_cast(unsigned, b); }
__device__ __forceinline__ unsigned f2bf(float f) { return pk2(f, 0.f) & 0xffffu; }
#ifndef WT_STORES
#define WT_STORES 0
#endif
__device__ __forceinline__ void st16(void* ptr, u32x4 v) {
#if WT_STORES
    asm volatile("global_store_dwordx4 %0, %1, off sc1\n\ts_nop 1" :: "v"(ptr), "v"(v) : "memory");
#else
    *(u32x4*)ptr = v;
#endif
}
template <int CTRL> __device__ __forceinline__ float dpp_f(float v) { return __builtin_bit_cast(float, __builtin_amdgcn_update_dpp(0, __builtin_bit_cast(int, v), CTRL, 0xf, 0xf, false)); }
__device__ __forceinline__ float bf2f(unsigned h) { return __builtin_bit_cast(float, (h & 0xffffu) << 16); }
__device__ __forceinline__ float sigmoidf_(float x) { return __builtin_amdgcn_rcpf(1.f + __expf(-x)); }
__device__ __forceinline__ float siluf_(float x) { return x * __builtin_amdgcn_rcpf(1.f + __expf(-x)); }
__device__ __forceinline__ float softplusf_(float x) { return x > 20.f ? x : log1pf(expf(x)); }

struct Params {
    const float *x, *w_in, *rpb, *conv_w, *a_log_f, *a_log_b, *dtb_f, *dtb_b, *norm_w, *w_proj_na, *w_proj_dn, *w_out, *ln1_g, *ln1_b;
    const float *wrg, *brg, *wre, *bre, *wgu, *wd, *ln2_g, *ln2_b;
    float* out;
    char* ws;
    unsigned* bar;
    int kdown, pad0;
#define WSP(T, mb) ((T*)(ws + ((size_t)(mb) << 20)))
    __device__ __forceinline__ bf16* WIN() const { return WSP(bf16, 1); }
    __device__ __forceinline__ bf16* WG() const { return WSP(bf16, 9); }
    __device__ __forceinline__ bf16* WPNA() const { return WSP(bf16, 13); }
    __device__ __forceinline__ bf16* WPDN() const { return WSP(bf16, 14); }
    __device__ __forceinline__ bf16* WOUT() const { return WSP(bf16, 15); }
    __device__ __forceinline__ bf16* XB() const { return WSP(bf16, 17); }
    __device__ __forceinline__ bf16* WGU() const { return WSP(bf16, 49); }
    __device__ __forceinline__ bf16* WD() const { return WSP(bf16, 81); }
    __device__ __forceinline__ bf16* QNA() const { return WSP(bf16, 49); }
    __device__ __forceinline__ bf16* KNA() const { return WSP(bf16, 65); }
    __device__ __forceinline__ bf16* VNAT() const { return WSP(bf16, 81); }
    __device__ __forceinline__ bf16* QKVDN() const { return WSP(bf16, 97); }
    __device__ __forceinline__ bf16* Z() const { return WSP(bf16, 145); }
    __device__ __forceinline__ float* GATES() const { return WSP(float, 161); }
    __device__ __forceinline__ bf16* NAOUT() const { return WSP(bf16, 163); }
    __device__ __forceinline__ bf16* DNOUT() const { return WSP(bf16, 129); }
};

struct TrItem { f32x4 a[2][2][2]; bf16* dst; };
__device__ __forceinline__ void transpose_load(TrItem& t, const float* W, size_t ldW, bf16* WT, int Kdst, int k0, int n0, int rowdst0, int lane) {
    const int m = lane & 15, g = lane >> 4;
#pragma unroll
    for (int kg = 0; kg < 2; ++kg)
#pragma unroll
        for (int q = 0; q < 2; ++q) {
            const float* src = W + (size_t)(k0 + 32 * kg + 8 * (m >> 2) + 4 * q + (m & 3)) * ldW + n0 + 8 * g;
            t.a[kg][q][0] = *(const f32x4*)src; t.a[kg][q][1] = *(const f32x4*)(src + 4);
        }
    t.dst = WT + (size_t)rowdst0 * Kdst + k0;
}
__device__ __forceinline__ void transpose_finish(const TrItem& t, int Kdst, int lane) {
    const int m = lane & 15, g = lane >> 4;
    bf16x8 idb[2];
#pragma unroll
    for (int half = 0; half < 2; ++half)
#pragma unroll
        for (int j = 0; j < 8; ++j) idb[half][j] = (8 * g + j == m + 16 * half) ? (short)0x3F80 : (short)0;
#pragma unroll
    for (int kg = 0; kg < 2; ++kg) {
        f32x4 d[2][2];
#pragma unroll
        for (int q = 0; q < 2; ++q) {
            const f32x4 a0 = t.a[kg][q][0], a1 = t.a[kg][q][1];
            u32x4 aw; aw.x = pk2(a0[0], a0[1]); aw.y = pk2(a0[2], a0[3]); aw.z = pk2(a1[0], a1[1]); aw.w = pk2(a1[2], a1[3]);
            const bf16x8 af = __builtin_bit_cast(bf16x8, aw);
#pragma unroll
            for (int half = 0; half < 2; ++half) d[q][half] = __builtin_amdgcn_mfma_f32_16x16x32_bf16(af, idb[half], (f32x4){0.f, 0.f, 0.f, 0.f}, 0, 0, 0);
        }
#pragma unroll
        for (int half = 0; half < 2; ++half) {
            u32x4 o; o.x = pk2(d[0][half][0], d[0][half][1]); o.y = pk2(d[0][half][2], d[0][half][3]); o.z = pk2(d[1][half][0], d[1][half][1]); o.w = pk2(d[1][half][2], d[1][half][3]);
            *(u32x4*)(t.dst + (size_t)(16 * half + m) * Kdst + 32 * kg + 8 * g) = o;
        }
    }
}
__device__ __forceinline__ void transpose_item(const float* W, size_t ldW, bf16* WT, int Kdst, int k0, int n0, int rowdst0, LAS float*  , int lane) {
    TrItem t; transpose_load(t, W, ldW, WT, Kdst, k0, n0, rowdst0, lane); transpose_finish(t, Kdst, lane);
}

#define IT_WIN (16 * 113)
#define IT_WG (16 * 64)
#define IT_WPNA (8 * 32)
#define IT_WPDN (8 * 32)
#define IT_WOUT (16 * 32)
#define IT_SMALL (IT_WIN + IT_WG + IT_WPNA + IT_WPDN + IT_WOUT)
#define IT_WGU (32 * 16 * 16)
#define IT_WD (32 * 4 * 32)

__device__ __forceinline__ void p0_small_item(const Params& p, int r, LAS float* scr, int lane) {
    if (r < IT_WIN) { const int kb = r / 113, nb = r % 113; transpose_item(p.w_in, D_IN, p.WIN(), 1024, kb * 64, nb * 32, nb * 32, scr, lane); return; } r -= IT_WIN;
    if (r < IT_WG) { const int kb = r / 64, nb = r % 64; transpose_item(p.w_in + 3616, D_IN, p.WG(), 1024, kb * 64, nb * 32, nb * 32, scr, lane); return; } r -= IT_WG;
    if (r < IT_WPNA) { const int kb = r / 32, nb = r % 32; transpose_item(p.w_proj_na, 1024, p.WPNA(), 512, kb * 64, nb * 32, nb * 32, scr, lane); return; } r -= IT_WPNA;
    if (r < IT_WPDN) { const int kb = r / 32, nb = r % 32; transpose_item(p.w_proj_dn, 1024, p.WPDN(), 512, kb * 64, nb * 32, nb * 32, scr, lane); return; } r -= IT_WPDN;
    { const int kb = r / 32, nb = r % 32; transpose_item(p.w_out, 1024, p.WOUT(), 1024, kb * 64, nb * 32, nb * 32, scr, lane); }
}
__device__ __forceinline__ int p0_moe_load(TrItem& t, const Params& p, int r, int lane) {
    if (r < IT_WGU) { const int e = r / 256, q = r % 256, kb = q / 16, nb = q % 16;
        const int n0 = nb * 32, up = n0 >= 256, f0 = n0 - (up ? 256 : 0);
        transpose_load(t, p.wgu + (size_t)e * 1024 * 512, 512, p.WGU(), 1024, kb * 64, n0, e * 512 + (f0 / 128) * 256 + (up ? 128 : 0) + (f0 % 128), lane); return 1024; }
    r -= IT_WGU;
    { const int e = r / 128, q = r % 128, kb = q / 32, nb = q % 32;
        transpose_load(t, p.wd + (size_t)e * 256 * 1024, 1024, p.WD(), 256, kb * 64, nb * 32, e * 1024 + nb * 32, lane); return 256; }
}
__device__ __forceinline__ void p0_moe_item(const Params& p, int r, LAS float* scr, int lane) {
    if (r < IT_WGU) { const int e = r / 256, q = r % 256, kb = q / 16, nb = q % 16;
        const int n0 = nb * 32, up = n0 >= 256, f0 = n0 - (up ? 256 : 0);
        transpose_item(p.wgu + (size_t)e * 1024 * 512, 512, p.WGU(), 1024, kb * 64, n0, e * 512 + (f0 / 128) * 256 + (up ? 128 : 0) + (f0 % 128), scr, lane); return; }
    r -= IT_WGU;
    { const int e = r / 128, q = r % 128, kb = q / 32, nb = q % 32;
        transpose_item(p.wd + (size_t)e * 256 * 1024, 1024, p.WD(), 256, kb * 64, nb * 32, e * 1024 + nb * 32, scr, lane); }
}

__device__ __forceinline__ void phase0_moe(const Params& p, unsigned* counter) {
    const int lane = fresh_tid() & 63;
    for (;;) {
        unsigned base = 0;
        if (lane == 0) base = __hip_atomic_fetch_add(counter, 4u, __ATOMIC_RELAXED, __HIP_MEMORY_SCOPE_AGENT);
        base = (unsigned)__builtin_amdgcn_readfirstlane((int)base);
        if (base >= (unsigned)(IT_WGU + IT_WD)) break;
        TrItem t[4]; int ks[4];
#pragma unroll
        for (int k = 0; k < 4; ++k) ks[k] = p0_moe_load(t[k], p, (int)base + k, lane);
#pragma unroll
        for (int k = 0; k < 4; ++k) transpose_finish(t[k], ks[k], lane);
    }
}
__device__ __forceinline__ void phase0(const Params& p, LAS unsigned char* lds) {
    const int tid = fresh_tid(), lane = tid & 63, wave = tid >> 6, G = gridDim.x;
    LAS float* scr = (LAS float*)(lds + wave * 16384);
    const int gw = blockIdx.x * 8 + wave, NGW = G * 8;
    for (int it = gw; it < IT_WIN; it += NGW) p0_small_item(p, it, scr, lane);
    const size_t gt = (size_t)blockIdx.x * NT + tid, GT = (size_t)G * NT;
    for (size_t i0 = gt; i0 < (size_t)NTOK * 1024 / 8; i0 += 4 * GT) {
        f32x4 a[4], b[4];
#pragma unroll
        for (int q = 0; q < 4; ++q) { const size_t i = i0 + q * GT; if (i < (size_t)NTOK * 1024 / 8) { a[q] = *(const f32x4*)(p.x + i * 8); b[q] = *(const f32x4*)(p.x + i * 8 + 4); } }
#pragma unroll
        for (int q = 0; q < 4; ++q) { const size_t i = i0 + q * GT; if (i < (size_t)NTOK * 1024 / 8) {
            u32x4 o; o.x = pk2(a[q].x, a[q].y); o.y = pk2(a[q].z, a[q].w); o.z = pk2(b[q].x, b[q].y); o.w = pk2(b[q].z, b[q].w);
            st16(p.XB() + i * 8, o); } }
    }
}

__device__ __forceinline__ void phase_late_weights(const Params& p, int lo, int hi) {
    const int tid = fresh_tid(), lane = tid & 63, wave = tid >> 6;
    for (int it = lo + (int)blockIdx.x * 8 + wave; it < hi; it += (int)gridDim.x * 8) p0_small_item(p, it, (LAS float*)nullptr, lane);
}

struct EpiInProj {
    static constexpr bool PERM = true, AFTER_DRAIN = false;
    LAS unsigned char* lds_epi;
    struct Mini { char* ws;
        __device__ __forceinline__ bf16* QNA() const { return WSP(bf16, 49); }
        __device__ __forceinline__ bf16* KNA() const { return WSP(bf16, 65); }
        __device__ __forceinline__ bf16* VNAT() const { return WSP(bf16, 81); }
        __device__ __forceinline__ bf16* QKVDN() const { return WSP(bf16, 97); }
    } p;
    __device__ __forceinline__ void operator()(const pg8::f32x4 (&acc)[2][2][4][2], const pg8::Unit& u, int wr, int wc, int fr, int fq) const {
        const int pn = u.pn;
#pragma unroll
        for (int ai = 0; ai < 2; ++ai)
#pragma unroll
            for (int m = 0; m < 4; ++m) {
                const int row = u.pm * 256 + ai * 128 + wr * 64 + m * 16 + fr;
                const int b = row >> 11, t = row & 2047;
#pragma unroll
                for (int bj = 0; bj < 2; ++bj) {
                    const pg8::f32x4 v0 = acc[ai][bj][m][0], v1 = acc[ai][bj][m][1];
                    const int head = (pn & 1) * 4 + bj * 2 + (wc >> 1), d0 = (wc & 1) * 32 + 8 * fq;
                    const size_t hm = ((size_t)(b * 8 + head) * 2048 + t) * 64 + d0;
                    if (pn < 4 || pn >= 6) {
                        bf16* dst; float sc = 1.f;
                        if (pn < 2) { dst = p.QNA(); sc = 0.125f * 1.4426950408889634f; }
                        else if (pn < 4) dst = p.KNA();
                        else dst = p.QKVDN() + (size_t)((pn - 6) >> 1) * ((size_t)NTOK * 512);
                        float e[8] = {v0[0], v0[1], v0[2], v0[3], v1[0], v1[1], v1[2], v1[3]};
#pragma unroll
                        for (int j = 0; j < 8; ++j) e[j] *= sc;
                        u32x4 w; w.x = pk2(e[0], e[1]); w.y = pk2(e[2], e[3]); w.z = pk2(e[4], e[5]); w.w = pk2(e[6], e[7]);
                        st16(dst + hm, w);
                    } else {
                        LAS bf16* scr = (LAS bf16*)(lds_epi + (wr * 4 + wc) * 1280);
                        const float e[8] = {v0[0], v0[1], v0[2], v0[3], v1[0], v1[1], v1[2], v1[3]};
#pragma unroll
                        for (int j = 0; j < 8; ++j) scr[(8 * fq + j) * 20 + fr] = (bf16)f2bf(e[j]);
                        LDS_WAIT();
                        const int lane = fq * 16 + fr, dd = lane >> 1, hf = lane & 1;
                        const u32x2 lo = *(const LAS u32x2*)(scr + dd * 20 + 8 * hf), hi = *(const LAS u32x2*)(scr + dd * 20 + 8 * hf + 4);
                        const int t0 = (u.pm * 256 + ai * 128 + wr * 64 + m * 16) & 2047;
                        u32x4 w; w.x = lo.x; w.y = lo.y; w.z = hi.x; w.w = hi.y;
                        st16(p.VNAT() + ((size_t)(b * 8 + head) * 64 + (wc & 1) * 32 + dd) * 2048 + t0 + 8 * hf, w);
                        LDS_WAIT();
                    }
                }
            }
    }
};
struct EpiZ {
    static constexpr bool PERM = true, AFTER_DRAIN = false;
    bf16* Z;
    __device__ __forceinline__ void operator()(const pg8::f32x4 (&acc)[2][2][4][2], const pg8::Unit& u, int wr, int wc, int fr, int fq) const {
#pragma unroll
        for (int ai = 0; ai < 2; ++ai)
#pragma unroll
            for (int m = 0; m < 4; ++m) {
                const int row = u.pm * 256 + ai * 128 + wr * 64 + m * 16 + fr;
                const int b = row >> 11, t = row & 2047;
#pragma unroll
                for (int bj = 0; bj < 2; ++bj) {
                    const pg8::f32x4 v0 = acc[ai][bj][m][0], v1 = acc[ai][bj][m][1];
                    const int head = (u.pn & 1) * 4 + bj * 2 + (wc >> 1), d0 = (wc & 1) * 32 + 8 * fq;
                    float e[8] = {v0[0], v0[1], v0[2], v0[3], v1[0], v1[1], v1[2], v1[3]};
#pragma unroll
                    for (int j = 0; j < 8; ++j) e[j] = siluf_(e[j]);
                    u32x4 w; w.x = pk2(e[0], e[1]); w.y = pk2(e[2], e[3]); w.z = pk2(e[4], e[5]); w.w = pk2(e[6], e[7]);
                    st16(Z + ((size_t)(b * 8 + head) * 2048 + t) * 64 + d0, w);
                }
            }
    }
};
__device__ __forceinline__ void gates_minigemm(const Params& p, LAS unsigned char* lds) {
    const int tid = fresh_tid(), lane = tid & 63, wave = tid >> 6, r16 = lane & 15, g = lane >> 4;
    LAS float* part = (LAS float*)lds;
    for (int blk = blockIdx.x; blk < 256; blk += gridDim.x) {
        f32x4 acc[4][2];
#pragma unroll
        for (int mt = 0; mt < 4; ++mt) { acc[mt][0] = (f32x4){0.f, 0.f, 0.f, 0.f}; acc[mt][1] = (f32x4){0.f, 0.f, 0.f, 0.f}; }
        const bf16* A = p.XB() + ((size_t)blk * 64 + r16) * 1024 + wave * 128 + 8 * g;
        const bf16* Bt = p.WIN() + ((size_t)3584 + r16) * 1024 + wave * 128 + 8 * g;
#pragma unroll
        for (int ks = 0; ks < 4; ++ks) {
            const bf16x8 b0 = *(const bf16x8*)(Bt + ks * 32), b1 = *(const bf16x8*)(Bt + (size_t)16 * 1024 + ks * 32);
#pragma unroll
            for (int mt = 0; mt < 4; ++mt) { const bf16x8 a = *(const bf16x8*)(A + (size_t)(mt * 16) * 1024 + ks * 32);
                acc[mt][0] = __builtin_amdgcn_mfma_f32_16x16x32_bf16(a, b0, acc[mt][0], 0, 0, 0); acc[mt][1] = __builtin_amdgcn_mfma_f32_16x16x32_bf16(a, b1, acc[mt][1], 0, 0, 0); }
        }
        __syncthreads();
#pragma unroll
        for (int mt = 0; mt < 4; ++mt)
#pragma unroll
            for (int nt = 0; nt < 2; ++nt) *(LAS f32x4*)(part + ((wave * 8 + mt * 2 + nt) * 64 + lane) * 4) = acc[mt][nt];
        __syncthreads();
#pragma unroll
        for (int q = 0; q < 4; ++q) {
            const int idx = tid + q * NT, tile = idx >> 8, l2 = (idx >> 2) & 63, r = idx & 3;
            float e = 0.f;
#pragma unroll
            for (int w2 = 0; w2 < 8; ++w2) e += part[((w2 * 8 + tile) * 64 + l2) * 4 + r];
            const int mt = tile >> 1, nt = tile & 1, col = nt * 16 + (l2 & 15), type = col >> 3, hd = col & 7;
            const size_t tg = (size_t)blk * 64 + mt * 16 + 4 * (l2 >> 4) + r; const int b = (int)(tg >> 11), t = (int)(tg & 2047);
            const float v = type < 2 ? sigmoidf_(e) : (type == 2 ? -expf(p.a_log_f[hd]) * softplusf_(e + p.dtb_f[hd]) : -expf(p.a_log_b[hd]) * softplusf_(e + p.dtb_b[hd]));
            p.GATES()[(size_t)type * NTOK * 8 + ((size_t)b * 8 + hd) * 2048 + t] = v;
        }
    }
}

struct EpiNull {
    static constexpr bool PERM = true, AFTER_DRAIN = false; float* sink;
    __device__ __forceinline__ void operator()(const pg8::f32x4 (&acc)[2][2][4][2], const pg8::Unit& u, int wr, int wc, int fr, int fq) const {
        float t = 0.f;
#pragma unroll
        for (int a = 0; a < 2; ++a)
#pragma unroll
            for (int b = 0; b < 2; ++b)
#pragma unroll
                for (int m = 0; m < 4; ++m)
#pragma unroll
                    for (int n = 0; n < 2; ++n) t += acc[a][b][m][n][0] + acc[a][b][m][n][1] + acc[a][b][m][n][2] + acc[a][b][m][n][3];
        if (t == 1.2345e-30f) sink[0] = t;
    }
};
template <int V = 0>
__device__ __forceinline__ void phase1(const Params& p, LAS unsigned char* lds) {
    pg8::Gemm g{p.XB(), p.WIN(), NTOK, NWIN, 1024};
    pg8::StaticOrder S; S.init(NTOK, NWIN, gridDim.x, (int)blockIdx.x);
    if (V == 1) { EpiNull E0{(float*)p.ws + 64}; pg8::gemm_phase<EpiNull, pg8::StaticOrder, true, true>(lds, g, S, E0); return; }
    EpiInProj E{lds + 131072, {p.ws}};
    RGN_B(20, lds);
    pg8::gemm_phase<EpiInProj, pg8::StaticOrder, true, true>(lds, g, S, E);
    RGN_E(20, lds); RGN_B(21, lds);
    gates_minigemm(p, lds);
    RGN_E(21, lds);
}
__device__ __forceinline__ void phase_zgemm(const Params& p, LAS unsigned char* lds, int nb, int c) {
    pg8::Gemm g{p.XB(), p.WIN() + (size_t)3072 * 1024, NTOK, 512, 1024};
    pg8::StaticOrder S; S.init(NTOK, 512, nb, c);
    EpiZ E{p.Z()};
    pg8::gemm_phase<EpiZ, pg8::StaticOrder, true, true>(lds, g, S, E);
}

#define XB_TMO      128
#define XB_XCNT(j)  (256  + 64 * (j))
#define XB_XSUB(j)  (1280 + 64 * (j))
#define XB_XGEN(j)  (2304 + 64 * (j))
#define XB_TOP      3328
#define XB_TOPGEN   3392
#define XCD_BAR_WORDS 3456
#define XB_SPIN_CAP (1u << 18)


__device__ __forceinline__ unsigned xb_ld(unsigned* p)              { return __hip_atomic_load(p, __ATOMIC_RELAXED, __HIP_MEMORY_SCOPE_AGENT); }
__device__ __forceinline__ unsigned xb_add(unsigned* p, unsigned v) { return __hip_atomic_fetch_add(p, v, __ATOMIC_RELAXED, __HIP_MEMORY_SCOPE_AGENT); }
__device__ __forceinline__ unsigned xb_xcc_id() { return (unsigned)__builtin_amdgcn_s_getreg((3 << 11) | 20) & 0xFu; }
#define XB_SPIN(cond, bar) do { unsigned _sp = 0; while (cond) { __builtin_amdgcn_s_sleep(1); \
    if ((++_sp & 255u) == 0u) { if (xb_ld(&(bar)[XB_TMO])) break; if (_sp > XB_SPIN_CAP) { atomicAdd(&(bar)[XB_TMO], 1u); break; } } } } while (0)

struct XcdBarrier {
    unsigned* bar; unsigned x;
    volatile LAS unsigned* st;
};

__device__ __forceinline__ XcdBarrier xcd_barrier_post(unsigned* bar, volatile LAS unsigned* st) {
    XcdBarrier b; b.bar = bar; b.x = xb_xcc_id(); b.st = st;
    if (threadIdx.x == 0) (void)xb_add(&bar[XB_XCNT(b.x)], 1u);
    return b;
}
__device__ __forceinline__ void xcd_barrier_complete(unsigned* bar, unsigned x, unsigned& nloc, unsigned& nx) {
    const unsigned G = gridDim.x * gridDim.y * gridDim.z;
    unsigned sum, cnt, mine, sp = 0u;
    for (;;) {
        sum = 0u; cnt = 0u; mine = 0u;
#pragma unroll
        for (unsigned j = 0; j < 16; ++j) { const unsigned c = xb_ld(&bar[XB_XCNT(j)]); sum += c; cnt += (c > 0u) ? 1u : 0u; mine = (j == x) ? c : mine; }
        if (sum == G) break;
        __builtin_amdgcn_s_sleep(1);
        if ((++sp & 255u) == 0u) { if (xb_ld(&bar[XB_TMO])) break; if (sp > XB_SPIN_CAP) { atomicAdd(&bar[XB_TMO], 1u); break; } }
    }
    nloc = mine > 0u ? mine : 1u; nx = cnt > 0u ? cnt : 1u;
}

#ifndef EARLY_WB
#define EARLY_WB 0
#endif
template <int FENCES = 3> __device__ __forceinline__ void xcd_barrier(const XcdBarrier& b) {
    asm volatile("s_waitcnt vmcnt(0)" ::: "memory");
    __syncthreads();
#if EARLY_WB
    if (threadIdx.x == 64) asm volatile("buffer_wbl2 sc1" ::: "memory");
#endif
    if (threadIdx.x == 0) {
        unsigned* bar = b.bar;
        __builtin_amdgcn_s_waitcnt(0);
        unsigned nloc = b.st[0], nx = b.st[1];
        if (nloc == 0u) { xcd_barrier_complete(bar, b.x, nloc, nx); b.st[0] = nloc; b.st[1] = nx; }
        const unsigned k = b.st[2]; b.st[2] = k + 1u;
        const unsigned old = xb_add(&bar[XB_XSUB(b.x)], 1u);
        bool released = false;
        if (old + 1u == (k + 1u) * nloc) {
            if (FENCES & 1) __builtin_amdgcn_fence(__ATOMIC_RELEASE, "agent");
            asm volatile("s_waitcnt vmcnt(0)" ::: "memory");
            const unsigned og = xb_add(&bar[XB_TOP], 1u);
            if (og + 1u == (k + 1u) * nx) { xb_add(&bar[XB_TOPGEN], 1u); released = true; }
        }
        if (FENCES & 2) asm volatile("buffer_inv sc1" ::: "memory");
        if (!released) XB_SPIN(xb_ld(&bar[XB_TOPGEN]) == k, bar);
        asm volatile("s_waitcnt vmcnt(0)" ::: "memory");
        __builtin_amdgcn_fence(__ATOMIC_ACQUIRE, "workgroup");
    }
    __syncthreads();
}
__device__ __forceinline__ void xcd_barrier_arrive(const XcdBarrier& b) {
    asm volatile("s_waitcnt vmcnt(0)" ::: "memory");
    __syncthreads();
    if (threadIdx.x == 0) {
        unsigned* bar = b.bar;
        __builtin_amdgcn_s_waitcnt(0);
        unsigned nloc = b.st[0], nx = b.st[1];
        if (nloc == 0u) { xcd_barrier_complete(bar, b.x, nloc, nx); b.st[0] = nloc; b.st[1] = nx; }
        const unsigned k = b.st[2]; b.st[3] = k;
        const unsigned old = xb_add(&bar[XB_XSUB(b.x)], 1u);
        if (old + 1u == (k + 1u) * nloc) {
            __builtin_amdgcn_fence(__ATOMIC_RELEASE, "agent");
            asm volatile("s_waitcnt vmcnt(0)" ::: "memory");
            const unsigned og = xb_add(&bar[XB_TOP], 1u);
            if (og + 1u == (k + 1u) * nx) xb_add(&bar[XB_TOPGEN], 1u);
        }
    }
}
__device__ __forceinline__ void xcd_barrier_wait(const XcdBarrier& b) {
    asm volatile("s_waitcnt vmcnt(0)" ::: "memory");
    __syncthreads();
    if (threadIdx.x == 0) {
        unsigned* bar = b.bar;
        const unsigned k = b.st[3]; b.st[2] = k + 1u;
        asm volatile("buffer_inv sc1" ::: "memory");
        XB_SPIN(xb_ld(&bar[XB_TOPGEN]) == k, bar);
        asm volatile("s_waitcnt vmcnt(0)" ::: "memory");
        __builtin_amdgcn_fence(__ATOMIC_ACQUIRE, "workgroup");
    }
    __syncthreads();
}
#define NA_KSW(col) (((col) & 3) | ((((col) >> 3) & 1) << 2))
#define NA_VSTR 528
#define NA_V_OFF 65536
#define NA_RPB_OFF (65536 + 64 * NA_VSTR * 2)
#define NA_X_OFF 134992
#define NA_LOG2E 1.4426950408889634f
template <int NAV = 0>
__device__ __forceinline__ void phase_na(const Params& p, LAS unsigned char* lds) {
    const int tid = fresh_tid(), lane = tid & 63, wave = tid >> 6, G = gridDim.x;
    const int vcu = (G % 8 == 0) ? ((int)blockIdx.x % 8) * (G / 8) + (int)blockIdx.x / 8 : (int)blockIdx.x;
    LAS unsigned char* Kl = lds;
    LAS bf16* Vl = (LAS bf16*)(lds + NA_V_OFF);
    LAS float* rpb_s = (LAS float*)(lds + NA_RPB_OFF);
    LAS float* X = (LAS float*)(lds + NA_X_OFF);
    const int qi = lane & 15, g = lane >> 4, qg = wave & 3, kh = wave >> 2;
    const int c0 = qg * 16, c = c0 + qi;
    int cs0 = c0 - 8; cs0 = cs0 < 0 ? 0 : (cs0 > 32 ? 32 : cs0);
    int csq = c - 8; csq = csq < 0 ? 0 : (csq > 48 ? 48 : csq);
    for (int task = vcu; task < 256; task += G) {
        const int bh = task >> 2, r0 = (task & 3) * 8, h = bh & 7, b = bh >> 3;
        const size_t hb = (size_t)bh * 2048;
        const bf16* Kg = p.KNA() + hb * 64;
        const bf16* Vg = p.VNAT() + (size_t)bh * 64 * 2048;
        __syncthreads();
        for (int i = tid; i < 465; i += NT) rpb_s[i] = p.rpb[h * 465 + i] * NA_LOG2E;
        {
            int rs0 = r0 - 4; rs0 = rs0 < 0 ? 0 : (rs0 > 24 ? 24 : rs0);
#pragma unroll
            for (int q = 0; q < 8; ++q) {
                const int pc = tid + q * NT;
                const int krow = pc >> 9, col = (pc >> 3) & 63, ch = pc & 7, kr = rs0 + krow, sl = kr & 7;
                const u32x4 kv = *(const u32x4*)(Kg + ((size_t)kr * 64 + col) * 64 + ch * 8);
                *(LAS u32x4*)(Kl + (sl * 64 + col) * 128 + ((ch ^ NA_KSW(col)) << 4)) = kv;
                const int d = (pc >> 3) & 63, vch = pc & 7;
                const u32x4 vv = *(const u32x4*)(Vg + (size_t)d * 2048 + kr * 64 + vch * 8);
                *(LAS u32x4*)(Vl + d * NA_VSTR + sl * 64 + vch * 8) = vv;
            }
        }
        __syncthreads();
        float bt[8][4];
        int bt_delta = 1000;
        bf16x8 qn[2];
#pragma unroll
        for (int ks = 0; ks < 2; ++ks) qn[ks] = *(const bf16x8*)(p.QNA() + (hb + r0 * 64 + c) * 64 + ks * 32 + 8 * g);
        for (int ri = 0; ri < 8; ++ri) {
            const int r = r0 + ri;
            int rs = r - 4; rs = rs < 0 ? 0 : (rs > 24 ? 24 : rs);
            int rsn = r + 1 - 4; rsn = rsn < 0 ? 0 : (rsn > 24 ? 24 : rsn);
            const bool add = (ri < 7) && (rsn != rs);
            u32x4 pk = {0u, 0u, 0u, 0u}, pv = {0u, 0u, 0u, 0u};
            const int ncol = tid >> 3, nch = tid & 7, nkr = rsn + 7;
            if (add) { pk = *(const u32x4*)(Kg + ((size_t)nkr * 64 + ncol) * 64 + nch * 8); pv = *(const u32x4*)(Vg + (size_t)ncol * 2048 + nkr * 64 + nch * 8); }
            bf16x8 qf[2]; qf[0] = qn[0]; qf[1] = qn[1];
            if (ri < 7) {
#pragma unroll
                for (int ks = 0; ks < 2; ++ks) qn[ks] = *(const bf16x8*)(p.QNA() + (hb + (r + 1) * 64 + c) * 64 + ks * 32 + 8 * g);
            }
            if (rs - r != bt_delta) {
                bt_delta = rs - r;
#pragma unroll
                for (int jj = 0; jj < 4; ++jj)
#pragma unroll
                    for (int ct = 0; ct < 2; ++ct)
#pragma unroll
                        for (int rr = 0; rr < 4; ++rr) {
                            const int kc = cs0 + 8 * g + 4 * ct + rr;
                            const bool valid = (kc >= csq) && (kc < csq + 16);
                            int dc = kc - c + 15; dc = dc < 0 ? 0 : (dc > 30 ? 30 : dc);
                            bt[jj * 2 + ct][rr] = valid ? rpb_s[(bt_delta + 4 * kh + jj + 7) * 31 + dc] : -1e30f;
                        }
            }
            float s[8][4];
#pragma unroll
            for (int jj = 0; jj < 4; ++jj) {
                const int sl = (rs + 4 * kh + jj) & 7;
#pragma unroll
                for (int ct = 0; ct < 2; ++ct) {
                    const int col = cs0 + 8 * (qi >> 2) + 4 * ct + (qi & 3);
                    const LAS unsigned char* kp = Kl + (sl * 64 + col) * 128;
                    f32x4 a = {0.f, 0.f, 0.f, 0.f};
#pragma unroll
                    for (int ks = 0; ks < 2; ++ks) {
                        const bf16x8 kf = *(const LAS bf16x8*)(kp + (((4 * ks + g) ^ NA_KSW(col)) << 4));
                        a = __builtin_amdgcn_mfma_f32_16x16x32_bf16(kf, qf[ks], a, 0, 0, 0);
                    }
#pragma unroll
                    for (int rr = 0; rr < 4; ++rr) s[jj * 2 + ct][rr] = a[rr] + bt[jj * 2 + ct][rr];
                }
            }
            float mx = -3e38f;
#pragma unroll
            for (int i = 0; i < 8; ++i)
#pragma unroll
                for (int rr = 0; rr < 4; ++rr) mx = fmaxf(mx, s[i][rr]);
            mx = fmaxf(mx, __shfl_xor(mx, 16)); mx = fmaxf(mx, __shfl_xor(mx, 32));
            float sum = 0.f;
#pragma unroll
            for (int i = 0; i < 8; ++i)
#pragma unroll
                for (int rr = 0; rr < 4; ++rr) { s[i][rr] = __builtin_amdgcn_exp2f(s[i][rr] - mx); sum += s[i][rr]; }
            sum += __shfl_xor(sum, 16); sum += __shfl_xor(sum, 32);
            f32x4 o[4];
#pragma unroll
            for (int dd = 0; dd < 4; ++dd) o[dd] = (f32x4){0.f, 0.f, 0.f, 0.f};
#pragma unroll
            for (int k2 = 0; k2 < 4; ++k2) {
                u32x4 pw; pw.x = pk2(s[2 * k2][0], s[2 * k2][1]); pw.y = pk2(s[2 * k2][2], s[2 * k2][3]);
                pw.z = pk2(s[2 * k2 + 1][0], s[2 * k2 + 1][1]); pw.w = pk2(s[2 * k2 + 1][2], s[2 * k2 + 1][3]);
                const bf16x8 pf = __builtin_bit_cast(bf16x8, pw);
                const int sl = (rs + 4 * kh + k2) & 7;
#pragma unroll
                for (int dd = 0; dd < 4; ++dd) {
                    const bf16x8 vf = *(const LAS bf16x8*)(Vl + (dd * 16 + qi) * NA_VSTR + sl * 64 + cs0 + 8 * g);
                    o[dd] = __builtin_amdgcn_mfma_f32_16x16x32_bf16(vf, pf, o[dd], 0, 0, 0);
                }
            }
            {
                const f32x4 s0 = kh ? o[0] : o[2], s1 = kh ? o[1] : o[3];
                LAS float* xw = X + (wave * 10) * 64 + lane;
#pragma unroll
                for (int rr = 0; rr < 4; ++rr) { xw[rr * 64] = s0[rr]; xw[(4 + rr) * 64] = s1[rr]; }
                xw[8 * 64] = mx; xw[9 * 64] = sum;
            }
            __syncthreads();
            {
                const LAS float* xr = X + ((wave ^ 4) * 10) * 64 + lane;
                f32x4 p0, p1;
#pragma unroll
                for (int rr = 0; rr < 4; ++rr) { p0[rr] = xr[rr * 64]; p1[rr] = xr[(4 + rr) * 64]; }
                const float mb = xr[8 * 64], lb = xr[9 * 64];
                const float m = fmaxf(mx, mb), fa = __builtin_amdgcn_exp2f(mx - m), fb = __builtin_amdgcn_exp2f(mb - m);
                const float inv = __builtin_amdgcn_rcpf(sum * fa + lb * fb), wa = fa * inv, wb = fb * inv;
                const f32x4 k0 = kh ? o[2] : o[0], k1 = kh ? o[3] : o[1];
                const size_t tg = (size_t)b * 2048 + r * 64 + c;
                u32x2 ov; ov.x = pk2(k0[0] * wa + p0[0] * wb, k0[1] * wa + p0[1] * wb); ov.y = pk2(k0[2] * wa + p0[2] * wb, k0[3] * wa + p0[3] * wb);
                *(u32x2*)(p.NAOUT() + tg * 512 + h * 64 + (2 * kh) * 16 + 4 * g) = ov;
                ov.x = pk2(k1[0] * wa + p1[0] * wb, k1[1] * wa + p1[1] * wb); ov.y = pk2(k1[2] * wa + p1[2] * wb, k1[3] * wa + p1[3] * wb);
                *(u32x2*)(p.NAOUT() + tg * 512 + h * 64 + (2 * kh + 1) * 16 + 4 * g) = ov;
            }
            if (add) { const int sl = nkr & 7;
                *(LAS u32x4*)(Kl + (sl * 64 + ncol) * 128 + ((nch ^ NA_KSW(ncol)) << 4)) = pk;
                *(LAS u32x4*)(Vl + ncol * NA_VSTR + sl * 64 + nch * 8) = pv; }
            __syncthreads();
        }
    }
}
#define LDSTR 80
#define MATB (64 * LDSTR * 2)
__device__ __forceinline__ f32x4 mfma16(bf16x8 a, bf16x8 b, f32x4 c) { return __builtin_amdgcn_mfma_f32_16x16x32_bf16(a, b, c, 0, 0, 0); }

template <bool SWZ_A = false, bool SWZ_B = false>
__device__ __forceinline__ void slab_mma(const LAS bf16* A, const LAS bf16* Bt, int w, int lane, f32x4 (&acc)[4]) {
    const int r16 = lane & 15, g = lane >> 4;
    const int ra = 16 * w + r16, sa = SWZ_A ? ((ra >> 3) & 7) : 0;
    const bf16x8 a0 = *(const LAS bf16x8*)(A + ra * LDSTR + 8 * (g ^ sa));
    const bf16x8 a1 = *(const LAS bf16x8*)(A + ra * LDSTR + 8 * ((4 + g) ^ sa));
#pragma unroll
    for (int nt = 0; nt < 4; ++nt) {
        const int rb = nt * 16 + r16, sb = SWZ_B ? ((rb >> 3) & 7) : 0;
        const bf16x8 b0 = *(const LAS bf16x8*)(Bt + rb * LDSTR + 8 * (g ^ sb));
        const bf16x8 b1 = *(const LAS bf16x8*)(Bt + rb * LDSTR + 8 * ((4 + g) ^ sb));
        acc[nt] = mfma16(a0, b0, acc[nt]); acc[nt] = mfma16(a1, b1, acc[nt]);
    }
}

struct DnBufs { char* ws; char* out;
    __device__ __forceinline__ bf16* MN() const { return (bf16*)out; }
    __device__ __forceinline__ bf16* QO() const { return WSP(bf16, 179); }
    __device__ __forceinline__ bf16* SB() const { return WSP(bf16, 97); } };

__device__ __forceinline__ void conv8(const LAS float* wl, const bf16* src, size_t hb, int t, int c0, float (&y)[8]) {
#pragma unroll
    for (int d = 0; d < 8; ++d) y[d] = 0.f;
#pragma unroll
    for (int j = 0; j < 5; ++j) {
        const int tt = t + j - 2;
        if (tt >= 0 && tt < SEQ) {
            const bf16x8 x0 = *(const bf16x8*)(src + (hb + tt) * 64 + c0);
            const f32x4 w0 = *(const LAS f32x4*)(wl + j * 192), w1 = *(const LAS f32x4*)(wl + j * 192 + 32);
#pragma unroll
            for (int d = 0; d < 4; ++d) { y[d] = fmaf(bf2f((unsigned short)x0[d]), w0[d], y[d]); y[4 + d] = fmaf(bf2f((unsigned short)x0[4 + d]), w1[d], y[4 + d]); }
        }
    }
#pragma unroll
    for (int d = 0; d < 8; ++d) y[d] = siluf_(y[d]);
}
__device__ __forceinline__ u32x4 pack8(const float (&y)[8]) { u32x4 o; o.x = pk2(y[0], y[1]); o.y = pk2(y[2], y[3]); o.z = pk2(y[4], y[5]); o.w = pk2(y[6], y[7]); return o; }

#ifndef DN_CONV_ITEMS
#define DN_CONV_ITEMS 1
#endif
#ifndef DN_STEP_DUP
#define DN_STEP_DUP 0
#endif
#define TEAM_BYTES 78080
#define XSTR2 40
__device__ __forceinline__ void phase_dnprep(const Params& p, const DnBufs& B, LAS unsigned char* lds) {
    const int tid = fresh_tid(), lane = tid & 63, wave = tid >> 6, team = wave >> 2, w = wave & 3, G = gridDim.x;
    const int r16 = lane & 15, g = lane >> 4;
    LAS unsigned char* base = lds + team * TEAM_BYTES;
    LAS bf16* Kr = (LAS bf16*)(base);
    LAS bf16* Qr = (LAS bf16*)(base + MATB);
    LAS bf16* KdT = (LAS bf16*)(base + 2 * MATB);
    LAS bf16* KbT = (LAS bf16*)(base + 3 * MATB);
    LAS bf16* VbT = (LAS bf16*)(base + 4 * MATB);
    LAS bf16* IN = (LAS bf16*)(base + 5 * MATB);
    LAS bf16* Lb = (LAS bf16*)(base + 6 * MATB);
    LAS bf16* TTa = Lb + 64 * LDSTR; LAS bf16* T22T = TTa + 32 * XSTR2; LAS bf16* XT = T22T + 16 * XSTR2;
    LAS bf16* Tm = Kr; LAS bf16* WT = Lb; LAS bf16* UT = KbT;
    LAS float* gsm = (LAS float*)(lds + 2 * TEAM_BYTES + team * 1024);
    const int dir0 = team;
    float pf_be = 0.f, pf_g = 0.f;
#define DN_GATE_PREFETCH(pi_) do { if (w == 0) { const int tc_ = (pi_) & 31, bh_ = (pi_) >> 5, cc_ = dir0 ? 31 - tc_ : tc_, s_ = cc_ * 64 + lane, t_ = dir0 ? 2047 - s_ : s_; \
        pf_be = p.GATES()[(size_t)dir0 * NTOK * 8 + (size_t)bh_ * 2048 + t_]; pf_g = p.GATES()[(size_t)(2 + dir0) * NTOK * 8 + (size_t)bh_ * 2048 + t_]; } } while (0)
#define DN_L2_PREFETCH(pi_) do { if (tid < 204) { const int tc_ = (pi_) & 31, bh_ = (pi_) >> 5, mtx_ = tid / 68, row_ = tid - mtx_ * 68; int t_ = tc_ * 64 - 2 + row_; t_ = t_ < 0 ? 0 : (t_ > SEQ - 1 ? SEQ - 1 : t_); \
        __builtin_amdgcn_global_load_lds((const unsigned*)(p.QKVDN() + (size_t)mtx_ * NTOK * 512 + ((size_t)bh_ * 2048 + t_) * 64), (LAS unsigned*)(lds + 2 * TEAM_BYTES + 2048 + wave * 256), 4, 0, 0); } } while (0)
#define DN_STEP0(buf_) do { if (w == 0) { float gv_ = pf_g; \
        _Pragma("unroll") for (int o_ = 1; o_ < 64; o_ <<= 1) { const float n_ = __shfl_up(gv_, o_); if (lane >= o_) gv_ += n_; } \
        gsm[(buf_) * 128 + lane] = pf_be; gsm[(buf_) * 128 + 64 + lane] = gv_; } } while (0)
    if ((int)blockIdx.x < 2048) { DN_GATE_PREFETCH((int)blockIdx.x); DN_STEP0(0); }
    int gbuf = 0;
    LAS float* cwl = (LAS float*)(lds + 2 * TEAM_BYTES + 2048 + 1024);
    int cw_h = -1;
    for (int pi = blockIdx.x; pi < 2048; pi += G) {
        const int tc = pi & 31, bh = pi >> 5, h = bh & 7, dir = team, cc = dir ? 31 - tc : tc;
        const int it = (bh * 2 + dir) * 32 + cc;
        const size_t hb = (size_t)bh * 2048;
        if (h != cw_h) {
            __syncthreads();
            for (int i = tid; i < 960; i += NT) { const int j = i / 192, r = i % 192, sec = r >> 6, c = r & 63; cwl[j * 192 + sec * 64 + ((c >> 2) & 1) * 32 + (c >> 3) * 4 + (c & 3)] = p.conv_w[j * 1536 + sec * 512 + h * 64 + c]; }
            cw_h = h;
        }
        __syncthreads();
        RGN_B(1, lds);
        LAS float* beta_s = gsm + gbuf * 128; LAS float* gc_s = beta_s + 64;
        for (int rep1 = 0; rep1 < 1 + (DN_STEP_DUP & 1); ++rep1) {
            const int tau = tid >> 3, c0 = (tid & 7) * 8, t = tc * 64 + tau;
            float yk[8], yq[8], yv[8];
            RGN_B(7, lds);
            const LAS float* cwb = cwl + (c0 >> 1);
            conv8(cwb + 64, p.QKVDN() + (size_t)NTOK * 512, hb, t, c0, yk);
            conv8(cwb, p.QKVDN(), hb, t, c0, yq);
            conv8(cwb + 128, p.QKVDN() + (size_t)2 * NTOK * 512, hb, t, c0, yv);
            asm volatile("" ::: "memory");
            RGN_E(7, lds); RGN_B(8, lds);
            if (pi + G < 2048) { DN_GATE_PREFETCH(pi + G); DN_L2_PREFETCH(pi + G); }
            float sk = 0.f, sq = 0.f;
#pragma unroll
            for (int d = 0; d < 8; ++d) { sk = fmaf(yk[d], yk[d], sk); sq = fmaf(yq[d], yq[d], sq); }
            sk += __shfl_xor(sk, 1); sq += __shfl_xor(sq, 1); sk += __shfl_xor(sk, 2); sq += __shfl_xor(sq, 2); sk += __shfl_xor(sk, 4); sq += __shfl_xor(sq, 4);
            const float rk = rsqrtf(sk + RMS_EPS), rq = rsqrtf(sq + RMS_EPS);
#pragma unroll
            for (int d = 0; d < 8; ++d) { yk[d] *= rk; yq[d] *= rq; }
            const u32x4 kp = pack8(yk), qp = pack8(yq);
#pragma unroll
            for (int dd = 0; dd < 2; ++dd) {
                LAS unsigned char* tb = lds + dd * TEAM_BYTES;
                const LAS float* bs = (const LAS float*)(lds + 2 * TEAM_BYTES + dd * 1024) + gbuf * 128; const LAS float* gs = bs + 64;
                const int i = dd ? 63 - tau : tau;
                const float be = bs[i], gci = gs[i], gl = gs[63];
                const float e_gc = __expf(gci), e_kd = __expf(gl - gci), bg = be * e_gc;
                *(LAS u32x4*)((LAS bf16*)tb + i * LDSTR + c0) = kp;
                *(LAS u32x4*)((LAS bf16*)(tb + MATB) + i * LDSTR + c0) = qp;
                LAS bf16* kd = (LAS bf16*)(tb + 2 * MATB); LAS bf16* kb = (LAS bf16*)(tb + 3 * MATB); LAS bf16* vb = (LAS bf16*)(tb + 4 * MATB);
#pragma unroll
                for (int d = 0; d < 8; ++d) { const int isw = i ^ ((c0 >> 3) << 3);
                    kd[(c0 + d) * LDSTR + isw] = (bf16)f2bf(yk[d] * e_kd); kb[(c0 + d) * LDSTR + isw] = (bf16)f2bf(yk[d] * bg); vb[(c0 + d) * LDSTR + isw] = (bf16)f2bf(yv[d] * be); }
            }
        }
        RGN_E(8, lds); RGN_B(9, lds);
        __syncthreads();
        RGN_E(9, lds);
        RGN_E(1, lds); RGN_B(2, lds);
#pragma unroll 1
        for (int rep2 = 0; rep2 < 1 + ((DN_STEP_DUP >> 3) & 1); ++rep2) {
            f32x4 akk[4], aqk[4];
#pragma unroll
            for (int nt = 0; nt < 4; ++nt) { akk[nt] = (f32x4){0.f, 0.f, 0.f, 0.f}; aqk[nt] = (f32x4){0.f, 0.f, 0.f, 0.f}; }
            slab_mma(Kr, Kr, w, lane, akk);
            slab_mma(Kr, Qr, w, lane, aqk);
            float gcj[4];
#pragma unroll
            for (int r = 0; r < 4; ++r) gcj[r] = gc_s[16 * w + 4 * g + r];
#pragma unroll
            for (int nt = 0; nt < 4; ++nt) {
                const int i = nt * 16 + r16; const float gci = gc_s[i], bi = beta_s[i];
                float lv[4], iv[4];
#pragma unroll
                for (int r = 0; r < 4; ++r) {
                    const int j = 16 * w + 4 * g + r;
                    const float dec = (j <= i) ? __expf(gci - gcj[r]) : 0.f;
                    lv[r] = (j < i) ? bi * akk[nt][r] * dec : 0.f;
                    iv[r] = aqk[nt][r] * 0.125f * dec;
                }
                u32x2 o; o.x = pk2(lv[0], lv[1]); o.y = pk2(lv[2], lv[3]); *(LAS u32x2*)(Lb + i * LDSTR + 16 * w + 4 * g) = o;
                o.x = pk2(iv[0], iv[1]); o.y = pk2(iv[2], iv[3]); *(LAS u32x2*)(IN + i * LDSTR + 16 * w + 4 * g) = o;
            }
        }
        __syncthreads();
        RGN_E(2, lds); RGN_B(3, lds);
        for (int rep3 = 0; rep3 < 1 + ((DN_STEP_DUP >> 1) & 1); ++rep3) if (w == 0) {
            const u32x4 z4 = {0u, 0u, 0u, 0u};
#pragma unroll
            for (int q = 0; q < 9; ++q) { const int idx = lane + 64 * q; *(LAS u32x4*)(Tm + (idx / 9) * LDSTR + (idx % 9) * 8) = z4; }
            const int blk = lane >> 4, j = lane & 15;
            float x[16];
#pragma unroll
            for (int i = 0; i < 16; ++i) {
                float a = (i == j) ? 1.f : 0.f;
                const LAS bf16* lr = Lb + (16 * blk + i) * LDSTR + 16 * blk;
                bf16x8 r0 = {0, 0, 0, 0, 0, 0, 0, 0}, r1 = r0;
                if (i > 0) r0 = *(const LAS bf16x8*)lr;
                if (i > 8) r1 = *(const LAS bf16x8*)(lr + 8);
#pragma unroll
                for (int m = 0; m < i; ++m) a = fmaf(-bf2f((unsigned short)(m < 8 ? r0[m & 7] : r1[m & 7])), x[m], a);
                x[i] = a;
            }
#pragma unroll
            for (int i = 0; i < 16; ++i) Tm[(16 * blk + i) * LDSTR + 16 * blk + j] = (bf16)f2bf(x[i]);
            {
                u32x4 lo, hi; lo.x = pk2(x[0], x[1]); lo.y = pk2(x[2], x[3]); lo.z = pk2(x[4], x[5]); lo.w = pk2(x[6], x[7]);
                hi.x = pk2(x[8], x[9]); hi.y = pk2(x[10], x[11]); hi.z = pk2(x[12], x[13]); hi.w = pk2(x[14], x[15]);
                if (blk < 2) { LAS bf16* dst = TTa + (16 * blk + j) * XSTR2 + 16 * blk; *(LAS u32x4*)dst = lo; *(LAS u32x4*)(dst + 8) = hi;
                    if (blk == 1) { *(LAS u32x4*)(TTa + (16 + j) * XSTR2) = z4; *(LAS u32x4*)(TTa + (16 + j) * XSTR2 + 8) = z4; } }
                else if (blk == 2) { *(LAS u32x4*)(T22T + j * XSTR2) = lo; *(LAS u32x4*)(T22T + j * XSTR2 + 8) = hi; }
            }
            LDS_WAIT();
            const bf16x8 zf = {0, 0, 0, 0, 0, 0, 0, 0};
            const f32x4 z0 = {0.f, 0.f, 0.f, 0.f};
            const bool lo2 = g < 2;
            {
                const bf16x8 aA = lo2 ? *(const LAS bf16x8*)(Lb + (16 + r16) * LDSTR + 8 * g) : zf, bA = lo2 ? *(const LAS bf16x8*)(TTa + r16 * XSTR2 + 8 * g) : zf;
                const bf16x8 aB = lo2 ? *(const LAS bf16x8*)(Lb + (48 + r16) * LDSTR + 32 + 8 * g) : zf, bB = lo2 ? *(const LAS bf16x8*)(T22T + r16 * XSTR2 + 8 * g) : zf;
                const f32x4 xa = mfma16(aA, bA, z0), xb = mfma16(aB, bB, z0);
                u32x2 o; o.x = pk2(xa[0], xa[1]); o.y = pk2(xa[2], xa[3]); *(LAS u32x2*)(XT + r16 * XSTR2 + 4 * g) = o;
                o.x = pk2(xb[0], xb[1]); o.y = pk2(xb[2], xb[3]); *(LAS u32x2*)(XT + (16 + r16) * XSTR2 + 4 * g) = o;
            }
            LDS_WAIT();
            {
                const bf16x8 aA = lo2 ? *(const LAS bf16x8*)(Tm + (16 + r16) * LDSTR + 16 + 8 * g) : zf, bA = lo2 ? *(const LAS bf16x8*)(XT + r16 * XSTR2 + 8 * g) : zf;
                const bf16x8 aB = lo2 ? *(const LAS bf16x8*)(Tm + (48 + r16) * LDSTR + 48 + 8 * g) : zf, bB = lo2 ? *(const LAS bf16x8*)(XT + (16 + r16) * XSTR2 + 8 * g) : zf;
                const f32x4 ta = mfma16(aA, bA, z0), tb2 = mfma16(aB, bB, z0);
#pragma unroll
                for (int r = 0; r < 4; ++r) { Tm[(16 + 4 * g + r) * LDSTR + r16] = (bf16)f2bf(-ta[r]); Tm[(48 + 4 * g + r) * LDSTR + 32 + r16] = (bf16)f2bf(-tb2[r]); }
                u32x2 o; o.x = pk2(-ta[0], -ta[1]); o.y = pk2(-ta[2], -ta[3]); *(LAS u32x2*)(TTa + r16 * XSTR2 + 16 + 4 * g) = o;
            }
            LDS_WAIT();
            {
                f32x4 x2[2][2];
#pragma unroll
                for (int mt = 0; mt < 2; ++mt) {
                    const bf16x8 a = *(const LAS bf16x8*)(Lb + (32 + 16 * mt + r16) * LDSTR + 8 * g);
#pragma unroll
                    for (int nt = 0; nt < 2; ++nt) { const bf16x8 b2 = *(const LAS bf16x8*)(TTa + (16 * nt + r16) * XSTR2 + 8 * g); x2[mt][nt] = mfma16(a, b2, z0); }
                }
#pragma unroll
                for (int mt = 0; mt < 2; ++mt)
#pragma unroll
                    for (int nt = 0; nt < 2; ++nt) { u32x2 o; o.x = pk2(x2[mt][nt][0], x2[mt][nt][1]); o.y = pk2(x2[mt][nt][2], x2[mt][nt][3]); *(LAS u32x2*)(XT + (16 * nt + r16) * XSTR2 + 16 * mt + 4 * g) = o; }
            }
            LDS_WAIT();
            {
#pragma unroll
                for (int mt = 0; mt < 2; ++mt) {
                    const bf16x8 a = *(const LAS bf16x8*)(Tm + (32 + 16 * mt + r16) * LDSTR + 32 + 8 * g);
#pragma unroll
                    for (int nt = 0; nt < 2; ++nt) {
                        const bf16x8 b2 = *(const LAS bf16x8*)(XT + (16 * nt + r16) * XSTR2 + 8 * g);
                        const f32x4 tv = mfma16(a, b2, z0);
#pragma unroll
                        for (int r = 0; r < 4; ++r) Tm[(32 + 16 * mt + 4 * g + r) * LDSTR + 16 * nt + r16] = (bf16)f2bf(-tv[r]);
                    }
                }
            }
        }
#if DN_CONV_ITEMS
        else if (rep3 == 0) {
            const int citem = ((pi / G) * G + (int)blockIdx.x) * 6 + team * 3 + (w - 1);
            if (citem < IT_WGU + IT_WD) { TrItem t; const int ks = p0_moe_load(t, p, citem, lane);
                if (pi < G) { unsigned* nad = p.bar + XCD_BAR_WORDS + 8; XB_SPIN(xb_ld(nad) < (unsigned)G, p.bar); }
                transpose_finish(t, ks, lane); }
        }
#endif
        __syncthreads();
        RGN_E(3, lds); RGN_B(4, lds);
        {
            f32x4 a[4];
#pragma unroll
            for (int nt = 0; nt < 4; ++nt) a[nt] = (f32x4){0.f, 0.f, 0.f, 0.f};
            slab_mma<false, true>(Tm, KbT, w, lane, a);
#pragma unroll
            for (int nt = 0; nt < 4; ++nt) { u32x2 o; o.x = pk2(a[nt][0], a[nt][1]); o.y = pk2(a[nt][2], a[nt][3]); *(LAS u32x2*)(WT + (nt * 16 + r16) * LDSTR + 16 * w + 4 * g) = o; }
        }
        __syncthreads();
        {
            f32x4 a[4];
#pragma unroll
            for (int nt = 0; nt < 4; ++nt) a[nt] = (f32x4){0.f, 0.f, 0.f, 0.f};
            slab_mma<false, true>(Tm, VbT, w, lane, a);
            if (pi + G < 2048) DN_STEP0(gbuf ^ 1);
#pragma unroll
            for (int nt = 0; nt < 4; ++nt) { u32x2 o; o.x = pk2(a[nt][0], a[nt][1]); o.y = pk2(a[nt][2], a[nt][3]); *(LAS u32x2*)(UT + (nt * 16 + r16) * LDSTR + 16 * w + 4 * g) = o; }
        }
        __syncthreads();
        RGN_E(4, lds); RGN_B(6, lds);
#pragma unroll 1
        for (int rep6 = 0; rep6 < 1 + ((DN_STEP_DUP >> 2) & 1); ++rep6) {
            const float egl = __expf(gc_s[63]);
            bf16* Mg = B.MN() + (size_t)it * 8192; bf16* NTg = Mg + 4096;
            bf16* Qg = B.QO() + ((size_t)((bh * 2 + dir) * 32 + tc)) * 8192; bf16* OTg = Qg + 4096;
            f32x4 a[4];
#pragma unroll
            for (int nt = 0; nt < 4; ++nt) a[nt] = (f32x4){0.f, 0.f, 0.f, 0.f};
            slab_mma<false, true>(WT, KdT, w, lane, a);
#pragma unroll
            for (int nt = 0; nt < 4; ++nt) { const int ra = nt * 16 + r16, cb = 16 * w + 4 * g; u32x2 o;
                o.x = pk2((ra == cb ? egl : 0.f) - a[nt][0], (ra == cb + 1 ? egl : 0.f) - a[nt][1]); o.y = pk2((ra == cb + 2 ? egl : 0.f) - a[nt][2], (ra == cb + 3 ? egl : 0.f) - a[nt][3]);
                *(u32x2*)(Mg + (((ra >> 4) * 2 + (cb >> 5)) * 64 + ((cb & 31) >> 3) * 16 + (ra & 15)) * 8 + (cb & 7)) = o; }
#pragma unroll
            for (int nt = 0; nt < 4; ++nt) a[nt] = (f32x4){0.f, 0.f, 0.f, 0.f};
            slab_mma<true, false>(KdT, UT, w, lane, a);
#pragma unroll
            for (int nt = 0; nt < 4; ++nt) { u32x2 o; o.x = pk2(a[nt][0], a[nt][1]); o.y = pk2(a[nt][2], a[nt][3]); *(u32x2*)(NTg + ((nt * 4 + w) * 64 + g * 16 + r16) * 4) = o; }
#pragma unroll
            for (int nt = 0; nt < 4; ++nt) a[nt] = (f32x4){0.f, 0.f, 0.f, 0.f};
            slab_mma(WT, IN, w, lane, a);
#pragma unroll
            for (int nt = 0; nt < 4; ++nt) { const int i = nt * 16 + r16, cb = 16 * w + 4 * g, ro = dir ? 63 - i : i;
                const float sc = 0.125f * __expf(gc_s[i]);
                const u32x2 qv = *(const LAS u32x2*)(Qr + i * LDSTR + cb);
                u32x2 o; o.x = pk2(bf2f(qv.x & 0xffffu) * sc - a[nt][0], bf2f(qv.x >> 16) * sc - a[nt][1]); o.y = pk2(bf2f(qv.y & 0xffffu) * sc - a[nt][2], bf2f(qv.y >> 16) * sc - a[nt][3]);
                *(u32x2*)(Qg + (((ro >> 4) * 2 + (cb >> 5)) * 64 + ((cb & 31) >> 3) * 16 + (ro & 15)) * 8 + (cb & 7)) = o; }
#pragma unroll
            for (int nt = 0; nt < 4; ++nt) a[nt] = (f32x4){0.f, 0.f, 0.f, 0.f};
            slab_mma(UT, IN, w, lane, a);
#pragma unroll
            for (int nt = 0; nt < 4; ++nt) { const int i = nt * 16 + r16, ro = dir ? 63 - i : i; u32x2 o; o.x = pk2(a[nt][0], a[nt][1]); o.y = pk2(a[nt][2], a[nt][3]);
                *(u32x2*)(OTg + (((ro >> 4) * 4 + w) * 64 + g * 16 + (ro & 15)) * 4) = o; }
        }
        RGN_E(6, lds);
        gbuf ^= 1;
    }
#undef DN_STEP0
#undef DN_GATE_PREFETCH
#undef DN_L2_PREFETCH
}

template <int VARIANT = 0>
__device__ __forceinline__ void phase_dnscan(const Params& p, const DnBufs& B, LAS unsigned char* lds) {
    const int tid = fresh_tid(), lane = tid & 63, wave = tid >> 6;
    const int r16 = lane & 15, g = lane >> 4;
    if (wave < 4) {
    const int vp = wave;
    LAS bf16* St = (LAS bf16*)(lds + wave * (16 * LDSTR * 2));
    for (int chain = blockIdx.x; chain < 128; chain += gridDim.x) {
    f32x4 sacc[4];
#pragma unroll
    for (int mt = 0; mt < 4; ++mt) sacc[mt] = (f32x4){0.f, 0.f, 0.f, 0.f};
    bf16x8 mf[4][4][2]; u32x2 nf[4][4];
    if (VARIANT == 2) {
#pragma unroll
        for (int a_ = 0; a_ < 4; ++a_)
#pragma unroll
            for (int b_ = 0; b_ < 4; ++b_) { mf[a_][b_][0] = (bf16x8){0,0,0,0,0,0,0,0}; mf[a_][b_][1] = mf[a_][b_][0]; nf[a_][b_] = (u32x2){0u, 0u}; }
    }
    const bf16* MN0 = B.MN() + (size_t)chain * 32 * 8192;
    bf16* SB0 = B.SB() + (size_t)chain * 32 * 4096;
#define SCAN_LOAD(slot, step) do { if (VARIANT == 2) break; const bf16* Mg_ = MN0 + (size_t)(step) * 8192; const bf16* NTg_ = Mg_ + 4096; \
        _Pragma("unroll") for (int mt = 0; mt < 4; ++mt) { mf[slot][mt][0] = *(const bf16x8*)(Mg_ + ((mt * 2) * 64 + lane) * 8); mf[slot][mt][1] = *(const bf16x8*)(Mg_ + ((mt * 2 + 1) * 64 + lane) * 8); \
            nf[slot][mt] = *(const u32x2*)(NTg_ + ((vp * 4 + mt) * 64 + lane) * 4); } } while (0)
#define SCAN_STEP(slot, step) do { bf16* Sg_ = SB0 + (size_t)(step) * 4096; \
        _Pragma("unroll") for (int mt = 0; mt < 4; ++mt) { u32x2 o; o.x = pk2(sacc[mt][0], sacc[mt][1]); o.y = pk2(sacc[mt][2], sacc[mt][3]); \
            if (VARIANT == 0) *(u32x2*)(Sg_ + ((vp * 2 + (mt >> 1)) * 64 + (2 * (mt & 1) + (g >> 1)) * 16 + r16) * 8 + 4 * (g & 1)) = o; *(LAS u32x2*)(St + r16 * LDSTR + mt * 16 + 4 * g) = o; } \
        LDS_WAIT(); \
        const bf16x8 s0 = *(const LAS bf16x8*)(St + r16 * LDSTR + 8 * g), s1 = *(const LAS bf16x8*)(St + r16 * LDSTR + 32 + 8 * g); \
        _Pragma("unroll") for (int mt = 0; mt < 4; ++mt) { const u32x2 nv = nf[slot][mt]; \
            f32x4 a = {bf2f(nv.x & 0xffffu), bf2f(nv.x >> 16), bf2f(nv.y & 0xffffu), bf2f(nv.y >> 16)}; \
            a = mfma16(mf[slot][mt][0], s0, a); a = mfma16(mf[slot][mt][1], s1, a); sacc[mt] = a; } \
        LDS_WAIT(); } while (0)
#define SCAN_PIN() asm volatile("" ::: "memory")
    SCAN_LOAD(0, 0); SCAN_LOAD(1, 1); SCAN_LOAD(2, 2); SCAN_PIN();
#pragma unroll
    for (int c0 = 0; c0 < 32; c0 += 4) {
        SCAN_LOAD(3, c0 + 3); SCAN_PIN();
        SCAN_STEP(0, c0); SCAN_PIN();
        if (c0 + 4 < 32) { SCAN_LOAD(0, c0 + 4); SCAN_PIN(); }
        SCAN_STEP(1, c0 + 1); SCAN_PIN();
        if (c0 + 5 < 32) { SCAN_LOAD(1, c0 + 5); SCAN_PIN(); }
        SCAN_STEP(2, c0 + 2); SCAN_PIN();
        if (c0 + 6 < 32) { SCAN_LOAD(2, c0 + 6); SCAN_PIN(); }
        SCAN_STEP(3, c0 + 3); SCAN_PIN();
    }
#undef SCAN_PIN
#undef SCAN_LOAD
#undef SCAN_STEP
    }
    }
}

__device__ __forceinline__ void phase_dnout(const Params& p, const DnBufs& B) {
    const int tid = fresh_tid(), lane = tid & 63, wave = tid >> 6, G = gridDim.x;
    const int r16 = lane & 15, g = lane >> 4;
    f32x4 nw[4];
#pragma unroll
    for (int vt = 0; vt < 4; ++vt) nw[vt] = *(const f32x4*)(p.norm_w + vt * 16 + 4 * g);
    for (int ct = blockIdx.x * 8 + wave; ct < 2048; ct += G * 8) {
        const int tc = ct & 31, bh = ct >> 5, h = bh & 7, b = bh >> 3;
        bf16x8 sf[2][4][2];
#pragma unroll
        for (int dir = 0; dir < 2; ++dir) {
            const int cc = dir ? 31 - tc : tc;
            const bf16* Sg = B.SB() + ((size_t)((bh * 2 + dir) * 32 + cc)) * 4096;
#pragma unroll
            for (int vt = 0; vt < 4; ++vt) { sf[dir][vt][0] = *(const bf16x8*)(Sg + ((vt * 2) * 64 + lane) * 8); sf[dir][vt][1] = *(const bf16x8*)(Sg + ((vt * 2 + 1) * 64 + lane) * 8); }
        }
        bf16x8 qf[2][2][2]; u32x2 of[2][2][4], zf[2][4];
#define DNOUT_LOAD(buf, w) do { \
        _Pragma("unroll") for (int dir = 0; dir < 2; ++dir) { const bf16* Qg = B.QO() + ((size_t)((bh * 2 + dir) * 32 + tc)) * 8192; const bf16* O0g = Qg + 4096; \
            qf[buf][dir][0] = *(const bf16x8*)(Qg + (((w) * 2) * 64 + lane) * 8); qf[buf][dir][1] = *(const bf16x8*)(Qg + (((w) * 2 + 1) * 64 + lane) * 8); \
            _Pragma("unroll") for (int vt = 0; vt < 4; ++vt) of[buf][dir][vt] = *(const u32x2*)(O0g + (((w) * 4 + vt) * 64 + lane) * 4); } \
        _Pragma("unroll") for (int vt = 0; vt < 4; ++vt) zf[buf][vt] = *(const u32x2*)(p.Z() + ((size_t)bh * 2048 + tc * 64 + 16 * (w) + r16) * 64 + vt * 16 + 4 * g); \
        asm volatile("" ::: "memory"); } while (0)
        DNOUT_LOAD(0, 0);
#pragma unroll
        for (int w = 0; w < 4; ++w) {
            if (w < 3) DNOUT_LOAD((w + 1) & 1, w + 1);
            f32x4 acc[4];
#pragma unroll
            for (int vt = 0; vt < 4; ++vt) {
                const u32x2 o0 = of[w & 1][0][vt], o1 = of[w & 1][1][vt];
                acc[vt] = (f32x4){bf2f(o0.x & 0xffffu) + bf2f(o1.x & 0xffffu), bf2f(o0.x >> 16) + bf2f(o1.x >> 16), bf2f(o0.y & 0xffffu) + bf2f(o1.y & 0xffffu), bf2f(o0.y >> 16) + bf2f(o1.y >> 16)};
#pragma unroll
                for (int dir = 0; dir < 2; ++dir) { acc[vt] = mfma16(sf[dir][vt][0], qf[w & 1][dir][0], acc[vt]); acc[vt] = mfma16(sf[dir][vt][1], qf[w & 1][dir][1], acc[vt]); }
            }
            float ss = 0.f;
#pragma unroll
            for (int vt = 0; vt < 4; ++vt)
#pragma unroll
                for (int r = 0; r < 4; ++r) ss = fmaf(acc[vt][r], acc[vt][r], ss);
            ss += __shfl_xor(ss, 16); ss += __shfl_xor(ss, 32);
            const float rn = rsqrtf(ss * (1.f / 64.f) + RMS_EPS);
            const int t = tc * 64 + 16 * w + r16;
#pragma unroll
            for (int vt = 0; vt < 4; ++vt) {
                const int v = vt * 16 + 4 * g;
                const u32x2 zv = zf[w & 1][vt];
                u32x2 o; o.x = pk2(acc[vt][0] * rn * nw[vt][0] * bf2f(zv.x & 0xffffu), acc[vt][1] * rn * nw[vt][1] * bf2f(zv.x >> 16));
                o.y = pk2(acc[vt][2] * rn * nw[vt][2] * bf2f(zv.y & 0xffffu), acc[vt][3] * rn * nw[vt][3] * bf2f(zv.y >> 16));
                *(u32x2*)(p.DNOUT() + ((size_t)b * 2048 + t) * 512 + h * 64 + v) = o;
            }
        }
#undef DNOUT_LOAD
    }
}
#define WSP_TAB_ROWINFO(ws_) ((int*)((ws_) + ((size_t)243 << 20) + ((size_t)576 << 10)))
struct MixBufs { char* ws; char* out;
    __device__ __forceinline__ unsigned char* GB() const { return (unsigned char*)out; }
    __device__ __forceinline__ unsigned char* GB2() const { return (unsigned char*)out + ((size_t)32 << 20); }
    __device__ __forceinline__ bf16* MERGED() const { return WSP(bf16, 211); }
    __device__ __forceinline__ bf16* V() const { return WSP(bf16, 179); } };
#define MERGE_DPM (-136)
struct PairSched {
    pg8::StaticOrder S; int dpm;
    __device__ __forceinline__ bool next(int i, pg8::Unit& u) const { if (!S.next(i >> 1, u)) return false; if (i & 1) { u.pm += dpm; u.pn += 4; } return true; }
    __device__ __forceinline__ void a_ready(const pg8::Unit&) const {}
    __device__ __forceinline__ void done(const pg8::Unit&) const {}
};
template <int MODE>
struct EpiMerge {
    static constexpr bool PERM = true, AFTER_DRAIN = false;
    unsigned char* GB; unsigned char* GB2; bf16* MG;
    __device__ __forceinline__ void operator()(const pg8::f32x4 (&acc)[2][2][4][2], const pg8::Unit& u, int wr, int wc, int fr, int fq) const {
        const bool second = u.pn >= 4;
        const int pm = (MODE == 1 && second) ? u.pm - MERGE_DPM : u.pm, pn = u.pn & 3;
        unsigned char* G = second ? GB2 : GB;
#pragma unroll
        for (int ai = 0; ai < 2; ++ai) {
            u32x2 gq[4][2]; u32x4 mq[4][2];
            if (MODE == 1) {
#pragma unroll
                for (int m = 0; m < 4; ++m)
#pragma unroll
                    for (int bj = 0; bj < 2; ++bj) {
                        const size_t row = (size_t)pm * 256 + ai * 128 + wr * 64 + m * 16 + fr; const int col = pn * 256 + bj * 128 + wc * 32 + 8 * fq;
                        gq[m][bj] = *(const u32x2*)(G + row * 1024 + col);
                        if (second) mq[m][bj] = *(const u32x4*)(MG + row * 1024 + col); else mq[m][bj] = (u32x4){0u, 0u, 0u, 0u};
                    }
                asm volatile("" ::: "memory");
            }
#pragma unroll
            for (int m = 0; m < 4; ++m) {
                const size_t row = (size_t)pm * 256 + ai * 128 + wr * 64 + m * 16 + fr;
#pragma unroll
                for (int bj = 0; bj < 2; ++bj) {
                    const int col = pn * 256 + bj * 128 + wc * 32 + 8 * fq;
                    const pg8::f32x4 v0 = acc[ai][bj][m][0], v1 = acc[ai][bj][m][1];
                    float e[8] = {v0[0], v0[1], v0[2], v0[3], v1[0], v1[1], v1[2], v1[3]};
                    if (MODE == 0) {
                        unsigned lo = 0u, hi = 0u;
#pragma unroll
                        for (int j = 0; j < 4; ++j) { lo |= (unsigned)(sigmoidf_(e[j]) * 255.f + 0.5f) << (8 * j); hi |= (unsigned)(sigmoidf_(e[4 + j]) * 255.f + 0.5f) << (8 * j); }
                        u32x2 w; w.x = lo; w.y = hi;
                        *(u32x2*)(G + row * 1024 + col) = w;
                    } else {
                        const unsigned gw[2] = {gq[m][bj].x, gq[m][bj].y}, mws[4] = {mq[m][bj].x, mq[m][bj].y, mq[m][bj].z, mq[m][bj].w};
#pragma unroll
                        for (int j = 0; j < 8; ++j) {
                            const float gv = (float)((gw[j >> 2] >> (8 * (j & 3))) & 0xffu) * (1.f / 255.f);
                            const float mv = (j & 1) ? bf2f(mws[j >> 1] >> 16) : bf2f(mws[j >> 1] & 0xffffu);
                            e[j] = fmaf(e[j], gv, mv);
                        }
                        u32x4 w; w.x = pk2(e[0], e[1]); w.y = pk2(e[2], e[3]); w.z = pk2(e[4], e[5]); w.w = pk2(e[6], e[7]);
                        st16(MG + row * 1024 + col, w);
                    }
                }
            }
        }
    }
};
struct EpiOutProj {
    static constexpr bool PERM = true, AFTER_DRAIN = false;
    const bf16* xb; bf16* V;
    __device__ __forceinline__ void operator()(const pg8::f32x4 (&acc)[2][2][4][2], const pg8::Unit& u, int wr, int wc, int fr, int fq) const {
#pragma unroll
        for (int ai = 0; ai < 2; ++ai)
#pragma unroll
            for (int m = 0; m < 4; ++m) {
                const size_t row = (size_t)u.pm * 256 + ai * 128 + wr * 64 + m * 16 + fr;
#pragma unroll
                for (int bj = 0; bj < 2; ++bj) {
                    const int col = u.pn * 256 + bj * 128 + wc * 32 + 8 * fq;
                    const u32x4 xv = *(const u32x4*)(xb + row * 1024 + col);
                    const pg8::f32x4 a0 = acc[ai][bj][m][0], a1 = acc[ai][bj][m][1];
                    u32x4 w; w.x = pk2(ALPHA * bf2f(xv.x & 0xffffu) + a0[0], ALPHA * bf2f(xv.x >> 16) + a0[1]); w.y = pk2(ALPHA * bf2f(xv.y & 0xffffu) + a0[2], ALPHA * bf2f(xv.y >> 16) + a0[3]);
                    w.z = pk2(ALPHA * bf2f(xv.z & 0xffffu) + a1[0], ALPHA * bf2f(xv.z >> 16) + a1[1]); w.w = pk2(ALPHA * bf2f(xv.w & 0xffffu) + a1[2], ALPHA * bf2f(xv.w >> 16) + a1[3]);
                    st16(V + row * 1024 + col, w);
                }
            }
    }
};
template <int STAGE>
__device__ __forceinline__ void phase_merge(const Params& p, const MixBufs& B, LAS unsigned char* lds) {
    pg8::StaticOrder S; S.init(NTOK, 1024, gridDim.x, (int)blockIdx.x);
    if (STAGE == 0) {
    RGN_B(30, lds);
    { pg8::Gemm g{p.XB(), p.WG(), NTOK, 2048, 1024}; PairSched PS{S, 0}; EpiMerge<0> E{B.GB(), B.GB2(), B.MERGED()}; pg8::gemm_phase<EpiMerge<0>, PairSched, true, true>(lds, g, PS, E); }
    RGN_E(30, lds);
    } else {
    RGN_B(31, lds);
    { pg8::Gemm g{p.NAOUT(), p.WPNA(), NTOK, 2048, 512}; PairSched PS{S, MERGE_DPM}; EpiMerge<1> E{B.GB(), B.GB2(), B.MERGED()}; pg8::gemm_phase<EpiMerge<1>, PairSched, true, true>(lds, g, PS, E); }
    RGN_E(31, lds);
    }
}
template <class WaitFn>
__device__ __forceinline__ void phase_outproj(const Params& p, const MixBufs& B, LAS unsigned char* lds, WaitFn wait_prev) {
    { int* ri = WSP_TAB_ROWINFO(p.ws); for (int i = blockIdx.x * NT + fresh_tid(); i < 40960; i += gridDim.x * NT) ri[i] = -1; }
    unsigned warm;
    {
        const int tid2 = fresh_tid(); const size_t line = (size_t)((((int)blockIdx.x >> 3) & 31) * 8 + (tid2 >> 6)) * 64 + (tid2 & 63);
        const unsigned* src = (const unsigned*)((const char*)p.WOUT() + line * 128);
        asm volatile("global_load_dword %0, %1, off" : "=v"(warm) : "v"(src) : "memory");
    }
    wait_prev();
    asm volatile("" :: "v"(warm));
    pg8::StaticOrder S; S.init(NTOK, 1024, gridDim.x, (int)blockIdx.x);
    pg8::Gemm g{B.MERGED(), p.WOUT(), NTOK, 1024, 1024}; EpiOutProj E{p.XB(), B.V()};
    pg8::gemm_phase<EpiOutProj, pg8::StaticOrder, true, true>(lds, g, S, E);
}
struct MoeBufs { char* ws; char* out; int kdown; unsigned* ctr;
#define TBP(T, kb) ((T*)(ws + ((size_t)243 << 20) + ((size_t)(kb) << 10)))
    __device__ __forceinline__ const bf16* V() const { return WSP(bf16, 179); }
    __device__ __forceinline__ bf16* X1B() const { return WSP(bf16, 17); }
    __device__ __forceinline__ bf16* XS() const { return WSP(bf16, 97); }
    __device__ __forceinline__ bf16* HID() const { return WSP(bf16, 211); }
    __device__ __forceinline__ bf16* YPART() const { return WSP(bf16, 97); }
    __device__ __forceinline__ int* SPILL() const { return TBP(int, 0); }
    __device__ __forceinline__ int* ROUTE() const { return TBP(int, 64); }
    __device__ __forceinline__ float* ROUTEP() const { return TBP(float, 384); }
    __device__ __forceinline__ int* ROWINFO() const { return TBP(int, 576); }
    __device__ __forceinline__ float* ROWPW() const { return TBP(float, 768); }
    __device__ __forceinline__ float* STATS() const { return TBP(float, 960); }
    __device__ __forceinline__ bf16* RWH() const { return TBP(bf16, 1152); }
    __device__ __forceinline__ bf16* RWL() const { return TBP(bf16, 1280); }
};
#define XSTR 1032
#define TAB_OFF 131072
#define MOE_OVF_BASE 32768
#ifndef MOE_CAP
#define MOE_CAP 1280
#endif
__device__ __forceinline__ int moe_row(int e, int slot) { return slot < 1024 ? e * 1024 + slot : MOE_OVF_BASE + e * 256 + (slot - 1024); }

__device__ __forceinline__ void phase0_router(const Params& p, const MoeBufs& B) {
    const size_t gt = (size_t)blockIdx.x * NT + fresh_tid(), GT = (size_t)gridDim.x * NT;
    for (size_t i = gt; i < 48 * 1024; i += GT) {
        const int n = (int)(i >> 10), k = (int)(i & 1023);
        const float w = n < 4 ? p.wrg[k * 4 + n] : (n < 36 ? p.wre[k * 32 + n - 4] : 0.f);
        const unsigned hi = f2bf(w); const float lo = w - bf2f(hi);
        B.RWH()[i] = (bf16)hi; B.RWL()[i] = (bf16)f2bf(lo);
    }
}

__device__ __forceinline__ float wave_sum64(float v) {
    v += dpp_f<0xB1>(v);
    v += dpp_f<0x4E>(v);
    v += dpp_f<0x141>(v);
    v += dpp_f<0x140>(v);
    const int iv = __builtin_bit_cast(int, v);
    return __builtin_bit_cast(float, __builtin_amdgcn_readlane(iv, 0)) + __builtin_bit_cast(float, __builtin_amdgcn_readlane(iv, 16))
         + __builtin_bit_cast(float, __builtin_amdgcn_readlane(iv, 32)) + __builtin_bit_cast(float, __builtin_amdgcn_readlane(iv, 48));
}

template <class WaitFn>
__device__ __forceinline__ void phase_ln1(const Params& p, const MoeBufs& B, LAS unsigned char* lds, WaitFn wait_prev) {
    const int tid = fresh_tid(), lane = tid & 63, wave = tid >> 6;
    const int r16 = lane & 15, g = lane >> 4;
    LAS bf16* XH = (LAS bf16*)lds;
    LAS bf16* XL = (LAS bf16*)(lds + 16 * XSTR * 2);
    LAS float* PART = (LAS float*)(lds + 2 * 16 * XSTR * 2);
    LAS float* LOG = PART + 8 * 16 * 48;
    LAS int* rowdst = (LAS int*)(LOG + 64 * 36);
    LAS int* ihist = rowdst + 128;
    LAS int* gb = ihist + 32;
    LAS int* rinfo = gb + 32;
    LAS float* rpw = (LAS float*)(rinfo + 256);
    bf16x8 rbh[4][3], rbl[4][3];
#pragma unroll
    for (int ks = 0; ks < 4; ++ks)
#pragma unroll
        for (int nt = 0; nt < 3; ++nt) { const int k0 = wave * 128 + ks * 32 + 8 * g;
            rbh[ks][nt] = *(const bf16x8*)(B.RWH() + (size_t)(nt * 16 + r16) * 1024 + k0); rbl[ks][nt] = *(const bf16x8*)(B.RWL() + (size_t)(nt * 16 + r16) * 1024 + k0); }
    wait_prev();
    for (int blk = blockIdx.x; blk < 256; blk += gridDim.x) {
        u32x4 vpre[2][2];
        float mus[4][2], rstds[4][2];
#pragma unroll
        for (int q = 0; q < 2; ++q)
#pragma unroll
            for (int j = 0; j < 2; ++j) vpre[q][j] = *(const u32x4*)(B.V() + ((size_t)blk * 64 + 2 * wave + q) * 1024 + 8 * lane + 512 * j);
        __syncthreads();
        if (tid < 32) ihist[tid] = 0;
        RGN_B(50, lds);
#pragma unroll
        for (int itn = 0; itn < 5; ++itn) {
            if (itn > 0) {
                for (int idx = tid; idx < 16 * 36; idx += NT) {
                    const int tk = idx / 36, n = idx % 36;
                    float a = n < 4 ? p.brg[n] : p.bre[n - 4];
#pragma unroll
                    for (int w2 = 0; w2 < 8; ++w2) a += PART[(w2 * 16 + tk) * 48 + n];
                    LOG[((itn - 1) * 16 + tk) * 36 + n] = a;
                }
            }
            if (itn < 4) {
#pragma unroll
            for (int q = 0; q < 2; ++q) {
                const int lt = 2 * wave + q; const size_t tg = (size_t)blk * 64 + itn * 16 + lt;
                float v[2][8]; float s = 0.f;
#pragma unroll
                for (int j = 0; j < 2; ++j) { const unsigned wv[4] = {vpre[q][j].x, vpre[q][j].y, vpre[q][j].z, vpre[q][j].w};
#pragma unroll
                    for (int e = 0; e < 4; ++e) { v[j][2 * e] = bf2f(wv[e] & 0xffffu); v[j][2 * e + 1] = bf2f(wv[e] >> 16); s += v[j][2 * e] + v[j][2 * e + 1]; } }
                if (itn < 3) {
#pragma unroll
                    for (int j = 0; j < 2; ++j) vpre[q][j] = *(const u32x4*)(B.V() + (tg + 16) * 1024 + 8 * lane + 512 * j);
                }
                const float mu = wave_sum64(s) * (1.f / 1024.f);
                float qq = 0.f;
#pragma unroll
                for (int j = 0; j < 2; ++j)
#pragma unroll
                    for (int e = 0; e < 8; ++e) { v[j][e] -= mu; qq = fmaf(v[j][e], v[j][e], qq); }
                const float rstd = rsqrtf(wave_sum64(qq) * (1.f / 1024.f) + LN_EPS);
                if (lane == 0) { B.STATS()[tg * 2] = mu; B.STATS()[tg * 2 + 1] = rstd; }
#pragma unroll
                for (int j = 0; j < 2; ++j) {
                    const int c = 8 * lane + 512 * j;
                    const f32x4 g0 = *(const f32x4*)(p.ln1_g + c), g1 = *(const f32x4*)(p.ln1_g + c + 4), b0 = *(const f32x4*)(p.ln1_b + c), b1 = *(const f32x4*)(p.ln1_b + c + 4);
                    float y[8], lo[8];
#pragma unroll
                    for (int e = 0; e < 4; ++e) { y[e] = v[j][e] * rstd * g0[e] + b0[e]; y[4 + e] = v[j][4 + e] * rstd * g1[e] + b1[e]; }
                    u32x4 hw; hw.x = pk2(y[0], y[1]); hw.y = pk2(y[2], y[3]); hw.z = pk2(y[4], y[5]); hw.w = pk2(y[6], y[7]);
                    const unsigned hws[4] = {hw.x, hw.y, hw.z, hw.w};
#pragma unroll
                    for (int e = 0; e < 4; ++e) { lo[2 * e] = y[2 * e] - bf2f(hws[e] & 0xffffu); lo[2 * e + 1] = y[2 * e + 1] - bf2f(hws[e] >> 16); }
                    u32x4 lw; lw.x = pk2(lo[0], lo[1]); lw.y = pk2(lo[2], lo[3]); lw.z = pk2(lo[4], lo[5]); lw.w = pk2(lo[6], lo[7]);
                    *(LAS u32x4*)(XH + lt * XSTR + c) = hw; *(LAS u32x4*)(XL + lt * XSTR + c) = lw;
                }
                mus[itn < 4 ? itn : 0][q] = mu; rstds[itn < 4 ? itn : 0][q] = rstd;
            }
            __syncthreads();
            {
                f32x4 acc[3];
#pragma unroll
                for (int nt = 0; nt < 3; ++nt) acc[nt] = (f32x4){0.f, 0.f, 0.f, 0.f};
#pragma unroll
                for (int ks = 0; ks < 4; ++ks) {
                    const int k0 = wave * 128 + ks * 32 + 8 * g;
                    const bf16x8 ah = *(const LAS bf16x8*)(XH + r16 * XSTR + k0), al = *(const LAS bf16x8*)(XL + r16 * XSTR + k0);
#pragma unroll
                    for (int nt = 0; nt < 3; ++nt) {
                        acc[nt] = mfma16(ah, rbh[ks][nt], acc[nt]); acc[nt] = mfma16(ah, rbl[ks][nt], acc[nt]); acc[nt] = mfma16(al, rbh[ks][nt], acc[nt]);
                    }
                }
#pragma unroll
                for (int nt = 0; nt < 3; ++nt)
#pragma unroll
                    for (int r = 0; r < 4; ++r) PART[(wave * 16 + 4 * g + r) * 48 + nt * 16 + r16] = acc[nt][r];
            }
            }
            __syncthreads();
        }
        RGN_E(50, lds); RGN_B(51, lds);
        if (tid < 64) {
            const LAS float* lg = LOG + tid * 36;
            int gi = 0; float gm = lg[0];
#pragma unroll
            for (int q = 1; q < 4; ++q) { const float v = lg[q]; if (v > gm) { gm = v; gi = q; } }
            float gs = 0.f;
#pragma unroll
            for (int q = 0; q < 4; ++q) gs += __expf(lg[q] - gm);
            const float gp = __builtin_amdgcn_rcpf(gs);
            const LAS float* el = lg + 4 + gi * 8;
            float ev[8];
#pragma unroll
            for (int e = 0; e < 8; ++e) ev[e] = el[e];
            int i1 = 0; float l1 = ev[0];
#pragma unroll
            for (int e = 1; e < 8; ++e) if (ev[e] > l1) { l1 = ev[e]; i1 = e; }
            int i2 = -1; float l2 = -3.0e38f;
#pragma unroll
            for (int e = 0; e < 8; ++e) if (e != i1 && ev[e] > l2) { l2 = ev[e]; i2 = e; }
            const float e2 = __expf(l2 - l1);
            const int e0 = gi * 8 + i1, e1 = gi * 8 + i2;
            const int rk0 = atomicAdd((int*)&ihist[e0], 1), rk1 = atomicAdd((int*)&ihist[e1], 1);
            const float pw0 = gp / (1.f + e2), pw1 = gp * e2 / (1.f + e2);
            LDS_WAIT(); __builtin_amdgcn_wave_barrier();
            if (tid < 32) { const int c = ihist[tid]; gb[tid] = c ? (int)__hip_atomic_fetch_add(B.ctr + tid, (unsigned)c, __ATOMIC_RELAXED, __HIP_MEMORY_SCOPE_AGENT) : 0; }
            LDS_WAIT(); __builtin_amdgcn_wave_barrier();
            const size_t tg = (size_t)blk * 64 + tid;
#pragma unroll
            for (int k = 0; k < 2; ++k) {
                const int e = k ? e1 : e0, slot = gb[e] + (k ? rk1 : rk0); const float pw = k ? pw1 : pw0;
                int row = -1;
                if (slot < MOE_CAP) { row = moe_row(e, slot); B.ROWINFO()[row] = (int)tg * 2 + k; B.ROWPW()[row] = pw; }
                else { const int si = (int)__hip_atomic_fetch_add(B.ctr + 32, 1u, __ATOMIC_RELAXED, __HIP_MEMORY_SCOPE_AGENT); B.SPILL()[si] = (int)tg * 2 + k; B.ROUTE()[tg * 4 + k] = e; B.ROUTEP()[tg * 2 + k] = pw; }
                rowdst[tid * 2 + k] = row;
            }
        }
        __syncthreads();
        RGN_E(51, lds); RGN_B(52, lds);
#pragma unroll
        for (int h2 = 0; h2 < 2; ++h2) {
            u32x4 vv[2][2][2];
#pragma unroll
            for (int i2 = 0; i2 < 2; ++i2)
#pragma unroll
                for (int q = 0; q < 2; ++q)
#pragma unroll
                    for (int j = 0; j < 2; ++j) vv[i2][q][j] = *(const u32x4*)(B.V() + ((size_t)blk * 64 + (2 * h2 + i2) * 16 + 2 * wave + q) * 1024 + 8 * lane + 512 * j);
#pragma unroll
            for (int i2 = 0; i2 < 2; ++i2)
#pragma unroll
                for (int q = 0; q < 2; ++q) {
                    const int itn = 2 * h2 + i2, tl = itn * 16 + 2 * wave + q;
                    const int row0 = rowdst[tl * 2], row1 = rowdst[tl * 2 + 1];
                    const float mu = mus[itn][q], rstd = rstds[itn][q];
#pragma unroll
                    for (int j = 0; j < 2; ++j) {
                        const int c = 8 * lane + 512 * j;
                        const f32x4 g0 = *(const f32x4*)(p.ln1_g + c), g1 = *(const f32x4*)(p.ln1_g + c + 4), b0 = *(const f32x4*)(p.ln1_b + c), b1 = *(const f32x4*)(p.ln1_b + c + 4);
                        const unsigned wv[4] = {vv[i2][q][j].x, vv[i2][q][j].y, vv[i2][q][j].z, vv[i2][q][j].w};
                        float y[8];
#pragma unroll
                        for (int e = 0; e < 2; ++e) { y[2 * e] = (bf2f(wv[e] & 0xffffu) - mu) * rstd * g0[2 * e] + b0[2 * e]; y[2 * e + 1] = (bf2f(wv[e] >> 16) - mu) * rstd * g0[2 * e + 1] + b0[2 * e + 1];
                            y[4 + 2 * e] = (bf2f(wv[2 + e] & 0xffffu) - mu) * rstd * g1[2 * e] + b1[2 * e]; y[4 + 2 * e + 1] = (bf2f(wv[2 + e] >> 16) - mu) * rstd * g1[2 * e + 1] + b1[2 * e + 1]; }
                        u32x4 hw; hw.x = pk2(y[0], y[1]); hw.y = pk2(y[2], y[3]); hw.z = pk2(y[4], y[5]); hw.w = pk2(y[6], y[7]);
                        if (row0 >= 0) *(u32x4*)(B.XS() + (size_t)row0 * 1024 + c) = hw;
                        if (row1 >= 0) *(u32x4*)(B.XS() + (size_t)row1 * 1024 + c) = hw;
                    }
                }
        }
        RGN_E(52, lds);
    }
}

__device__ __forceinline__ void moe_tables(const MoeBufs& B, LAS unsigned char* lds, int nj) {
    const int tid = fresh_tid();
    LAS int* tab = (LAS int*)(lds + TAB_OFF);
    __syncthreads();
    if (tid < 32) { int c = (int)__hip_atomic_load(B.ctr + tid, __ATOMIC_RELAXED, __HIP_MEMORY_SCOPE_AGENT); tab[66 + tid] = c > MOE_CAP ? MOE_CAP : c; }
    __syncthreads();
    if (tid == 0) { int cum = 0, og = 0; for (int e = 0; e < 32; ++e) { tab[e] = cum; tab[33 + e] = 4 * e; tab[132 + e] = og; const int tot = tab[66 + e]; const int mainr = tot > 1024 ? 1024 : tot;
            cum += ((mainr + 255) >> 8) * nj; og += tot > 1024 ? (tot - 1024 + 15) >> 4 : 0; } tab[32] = cum; tab[164] = og; }
    __syncthreads();
}
struct MoeSched {
    const LAS int* tab; int G, c, nj;
    __device__ __forceinline__ bool next(int i, pg8::Unit& u) const {
        int L = i * G + c; const int U = tab[32]; if (L >= U) return false;
        { const int q = U >> 3, r = U & 7, xcd = L & 7, off = L >> 3; L = (xcd < r ? xcd * (q + 1) : r * (q + 1) + (xcd - r) * q) + off; }
        int e = 0;
#pragma unroll
        for (int k = 1; k < 32; ++k) e += (L >= tab[k]) ? 1 : 0;
        const int rem = L - tab[e], j = rem % nj, rt = rem / nj;
        u.pm = tab[33 + e] + rt; u.pn = e * nj + j; return true;
    }
    __device__ __forceinline__ void a_ready(const pg8::Unit&) const {}
    __device__ __forceinline__ void done(const pg8::Unit&) const {}
};
struct EpiGateUp {
    static constexpr bool PERM = true, AFTER_DRAIN = false;
    bf16* HID; const float* ROWPW;
    __device__ __forceinline__ void operator()(const pg8::f32x4 (&acc)[2][2][4][2], const pg8::Unit& u, int wr, int wc, int fr, int fq) const {
#pragma unroll
        for (int ai = 0; ai < 2; ++ai)
#pragma unroll
            for (int m = 0; m < 4; ++m) {
                const size_t row = (size_t)u.pm * 256 + ai * 128 + wr * 64 + m * 16 + fr;
                const float pw = ROWPW[row];
                const int f = (u.pn & 1) * 128 + wc * 32 + 8 * fq;
                const pg8::f32x4 g0 = acc[ai][0][m][0], g1 = acc[ai][0][m][1], u0 = acc[ai][1][m][0], u1 = acc[ai][1][m][1];
                float e[8];
#pragma unroll
                for (int j = 0; j < 4; ++j) { e[j] = siluf_(g0[j]) * u0[j] * pw; e[4 + j] = siluf_(g1[j]) * u1[j] * pw; }
                u32x4 w; w.x = pk2(e[0], e[1]); w.y = pk2(e[2], e[3]); w.z = pk2(e[4], e[5]); w.w = pk2(e[6], e[7]);
                st16(HID + row * 256 + f, w);
            }
    }
};
struct EpiDown {
    static constexpr bool PERM = true, AFTER_DRAIN = false;
    bf16* YPART; const int* ROWINFO;
    __device__ __forceinline__ void operator()(const pg8::f32x4 (&acc)[2][2][4][2], const pg8::Unit& u, int wr, int wc, int fr, int fq) const {
        const int j = u.pn & 3;
#pragma unroll
        for (int ai = 0; ai < 2; ++ai)
#pragma unroll
            for (int m = 0; m < 4; ++m) {
                const int row = u.pm * 256 + ai * 128 + wr * 64 + m * 16 + fr;
                asm volatile("" ::: "memory");
                const int info = ROWINFO[row];
                if (info >= 0) {
                    const size_t tg = (size_t)(info >> 1); const int k = info & 1;
#pragma unroll
                    for (int bj = 0; bj < 2; ++bj) {
                        const int col = j * 256 + bj * 128 + wc * 32 + 8 * fq;
                        const pg8::f32x4 v0 = acc[ai][bj][m][0], v1 = acc[ai][bj][m][1];
                        u32x4 w; w.x = pk2(v0[0], v0[1]); w.y = pk2(v0[2], v0[3]); w.z = pk2(v1[0], v1[1]); w.w = pk2(v1[2], v1[3]);
                        st16(YPART + ((size_t)k * NTOK + tg) * 1024 + col, w);
                    }
                }
            }
    }
};
__device__ __forceinline__ void moe1_overflow(const Params& p, const MoeBufs& B, LAS unsigned char* lds) {
    const int tid = fresh_tid(), lane = tid & 63, wave = tid >> 6, r16 = lane & 15, g = lane >> 4;
    const LAS int* tab = (const LAS int*)(lds + TAB_OFF);
    LAS float* part = (LAS float*)lds;
    const int ntask = tab[164] * 8;
    bf16x8 af[4], wf[4][4]; size_t R0n = 0;
#define MOE1_OVF_LOAD(tk_) do { const int t_ = (tk_) >> 3, fc_ = (tk_) & 7; int e_ = 0; \
        _Pragma("unroll") for (int k = 1; k < 32; ++k) e_ += (t_ >= tab[132 + k]) ? 1 : 0; \
        R0n = (size_t)MOE_OVF_BASE + (size_t)e_ * 256 + (size_t)(t_ - tab[132 + e_]) * 16; \
        const bf16* A_ = B.XS() + (R0n + r16) * 1024 + wave * 128 + 8 * g; \
        const bf16* Wg_ = p.WGU() + ((size_t)e_ * 512 + (fc_ >> 2) * 256 + 32 * (fc_ & 3) + r16) * 1024 + wave * 128 + 8 * g;     \
        _Pragma("unroll") for (int ks = 0; ks < 4; ++ks) { af[ks] = *(const bf16x8*)(A_ + ks * 32); \
            _Pragma("unroll") for (int q = 0; q < 4; ++q) wf[ks][q] = *(const bf16x8*)(Wg_ + (size_t)((q >> 1) * 128 + 16 * (q & 1)) * 1024 + ks * 32); } } while (0)
    int tk = blockIdx.x;
    if (tk < ntask) MOE1_OVF_LOAD(tk);
    for (; tk < ntask; tk += gridDim.x) {
        const int fc = tk & 7; const size_t R0 = R0n;
        f32x4 acc[4];
#pragma unroll
        for (int q = 0; q < 4; ++q) acc[q] = (f32x4){0.f, 0.f, 0.f, 0.f};
#pragma unroll
        for (int ks = 0; ks < 4; ++ks)
#pragma unroll
            for (int q = 0; q < 4; ++q) acc[q] = mfma16(af[ks], wf[ks][q], acc[q]);
        if (tk + (int)gridDim.x < ntask) MOE1_OVF_LOAD(tk + (int)gridDim.x);
        __syncthreads();
#pragma unroll
        for (int q = 0; q < 4; ++q) *(LAS f32x4*)(part + ((wave * 4 + q) * 64 + lane) * 4) = acc[q];
        __syncthreads();
        {
            const int fs = tid >> 8, l2 = (tid >> 2) & 63, r = tid & 3;
            float gs = 0.f, us = 0.f;
#pragma unroll
            for (int w2 = 0; w2 < 8; ++w2) { gs += part[((w2 * 4 + fs) * 64 + l2) * 4 + r]; us += part[((w2 * 4 + 2 + fs) * 64 + l2) * 4 + r]; }
            const size_t row = R0 + 4 * (l2 >> 4) + r;
            B.HID()[row * 256 + 32 * fc + 16 * fs + (l2 & 15)] = (bf16)f2bf(siluf_(gs) * us * B.ROWPW()[row]);
        }
    }
#undef MOE1_OVF_LOAD
}
__device__ __forceinline__ void moe2_overflow(const Params& p, const MoeBufs& B, LAS unsigned char* lds) {
    const int tid = fresh_tid(), lane = tid & 63, wave = tid >> 6, r16 = lane & 15, g = lane >> 4;
    const LAS int* tab = (const LAS int*)(lds + TAB_OFF);
    LAS float* part = (LAS float*)lds;
    const int ntask = tab[164] * 8;
    bf16x8 af, wf[8]; size_t R0n = 0;
#define MOE2_OVF_LOAD(tk_) do { const int t_ = (tk_) >> 3, nc_ = (tk_) & 7; int e_ = 0; \
        _Pragma("unroll") for (int k = 1; k < 32; ++k) e_ += (t_ >= tab[132 + k]) ? 1 : 0; \
        R0n = (size_t)MOE_OVF_BASE + (size_t)e_ * 256 + (size_t)(t_ - tab[132 + e_]) * 16; \
        af = *(const bf16x8*)(B.HID() + (R0n + r16) * 256 + wave * 32 + 8 * g); \
        const bf16* W_ = p.WD() + ((size_t)e_ * 1024 + 128 * nc_ + r16) * 256 + wave * 32 + 8 * g; \
        _Pragma("unroll") for (int nt = 0; nt < 8; ++nt) wf[nt] = *(const bf16x8*)(W_ + (size_t)(16 * nt) * 256); } while (0)
    int tk = blockIdx.x;
    if (tk < ntask) MOE2_OVF_LOAD(tk);
    for (; tk < ntask; tk += gridDim.x) {
        const int nc = tk & 7; const size_t R0 = R0n;
        f32x4 v[8];
#pragma unroll
        for (int nt = 0; nt < 8; ++nt) v[nt] = mfma16(af, wf[nt], (f32x4){0.f, 0.f, 0.f, 0.f});
        if (tk + (int)gridDim.x < ntask) MOE2_OVF_LOAD(tk + (int)gridDim.x);
        __syncthreads();
#pragma unroll
        for (int nt = 0; nt < 8; ++nt) *(LAS f32x4*)(part + ((wave * 8 + nt) * 64 + lane) * 4) = v[nt];
        __syncthreads();
#pragma unroll
        for (int q = 0; q < 4; ++q) {
            const int idx = tid + q * NT, nt = idx >> 8, l2 = (idx >> 2) & 63, r = idx & 3;
            float s = 0.f;
#pragma unroll
            for (int w2 = 0; w2 < 8; ++w2) s += part[((w2 * 8 + nt) * 64 + l2) * 4 + r];
            const int info = B.ROWINFO()[R0 + 4 * (l2 >> 4) + r];
            if (info >= 0) B.YPART()[((size_t)(info & 1) * NTOK + (size_t)(info >> 1)) * 1024 + 128 * nc + 16 * nt + (l2 & 15)] = (bf16)f2bf(s);
        }
    }
#undef MOE2_OVF_LOAD
}
__device__ __forceinline__ void moe_spill(const Params& p, const MoeBufs& B, LAS unsigned char* lds) {
    const int tid = fresh_tid(), lane = tid & 63, wave = tid >> 6;
    LAS float* hid_s = (LAS float*)lds;
    const int nsp = (int)__hip_atomic_load(B.ctr + 32, __ATOMIC_RELAXED, __HIP_MEMORY_SCOPE_AGENT);
    for (int si = blockIdx.x; si < nsp; si += gridDim.x) {
        const int info = B.SPILL()[si]; const size_t tg = (size_t)(info >> 1); const int k = info & 1;
        const int e = B.ROUTE()[tg * 4 + k]; const float pw = B.ROUTEP()[tg * 2 + k];
        const float mu = B.STATS()[tg * 2], rstd = B.STATS()[tg * 2 + 1];
        float x1[16];
#pragma unroll
        for (int j = 0; j < 2; ++j) { const int c = 8 * lane + 512 * j; const u32x4 xv = *(const u32x4*)(B.V() + tg * 1024 + c); const unsigned xs[4] = {xv.x, xv.y, xv.z, xv.w};
#pragma unroll
            for (int i = 0; i < 8; ++i) { const float v = (i & 1) ? bf2f(xs[i >> 1] >> 16) : bf2f(xs[i >> 1] & 0xffffu); x1[8 * j + i] = bf2f(f2bf((v - mu) * rstd * p.ln1_g[c + i] + p.ln1_b[c + i])); } }
        __syncthreads();
#pragma unroll 1
        for (int f0 = 32 * wave; f0 < 32 * wave + 32; f0 += 4) {
            float hv[4];
#pragma unroll
            for (int q = 0; q < 4; ++q) { const int f = f0 + q; const bf16* wg = p.WGU() + ((size_t)e * 512 + (f >> 7) * 256 + (f & 127)) * 1024; const bf16* wu = wg + (size_t)128 * 1024;
                float sg = 0.f, su = 0.f;
#pragma unroll
                for (int j = 0; j < 2; ++j) { const u32x4 a = *(const u32x4*)(wg + 8 * lane + 512 * j), b2 = *(const u32x4*)(wu + 8 * lane + 512 * j); const unsigned as[4] = {a.x, a.y, a.z, a.w}, bs[4] = {b2.x, b2.y, b2.z, b2.w};
#pragma unroll
                    for (int i = 0; i < 8; ++i) { const float xa = x1[8 * j + i]; sg = fmaf(xa, (i & 1) ? bf2f(as[i >> 1] >> 16) : bf2f(as[i >> 1] & 0xffffu), sg); su = fmaf(xa, (i & 1) ? bf2f(bs[i >> 1] >> 16) : bf2f(bs[i >> 1] & 0xffffu), su); } }
                sg = wave_sum64(sg); su = wave_sum64(su);
                hv[q] = bf2f(f2bf(siluf_(sg) * su * pw)); }
            if (lane < 4) hid_s[f0 + lane] = lane == 0 ? hv[0] : (lane == 1 ? hv[1] : (lane == 2 ? hv[2] : hv[3]));
        }
        __syncthreads();
        const float h0 = hid_s[4 * lane], h1 = hid_s[4 * lane + 1], h2 = hid_s[4 * lane + 2], h3 = hid_s[4 * lane + 3];
#pragma unroll 1
        for (int n0 = 128 * wave; n0 < 128 * wave + 128; n0 += 8) {
            float s8[8];
#pragma unroll
            for (int q = 0; q < 8; ++q) {
                const u32x2 wv = *(const u32x2*)(p.WD() + ((size_t)e * 1024 + n0 + q) * 256 + 4 * lane);
                s8[q] = h0 * bf2f(wv.x & 0xffffu) + h1 * bf2f(wv.x >> 16) + h2 * bf2f(wv.y & 0xffffu) + h3 * bf2f(wv.y >> 16);
            }
#pragma unroll
            for (int q = 0; q < 8; ++q) s8[q] = wave_sum64(s8[q]);
            if (lane == 0) { u32x4 o; o.x = pk2(s8[0], s8[1]); o.y = pk2(s8[2], s8[3]); o.z = pk2(s8[4], s8[5]); o.w = pk2(s8[6], s8[7]);
                *(u32x4*)(B.YPART() + ((size_t)k * NTOK + tg) * 1024 + n0) = o; }
        }
    }
}
__device__ __forceinline__ void phase_moe1(const Params& p, const MoeBufs& B, LAS unsigned char* lds) {
    moe_tables(B, lds, 2);
    MoeSched S{(const LAS int*)(lds + TAB_OFF), (int)gridDim.x, (int)blockIdx.x, 2};
    pg8::Gemm g{B.XS(), p.WGU(), 0, 0, 1024}; EpiGateUp E{B.HID(), B.ROWPW()};
    RGN_B(22, lds);
    pg8::gemm_phase<EpiGateUp, MoeSched, true, true>(lds, g, S, E);
    RGN_E(22, lds); RGN_B(23, lds);
    moe1_overflow(p, B, lds);
    RGN_E(23, lds);
}
template <class WaitFn>
__device__ __forceinline__ void phase_moe2(const Params& p, const MoeBufs& B, LAS unsigned char* lds, WaitFn wait_prev) {
    moe_tables(B, lds, 4);
    wait_prev();
    MoeSched S{(const LAS int*)(lds + TAB_OFF), (int)gridDim.x, (int)blockIdx.x, 4};
    pg8::Gemm g{B.HID(), p.WD(), 0, 0, B.kdown}; EpiDown E{B.YPART(), B.ROWINFO()};
    RGN_B(24, lds);
    pg8::gemm_phase<EpiDown, MoeSched, true, true>(lds, g, S, E);
    RGN_E(24, lds); RGN_B(25, lds);
    moe2_overflow(p, B, lds);
    moe_spill(p, B, lds);
    RGN_E(25, lds);
}
template <class WaitFn>
__device__ __forceinline__ void phase_ln2(const Params& p, const MoeBufs& B, WaitFn wait_prev) {
    const int tid = fresh_tid(), lane = tid & 63, wave = tid >> 6;
    f32x4 g1[2][2], b1[2][2], g2[2][2], b2[2][2];
#pragma unroll
    for (int j = 0; j < 2; ++j)
#pragma unroll
        for (int hf = 0; hf < 2; ++hf) { const int c = 8 * lane + 512 * j + 4 * hf;
            g1[j][hf] = *(const f32x4*)(p.ln1_g + c); b1[j][hf] = *(const f32x4*)(p.ln1_b + c); g2[j][hf] = *(const f32x4*)(p.ln2_g + c); b2[j][hf] = *(const f32x4*)(p.ln2_b + c); }
    const size_t step = (size_t)gridDim.x * 8;
    u32x4 nx[2], ny0[2], ny1[2]; float nmu = 0.f, nrs = 0.f;
#define LN2_LOAD(tg_) do { nmu = B.STATS()[(tg_) * 2]; nrs = B.STATS()[(tg_) * 2 + 1]; \
        _Pragma("unroll") for (int j = 0; j < 2; ++j) { const int c = 8 * lane + 512 * j; nx[j] = *(const u32x4*)(B.V() + (tg_) * 1024 + c); \
            ny0[j] = *(const u32x4*)(B.YPART() + (tg_) * 1024 + c); ny1[j] = *(const u32x4*)(B.YPART() + ((size_t)NTOK + (tg_)) * 1024 + c); } } while (0)
    size_t tg = (size_t)blockIdx.x * 8 + wave;
    if (tg < NTOK) { nmu = B.STATS()[tg * 2]; nrs = B.STATS()[tg * 2 + 1];
#pragma unroll
        for (int j = 0; j < 2; ++j) nx[j] = *(const u32x4*)(B.V() + tg * 1024 + 8 * lane + 512 * j); }
    asm volatile("" ::: "memory");
    wait_prev();
    if (tg < NTOK) {
#pragma unroll
        for (int j = 0; j < 2; ++j) { const int c = 8 * lane + 512 * j; ny0[j] = *(const u32x4*)(B.YPART() + tg * 1024 + c); ny1[j] = *(const u32x4*)(B.YPART() + ((size_t)NTOK + tg) * 1024 + c); } }
    for (; tg < NTOK; tg += step) {
        const float mu1 = nmu, rstd1 = nrs;
        u32x4 cx[2], cy0[2], cy1[2];
#pragma unroll
        for (int j = 0; j < 2; ++j) { cx[j] = nx[j]; cy0[j] = ny0[j]; cy1[j] = ny1[j]; }
        if (tg + step < NTOK) LN2_LOAD(tg + step);
        asm volatile("" ::: "memory");
        float v[2][8]; float s = 0.f;
#pragma unroll
        for (int j = 0; j < 2; ++j) {
            const unsigned xs[4] = {cx[j].x, cx[j].y, cx[j].z, cx[j].w}, y0s[4] = {cy0[j].x, cy0[j].y, cy0[j].z, cy0[j].w}, y1s[4] = {cy1[j].x, cy1[j].y, cy1[j].z, cy1[j].w};
#pragma unroll
            for (int e = 0; e < 4; ++e) {
                const float ga = g1[j][e >> 1][2 * (e & 1)], gb = g1[j][e >> 1][2 * (e & 1) + 1], ba = b1[j][e >> 1][2 * (e & 1)], bb = b1[j][e >> 1][2 * (e & 1) + 1];
                v[j][2 * e] = ALPHA * ((bf2f(xs[e] & 0xffffu) - mu1) * rstd1 * ga + ba) + bf2f(y0s[e] & 0xffffu) + bf2f(y1s[e] & 0xffffu);
                v[j][2 * e + 1] = ALPHA * ((bf2f(xs[e] >> 16) - mu1) * rstd1 * gb + bb) + bf2f(y0s[e] >> 16) + bf2f(y1s[e] >> 16);
                s += v[j][2 * e] + v[j][2 * e + 1];
            }
        }
        const float mu = wave_sum64(s) * (1.f / 1024.f);
        float qq = 0.f;
#pragma unroll
        for (int j = 0; j < 2; ++j)
#pragma unroll
            for (int e = 0; e < 8; ++e) { v[j][e] -= mu; qq = fmaf(v[j][e], v[j][e], qq); }
        const float rstd = rsqrtf(wave_sum64(qq) * (1.f / 1024.f) + LN_EPS);
#pragma unroll
        for (int j = 0; j < 2; ++j) {
            const int c = 8 * lane + 512 * j;
            f32x4 o0, o1;
#pragma unroll
            for (int e = 0; e < 4; ++e) { o0[e] = v[j][e] * rstd * g2[j][0][e] + b2[j][0][e]; o1[e] = v[j][4 + e] * rstd * g2[j][1][e] + b2[j][1][e]; }
            *(f32x4*)(p.out + tg * 1024 + c) = o0; *(f32x4*)(p.out + tg * 1024 + c + 4) = o1;
        }
    }
#undef LN2_LOAD
}
#ifndef SCAN_VARIANT
#define SCAN_VARIANT 0
#endif
#ifndef BAR_DUP
#define BAR_DUP 0
#endif
#ifndef BAR_DUP_FENCES
#define BAR_DUP_FENCES 3
#endif
#ifndef NA_VARIANT
#define NA_VARIANT 0
#endif
#ifndef P1_VARIANT
#define P1_VARIANT 0
#endif
#ifndef FWD_REP
#define FWD_REP 1
#endif
#ifndef PH_DUP
#define PH_DUP 0
#endif
#ifndef PH_MASK
#define PH_MASK 8191
#endif
#define BAR_LDS_OFF (LDS_BYTES - 64)
struct MegaArgs { Params p; };
#define CAS __attribute__((address_space(4)))
#define GASC __attribute__((address_space(1)))
__device__ __forceinline__ Params load_params(const CAS char* kp) {
    Params p; const CAS unsigned long long* src = (const CAS unsigned long long*)kp;
    const float** pf = (const float**)&p;
#pragma unroll
    for (int i = 0; i < 22; ++i) pf[i] = (const float*)(const GASC float*)src[i];
    static_assert(offsetof(Params, out) == 22 * 8 && offsetof(Params, ws) == 23 * 8 && offsetof(Params, bar) == 24 * 8 && offsetof(Params, kdown) == 25 * 8, "Params layout");
    p.out = (float*)(GASC float*)src[22]; p.ws = (char*)(GASC char*)src[23]; p.bar = (unsigned*)(GASC unsigned*)src[24];
    p.kdown = (int)(src[25] & 0xffffffffu); p.pad0 = 0;
    return p;
}
#define FRESH_P(name) const CAS char* name##_kp = kptr; asm volatile("" : "+s"(name##_kp)); const Params name = load_params(name##_kp)
#define GRID_BAR() do { const CAS char* b_kp = kptr; asm volatile("" : "+s"(b_kp)); XcdBarrier bar; bar.bar = (unsigned*)(GASC unsigned*)(*(const CAS unsigned long long*)(b_kp + offsetof(Params, bar))); bar.x = xb_xcc_id(); \
        bar.st = (volatile LAS unsigned*)(lds + BAR_LDS_OFF); xcd_barrier(bar); if (BAR_DUP) xcd_barrier<BAR_DUP_FENCES>(bar); } while (0)
#define GRID_BAR_ARRIVE() do { const CAS char* b_kp = kptr; asm volatile("" : "+s"(b_kp)); XcdBarrier bar; bar.bar = (unsigned*)(GASC unsigned*)(*(const CAS unsigned long long*)(b_kp + offsetof(Params, bar))); bar.x = xb_xcc_id(); \
        bar.st = (volatile LAS unsigned*)(lds + BAR_LDS_OFF); xcd_barrier_arrive(bar); } while (0)
#define GRID_BAR_WAIT() do { const CAS char* b_kp = kptr; asm volatile("" : "+s"(b_kp)); XcdBarrier bar; bar.bar = (unsigned*)(GASC unsigned*)(*(const CAS unsigned long long*)(b_kp + offsetof(Params, bar))); bar.x = xb_xcc_id(); \
        bar.st = (volatile LAS unsigned*)(lds + BAR_LDS_OFF); xcd_barrier_wait(bar); } while (0)
#ifndef PROBE_SEG
#define PROBE_SEG (-1)
#endif
#define STAMP(n) do { if (PROBE_SEG >= 0 && blockIdx.x == 0 && threadIdx.x == 0) { \
        if ((n) == PROBE_SEG || (PROBE_SEG == 21 && (n) == 10)) ((volatile LAS unsigned*)(lds + BAR_LDS_OFF))[4] = (unsigned)__builtin_amdgcn_s_memrealtime(); \
        if ((n) == PROBE_SEG + 1 || (PROBE_SEG == 20 && (n) == 0)) ((volatile LAS unsigned*)(lds + BAR_LDS_OFF))[6] = (unsigned)__builtin_amdgcn_s_memrealtime(); } } while (0)
__global__ void __launch_bounds__(NT, 2) mega_fwd(MegaArgs) {
    extern __shared__ __attribute__((aligned(16))) unsigned char lds_raw[];
    LAS unsigned char* lds = (LAS unsigned char*)lds_raw;
    const CAS char* kptr = (const CAS char*)__builtin_amdgcn_kernarg_segment_ptr();
    if (threadIdx.x < 16) ((LAS unsigned*)(lds + BAR_LDS_OFF))[threadIdx.x] = 0u;
    __syncthreads();
    if ((PROBE_SEG == 20 || PROBE_SEG == 30) && blockIdx.x == 0 && threadIdx.x == 0) ((volatile LAS unsigned*)(lds + BAR_LDS_OFF))[4] = (unsigned)__builtin_amdgcn_s_memrealtime();
    if (PROBE_SEG == 50 && threadIdx.x == 0) { FRESH_P(pp); const unsigned ts = (unsigned)__builtin_amdgcn_s_memrealtime();
        __hip_atomic_fetch_max(pp.bar + XCD_BAR_WORDS + 10, ts, __ATOMIC_RELAXED, __HIP_MEMORY_SCOPE_AGENT); __hip_atomic_fetch_max(pp.bar + XCD_BAR_WORDS + 11, ~ts, __ATOMIC_RELAXED, __HIP_MEMORY_SCOPE_AGENT); }
    { FRESH_P(p); (void)xcd_barrier_post(p.bar, (volatile LAS unsigned*)(lds + BAR_LDS_OFF)); }
#if PH_MASK & 1
    { FRESH_P(p); phase0(p, lds); }
#endif
#if PH_DUP & 1
    GRID_BAR();
    { FRESH_P(p); const MoeBufs Q{p.ws, (char*)p.out, p.kdown, p.bar + XCD_BAR_WORDS + 16}; phase0(p, lds); phase0_router(p, Q); }
#endif
    GRID_BAR_ARRIVE(); { FRESH_P(p); const MoeBufs Q{p.ws, (char*)p.out, p.kdown, p.bar + XCD_BAR_WORDS + 16}; phase0_router(p, Q); } GRID_BAR_WAIT(); STAMP(0);
#if PH_MASK & 2
#if PH_DUP & 2
    { FRESH_P(p); phase1<P1_VARIANT>(p, lds); }
#else
    { FRESH_P(p); phase1(p, lds); }
#endif
#endif
#if PH_DUP & 2
    GRID_BAR();
    { FRESH_P(p); phase1(p, lds); }
#endif
    GRID_BAR_ARRIVE(); { FRESH_P(p); phase_late_weights(p, IT_WIN, IT_WIN + IT_WG); } GRID_BAR_WAIT(); STAMP(1);
#if PH_MASK & 4
#if PH_DUP & 4
    { FRESH_P(p); phase_na<NA_VARIANT>(p, lds); }
#else
    { FRESH_P(p); phase_na(p, lds); }
#endif
#endif
    { FRESH_P(p); asm volatile("s_waitcnt vmcnt(0)" ::: "memory"); __syncthreads(); if (threadIdx.x == 0) (void)xb_add(p.bar + XCD_BAR_WORDS + 8, 1u); } STAMP(2);
#if PH_DUP & 4
    GRID_BAR();
    { FRESH_P(p); phase_na(p, lds); }
    GRID_BAR();
#endif
#if PH_MASK & 8
    { FRESH_P(p); const DnBufs D{p.ws, (char*)p.out}; phase_dnprep(p, D, lds); }
#endif
#if PH_DUP & 8
    GRID_BAR();
    { FRESH_P(p); const DnBufs D{p.ws, (char*)p.out}; phase_dnprep(p, D, lds); }
    GRID_BAR();
#endif
    GRID_BAR_ARRIVE();
    if ((int)blockIdx.x < 128) GRID_BAR_WAIT();
    STAMP(3);
#if PH_MASK & 16
    {
        FRESH_P(p); const DnBufs D{p.ws, (char*)p.out};
        const int nb = (int)gridDim.x;
        unsigned* counter = p.bar + XCD_BAR_WORDS;
        RGN_B(41, lds);
        if ((int)blockIdx.x >= 128) phase_zgemm(p, lds, nb - 128, (int)blockIdx.x - 128);
#if !DN_CONV_ITEMS
        else if ((fresh_tid() >> 6) >= 4) phase0_moe(p, counter);
#endif
        RGN_E(41, lds); RGN_B(40, lds);
        if ((int)blockIdx.x < 128) phase_dnscan(p, D, lds);
        RGN_E(40, lds);
#if !DN_CONV_ITEMS
        if ((int)blockIdx.x >= 128 || (fresh_tid() >> 6) < 4) phase0_moe(p, counter);
#endif
    }
#endif
    if ((int)blockIdx.x >= 128) GRID_BAR_WAIT();
#if PH_DUP & 16
    GRID_BAR();
    {
        FRESH_P(p); const DnBufs D{p.ws, (char*)p.out};
        const int nb = (int)gridDim.x;
        unsigned* counter = p.bar + XCD_BAR_WORDS;
#if !(PH_DUP & 8192)
        if ((int)blockIdx.x >= 128) phase_zgemm(p, lds, nb - 128, (int)blockIdx.x - 128);
#endif
        if ((int)blockIdx.x >= 128) {} else if ((fresh_tid() >> 6) >= 4) phase0_moe(p, counter);
#if !(PH_DUP & 16384)
        if ((int)blockIdx.x < 128) phase_dnscan<SCAN_VARIANT>(p, D, lds);
#endif
#if !DN_CONV_ITEMS
        if ((int)blockIdx.x >= 128 || (fresh_tid() >> 6) < 4) phase0_moe(p, counter);
#endif
    }
#endif
    GRID_BAR_ARRIVE(); { FRESH_P(p); phase_late_weights(p, IT_WIN + IT_WG, IT_SMALL); } GRID_BAR_WAIT(); STAMP(4);
#if PH_MASK & 32
    { FRESH_P(p); const DnBufs D{p.ws, (char*)p.out}; phase_dnout(p, D); }
#endif
#if PH_DUP & 32
    GRID_BAR();
    { FRESH_P(p); const DnBufs D{p.ws, (char*)p.out}; phase_dnout(p, D); }
#endif
    GRID_BAR_ARRIVE(); STAMP(5);
#if PH_MASK & 64
    { FRESH_P(p); const MixBufs X{p.ws, (char*)p.out}; phase_merge<0>(p, X, lds); }
#endif
    GRID_BAR_WAIT();
#if PH_MASK & 64
    { FRESH_P(p); const MixBufs X{p.ws, (char*)p.out}; phase_merge<1>(p, X, lds); }
#endif
#if PH_DUP & 64
    GRID_BAR();
    { FRESH_P(p); const MixBufs X{p.ws, (char*)p.out}; phase_merge<0>(p, X, lds); phase_merge<1>(p, X, lds); }
#endif
    GRID_BAR_ARRIVE(); STAMP(6);
#if PH_MASK & 128
    { FRESH_P(p); const MixBufs X{p.ws, (char*)p.out}; phase_outproj(p, X, lds, [&]() { GRID_BAR_WAIT(); }); }
#else
    GRID_BAR_WAIT();
#endif
#if PH_DUP & 128
    GRID_BAR();
    { FRESH_P(p); const MixBufs X{p.ws, (char*)p.out}; phase_outproj(p, X, lds, []() {}); }
#endif
    GRID_BAR_ARRIVE(); STAMP(7);
#if PH_MASK & 256
    { FRESH_P(p); const MoeBufs Q{p.ws, (char*)p.out, p.kdown, p.bar + XCD_BAR_WORDS + 16}; phase_ln1(p, Q, lds, [&]() { GRID_BAR_WAIT(); }); }
#endif
#if PH_DUP & 256
    GRID_BAR();
    { FRESH_P(p); const MoeBufs Q{p.ws, (char*)p.out, p.kdown, p.bar + XCD_BAR_WORDS + 16}; phase_ln1(p, Q, lds, []() {}); }
#endif
    GRID_BAR(); STAMP(8);
#if PH_MASK & 1024
    { FRESH_P(p); const MoeBufs Q{p.ws, (char*)p.out, p.kdown, p.bar + XCD_BAR_WORDS + 16}; phase_moe1(p, Q, lds); }
#endif
#if PH_DUP & 1024
    GRID_BAR();
    { FRESH_P(p); const MoeBufs Q{p.ws, (char*)p.out, p.kdown, p.bar + XCD_BAR_WORDS + 16}; phase_moe1(p, Q, lds); }
#endif
    GRID_BAR_ARRIVE(); STAMP(9);
#if PH_MASK & 2048
    { FRESH_P(p); const MoeBufs Q{p.ws, (char*)p.out, p.kdown, p.bar + XCD_BAR_WORDS + 16}; phase_moe2(p, Q, lds, [&]() { GRID_BAR_WAIT(); }); }
#endif
#if PH_DUP & 2048
    GRID_BAR();
    { FRESH_P(p); const MoeBufs Q{p.ws, (char*)p.out, p.kdown, p.bar + XCD_BAR_WORDS + 16}; phase_moe2(p, Q, lds, []() {}); }
#endif
    GRID_BAR_ARRIVE(); STAMP(10);
#if PH_MASK & 4096
    { FRESH_P(p); const MoeBufs Q{p.ws, (char*)p.out, p.kdown, p.bar + XCD_BAR_WORDS + 16}; phase_ln2(p, Q, [&]() { GRID_BAR_WAIT(); }); }
#endif
#if FWD_REP > 1
    GRID_BAR();
    { FRESH_P(p); if (blockIdx.x == 0 && threadIdx.x < 64) __hip_atomic_store(p.bar + XCD_BAR_WORDS + threadIdx.x, 0u, __ATOMIC_RELAXED, __HIP_MEMORY_SCOPE_AGENT); }
    GRID_BAR();
#if PH_MASK & 1
    { FRESH_P(p); const MoeBufs Q{p.ws, (char*)p.out, p.kdown, p.bar + XCD_BAR_WORDS + 16}; phase0(p, lds); phase0_router(p, Q); }
#endif
#if PH_DUP & 1
    GRID_BAR();
    { FRESH_P(p); const MoeBufs Q{p.ws, (char*)p.out, p.kdown, p.bar + XCD_BAR_WORDS + 16}; phase0(p, lds); phase0_router(p, Q); }
#endif
    GRID_BAR();
#if PH_MASK & 2
    { FRESH_P(p); phase1(p, lds); }
#endif
#if PH_DUP & 2
    GRID_BAR();
    { FRESH_P(p); phase1(p, lds); }
#endif
    GRID_BAR();
#if PH_MASK & 4
    { FRESH_P(p); phase_na(p, lds); }
#endif
#if PH_DUP & 4
    GRID_BAR();
    { FRESH_P(p); phase_na(p, lds); }
    GRID_BAR();
#endif
#if PH_MASK & 8
    { FRESH_P(p); const DnBufs D{p.ws, (char*)p.out}; phase_dnprep(p, D, lds); }
#endif
#if PH_DUP & 8
    GRID_BAR();
    { FRESH_P(p); const DnBufs D{p.ws, (char*)p.out}; phase_dnprep(p, D, lds); }
    GRID_BAR();
#endif
    GRID_BAR();
#if PH_MASK & 16
    {
        FRESH_P(p); const DnBufs D{p.ws, (char*)p.out};
        const int nb = (int)gridDim.x;
        unsigned* counter = p.bar + XCD_BAR_WORDS;
        if ((int)blockIdx.x >= 128) phase_zgemm(p, lds, nb - 128, (int)blockIdx.x - 128);
#if !DN_CONV_ITEMS
        else if ((fresh_tid() >> 6) >= 4) phase0_moe(p, counter);
#endif
        if ((int)blockIdx.x < 128) phase_dnscan(p, D, lds);
#if !DN_CONV_ITEMS
        if ((int)blockIdx.x >= 128 || (fresh_tid() >> 6) < 4) phase0_moe(p, counter);
#endif
    }
#endif
#if PH_DUP & 16
    GRID_BAR();
    {
        FRESH_P(p); const DnBufs D{p.ws, (char*)p.out};
        const int nb = (int)gridDim.x;
        unsigned* counter = p.bar + XCD_BAR_WORDS;
#if !(PH_DUP & 8192)
        if ((int)blockIdx.x >= 128) phase_zgemm(p, lds, nb - 128, (int)blockIdx.x - 128);
#endif
        if ((int)blockIdx.x >= 128) {} else if ((fresh_tid() >> 6) >= 4) phase0_moe(p, counter);
#if !(PH_DUP & 16384)
        if ((int)blockIdx.x < 128) phase_dnscan<SCAN_VARIANT>(p, D, lds);
#endif
#if !DN_CONV_ITEMS
        if ((int)blockIdx.x >= 128 || (fresh_tid() >> 6) < 4) phase0_moe(p, counter);
#endif
    }
#endif
    GRID_BAR();
#if PH_MASK & 32
    { FRESH_P(p); const DnBufs D{p.ws, (char*)p.out}; phase_dnout(p, D); }
#endif
#if PH_DUP & 32
    GRID_BAR();
    { FRESH_P(p); const DnBufs D{p.ws, (char*)p.out}; phase_dnout(p, D); }
#endif
    GRID_BAR();
#if PH_MASK & 64
    { FRESH_P(p); const MixBufs X{p.ws, (char*)p.out}; phase_merge<0>(p, X, lds); phase_merge<1>(p, X, lds); }
#endif
#if PH_DUP & 64
    GRID_BAR();
    { FRESH_P(p); const MixBufs X{p.ws, (char*)p.out}; phase_merge<0>(p, X, lds); phase_merge<1>(p, X, lds); }
#endif
    GRID_BAR();
#if PH_MASK & 128
    { FRESH_P(p); const MixBufs X{p.ws, (char*)p.out}; phase_outproj(p, X, lds, []() {}); }
#endif
#if PH_DUP & 128
    GRID_BAR();
    { FRESH_P(p); const MixBufs X{p.ws, (char*)p.out}; phase_outproj(p, X, lds, []() {}); }
#endif
    GRID_BAR();
#if PH_MASK & 256
    { FRESH_P(p); const MoeBufs Q{p.ws, (char*)p.out, p.kdown, p.bar + XCD_BAR_WORDS + 16}; phase_ln1(p, Q, lds, []() {}); }
#endif
#if PH_DUP & 256
    GRID_BAR();
    { FRESH_P(p); const MoeBufs Q{p.ws, (char*)p.out, p.kdown, p.bar + XCD_BAR_WORDS + 16}; phase_ln1(p, Q, lds, []() {}); }
#endif
    GRID_BAR();
#if PH_MASK & 1024
    { FRESH_P(p); const MoeBufs Q{p.ws, (char*)p.out, p.kdown, p.bar + XCD_BAR_WORDS + 16}; phase_moe1(p, Q, lds); }
#endif
#if PH_DUP & 1024
    GRID_BAR();
    { FRESH_P(p); const MoeBufs Q{p.ws, (char*)p.out, p.kdown, p.bar + XCD_BAR_WORDS + 16}; phase_moe1(p, Q, lds); }
#endif
    GRID_BAR();
#if PH_MASK & 2048
    { FRESH_P(p); const MoeBufs Q{p.ws, (char*)p.out, p.kdown, p.bar + XCD_BAR_WORDS + 16}; phase_moe2(p, Q, lds, []() {}); }
#endif
#if PH_DUP & 2048
    GRID_BAR();
    { FRESH_P(p); const MoeBufs Q{p.ws, (char*)p.out, p.kdown, p.bar + XCD_BAR_WORDS + 16}; phase_moe2(p, Q, lds, []() {}); }
#endif
    GRID_BAR();
#if PH_MASK & 4096
    { FRESH_P(p); const MoeBufs Q{p.ws, (char*)p.out, p.kdown, p.bar + XCD_BAR_WORDS + 16}; phase_ln2(p, Q, []() {}); }
#endif
#endif
#if PROBE_RGN >= 0 || PROBE_SEG >= 0
    if (PROBE_SEG == 21 || PROBE_SEG == 30) { if (blockIdx.x == 0 && threadIdx.x == 0) ((volatile LAS unsigned*)(lds + BAR_LDS_OFF))[6] = (unsigned)__builtin_amdgcn_s_memrealtime(); }
    GRID_BAR();
#endif
    if (PROBE_RGN >= 0 && blockIdx.x == PROBE_BLK && threadIdx.x == 0) {
        const unsigned dt = RGN_WORD(lds)[0];
        const unsigned long long t0 = __builtin_amdgcn_s_memrealtime();
        while ((unsigned)(__builtin_amdgcn_s_memrealtime() - t0) < dt) __builtin_amdgcn_s_sleep(8);
    }
#if PROBE_SEG == 10
    GRID_BAR(); STAMP(11);
#endif
    if (PROBE_SEG >= 0 && blockIdx.x == 0 && threadIdx.x == 0) {
        volatile LAS unsigned* st_ = (volatile LAS unsigned*)(lds + BAR_LDS_OFF);
        unsigned dt = st_[6] - st_[4];
        if (PROBE_SEG == 50) { FRESH_P(pp); dt = __hip_atomic_load(pp.bar + XCD_BAR_WORDS + 10, __ATOMIC_RELAXED, __HIP_MEMORY_SCOPE_AGENT) - ~__hip_atomic_load(pp.bar + XCD_BAR_WORDS + 11, __ATOMIC_RELAXED, __HIP_MEMORY_SCOPE_AGENT); }
        const unsigned long long t0 = __builtin_amdgcn_s_memrealtime();
        while ((unsigned)(__builtin_amdgcn_s_memrealtime() - t0) < dt) __builtin_amdgcn_s_sleep(8);
    }
}

#define MB(x) ((size_t)(x) << 20)
extern "C" void kernel_launch(void* const* d_in, const int* in_sizes, int n_in, void* d_out, int out_size, void* d_ws, size_t ws_size, hipStream_t stream) {
    MegaArgs a{};
    Params& p = a.p;
    p.x = (const float*)d_in[0]; p.w_in = (const float*)d_in[1]; p.rpb = (const float*)d_in[2]; p.conv_w = (const float*)d_in[3];
    p.a_log_f = (const float*)d_in[4]; p.a_log_b = (const float*)d_in[5]; p.dtb_f = (const float*)d_in[6]; p.dtb_b = (const float*)d_in[7];
    p.norm_w = (const float*)d_in[8]; p.w_proj_na = (const float*)d_in[9]; p.w_proj_dn = (const float*)d_in[10]; p.w_out = (const float*)d_in[11];
    p.ln1_g = (const float*)d_in[12]; p.ln1_b = (const float*)d_in[13]; p.wrg = (const float*)d_in[14]; p.brg = (const float*)d_in[15];
    p.wre = (const float*)d_in[16]; p.bre = (const float*)d_in[17]; p.wgu = (const float*)d_in[18]; p.wd = (const float*)d_in[19];
    p.ln2_g = (const float*)d_in[20]; p.ln2_b = (const float*)d_in[21];
    p.out = (float*)d_out;
    p.ws = (char*)d_ws; p.bar = (unsigned*)d_ws; p.kdown = 256;

    static int grid = 0;
    if (grid == 0) {
        int dev = 0, cus = 0, per_cu = 0;
        hipGetDevice(&dev);
        hipDeviceGetAttribute(&cus, hipDeviceAttributeMultiprocessorCount, dev);
        hipFuncSetAttribute((const void*)mega_fwd, hipFuncAttributeMaxDynamicSharedMemorySize, LDS_BYTES);
        hipOccupancyMaxActiveBlocksPerMultiprocessor(&per_cu, (const void*)mega_fwd, NT, LDS_BYTES);
        if (per_cu < 1) { fprintf(stderr, "kernel_launch: occupancy query reports %d workgroups per CU\n", per_cu); per_cu = 1; }
        if (per_cu > 1) per_cu = 1;
        grid = cus * per_cu;
        if (grid > 256) grid = 256;
        (void)hipGetLastError();
    }
    hipMemsetAsync(p.bar, 0, (XCD_BAR_WORDS + 64) * sizeof(unsigned), stream);
    hipLaunchKernelGGL(mega_fwd, dim3(grid), dim3(NT), LDS_BYTES, stream, a);
}
```
